# Optimizing an MI355X kernel written in HIP

```python
import math
import jax, jax.numpy as jnp
from jax import lax
import numpy as np

D_MODEL = 2048
BATCH = 2
SEQ = 4096
DEPTH = 1

D_MIX = D_MODEL
D_HYENA = D_MIX // 2
D_GDN = D_MIX - D_HYENA
GDN_HEADS = 8
GDN_HEAD_DIM = D_GDN // GDN_HEADS
GDN_CHUNK = 64
HYENA_SHORT_CONV = 3
GDN_SHORT_CONV = 3
POS_EMB_DIM = 33
FILTER_WIDTH = 64
DECAY_TARGET = 1e-2
FAST_DECAY_PCT = 0.3
SLOW_DECAY_PCT = 1.5
N_GROUPS = 8
EXPERTS_PER_GROUP = 8
N_EXPERTS = N_GROUPS * EXPERTS_PER_GROUP
TOP_K = 2
D_EXPERT = D_MODEL // 4
ROW_BLOCK = 256
EPS = 1e-6
N_PROJ = 3 * D_HYENA + 4 * D_GDN + 4 * GDN_HEADS

kernel_name = 'hybrid_hyena_gdn_hmoe_encoder'


def rms_norm(x, w):
    xf = x.astype(jnp.float32)
    y = xf * lax.rsqrt(jnp.mean(xf * xf, axis=-1, keepdims=True) + EPS)
    return (y * w.astype(jnp.float32)).astype(x.dtype)


def centred_depthwise_conv(x, w):
    K = w.shape[0]
    L = x.shape[1]
    p = K // 2
    xp = jnp.pad(x, ((0, 0), (p, p), (0, 0)))
    y = xp[:, 0:L] * w[0]
    for j in range(1, K):
        y = y + xp[:, j:j + L] * w[j]
    return y


def l2_normalize(x):
    return x * lax.rsqrt(jnp.sum(x * x, axis=-1, keepdims=True) + EPS)


def hyena_implicit_filters(L, w1, b1, w2, b2, w3, b3, w4, freq):
    f32 = jnp.float32
    t = jnp.linspace(0.0, 1.0, L, dtype=f32)[:, None]
    bands = (POS_EMB_DIM - 1) // 2
    omega = (2.0 * math.pi / L) * jnp.arange(L, dtype=f32)
    fb = jnp.linspace(1e-4, bands - 1, bands, dtype=f32)
    ang = omega[:, None] * fb[None, :]
    z = jnp.concatenate([t, jnp.cos(ang), -jnp.sin(ang)], axis=-1)
    fr = freq.astype(f32)
    h = jnp.sin(fr * (z @ w1.astype(f32) + b1.astype(f32)))
    h = jnp.sin(fr * (h @ w2.astype(f32) + b2.astype(f32)))
    h = jnp.sin(fr * (h @ w3.astype(f32) + b3.astype(f32)))
    h = h @ w4.astype(f32)
    max_decay = math.log(DECAY_TARGET) / FAST_DECAY_PCT
    min_decay = math.log(DECAY_TARGET) / SLOW_DECAY_PCT
    deltas = jnp.abs(jnp.linspace(min_decay, max_decay, D_HYENA, dtype=f32))
    window = jnp.exp(-t * deltas[None, :])
    h = h.reshape(L, 2, D_HYENA) * window[:, None, :]
    return h[:, 0], h[:, 1]


def hyena_mixer(p, conv_w, conv_b, fw1, fb1, fw2, fb2, fw3, fb3, fw4, freq, skip, norm_w):
    f32 = jnp.float32
    B, L, _ = p.shape
    pc = centred_depthwise_conv(p, conv_w) + conv_b
    x0, x1, v = jnp.split(pc.astype(f32), 3, axis=-1)
    h_fwd, h_bwd = hyena_implicit_filters(L, fw1, fb1, fw2, fb2, fw3, fb3, fw4, freq)
    n = 2 * L
    vg = v * x1
    v_f = jnp.fft.rfft(vg, n=n, axis=1)
    h_f = jnp.fft.rfft(h_fwd, n=n, axis=0) + jnp.conj(jnp.fft.rfft(h_bwd, n=n, axis=0))
    y = jnp.fft.irfft(v_f * h_f[None], n=n, axis=1)[:, :L] + vg * skip.astype(f32)
    y = y * x0
    return rms_norm(y, norm_w).astype(p.dtype)


def chunked_gated_delta(q, k, v, g, beta):
    f32 = jnp.float32
    B, L, H, DK = q.shape
    DV = v.shape[-1]
    C = GDN_CHUNK
    N = L // C

    def chunks(t):
        return jnp.moveaxis(t.reshape(B, N, C, H, -1), 3, 1)

    qc = chunks(q) * (DK ** -0.5)
    kc = chunks(k)
    vc = chunks(v)
    bc = jnp.moveaxis(beta.reshape(B, N, C, H), 3, 1)
    gc = jnp.cumsum(jnp.moveaxis(g.reshape(B, N, C, H), 3, 1), axis=-1)
    incl = jnp.tril(jnp.ones((C, C), dtype=bool))
    strict = jnp.tril(jnp.ones((C, C), dtype=bool), -1)
    diff = gc[..., :, None] - gc[..., None, :]
    decay = jnp.where(incl, jnp.exp(jnp.where(incl, diff, 0.0)), 0.0)
    kb = kc * bc[..., None]
    a = jnp.where(strict, jnp.einsum('bhnid,bhnjd->bhnij', kb, kc) * decay, 0.0)
    eye = jnp.eye(C, dtype=f32)
    t_inv = lax.linalg.triangular_solve(eye + a, jnp.broadcast_to(eye, a.shape),
                                        left_side=True, lower=True, unit_diagonal=True)
    w = jnp.einsum('bhnij,bhnjd->bhnid', t_inv, kb * jnp.exp(gc)[..., None])
    u = jnp.einsum('bhnij,bhnjd->bhnid', t_inv, vc * bc[..., None])
    qk = jnp.where(incl, jnp.einsum('bhnid,bhnjd->bhnij', qc, kc) * decay, 0.0)
    q_dec = qc * jnp.exp(gc)[..., None]
    k_dec = kc * jnp.exp(gc[..., -1:] - gc)[..., None]
    chunk_decay = jnp.exp(gc[..., -1])

    def step(state, inp):
        qk_n, w_n, u_n, qd_n, kd_n, cd_n = inp
        v_new = u_n - jnp.einsum('bhcd,bhde->bhce', w_n, state)
        out = (jnp.einsum('bhcd,bhde->bhce', qd_n, state)
               + jnp.einsum('bhij,bhje->bhie', qk_n, v_new))
        state = state * cd_n[..., None, None] + jnp.einsum('bhcd,bhce->bhde', kd_n, v_new)
        return state, out

    xs = (jnp.moveaxis(qk, 2, 0), jnp.moveaxis(w, 2, 0), jnp.moveaxis(u, 2, 0),
          jnp.moveaxis(q_dec, 2, 0), jnp.moveaxis(k_dec, 2, 0), jnp.moveaxis(chunk_decay, 2, 0))
    s0 = jnp.zeros((B, H, DK, DV), f32)
    _, o = lax.scan(step, s0, xs)
    return o.transpose(1, 0, 3, 2, 4).reshape(B, L, H, DV)


def gdn_mixer(p, conv_w, a_log_f, a_log_b, dt_bias_f, dt_bias_b, norm_w):
    f32 = jnp.float32
    B, L, _ = p.shape
    H, Dh = GDN_HEADS, GDN_HEAD_DIM
    qkv = jax.nn.silu(centred_depthwise_conv(p[..., :3 * D_GDN], conv_w)).astype(f32)
    q, k, v = jnp.split(qkv, 3, axis=-1)
    q = l2_normalize(q.reshape(B, L, H, Dh))
    k = l2_normalize(k.reshape(B, L, H, Dh))
    v = v.reshape(B, L, H, Dh)
    z = p[..., 3 * D_GDN:4 * D_GDN].reshape(B, L, H, Dh).astype(f32)
    beta_f, beta_b, a_f, a_b = jnp.split(p[..., 4 * D_GDN:].astype(f32), 4, axis=-1)

    def log_decay(a, a_log, dt_bias):
        return -jnp.exp(a_log.astype(f32)) * jax.nn.softplus(a + dt_bias.astype(f32))

    def rev(t):
        return jnp.flip(t, axis=1)

    o_f = chunked_gated_delta(q, k, v, log_decay(a_f, a_log_f, dt_bias_f), jax.nn.sigmoid(beta_f))
    o_b = rev(chunked_gated_delta(rev(q), rev(k), rev(v),
                                  rev(log_decay(a_b, a_log_b, dt_bias_b)),
                                  rev(jax.nn.sigmoid(beta_b))))
    o = o_f + o_b
    o = (o * lax.rsqrt(jnp.mean(o * o, axis=-1, keepdims=True) + EPS)
         * norm_w.astype(f32) * jax.nn.silu(z))
    return o.reshape(B, L, D_GDN).astype(p.dtype)


def hierarchical_moe(u, rg_w, rg_b, re_w, re_b, w1, w3, w2):
    f32 = jnp.float32
    B, L, D = u.shape
    T = B * L
    xt = u.reshape(T, D)
    xf = xt.astype(f32)
    grp_logits = xf @ rg_w.astype(f32) + rg_b.astype(f32)
    grp_prob = jax.nn.softmax(grp_logits, axis=-1)
    grp_idx = jnp.argmax(grp_logits, axis=-1)
    grp_gate = jnp.take_along_axis(grp_prob, grp_idx[:, None], axis=-1)[:, 0]
    exp_logits = (xf @ re_w.astype(f32) + re_b.astype(f32)).reshape(T, N_GROUPS, EXPERTS_PER_GROUP)
    local_logits = jnp.take_along_axis(exp_logits, grp_idx[:, None, None], axis=1)[:, 0]
    local_prob = jax.nn.softmax(local_logits, axis=-1)
    top_p, top_i = lax.top_k(local_prob, TOP_K)
    top_p = top_p / jnp.sum(top_p, axis=-1, keepdims=True)
    expert_id = (grp_idx[:, None] * EXPERTS_PER_GROUP + top_i).astype(jnp.int32)
    gate = grp_gate[:, None] * top_p

    A = T * TOP_K
    flat_e = expert_id.reshape(A)
    flat_t = jnp.arange(A, dtype=jnp.int32) // TOP_K
    flat_g = gate.reshape(A)
    order = jnp.argsort(flat_e)
    se = flat_e[order]
    counts = jnp.bincount(flat_e, length=N_EXPERTS)
    padded = (counts + ROW_BLOCK - 1) // ROW_BLOCK * ROW_BLOCK
    pad_end = jnp.cumsum(padded)
    pad_start = pad_end - padded
    start = jnp.cumsum(counts) - counts
    dest = pad_start[se] + jnp.arange(A, dtype=jnp.int32) - start[se]
    n_blocks = -(-(A + N_EXPERTS * (ROW_BLOCK - 1)) // ROW_BLOCK)
    P = n_blocks * ROW_BLOCK
    slot_tok = jnp.full((P,), T, dtype=jnp.int32).at[dest].set(flat_t[order])
    slot_gate = jnp.zeros((P,), f32).at[dest].set(flat_g[order])
    block_start = jnp.arange(n_blocks, dtype=jnp.int32) * ROW_BLOCK
    block_expert = jnp.minimum(jnp.searchsorted(pad_end, block_start, side='right'), N_EXPERTS - 1)

    x_pad = jnp.concatenate([xt, jnp.zeros((1, D), xt.dtype)], axis=0)
    xb = x_pad[slot_tok].reshape(n_blocks, ROW_BLOCK, D)

    def run_block(args):
        xblk, e = args
        h = jax.nn.silu(xblk @ w1[e]) * (xblk @ w3[e])
        return h @ w2[e]

    yb = lax.map(run_block, (xb, block_expert)).reshape(P, D)
    y = jax.ops.segment_sum(yb * slot_gate[:, None].astype(yb.dtype), slot_tok, num_segments=T + 1)[:T]
    return y.reshape(B, L, D).astype(u.dtype)


def setup_inputs(seed: int = 0) -> dict:
    key = jax.random.key(seed)
    ks = jax.random.split(key, 32)
    f32 = jnp.float32

    def nrm(k, shape, s):
        return s * jax.random.normal(k, shape, f32)

    def gain(k, n):
        return 1.0 + 0.02 * jax.random.normal(k, (DEPTH, n), f32)

    def dt_bias(k):
        dt = jnp.exp(jax.random.uniform(k, (DEPTH, GDN_HEADS), f32, math.log(1e-3), math.log(1e-1)))
        return dt + jnp.log(-jnp.expm1(-dt))

    return {
        'x': jax.random.normal(ks[0], (BATCH, SEQ, D_MODEL), f32),
        'norm1_w': gain(ks[1], D_MODEL),
        'w_in': nrm(ks[2], (DEPTH, D_MODEL, N_PROJ), D_MODEL ** -0.5),
        'hy_conv_w': nrm(ks[3], (DEPTH, HYENA_SHORT_CONV, 3 * D_HYENA), HYENA_SHORT_CONV ** -0.5),
        'hy_conv_b': nrm(ks[4], (DEPTH, 3 * D_HYENA), 0.02),
        'hy_filt_w1': nrm(ks[5], (DEPTH, POS_EMB_DIM, FILTER_WIDTH), POS_EMB_DIM ** -0.5),
        'hy_filt_b1': nrm(ks[6], (DEPTH, FILTER_WIDTH), 0.1),
        'hy_filt_w2': nrm(ks[7], (DEPTH, FILTER_WIDTH, FILTER_WIDTH), FILTER_WIDTH ** -0.5),
        'hy_filt_b2': nrm(ks[8], (DEPTH, FILTER_WIDTH), 0.1),
        'hy_filt_w3': nrm(ks[9], (DEPTH, FILTER_WIDTH, FILTER_WIDTH), FILTER_WIDTH ** -0.5),
        'hy_filt_b3': nrm(ks[10], (DEPTH, FILTER_WIDTH), 0.1),
        'hy_filt_w4': nrm(ks[11], (DEPTH, FILTER_WIDTH, 2 * D_HYENA), FILTER_WIDTH ** -0.5),
        'hy_sin_freq': gain(ks[12], FILTER_WIDTH),
        'hy_skip': nrm(ks[13], (DEPTH, D_HYENA), 1.0),
        'hy_norm_w': gain(ks[14], D_HYENA),
        'gdn_conv_w': nrm(ks[15], (DEPTH, GDN_SHORT_CONV, 3 * D_GDN), GDN_SHORT_CONV ** -0.5),
        'gdn_a_log_f': jnp.log(jax.random.uniform(ks[16], (DEPTH, GDN_HEADS), f32, 1.0, 16.0)),
        'gdn_a_log_b': jnp.log(jax.random.uniform(ks[17], (DEPTH, GDN_HEADS), f32, 1.0, 16.0)),
        'gdn_dt_bias_f': dt_bias(ks[18]),
        'gdn_dt_bias_b': dt_bias(ks[19]),
        'gdn_norm_w': gain(ks[20], GDN_HEAD_DIM),
        'w_out': nrm(ks[21], (DEPTH, D_MIX, D_MODEL), D_MIX ** -0.5),
        'norm2_w': gain(ks[22], D_MODEL),
        'router_group_w': nrm(ks[23], (DEPTH, D_MODEL, N_GROUPS), D_MODEL ** -0.5),
        'router_group_b': nrm(ks[24], (DEPTH, N_GROUPS), 0.01),
        'router_expert_w': nrm(ks[25], (DEPTH, D_MODEL, N_EXPERTS), D_MODEL ** -0.5),
        'router_expert_b': nrm(ks[26], (DEPTH, N_EXPERTS), 0.01),
        'exp_w1': nrm(ks[27], (DEPTH, N_EXPERTS, D_MODEL, D_EXPERT), D_MODEL ** -0.5),
        'exp_w3': nrm(ks[28], (DEPTH, N_EXPERTS, D_MODEL, D_EXPERT), D_MODEL ** -0.5),
        'exp_w2': nrm(ks[29], (DEPTH, N_EXPERTS, D_EXPERT, D_MODEL), D_EXPERT ** -0.5),
        'final_norm_w': 1.0 + 0.02 * jax.random.normal(ks[30], (D_MODEL,), f32),
    }


def reference(x, norm1_w, w_in, hy_conv_w, hy_conv_b, hy_filt_w1, hy_filt_b1, hy_filt_w2, hy_filt_b2,
              hy_filt_w3, hy_filt_b3, hy_filt_w4, hy_sin_freq, hy_skip, hy_norm_w, gdn_conv_w,
              gdn_a_log_f, gdn_a_log_b, gdn_dt_bias_f, gdn_dt_bias_b, gdn_norm_w, w_out, norm2_w,
              router_group_w, router_group_b, router_expert_w, router_expert_b, exp_w1, exp_w3, exp_w2,
              final_norm_w):
    for l in range(DEPTH):
        h = rms_norm(x, norm1_w[l])
        p = h @ w_in[l]
        y_hy = hyena_mixer(p[..., :3 * D_HYENA], hy_conv_w[l], hy_conv_b[l],
                           hy_filt_w1[l], hy_filt_b1[l], hy_filt_w2[l], hy_filt_b2[l],
                           hy_filt_w3[l], hy_filt_b3[l], hy_filt_w4[l], hy_sin_freq[l],
                           hy_skip[l], hy_norm_w[l])
        y_gd = gdn_mixer(p[..., 3 * D_HYENA:], gdn_conv_w[l], gdn_a_log_f[l], gdn_a_log_b[l],
                         gdn_dt_bias_f[l], gdn_dt_bias_b[l], gdn_norm_w[l])
        x = x + jnp.concatenate([y_hy, y_gd], axis=-1) @ w_out[l]
        x = x + hierarchical_moe(rms_norm(x, norm2_w[l]), router_group_w[l], router_group_b[l],
                                 router_expert_w[l], router_expert_b[l],
                                 exp_w1[l], exp_w3[l], exp_w2[l])
    return rms_norm(x, final_norm_w)
```

```cpp
#include <hip/hip_runtime.h>
#include <cstdio>
#include <cstdint>
#include <cmath>

constexpr int BATCH = 2, LSEQ = 4096, DM = 2048, T = BATCH * LSEQ;
constexpr int DHY = 1024, DGD = 1024, NH = 8, HD = 128;
constexpr int NPROJ = 3 * DHY + 4 * DGD + 4 * NH;
constexpr int GOFF = 3 * DHY;
constexpr int NG = 8, EPG = 8, NE = 64, DE = 512;
constexpr int RB = 256, PMAX = 32768, NBLK_MAX = 128;
constexpr float EPS = 1e-6f;

constexpr size_t MiB = 1u << 20;
constexpr size_t WS_CTL = 0;
constexpr size_t WS_SMALL = 2 * MiB;
constexpr size_t WS_H = 16 * MiB;
constexpr size_t WS_P = 80 * MiB;
constexpr size_t WS_KK = 320 * MiB;
constexpr size_t WS_X0 = 352 * MiB, WS_VG = 384 * MiB, WS_YH = 416 * MiB;
constexpr size_t WS_Q = 448 * MiB, WS_K = 480 * MiB, WS_V = 512 * MiB, WS_OF = 544 * MiB, WS_OB = 576 * MiB;
constexpr size_t WS_A2 = 608 * MiB, WS_X1 = 672 * MiB, WS_U = 736 * MiB, WS_HH = 802 * MiB;
constexpr size_t WS_Y = 16 * MiB;
constexpr size_t SM_LOGITS = 0;
constexpr size_t SM_GB = SM_LOGITS + (size_t)T * 72 * 4;
constexpr size_t SM_EID = SM_GB + (size_t)4 * T * 8 * 4;
constexpr size_t SM_GATE = SM_EID + (size_t)T * 2 * 4;
constexpr size_t SM_POS = SM_GATE + (size_t)T * 2 * 4;
constexpr size_t SM_TSLOT = SM_POS + (size_t)T * 2 * 4;
constexpr size_t SM_SLOTTOK = SM_TSLOT + (size_t)T * 2 * 4;
constexpr size_t SM_BLKEXP = SM_SLOTTOK + (size_t)PMAX * 4;
constexpr size_t SM_PADSTART = SM_BLKEXP + NBLK_MAX * 4;
constexpr size_t SM_NBLK = SM_PADSTART + NE * 4;

__device__ __forceinline__ float wave_sum(float v) {
#pragma unroll
    for (int o = 1; o < 64; o <<= 1) v += __shfl_xor(v, o);
    return v;
}
__device__ __forceinline__ float silu_f(float x) { return x / (1.f + expf(-x)); }
__device__ __forceinline__ float sigmoid_f(float x) { return 1.f / (1.f + expf(-x)); }
__device__ __forceinline__ float softplus_f(float x) { return fmaxf(x, 0.f) + log1pf(expf(-fabsf(x))); }

__global__ void k_rmsnorm(const float* __restrict__ x, const float* __restrict__ w, float* __restrict__ out, int D, int ldo, int rows) {
    const int row = blockIdx.x * 4 + (threadIdx.x >> 6), lane = threadIdx.x & 63;
    if (row >= rows) return;
    const float* xr = x + (size_t)row * D;
    float s = 0.f;
    for (int i = lane; i < D; i += 64) { float v = xr[i]; s += v * v; }
    s = wave_sum(s);
    const float r = rsqrtf(s / D + EPS);
    for (int i = lane; i < D; i += 64) out[(size_t)row * ldo + i] = xr[i] * r * w[i];
}

template <int MODE>
__global__ void __launch_bounds__(256) k_sgemm(const float* __restrict__ A, int lda, const int* __restrict__ rowidx,
                                               const float* __restrict__ B, int ldb, float* __restrict__ C, int ldc,
                                               int M, int N, int K, const float* __restrict__ R,
                                               const int* __restrict__ blk_expert, size_t strideB, const int* __restrict__ nblk) {
    __shared__ float As[16][64 + 4];
    __shared__ float Bs[16][64 + 4];
    const int tm = blockIdx.y * 64, tn = blockIdx.x * 64;
    if (nblk && (tm / RB) >= *nblk) return;
    if (blk_expert) B += (size_t)blk_expert[tm / RB] * strideB;
    const int tid = threadIdx.x, tx = tid & 15, ty = tid >> 4;
    float acc[4][4];
#pragma unroll
    for (int i = 0; i < 4; ++i)
#pragma unroll
        for (int j = 0; j < 4; ++j) acc[i][j] = 0.f;
    const int ar = tid >> 2, ak = (tid & 3) * 4;
    int arow = tm + ar; const bool arow_ok = arow < M;
    if (arow_ok && rowidx) arow = rowidx[arow];
    const float* Ap = A + (size_t)(arow_ok ? arow : 0) * lda;
    const int bk = tid >> 4, bn = (tid & 15) * 4;
    for (int k0 = 0; k0 < K; k0 += 16) {
#pragma unroll
        for (int j = 0; j < 4; ++j) { const int kk = k0 + ak + j; As[ak + j][ar] = (arow_ok && kk < K) ? Ap[kk] : 0.f; }
#pragma unroll
        for (int j = 0; j < 4; ++j) { const int nn = tn + bn + j, kk = k0 + bk; Bs[bk][bn + j] = (nn < N && kk < K) ? B[(size_t)kk * ldb + nn] : 0.f; }
        __syncthreads();
#pragma unroll
        for (int kk = 0; kk < 16; ++kk) {
            float a[4], b[4];
#pragma unroll
            for (int i = 0; i < 4; ++i) a[i] = As[kk][ty * 4 + i];
#pragma unroll
            for (int j = 0; j < 4; ++j) b[j] = Bs[kk][tx * 4 + j];
#pragma unroll
            for (int i = 0; i < 4; ++i)
#pragma unroll
                for (int j = 0; j < 4; ++j) acc[i][j] = fmaf(a[i], b[j], acc[i][j]);
        }
        __syncthreads();
    }
#pragma unroll
    for (int i = 0; i < 4; ++i) {
        const int r = tm + ty * 4 + i; if (r >= M) continue;
#pragma unroll
        for (int j = 0; j < 4; ++j) {
            const int c = tn + tx * 4 + j; if (c >= N) continue;
            const size_t o = (size_t)r * ldc + c;
            float v = acc[i][j];
            if (MODE == 1) v += R[o];
            if (MODE == 2) v = silu_f(C[o]) * v;
            C[o] = v;
        }
    }
}

__global__ void __launch_bounds__(256) k_hy_filter(const float* __restrict__ w1, const float* __restrict__ b1, const float* __restrict__ w2, const float* __restrict__ b2,
                                                   const float* __restrict__ w3, const float* __restrict__ b3, const float* __restrict__ w4, const float* __restrict__ freq,
                                                   float* __restrict__ KK) {
    __shared__ float z[33], ha[64], hb[64];
    const int l = blockIdx.x, tid = threadIdx.x;
    const float t = (float)l / (float)(LSEQ - 1);
    if (tid == 0) z[0] = t;
    if (tid < 16) {
        const float omega = (2.0f * 3.14159265358979323846f / (float)LSEQ) * (float)l;
        const float fb = 1e-4f + (float)tid * ((15.0f - 1e-4f) / 15.0f);
        const float ang = omega * fb;
        z[1 + tid] = cosf(ang); z[17 + tid] = -sinf(ang);
    }
    __syncthreads();
    if (tid < 64) { float s = b1[tid]; for (int i = 0; i < 33; ++i) s += z[i] * w1[i * 64 + tid]; ha[tid] = sinf(freq[tid] * s); }
    __syncthreads();
    if (tid < 64) { float s = b2[tid]; for (int i = 0; i < 64; ++i) s += ha[i] * w2[i * 64 + tid]; hb[tid] = sinf(freq[tid] * s); }
    __syncthreads();
    if (tid < 64) { float s = b3[tid]; for (int i = 0; i < 64; ++i) s += hb[i] * w3[i * 64 + tid]; ha[tid] = sinf(freq[tid] * s); }
    __syncthreads();
    const float max_decay = logf(1e-2f) / 0.3f, min_decay = logf(1e-2f) / 1.5f;
    for (int c = tid; c < DHY; c += 256) {
        float sf = 0.f, sb = 0.f;
        for (int i = 0; i < 64; ++i) { sf += ha[i] * w4[i * 2048 + c]; sb += ha[i] * w4[i * 2048 + 1024 + c]; }
        const float delta = fabsf(min_decay + (float)c * ((max_decay - min_decay) / (float)(DHY - 1)));
        const float win = expf(-t * delta);
        sf *= win; sb *= win;
        if (l == 0) KK[(size_t)4095 * DHY + c] = sf + sb;
        else { KK[(size_t)(4095 + l) * DHY + c] = sf; KK[(size_t)(4095 - l) * DHY + c] = sb; }
    }
}
__global__ void k_hy_pre(const float* __restrict__ P, const float* __restrict__ cw, const float* __restrict__ cb, float* __restrict__ X0, float* __restrict__ VG) {
    const size_t i = (size_t)blockIdx.x * 256 + threadIdx.x;
    const int c = (int)(i & 1023), tok = (int)(i >> 10), l = tok & (LSEQ - 1);
    float r[3];
#pragma unroll
    for (int part = 0; part < 3; ++part) {
        const int ch = part * 1024 + c;
        float s = cb[ch] + cw[1 * 3072 + ch] * P[(size_t)tok * NPROJ + ch];
        if (l > 0) s += cw[0 * 3072 + ch] * P[(size_t)(tok - 1) * NPROJ + ch];
        if (l < LSEQ - 1) s += cw[2 * 3072 + ch] * P[(size_t)(tok + 1) * NPROJ + ch];
        r[part] = s;
    }
    X0[i] = r[0]; VG[i] = r[2] * r[1];
}
__global__ void __launch_bounds__(256) k_hy_conv(const float* __restrict__ KK, const float* __restrict__ VG, const float* __restrict__ X0, const float* __restrict__ skip, float* __restrict__ YH) {
    const int c = blockIdx.x * 256 + threadIdx.x;
    const int t0 = blockIdx.y * 8, b = blockIdx.z;
    float acc[8];
#pragma unroll
    for (int j = 0; j < 8; ++j) acc[j] = 0.f;
    float kk[8];
#pragma unroll
    for (int j = 0; j < 8; ++j) kk[j] = KK[(size_t)(t0 + j + 4095) * DHY + c];
    const float* vg = VG + (size_t)b * LSEQ * DHY + c;
    for (int s = 0; s < LSEQ; s += 8) {
#pragma unroll
        for (int u = 0; u < 8; ++u) {
            const float v = vg[(size_t)(s + u) * DHY];
#pragma unroll
            for (int j = 0; j < 8; ++j) acc[j] = fmaf(kk[(j - u) & 7], v, acc[j]);
            const int nl = t0 - (s + u + 1) + 4095;
            kk[(7 - u) & 7] = (nl >= 0) ? KK[(size_t)nl * DHY + c] : 0.f;
        }
    }
#pragma unroll
    for (int j = 0; j < 8; ++j) {
        const size_t o = ((size_t)b * LSEQ + t0 + j) * DHY + c;
        YH[o] = (acc[j] + VG[o] * skip[c]) * X0[o];
    }
}

__global__ void __launch_bounds__(256) k_gdn_pre(const float* __restrict__ P, const float* __restrict__ cw, const float* __restrict__ alf, const float* __restrict__ alb,
                                                 const float* __restrict__ dtf, const float* __restrict__ dtb, float* __restrict__ Q, float* __restrict__ Kk, float* __restrict__ V, float* __restrict__ GB) {
    const int w = blockIdx.x * 4 + (threadIdx.x >> 6), lane = threadIdx.x & 63;
    const int tok = w >> 3, h = w & 7, l = tok & (LSEQ - 1);
    float r[3][2];
#pragma unroll
    for (int part = 0; part < 3; ++part)
#pragma unroll
        for (int e = 0; e < 2; ++e) {
            const int ch = part * 1024 + h * 128 + lane * 2 + e;
            float s = cw[1 * 3072 + ch] * P[(size_t)tok * NPROJ + GOFF + ch];
            if (l > 0) s += cw[0 * 3072 + ch] * P[(size_t)(tok - 1) * NPROJ + GOFF + ch];
            if (l < LSEQ - 1) s += cw[2 * 3072 + ch] * P[(size_t)(tok + 1) * NPROJ + GOFF + ch];
            r[part][e] = silu_f(s);
        }
    const float qs = rsqrtf(wave_sum(r[0][0] * r[0][0] + r[0][1] * r[0][1]) + EPS);
    const float ks = rsqrtf(wave_sum(r[1][0] * r[1][0] + r[1][1] * r[1][1]) + EPS);
    const size_t o = (size_t)tok * DGD + h * 128 + lane * 2;
    Q[o] = r[0][0] * qs; Q[o + 1] = r[0][1] * qs;
    Kk[o] = r[1][0] * ks; Kk[o + 1] = r[1][1] * ks;
    V[o] = r[2][0]; V[o + 1] = r[2][1];
    if (lane == 0) {
        const float* pr = P + (size_t)tok * NPROJ + GOFF + 4096;
        const float bf = pr[h], bb = pr[8 + h], af = pr[16 + h], ab = pr[24 + h];
        GB[(size_t)0 * T * 8 + tok * 8 + h] = -expf(alf[h]) * softplus_f(af + dtf[h]);
        GB[(size_t)1 * T * 8 + tok * 8 + h] = -expf(alb[h]) * softplus_f(ab + dtb[h]);
        GB[(size_t)2 * T * 8 + tok * 8 + h] = sigmoid_f(bf);
        GB[(size_t)3 * T * 8 + tok * 8 + h] = sigmoid_f(bb);
    }
}
__global__ void __launch_bounds__(128) k_gdn_seq(const float* __restrict__ Q, const float* __restrict__ Kk, const float* __restrict__ V, const float* __restrict__ GB,
                                                 float* __restrict__ OF, float* __restrict__ OB) {
    __shared__ float ks[2][128], qs[2][128];
    const int dir = blockIdx.x & 1, h = (blockIdx.x >> 1) & 7, b = blockIdx.x >> 4, dv = threadIdx.x;
    const float* G = GB + (size_t)dir * T * 8; const float* Bt = GB + (size_t)(2 + dir) * T * 8;
    float* O = dir ? OB : OF;
    float S[128];
#pragma unroll
    for (int i = 0; i < 128; ++i) S[i] = 0.f;
    const float qscale = 0.08838834764831845f;
    for (int step = 0; step < LSEQ; ++step) {
        const int l = dir ? (LSEQ - 1 - step) : step, tok = b * LSEQ + l, buf = step & 1;
        const size_t o = (size_t)tok * DGD + h * 128;
        ks[buf][dv] = Kk[o + dv]; qs[buf][dv] = Q[o + dv] * qscale;
        const float v = V[o + dv], a = expf(G[tok * 8 + h]), bt = Bt[tok * 8 + h];
        __syncthreads();
        float r = 0.f;
#pragma unroll
        for (int i = 0; i < 128; ++i) { S[i] *= a; r = fmaf(S[i], ks[buf][i], r); }
        const float vn = bt * (v - r);
        float ov = 0.f;
#pragma unroll
        for (int i = 0; i < 128; ++i) { S[i] = fmaf(ks[buf][i], vn, S[i]); ov = fmaf(S[i], qs[buf][i], ov); }
        O[o + dv] = ov;
    }
}
__global__ void __launch_bounds__(256) k_gdn_post(const float* __restrict__ OF, const float* __restrict__ OB, const float* __restrict__ P, const float* __restrict__ nw, float* __restrict__ A2) {
    const int w = blockIdx.x * 4 + (threadIdx.x >> 6), lane = threadIdx.x & 63;
    const int tok = w >> 3, h = w & 7;
    const size_t o = (size_t)tok * DGD + h * 128 + lane * 2;
    const float o0 = OF[o] + OB[o], o1 = OF[o + 1] + OB[o + 1];
    const float r = rsqrtf(wave_sum(o0 * o0 + o1 * o1) / 128.f + EPS);
    const float* z = P + (size_t)tok * NPROJ + GOFF + 3072 + h * 128 + lane * 2;
    A2[(size_t)tok * DM + 1024 + h * 128 + lane * 2] = o0 * r * nw[lane * 2] * silu_f(z[0]);
    A2[(size_t)tok * DM + 1024 + h * 128 + lane * 2 + 1] = o1 * r * nw[lane * 2 + 1] * silu_f(z[1]);
}

__global__ void k_route(const float* __restrict__ logits, const float* __restrict__ gbias, const float* __restrict__ ebias, int* __restrict__ eid, float* __restrict__ gate, int* __restrict__ pos, int* __restrict__ cnt) {
    const int t = blockIdx.x * 256 + threadIdx.x; if (t >= T) return;
    const float* lg = logits + (size_t)t * 72;
    float g[8]; int gi = 0; float gm = -INFINITY;
#pragma unroll
    for (int i = 0; i < 8; ++i) { g[i] = lg[i] + gbias[i]; if (g[i] > gm) { gm = g[i]; gi = i; } }
    float gs = 0.f;
#pragma unroll
    for (int i = 0; i < 8; ++i) gs += expf(g[i] - gm);
    const float ggate = 1.f / gs;
    float e[8]; float em = -INFINITY;
#pragma unroll
    for (int i = 0; i < 8; ++i) { e[i] = lg[8 + gi * 8 + i] + ebias[gi * 8 + i]; em = fmaxf(em, e[i]); }
    float es = 0.f; float p[8];
#pragma unroll
    for (int i = 0; i < 8; ++i) { p[i] = expf(e[i] - em); es += p[i]; }
    int i1 = 0; float p1 = -1.f;
#pragma unroll
    for (int i = 0; i < 8; ++i) if (p[i] > p1) { p1 = p[i]; i1 = i; }
    int i2 = 0; float p2 = -1.f;
#pragma unroll
    for (int i = 0; i < 8; ++i) if (i != i1 && p[i] > p2) { p2 = p[i]; i2 = i; }
    const float q1 = p1 / es, q2 = p2 / es, qs = q1 + q2;
    const int e1 = gi * 8 + i1, e2 = gi * 8 + i2;
    eid[t * 2] = e1; eid[t * 2 + 1] = e2;
    gate[t * 2] = ggate * (q1 / qs); gate[t * 2 + 1] = ggate * (q2 / qs);
    pos[t * 2] = atomicAdd(&cnt[e1], 1); pos[t * 2 + 1] = atomicAdd(&cnt[e2], 1);
}
__global__ void k_scan(const int* __restrict__ cnt, int* __restrict__ slot_tok, int* __restrict__ blk_exp, int* __restrict__ pad_start, int* __restrict__ nblk) {
    __shared__ int ps[NE + 1];
    if (threadIdx.x == 0) { int s = 0; for (int e = 0; e < NE; ++e) { ps[e] = s; s += (cnt[e] + RB - 1) / RB * RB; } ps[NE] = s; }
    __syncthreads();
    const int b = blockIdx.x;
    slot_tok[b * RB + threadIdx.x] = T;
    if (threadIdx.x == 0) {
        int e = NE - 1;
        for (int i = 0; i < NE; ++i) if (b * RB >= ps[i] && b * RB < ps[i + 1]) { e = i; break; }
        blk_exp[b] = e;
        if (b == 0) { *nblk = ps[NE] / RB; for (int i = 0; i < NE; ++i) pad_start[i] = ps[i]; }
    }
}
__global__ void k_fill(const int* __restrict__ eid, const int* __restrict__ pos, const int* __restrict__ pad_start, int* __restrict__ slot_tok, int* __restrict__ tslot) {
    const int i = blockIdx.x * 256 + threadIdx.x; if (i >= T * 2) return;
    const int s = pad_start[eid[i]] + pos[i];
    slot_tok[s] = i >> 1; tslot[i] = s;
}
__global__ void __launch_bounds__(256) k_final(const float* __restrict__ X1, const float* __restrict__ Y, const int* __restrict__ tslot, const float* __restrict__ gate, const float* __restrict__ fw, float* __restrict__ out) {
    const int t = blockIdx.x * 4 + (threadIdx.x >> 6), lane = threadIdx.x & 63;
    const int s1 = tslot[t * 2], s2 = tslot[t * 2 + 1]; const float g1 = gate[t * 2], g2 = gate[t * 2 + 1];
    float v[32]; float ss = 0.f;
#pragma unroll
    for (int j = 0; j < 32; ++j) {
        const int c = lane + 64 * j;
        float y = g1 * Y[(size_t)s1 * DM + c]; y += g2 * Y[(size_t)s2 * DM + c];
        v[j] = X1[(size_t)t * DM + c] + y; ss += v[j] * v[j];
    }
    const float r = rsqrtf(wave_sum(ss) / DM + EPS);
#pragma unroll
    for (int j = 0; j < 32; ++j) { const int c = lane + 64 * j; out[(size_t)t * DM + c] = v[j] * r * fw[c]; }
}
__global__ void k_zero(float* p, int n) { const int i = blockIdx.x * 256 + threadIdx.x; if (i < n) p[i] = 0.f; }

extern "C" void kernel_launch(void* const* d_in, const int* in_sizes, int n_in, void* d_out, int out_size, void* d_ws, size_t ws_size, hipStream_t stream) {
    const float* x = (const float*)d_in[0]; const float* norm1_w = (const float*)d_in[1]; const float* w_in = (const float*)d_in[2];
    const float* hy_conv_w = (const float*)d_in[3]; const float* hy_conv_b = (const float*)d_in[4];
    const float* fw1 = (const float*)d_in[5]; const float* fb1 = (const float*)d_in[6]; const float* fw2 = (const float*)d_in[7]; const float* fb2 = (const float*)d_in[8];
    const float* fw3 = (const float*)d_in[9]; const float* fb3 = (const float*)d_in[10]; const float* fw4 = (const float*)d_in[11]; const float* sfreq = (const float*)d_in[12];
    const float* hy_skip = (const float*)d_in[13]; const float* hy_norm_w = (const float*)d_in[14]; const float* gdn_conv_w = (const float*)d_in[15];
    const float* alf = (const float*)d_in[16]; const float* alb = (const float*)d_in[17]; const float* dtf = (const float*)d_in[18]; const float* dtb = (const float*)d_in[19];
    const float* gdn_norm_w = (const float*)d_in[20]; const float* w_out = (const float*)d_in[21]; const float* norm2_w = (const float*)d_in[22];
    const float* rg_w = (const float*)d_in[23]; const float* rg_b = (const float*)d_in[24]; const float* re_w = (const float*)d_in[25]; const float* re_b = (const float*)d_in[26];
    const float* ew1 = (const float*)d_in[27]; const float* ew3 = (const float*)d_in[28]; const float* ew2 = (const float*)d_in[29]; const float* final_w = (const float*)d_in[30];
    float* out = (float*)d_out;
    char* ws = (char*)d_ws;
    int* cnt = (int*)(ws + WS_CTL);
    char* sm = ws + WS_SMALL;
    float* logits = (float*)(sm + SM_LOGITS); float* GB = (float*)(sm + SM_GB); int* eid = (int*)(sm + SM_EID); float* gate = (float*)(sm + SM_GATE);
    int* pos = (int*)(sm + SM_POS); int* tslot = (int*)(sm + SM_TSLOT); int* slot_tok = (int*)(sm + SM_SLOTTOK); int* blk_exp = (int*)(sm + SM_BLKEXP);
    int* pad_start = (int*)(sm + SM_PADSTART); int* nblk = (int*)(sm + SM_NBLK);
    float* H = (float*)(ws + WS_H); float* P = (float*)(ws + WS_P); float* KK = (float*)(ws + WS_KK);
    float* X0 = (float*)(ws + WS_X0); float* VG = (float*)(ws + WS_VG); float* YH = (float*)(ws + WS_YH);
    float* Q = (float*)(ws + WS_Q); float* Kk = (float*)(ws + WS_K); float* V = (float*)(ws + WS_V); float* OF = (float*)(ws + WS_OF); float* OB = (float*)(ws + WS_OB);
    float* A2 = (float*)(ws + WS_A2); float* X1 = (float*)(ws + WS_X1); float* U = (float*)(ws + WS_U); float* HH = (float*)(ws + WS_HH); float* Y = (float*)(ws + WS_Y);

    hipMemsetAsync(cnt, 0, 4096, stream);
    k_rmsnorm<<<T / 4, 256, 0, stream>>>(x, norm1_w, H, DM, DM, T);
    k_sgemm<0><<<dim3((NPROJ + 63) / 64, T / 64), 256, 0, stream>>>(H, DM, nullptr, w_in, NPROJ, P, NPROJ, T, NPROJ, DM, nullptr, nullptr, 0, nullptr);
    k_hy_filter<<<LSEQ, 256, 0, stream>>>(fw1, fb1, fw2, fb2, fw3, fb3, fw4, sfreq, KK);
    k_hy_pre<<<T * 1024 / 256, 256, 0, stream>>>(P, hy_conv_w, hy_conv_b, X0, VG);
    k_hy_conv<<<dim3(4, LSEQ / 8, BATCH), 256, 0, stream>>>(KK, VG, X0, hy_skip, YH);
    k_rmsnorm<<<T / 4, 256, 0, stream>>>(YH, hy_norm_w, A2, DHY, DM, T);
    k_gdn_pre<<<T * 8 / 4, 256, 0, stream>>>(P, gdn_conv_w, alf, alb, dtf, dtb, Q, Kk, V, GB);
    k_gdn_seq<<<32, 128, 0, stream>>>(Q, Kk, V, GB, OF, OB);
    k_gdn_post<<<T * 8 / 4, 256, 0, stream>>>(OF, OB, P, gdn_norm_w, A2);
    k_sgemm<1><<<dim3(DM / 64, T / 64), 256, 0, stream>>>(A2, DM, nullptr, w_out, DM, X1, DM, T, DM, DM, x, nullptr, 0, nullptr);
    k_rmsnorm<<<T / 4, 256, 0, stream>>>(X1, norm2_w, U, DM, DM, T);
    k_zero<<<DM / 256, 256, 0, stream>>>(U + (size_t)T * DM, DM);
    k_sgemm<0><<<dim3(1, T / 64), 256, 0, stream>>>(U, DM, nullptr, rg_w, NG, logits, 72, T, NG, DM, nullptr, nullptr, 0, nullptr);
    k_sgemm<0><<<dim3(1, T / 64), 256, 0, stream>>>(U, DM, nullptr, re_w, NE, logits + 8, 72, T, NE, DM, nullptr, nullptr, 0, nullptr);
    k_route<<<T / 256, 256, 0, stream>>>(logits, rg_b, re_b, eid, gate, pos, cnt);
    k_scan<<<NBLK_MAX, 256, 0, stream>>>(cnt, slot_tok, blk_exp, pad_start, nblk);
    k_fill<<<T * 2 / 256, 256, 0, stream>>>(eid, pos, pad_start, slot_tok, tslot);
    k_sgemm<0><<<dim3(DE / 64, PMAX / 64), 256, 0, stream>>>(U, DM, slot_tok, ew1, DE, HH, DE, PMAX, DE, DM, nullptr, blk_exp, (size_t)DM * DE, nblk);
    k_sgemm<2><<<dim3(DE / 64, PMAX / 64), 256, 0, stream>>>(U, DM, slot_tok, ew3, DE, HH, DE, PMAX, DE, DM, nullptr, blk_exp, (size_t)DM * DE, nblk);
    k_sgemm<0><<<dim3(DM / 64, PMAX / 64), 256, 0, stream>>>(HH, DE, nullptr, ew2, DM, Y, DM, PMAX, DM, DE, nullptr, blk_exp, (size_t)DE * DM, nblk);
    k_final<<<T / 4, 256, 0, stream>>>(X1, Y, tslot, gate, final_w, out);
}
```

```cpp
#include <hip/hip_runtime.h>
#include <cstdio>
#include <cstdint>
#include <cmath>

constexpr int BATCH = 2, LSEQ = 4096, DM = 2048, T = BATCH * LSEQ;
constexpr int DHY = 1024, DGD = 1024, NH = 8, HD = 128;
constexpr int NPROJ = 3 * DHY + 4 * DGD + 4 * NH;
constexpr int GOFF = 3 * DHY;
constexpr int NPROJ_PAD = 7424;
constexpr int NG = 8, EPG = 8, NE = 64, DE = 512;
constexpr int RB = 256, PMAX = 32768, NBLK_MAX = 128;
constexpr float EPS = 1e-6f;

constexpr size_t MiB = 1u << 20;
constexpr size_t WS_CTL = 0;
constexpr size_t CTL_ZERO_BYTES = 1 * MiB;
constexpr size_t WS_SMALL = 2 * MiB;
constexpr size_t WS_WINT = 16 * MiB;
constexpr size_t WS_WOUTT = 608 * MiB;
constexpr size_t WS_HB = 56 * MiB;
constexpr size_t WS_PT = 88 * MiB;
constexpr size_t WS_PG = 184 * MiB;
constexpr size_t WS_PGATE = 248 * MiB;
constexpr size_t WS_A2 = 250 * MiB;
constexpr size_t WS_KC = 282 * MiB;
constexpr size_t WS_YHT = 314 * MiB;
constexpr size_t WS_X0 = 314 * MiB, WS_VG = 346 * MiB, WS_YH = 378 * MiB;
constexpr size_t WS_QN = 16 * MiB, WS_KN = 32 * MiB, WS_KT = 48 * MiB, WS_VT = 64 * MiB;
constexpr size_t WS_V = 346 * MiB, WS_OF = 378 * MiB, WS_OB = 410 * MiB;
constexpr size_t GW_B = 64 * 272, GKDT_B = 128 * 144, GQK_B = 64 * 144, GUT_B = 128 * 128;
constexpr size_t WS_GW = 442 * MiB;
constexpr size_t WS_GQD = WS_GW + 2048 * GW_B;
constexpr size_t WS_GKDT = WS_GQD + 2048 * GW_B;
constexpr size_t WS_GQK = WS_GKDT + 2048 * GKDT_B;
constexpr size_t WS_GUT = WS_GQK + 2048 * GQK_B;
constexpr size_t WS_GCD = WS_GUT + 2048 * GUT_B + 4096;
static_assert(WS_GCD + 2048 * 4 <= 640 * MiB, "ws map");
constexpr size_t WS_W13T = 640 * MiB;
constexpr size_t WS_W2T = 896 * MiB;
constexpr size_t WS_X1 = 282 * MiB;
constexpr size_t WS_U = 346 * MiB;
constexpr size_t WS_UB = 412 * MiB;
constexpr size_t WS_HH = 446 * MiB;
constexpr size_t WS_Y = 88 * MiB;
constexpr int CW_CNT = 0;
constexpr int CW_BAR = 4096;
constexpr size_t SM_LOGITS = 0;
constexpr size_t SM_GB = SM_LOGITS + (size_t)T * 72 * 4;
constexpr size_t SM_EID = SM_GB + (size_t)4 * T * 8 * 4;
constexpr size_t SM_GATE = SM_EID + (size_t)T * 2 * 4;
constexpr size_t SM_POS = SM_GATE + (size_t)T * 2 * 4;
constexpr size_t SM_TSLOT = SM_POS + (size_t)T * 2 * 4;
constexpr size_t SM_SLOTTOK = SM_TSLOT + (size_t)T * 2 * 4;
constexpr size_t SM_BLKEXP = SM_SLOTTOK + (size_t)PMAX * 4;
constexpr size_t SM_PADSTART = SM_BLKEXP + NBLK_MAX * 4;
constexpr size_t SM_NBLK = SM_PADSTART + NE * 4;

#define LAS __attribute__((address_space(3)))
#define GAS __attribute__((address_space(1)))
typedef unsigned short bf16;
typedef unsigned v4u __attribute__((ext_vector_type(4)));

__device__ __forceinline__ float wave_sum(float v) {
#pragma unroll
    for (int o = 1; o < 64; o <<= 1) v += __shfl_xor(v, o);
    return v;
}
__device__ __forceinline__ float silu_f(float x) { return x / (1.f + expf(-x)); }
__device__ __forceinline__ float sigmoid_f(float x) { return 1.f / (1.f + expf(-x)); }
__device__ __forceinline__ float softplus_f(float x) { return fmaxf(x, 0.f) + log1pf(expf(-fabsf(x))); }
__device__ __forceinline__ unsigned f2bf(float f) { unsigned u = __builtin_bit_cast(unsigned, f); return (u + 0x7fffu + ((u >> 16) & 1u)) >> 16; }
__device__ __forceinline__ unsigned pk2(float lo, float hi) { return f2bf(lo) | (f2bf(hi) << 16); }
__device__ __forceinline__ float bf2f(bf16 b) { return __builtin_bit_cast(float, ((unsigned)b) << 16); }

constexpr int LDSCTL_OFF_C = 147456 - 256;
namespace pg8 {
#define PG8_LAS __attribute__((address_space(3)))
typedef unsigned short bf16_t;
typedef short bf16x8 __attribute__((ext_vector_type(8)));
typedef float f32x4 __attribute__((ext_vector_type(4)));
typedef unsigned u32x4 __attribute__((ext_vector_type(4)));
constexpr int BM = 256, BK = 64, HALF = 128, HTB = HALF * BK * 2  , STAGE_BYTES = 8 * HTB, NXCD = 8, WGM = 8;

__host__ __device__ __forceinline__ int lds_byte(int r, int c) { const int st = (r >> 4) * 2 + (c >> 5), rr = r & 15, cc = c & 31, ob = rr * 64 + cc * 2; return st * 1024 + (ob ^ (((ob >> 9) & 1) << 5)); }
__host__ __device__ __forceinline__ void stage_rc(int b, int& R, int& C) { const int st = b / 1024, sb = b % 1024, swz = sb ^ (((sb >> 9) & 1) << 5); R = (st >> 1) * 16 + swz / 64; C = (st & 1) * 32 + (swz % 64) / 2; }
__host__ __device__ __forceinline__ int perm32(int rho) { const int n = rho >> 4, i = rho & 15; return 8 * (i >> 2) + 4 * n + (i & 3); }

struct Unit { const char* A; const char* B; const int* rows; int pm, pn, kind; };

__device__ __forceinline__ void tile_of(int L, int nM, int nN, int& pm, int& pn) {
    const int nwg = nM * nN;
    int wgid = L; { const int q = nwg / NXCD, r = nwg % NXCD, xcd = wgid % NXCD, off = wgid / NXCD; wgid = (xcd < r ? xcd * (q + 1) : r * (q + 1) + (xcd - r) * q) + off; }
    const int nig = WGM * nN, gid = wgid / nig, fm = gid * WGM, gsz = (nM - fm) < WGM ? (nM - fm) : WGM;
    pm = fm + ((wgid % nig) % gsz); pn = (wgid % nig) / gsz;
}

typedef float cvt_f2 __attribute__((ext_vector_type(2)));
typedef __bf16 cvt_b2 __attribute__((ext_vector_type(2)));
__device__ __forceinline__ unsigned cvt_pk_bf16(float lo, float hi) { const cvt_f2 f = {lo, hi}; const cvt_b2 v = __builtin_convertvector(f, cvt_b2); return __builtin_bit_cast(unsigned, v); }

template <class Epi, class Sched, bool GATHER>
__device__ __forceinline__ void gemm_phase(PG8_LAS unsigned char* lds, const int K, const Sched& S, const Epi& E) {
    const int tid = threadIdx.x, wid = __builtin_amdgcn_readfirstlane(tid >> 6), lane = tid & 63, wr = wid >> 2, wc = wid & 3, fr = lane & 15, fq = lane >> 4;
    const int nt = K / BK;
    int Rr[2], Cc[2];
    unsigned voffB[2];
#pragma unroll
    for (int i = 0; i < 2; ++i) { stage_rc(tid * 16 + i * 8192, Rr[i], Cc[i]); const int Rb = (Rr[i] & ~31) + perm32(Rr[i] & 31); voffB[i] = (unsigned)(Rb * K + Cc[i]) * 2u; }
    const size_t kstep = (size_t)(BK * 2);
    const size_t hstep = (size_t)HALF * K * 2;
    const unsigned ldsw = (unsigned)wid * 1024u;
    const int aoff = lds_byte(wr * 64 + fr, fq * 8), boff = lds_byte(wc * 32 + fr, fq * 8);
#define PG8_SA(b, h) (((b) * 2 + (h)) * HTB)
#define PG8_SB(b, h) ((4 + (b) * 2 + (h)) * HTB)
#define PG8_STAGE2(bufoff, gbase, v0, v1) do { \
        __builtin_amdgcn_global_load_lds((const unsigned*)((const char*)(gbase) + (v0)), (PG8_LAS unsigned*)(lds + (bufoff) + ldsw), 16, 0, 0); \
        __builtin_amdgcn_global_load_lds((const unsigned*)((const char*)(gbase) + (v1)), (PG8_LAS unsigned*)(lds + (bufoff) + ldsw + 8192), 16, 0, 0); } while (0)
#define PG8_STAGEB(bufoff, gbase) PG8_STAGE2(bufoff, gbase, voffB[0], voffB[1])
#define PG8_LDA(dst, b, h) do { _Pragma("unroll") for (int m = 0; m < 4; ++m) _Pragma("unroll") for (int k = 0; k < 2; ++k) dst[m][k] = *(const PG8_LAS bf16x8*)(lds + PG8_SA(b, h) + aoff + m * 2048 + k * 1024); } while (0)
#define PG8_LDB(dst, b, h) do { _Pragma("unroll") for (int n = 0; n < 2; ++n) _Pragma("unroll") for (int k = 0; k < 2; ++k) dst[n][k] = *(const PG8_LAS bf16x8*)(lds + PG8_SB(b, h) + boff + n * 2048 + k * 1024); } while (0)
#define PG8_MMA(ai, bj, At, Bt) do { __builtin_amdgcn_s_setprio(1); _Pragma("unroll") for (int m = 0; m < 4; ++m) _Pragma("unroll") for (int n = 0; n < 2; ++n) _Pragma("unroll") for (int k = 0; k < 2; ++k) \
        acc[ai][bj][m][n] = __builtin_amdgcn_mfma_f32_16x16x32_bf16(Bt[n][k], At[m][k], acc[ai][bj][m][n], 0, 0, 0); __builtin_amdgcn_s_setprio(0); } while (0)
#define PG8_WAIT_V(n) asm volatile("s_waitcnt vmcnt(" #n ")" ::: "memory")
#define PG8_WAIT_L(n) asm volatile("s_waitcnt lgkmcnt(" #n ")" ::: "memory")
#define PG8_BAR __builtin_amdgcn_s_barrier()
#define PG8_SCHED __builtin_amdgcn_sched_barrier(0)
    Unit cur, nxt; int ui = 0;
    if (!S.next(0, cur)) return;
    f32x4 acc[2][2][4][2];
#pragma unroll
    for (int a = 0; a < 2; ++a)
#pragma unroll
        for (int b = 0; b < 2; ++b)
#pragma unroll
            for (int m = 0; m < 4; ++m)
#pragma unroll
                for (int n = 0; n < 2; ++n) acc[a][b][m][n] = (f32x4){0.f, 0.f, 0.f, 0.f};
    bf16x8 At[4][2], B0[2][2], B1[2][2];
    unsigned c00, c01, c10, c11, n00, n01, n10, n11;
    if constexpr (GATHER) {
        c00 = (unsigned)cur.rows[Rr[0]] * (unsigned)(K * 2) + (unsigned)Cc[0] * 2u; c01 = (unsigned)cur.rows[Rr[1]] * (unsigned)(K * 2) + (unsigned)Cc[1] * 2u;
        c10 = (unsigned)cur.rows[128 + Rr[0]] * (unsigned)(K * 2) + (unsigned)Cc[0] * 2u; c11 = (unsigned)cur.rows[128 + Rr[1]] * (unsigned)(K * 2) + (unsigned)Cc[1] * 2u;
    } else {
        c00 = (unsigned)(Rr[0] * K + Cc[0]) * 2u; c01 = (unsigned)(Rr[1] * K + Cc[1]) * 2u;
        c10 = c00 + (unsigned)hstep; c11 = c01 + (unsigned)hstep;
    }
    n00 = c00; n01 = c01; n10 = c10; n11 = c11;
    const char* cA = cur.A; const char* cB = cur.B;
    PG8_STAGEB(PG8_SB(0, 0), cB); PG8_STAGEB(PG8_SB(0, 1), cB + hstep); PG8_STAGE2(PG8_SA(0, 0), cA, c00, c01); PG8_STAGE2(PG8_SA(0, 1), cA, c10, c11);
    if (wr == 1) PG8_BAR;
    PG8_WAIT_V(2); PG8_BAR;
    PG8_STAGEB(PG8_SB(1, 0), cB + kstep); PG8_STAGE2(PG8_SA(1, 0), cA + kstep, c00, c01); PG8_STAGEB(PG8_SB(1, 1), cB + hstep + kstep);
    PG8_WAIT_V(6); PG8_BAR;
    for (;;) {
        const bool has_next = S.next(ui + 1, nxt);
        const char* nA = has_next ? nxt.A : cA; const char* nB = has_next ? nxt.B : cB;
        if constexpr (GATHER) {
            if (has_next) {
                n00 = (unsigned)nxt.rows[Rr[0]] * (unsigned)(K * 2) + (unsigned)Cc[0] * 2u; n01 = (unsigned)nxt.rows[Rr[1]] * (unsigned)(K * 2) + (unsigned)Cc[1] * 2u;
                n10 = (unsigned)nxt.rows[128 + Rr[0]] * (unsigned)(K * 2) + (unsigned)Cc[0] * 2u; n11 = (unsigned)nxt.rows[128 + Rr[1]] * (unsigned)(K * 2) + (unsigned)Cc[1] * 2u;
            } else { n00 = c00; n01 = c01; n10 = c10; n11 = c11; }
        }
        for (int t = 0; t < nt; t += 2) {
            const bool last = (t == nt - 2);
            const char* a1 = cA + (size_t)(t + 1) * kstep;
            const char* a2 = last ? nA : cA + (size_t)(t + 2) * kstep; const char* b2 = last ? nB : cB + (size_t)(t + 2) * kstep;
            const char* a3 = a2 + kstep; const char* b3 = b2 + kstep;
            unsigned e00, e01, e10, e11;
            if constexpr (GATHER) { e00 = last ? n00 : c00; e01 = last ? n01 : c01; e10 = last ? n10 : c10; e11 = last ? n11 : c11; } else { e00 = c00; e01 = c01; e10 = c10; e11 = c11; }
            PG8_LDB(B0, 0, 0); PG8_LDB(B1, 0, 1); PG8_SCHED; PG8_LDA(At, 0, 0); PG8_STAGE2(PG8_SA(1, 1), a1, c10, c11);
            PG8_WAIT_V(8); PG8_WAIT_L(0); PG8_BAR; PG8_MMA(0, 0, At, B0); PG8_MMA(0, 1, At, B1); PG8_BAR; PG8_SCHED;
            PG8_LDA(At, 0, 1); PG8_STAGEB(PG8_SB(0, 0), b2); PG8_STAGEB(PG8_SB(0, 1), b2 + hstep); PG8_STAGE2(PG8_SA(0, 0), a2, e00, e01);
            PG8_WAIT_V(8); PG8_WAIT_L(0); PG8_BAR; PG8_MMA(1, 0, At, B0); PG8_MMA(1, 1, At, B1); PG8_BAR; PG8_SCHED;
            PG8_LDB(B0, 1, 0); PG8_LDB(B1, 1, 1); PG8_SCHED; PG8_LDA(At, 1, 0); PG8_STAGE2(PG8_SA(0, 1), a2, e10, e11);
            PG8_WAIT_V(8); PG8_WAIT_L(0); PG8_BAR; PG8_MMA(0, 0, At, B0); PG8_MMA(0, 1, At, B1); PG8_BAR; PG8_SCHED;
            PG8_LDA(At, 1, 1); PG8_STAGEB(PG8_SB(1, 0), b3); PG8_STAGEB(PG8_SB(1, 1), b3 + hstep); PG8_STAGE2(PG8_SA(1, 0), a3, e00, e01);
            PG8_WAIT_V(8); PG8_WAIT_L(0); PG8_BAR; PG8_MMA(1, 0, At, B0); PG8_MMA(1, 1, At, B1); PG8_BAR; PG8_SCHED;
        }
        if (wr == 0) PG8_BAR;
        E(acc, cur, wr, wc, fr, fq);
        if (!has_next) break;
#pragma unroll
        for (int a = 0; a < 2; ++a)
#pragma unroll
            for (int b = 0; b < 2; ++b)
#pragma unroll
                for (int m = 0; m < 4; ++m)
#pragma unroll
                    for (int n = 0; n < 2; ++n) acc[a][b][m][n] = (f32x4){0.f, 0.f, 0.f, 0.f};
        cur = nxt; cA = nA; cB = nB; ++ui;
        if constexpr (GATHER) { c00 = n00; c01 = n01; c10 = n10; c11 = n11; }
        if (wr == 1) PG8_BAR;
    }
    PG8_WAIT_V(0);
    PG8_BAR;
#undef PG8_SA
#undef PG8_SB
#undef PG8_STAGE2
#undef PG8_STAGEB
#undef PG8_LDA
#undef PG8_LDB
#undef PG8_MMA
#undef PG8_WAIT_V
#undef PG8_WAIT_L
#undef PG8_BAR
#undef PG8_SCHED
}
}

#define XB_TMO      128
#define XB_XCNT(j)  (256  + 64 * (j))
#define XB_XSUB(j)  (1280 + 64 * (j))
#define XB_XGEN(j)  (2304 + 64 * (j))
#define XB_TOP      3328
#define XB_TOPGEN   3392
#define XCD_BAR_WORDS 3456
#define XB_SPIN_CAP (1u << 18)
__device__ __forceinline__ unsigned xb_ld(unsigned* p)              { return __hip_atomic_load(p, __ATOMIC_RELAXED, __HIP_MEMORY_SCOPE_AGENT); }
__device__ __forceinline__ unsigned xb_add(unsigned* p, unsigned v) { return __hip_atomic_fetch_add(p, v, __ATOMIC_RELAXED, __HIP_MEMORY_SCOPE_AGENT); }
__device__ __forceinline__ unsigned xb_xcc_id() { return (unsigned)__builtin_amdgcn_s_getreg((3 << 11) | 20) & 0xFu; }
#define XB_SPIN(cond, bar) do { unsigned _sp = 0; while (cond) { __builtin_amdgcn_s_sleep(1); \
    if ((++_sp & 255u) == 0u) { if (xb_ld(&(bar)[XB_TMO])) break; if (_sp > XB_SPIN_CAP) { atomicAdd(&(bar)[XB_TMO], 1u); break; } } } } while (0)
struct XcdBarrier { unsigned* bar; unsigned x; volatile LAS unsigned* st; };
__device__ __forceinline__ XcdBarrier xcd_barrier_post(unsigned* bar, volatile LAS unsigned* st) {
    XcdBarrier b; b.bar = bar; b.x = xb_xcc_id(); b.st = st;
    if (threadIdx.x == 0) (void)xb_add(&bar[XB_XCNT(b.x)], 1u);
    return b;
}
__device__ __forceinline__ void xcd_barrier_complete(unsigned* bar, unsigned x, unsigned& nloc, unsigned& nx) {
    const unsigned G = gridDim.x * gridDim.y * gridDim.z;
    unsigned sum, cnt, mine, sp = 0u;
    for (;;) {
        sum = 0u; cnt = 0u; mine = 0u;
#pragma unroll
        for (unsigned j = 0; j < 16; ++j) { const unsigned c = xb_ld(&bar[XB_XCNT(j)]); sum += c; cnt += (c > 0u) ? 1u : 0u; mine = (j == x) ? c : mine; }
        if (sum == G) break;
        __builtin_amdgcn_s_sleep(1);
        if ((++sp & 255u) == 0u) { if (xb_ld(&bar[XB_TMO])) break; if (sp > XB_SPIN_CAP) { atomicAdd(&bar[XB_TMO], 1u); break; } }
    }
    nloc = mine > 0u ? mine : 1u; nx = cnt > 0u ? cnt : 1u;
}
__device__ __forceinline__ void xcd_barrier(const XcdBarrier& b) {
    asm volatile("s_waitcnt vmcnt(0)" ::: "memory");
    __syncthreads();
    if (threadIdx.x == 0) {
        unsigned* bar = b.bar;
        __builtin_amdgcn_s_waitcnt(0);
        unsigned nloc = b.st[0], nx = b.st[1];
        if (nloc == 0u) { xcd_barrier_complete(bar, b.x, nloc, nx); b.st[0] = nloc; b.st[1] = nx; }
        const unsigned old = xb_add(&bar[XB_XSUB(b.x)], 1u);
        const unsigned gen = old / nloc;
        if (old + 1u == (gen + 1u) * nloc) {
            __builtin_amdgcn_fence(__ATOMIC_RELEASE, "agent");
            asm volatile("s_waitcnt vmcnt(0)" ::: "memory");
            const unsigned og = xb_add(&bar[XB_TOP], 1u);
            const unsigned tg = og / nx;
            if (og + 1u == (tg + 1u) * nx) xb_add(&bar[XB_TOPGEN], 1u);
            else XB_SPIN(xb_ld(&bar[XB_TOPGEN]) == tg, bar);
            __builtin_amdgcn_fence(__ATOMIC_ACQUIRE, "agent");
            xb_add(&bar[XB_XGEN(b.x)], 1u);
            asm volatile("s_waitcnt vmcnt(0)" ::: "memory");
        } else {
            XB_SPIN(xb_ld(&bar[XB_XGEN(b.x)]) == gen, bar);
            __builtin_amdgcn_fence(__ATOMIC_ACQUIRE, "agent");
            asm volatile("s_waitcnt vmcnt(0)" ::: "memory");
        }
    }
    __syncthreads();
}


#define HD __device__ __forceinline__
struct cpx { float x, y; };
HD cpx cadd(cpx a, cpx b) { return cpx{a.x + b.x, a.y + b.y}; }
HD cpx csub(cpx a, cpx b) { return cpx{a.x - b.x, a.y - b.y}; }
HD cpx cmul(cpx a, cpx b) { return cpx{a.x * b.x - a.y * b.y, a.x * b.y + a.y * b.x}; }
HD cpx cconj(cpx a) { return cpx{a.x, -a.y}; }
HD int fft_pp(int p) { return p + 2 * (p >> 5); }
constexpr int FFT_N = 8192, FFT_BUF_BYTES = (FFT_N + 2 * (FFT_N >> 5)) * 8;

template <bool INV> HD cpx mul_w16(cpx d, int k) {
    const float C1 = 0.92387953251128674f, S1 = 0.38268343236508977f, R2 = 0.70710678118654752f;
    float c, s;
    switch (k & 15) {
        case 0: return d;
        case 4: return INV ? cpx{-d.y, d.x} : cpx{d.y, -d.x};
        case 8: return cpx{-d.x, -d.y};
        case 12: return INV ? cpx{d.y, -d.x} : cpx{-d.y, d.x};
        case 1: c = C1; s = S1; break;
        case 2: c = R2; s = R2; break;
        case 3: c = S1; s = C1; break;
        case 5: c = -S1; s = C1; break;
        case 6: c = -R2; s = R2; break;
        case 7: c = -C1; s = S1; break;
        case 9: c = -C1; s = -S1; break;
        case 10: c = -R2; s = -R2; break;
        case 11: c = -S1; s = -C1; break;
        case 13: c = S1; s = -C1; break;
        case 14: c = R2; s = -R2; break;
        default: c = C1; s = -S1; break;
    }
    if (INV) s = -s;
    return cpx{d.x * c + d.y * s, d.y * c - d.x * s};
}
template <bool INV, int HALF> HD void dft16_stage(cpx (&v)[16]) {
#pragma unroll
    for (int g = 0; g < 16; g += 2 * HALF) {
#pragma unroll
        for (int i = 0; i < HALF; ++i) {
            const cpx a = v[g + i], b = v[g + i + HALF];
            v[g + i] = cadd(a, b);
            v[g + i + HALF] = mul_w16<INV>(csub(a, b), i * (8 / HALF));
        }
    }
}
template <bool INV> HD void dft16(cpx (&v)[16]) {
    dft16_stage<INV, 8>(v); dft16_stage<INV, 4>(v); dft16_stage<INV, 2>(v); dft16_stage<INV, 1>(v);
    cpx t;
    t = v[1]; v[1] = v[8]; v[8] = t;   t = v[2]; v[2] = v[4]; v[4] = t;   t = v[3]; v[3] = v[12]; v[12] = t;
    t = v[5]; v[5] = v[10]; v[10] = t; t = v[7]; v[7] = v[14]; v[14] = t; t = v[11]; v[11] = v[13]; v[13] = t;
}
template <bool INV> HD void twiddle16(cpx (&v)[16], float frac) {
    float s, c;
    asm volatile("" : "+v"(frac));
#if defined(__HIP_DEVICE_COMPILE__)
    sincospif(2.0f * frac, &s, &c);
#else
    s = sinf(6.283185307179586f * frac); c = cosf(6.283185307179586f * frac);
#endif
    const cpx w1 = INV ? cpx{c, s} : cpx{c, -s};
    cpx w = w1;
#pragma unroll
    for (int q = 1; q < 16; ++q) { v[q] = cmul(v[q], w); if (q < 15) w = cmul(w, w1); }
}
HD int fft_k_of_p(int p) { return (p >> 9) + 16 * ((p >> 5) & 15) + 256 * (p & 31); }
HD int fft_p_of_k(int k) { return (k & 15) * 512 + ((k >> 4) & 15) * 32 + (k >> 8); }

typedef float f2v __attribute__((ext_vector_type(2)));
__device__ __forceinline__ cpx ldc(const LAS cpx* b, int i) { const f2v v = ((const LAS f2v*)b)[i]; return cpx{v.x, v.y}; }
__device__ __forceinline__ void stc(LAS cpx* b, int i, cpx v) { ((LAS f2v*)b)[i] = (f2v){v.x, v.y}; }
__device__ __forceinline__ float dpp_xor1(float v) { return __builtin_bit_cast(float, __builtin_amdgcn_update_dpp(0, __builtin_bit_cast(int, v), 0xB1, 0xF, 0xF, true)); }
__device__ __forceinline__ void fft_fwd_pass2(LAS cpx* buf, int t) {
    const int blk = t >> 5, r2 = t & 31; cpx v[16];
#pragma unroll
    for (int j = 0; j < 16; ++j) v[j] = ldc(buf, fft_pp(blk * 512 + j * 32 + r2));
    dft16<false>(v); twiddle16<false>(v, (float)r2 * (1.f / 512.f));
#pragma unroll
    for (int q = 0; q < 16; ++q) stc(buf, fft_pp(blk * 512 + q * 32 + r2), v[q]);
}
__device__ __forceinline__ void fft_fwd_pass3(const LAS cpx* buf, int t, cpx (&v)[16]) {
    const int b = t >> 1, r = t & 1;
#pragma unroll
    for (int j = 0; j < 16; ++j) v[j] = ldc(buf, fft_pp(b * 32 + 2 * j + r));
    dft16<false>(v); twiddle16<false>(v, (float)r * (1.f / 32.f));
#pragma unroll
    for (int q = 0; q < 16; ++q) { const float px = dpp_xor1(v[q].x), py = dpp_xor1(v[q].y);
        v[q] = r ? cpx{px - v[q].x, py - v[q].y} : cpx{v[q].x + px, v[q].y + py}; }
}
__device__ __forceinline__ float bload(__amdgpu_buffer_rsrc_t rs, int voff, int soff) { return __builtin_bit_cast(float, __builtin_amdgcn_raw_buffer_load_b32(rs, voff, soff, 0)); }
__device__ __forceinline__ float conv3_b(__amdgpu_buffer_rsrc_t rs, int voff, int e0, float w0, float w1, float w2, float bias, bool lo_ok, bool hi_ok) {
    const float xm = (e0 > 0) ? bload(rs, voff, e0 * 4 - 4) : bload(rs, voff - 4, 0);
    const float xc = bload(rs, voff, e0 * 4), xp = bload(rs, voff + 4, e0 * 4);
    return bias + w1 * xc + (lo_ok ? w0 * xm : 0.f) + (hi_ok ? w2 * xp : 0.f);
}
__device__ __forceinline__ void hyena_phase(LAS unsigned char* lds, const float* PT, const float* KC, const float* cw, const float* cb, const float* skip, float* YHT, int G, int vcu) {
    LAS cpx* Wb = (LAS cpx*)lds;
    LAS cpx* Lb = (LAS cpx*)(lds + FFT_BUF_BYTES);
    const int t = threadIdx.x;
    for (int pair = vcu; pair < 512; pair += G) {
        const int c0 = 2 * pair;
        {
            const __amdgpu_buffer_rsrc_t rsk = __builtin_amdgcn_make_buffer_rsrc((void*)(KC + (size_t)c0 * 8192), 0, 65536, 0x00020000);
            cpx v[16];
#pragma unroll
            for (int j = 0; j < 16; ++j) v[j] = cpx{bload(rsk, t * 4, j * 2048), bload(rsk, t * 4, 32768 + j * 2048)};
            dft16<false>(v); twiddle16<false>(v, (float)t * (1.f / 8192.f));
#pragma unroll
            for (int q = 0; q < 16; ++q) stc(Wb, fft_pp(q * 512 + t), v[q]);
        }
        __syncthreads();
        fft_fwd_pass2(Wb, t);
        __syncthreads();
        { cpx v[16]; fft_fwd_pass3(Wb, t, v); __syncthreads();
          const int b = t >> 1, r = t & 1;
#pragma unroll
          for (int q = 0; q < 16; ++q) stc(Wb, fft_pp(b * 32 + 16 * r + q), v[q]); }
        __syncthreads();
#pragma unroll 1
        for (int ch = 0; ch < 2; ++ch) {
            const int c = c0 + ch;
            float vg[2][8];
            {
                const __amdgpu_buffer_rsrc_t rs1 = __builtin_amdgcn_make_buffer_rsrc((void*)(PT + (size_t)(1024 + c) * T), 0, T * 4, 0x00020000);
                const __amdgpu_buffer_rsrc_t rs2 = __builtin_amdgcn_make_buffer_rsrc((void*)(PT + (size_t)(2048 + c) * T), 0, T * 4, 0x00020000);
                const float a0 = cw[1024 + c], a1 = cw[3072 + 1024 + c], a2 = cw[6144 + 1024 + c], ab = cb[1024 + c];
                const float v0 = cw[2048 + c], v1 = cw[3072 + 2048 + c], v2 = cw[6144 + 2048 + c], vb = cb[2048 + c];
#pragma unroll
                for (int b = 0; b < 2; ++b)
#pragma unroll
                    for (int j = 0; j < 8; ++j) { const bool lo = (j > 0) || (t > 0), hi = (j < 7) || (t < 511);
                        vg[b][j] = conv3_b(rs2, t * 4, b * LSEQ + j * 512, v0, v1, v2, vb, lo, hi) * conv3_b(rs1, t * 4, b * LSEQ + j * 512, a0, a1, a2, ab, lo, hi);
                        if (j & 1) asm volatile("" ::: "memory"); }
                cpx v[16];
#pragma unroll
                for (int j = 0; j < 8; ++j) { v[j] = cpx{vg[0][j], vg[1][j]}; v[8 + j] = cpx{0.f, 0.f}; }
                dft16<false>(v); twiddle16<false>(v, (float)t * (1.f / 8192.f));
#pragma unroll
                for (int q = 0; q < 16; ++q) stc(Lb, fft_pp(q * 512 + t), v[q]);
            }
            __syncthreads();
            fft_fwd_pass2(Lb, t);
            __syncthreads();
            {
                cpx v[16]; fft_fwd_pass3(Lb, t, v);
                const int b = t >> 1, r = t & 1;
                const float sc = 0.5f / 8192.f;
#pragma unroll
                for (int q = 0; q < 16; ++q) {
                    const int p = b * 32 + 16 * r + q, k = fft_k_of_p(p), km = (8192 - k) & 8191, pm = fft_p_of_k(km);
                    const cpx Wk = ldc(Wb, fft_pp(p)), Wm = ldc(Wb, fft_pp(pm));
                    cpx H;
                    if (ch == 0) H = cpx{(Wk.x + Wm.x) * sc, (Wk.y - Wm.y) * sc};
                    else H = cpx{(Wk.y + Wm.y) * sc, (Wm.x - Wk.x) * sc};
                    v[q] = cmul(v[q], H);
                }
#pragma unroll
                for (int q = 0; q < 16; ++q) { const float px = dpp_xor1(v[q].x), py = dpp_xor1(v[q].y);
                    v[q] = r ? cpx{px - v[q].x, py - v[q].y} : cpx{v[q].x + px, v[q].y + py}; }
                twiddle16<true>(v, (float)r * (1.f / 32.f)); dft16<true>(v);
                __syncthreads();
#pragma unroll
                for (int j = 0; j < 16; ++j) stc(Lb, fft_pp(b * 32 + 2 * j + r), v[j]);
            }
            __syncthreads();
            {
                const int blk = t >> 5, r2 = t & 31; cpx v[16];
#pragma unroll
                for (int q = 0; q < 16; ++q) v[q] = ldc(Lb, fft_pp(blk * 512 + q * 32 + r2));
                twiddle16<true>(v, (float)r2 * (1.f / 512.f)); dft16<true>(v);
                __syncthreads();
#pragma unroll
                for (int j = 0; j < 16; ++j) stc(Lb, fft_pp(blk * 512 + j * 32 + r2), v[j]);
            }
            __syncthreads();
            {
                cpx v[16];
#pragma unroll
                for (int q = 0; q < 16; ++q) v[q] = ldc(Lb, fft_pp(q * 512 + t));
                twiddle16<true>(v, (float)t * (1.f / 8192.f)); dft16<true>(v);
                const __amdgpu_buffer_rsrc_t rs0 = __builtin_amdgcn_make_buffer_rsrc((void*)(PT + (size_t)c * T), 0, T * 4, 0x00020000);
                const __amdgpu_buffer_rsrc_t rsy = __builtin_amdgcn_make_buffer_rsrc((void*)(YHT + (size_t)c * T), 0, T * 4, 0x00020000);
                const float x0 = cw[c], x1 = cw[3072 + c], x2 = cw[6144 + c], xb = cb[c], sk = skip[c];
#pragma unroll
                for (int j = 0; j < 8; ++j) { const bool lo = (j > 0) || (t > 0), hi = (j < 7) || (t < 511);
                    const float o0 = (v[j].x + vg[0][j] * sk) * conv3_b(rs0, t * 4, j * 512, x0, x1, x2, xb, lo, hi);
                    const float o1 = (v[j].y + vg[1][j] * sk) * conv3_b(rs0, t * 4, LSEQ + j * 512, x0, x1, x2, xb, lo, hi);
                    __builtin_amdgcn_raw_buffer_store_b32(__builtin_bit_cast(unsigned, o0), rsy, t * 4, j * 2048, 0);
                    __builtin_amdgcn_raw_buffer_store_b32(__builtin_bit_cast(unsigned, o1), rsy, t * 4, (LSEQ + j * 512) * 4, 0);
                    if (j & 1) asm volatile("" ::: "memory"); }
            }
            __syncthreads();
        }
    }
}
__device__ __forceinline__ void hyena_filter_item(LAS unsigned char* lds, int item, const float* w1, const float* b1, const float* w2, const float* b2, const float* w3, const float* b3,
                                                  const float* w4, const float* freq, float* KC, int tid, int lane, int wave) {
    LAS float* H3 = (LAS float*)lds;
    LAS float* sc = (LAS float*)(lds + 4096) + wave * 128;
    const int l0 = item * 16;
    __syncthreads();
#pragma unroll 1
    for (int pp = 0; pp < 2; ++pp) {
        const int li = wave * 2 + pp, l = l0 + li;
        const float tt = (float)l / (float)(LSEQ - 1);
        if (lane == 0) sc[0] = tt;
        if (lane < 16) { const float omega = (2.0f * 3.14159265358979323846f / (float)LSEQ) * (float)l; const float fb = 1e-4f + (float)lane * ((15.0f - 1e-4f) / 15.0f); const float ang = omega * fb;
            sc[1 + lane] = cosf(ang); sc[17 + lane] = -sinf(ang); }
        asm volatile("s_waitcnt lgkmcnt(0)" ::: "memory");
        const float fr = freq[lane];
        float s = b1[lane];
#pragma unroll 3
        for (int i = 0; i < 33; ++i) s += sc[i] * w1[i * 64 + lane];
        float h = sinf(fr * s);
        asm volatile("s_waitcnt lgkmcnt(0)" ::: "memory"); sc[64 + lane] = h; asm volatile("s_waitcnt lgkmcnt(0)" ::: "memory");
        s = b2[lane];
#pragma unroll 4
        for (int i = 0; i < 64; ++i) s += sc[64 + i] * w2[i * 64 + lane];
        h = sinf(fr * s);
        asm volatile("s_waitcnt lgkmcnt(0)" ::: "memory"); sc[lane] = h; asm volatile("s_waitcnt lgkmcnt(0)" ::: "memory");
        s = b3[lane];
#pragma unroll 4
        for (int i = 0; i < 64; ++i) s += sc[i] * w3[i * 64 + lane];
        h = sinf(fr * s);
        H3[lane * 16 + li] = h;
        asm volatile("s_waitcnt lgkmcnt(0)" ::: "memory");
    }
    __syncthreads();
    const float max_decay = logf(1e-2f) / 0.3f, min_decay = logf(1e-2f) / 1.5f;
#pragma unroll 1
    for (int cc = 0; cc < 2; ++cc) {
        const int c = tid + 512 * cc;
        float hf[16], hb[16];
#pragma unroll
        for (int l = 0; l < 16; ++l) { hf[l] = 0.f; hb[l] = 0.f; }
#pragma unroll 2
        for (int i = 0; i < 64; ++i) {
            const float wf = w4[i * 2048 + c], wb = w4[i * 2048 + 1024 + c];
#pragma unroll
            for (int l = 0; l < 16; ++l) { const float hv = H3[i * 16 + l]; hf[l] = fmaf(hv, wf, hf[l]); hb[l] = fmaf(hv, wb, hb[l]); }
        }
        const float delta = fabsf(min_decay + (float)c * ((max_decay - min_decay) / (float)(DHY - 1)));
        float* kc = KC + (size_t)c * 8192;
#pragma unroll
        for (int l = 0; l < 16; ++l) {
            const int ll = l0 + l; const float win = expf(-((float)ll / (float)(LSEQ - 1)) * delta);
            const float f = hf[l] * win, bb = hb[l] * win;
            if (ll == 0) { kc[0] = f + bb; kc[4096] = 0.f; } else { kc[ll] = f; kc[8192 - ll] = bb; }
        }
    }
    __syncthreads();
}
__device__ __forceinline__ void hyena_post_tile(LAS unsigned char* lds, int tile, const float* YHT, const float* nw, bf16* A2, int tid, int lane, int wave) {
    LAS float* tl = (LAS float*)lds;
    const int tok0 = tile * 32, tk = tid & 31, cg = tid >> 5;
    for (int i = 0; i < 64; ++i) { const int c = cg + 16 * i; tl[c * 33 + tk] = YHT[(size_t)c * T + tok0 + tk]; }
    __syncthreads();
    for (int q = 0; q < 4; ++q) {
        const int tq = wave * 4 + q; float v[16]; float ss = 0.f;
#pragma unroll
        for (int i = 0; i < 16; ++i) { v[i] = tl[(lane + 64 * i) * 33 + tq]; ss += v[i] * v[i]; }
        const float r = rsqrtf(wave_sum(ss) * (1.f / DHY) + EPS);
#pragma unroll
        for (int i = 0; i < 16; ++i) { const int c = lane + 64 * i; A2[(size_t)(tok0 + tq) * DM + c] = (bf16)f2bf(v[i] * r * nw[c]); }
    }
    __syncthreads();
}


constexpr int GP_TILE = 128 * 132;
constexpr int GP_GATES = 139264;
constexpr int GP_WREG = 16896;
static_assert(8 * GP_TILE <= GP_GATES && 8 * GP_WREG <= GP_GATES && GP_GATES + 4096 <= LDSCTL_OFF_C, "gdn prep LDS");
__device__ __forceinline__ void gdn_pre(LAS unsigned char* lds, int wg, const bf16* PG, const float* PGATE, const float* cw, const float* alf, const float* alb, const float* dtf, const float* dtb,
                                        unsigned char* ws, int tid, int lane, int wave) {
    const int bh = wg >> 4, b = bh >> 3, h = bh & 7, l0 = 256 * (wg & 15), cid0 = bh * 64 + 4 * (wg & 15);
    LAS float* gates = (LAS float*)(lds + GP_GATES);
    float w[3][3][2];
#pragma unroll
    for (int x = 0; x < 3; ++x)
#pragma unroll
        for (int tp = 0; tp < 3; ++tp)
#pragma unroll
            for (int e = 0; e < 2; ++e) w[x][tp][e] = cw[tp * 3072 + x * 1024 + h * 128 + 2 * lane + e];
    const int lw = l0 + 32 * wave;
    const unsigned* pgw = (const unsigned*)PG;
    auto ldraw = [&](int l, int x) -> unsigned { return (l >= 0 && l < LSEQ) ? pgw[((size_t)(b * LSEQ + l) * 4096 + x * 1024 + h * 128) / 2 + lane] : 0u; };
    unsigned prv[3], cur[3], nxt[3];
#pragma unroll
    for (int x = 0; x < 3; ++x) { prv[x] = ldraw(lw - 1, x); cur[x] = ldraw(lw, x); }
    for (int tt = 0; tt < 32; ++tt) {
        const int l = lw + tt, li = 32 * wave + tt, cl = li >> 6, i = li & 63;
#pragma unroll
        for (int x = 0; x < 3; ++x) nxt[x] = ldraw(l + 1, x);
        float r[3][2];
#pragma unroll
        for (int x = 0; x < 3; ++x) {
            const float p0 = __builtin_bit_cast(float, prv[x] << 16), p1 = __builtin_bit_cast(float, prv[x] & 0xffff0000u);
            const float c0 = __builtin_bit_cast(float, cur[x] << 16), c1 = __builtin_bit_cast(float, cur[x] & 0xffff0000u);
            const float n0 = __builtin_bit_cast(float, nxt[x] << 16), n1 = __builtin_bit_cast(float, nxt[x] & 0xffff0000u);
            r[x][0] = silu_f(w[x][0][0] * p0 + w[x][1][0] * c0 + w[x][2][0] * n0);
            r[x][1] = silu_f(w[x][0][1] * p1 + w[x][1][1] * c1 + w[x][2][1] * n1);
        }
        const float qs = rsqrtf(wave_sum(r[0][0] * r[0][0] + r[0][1] * r[0][1]) + EPS);
        const float ks = rsqrtf(wave_sum(r[1][0] * r[1][0] + r[1][1] * r[1][1]) + EPS);
        const unsigned qp = pk2(r[0][0] * qs, r[0][1] * qs), kp = pk2(r[1][0] * ks, r[1][1] * ks), vp = pk2(r[2][0], r[2][1]);
        const size_t rowoff = ((size_t)(cid0 + cl) * 64 + i) * 64 + lane;
        ((unsigned*)(ws + WS_QN))[rowoff] = qp; ((unsigned*)(ws + WS_KN))[rowoff] = kp;
        LAS bf16* kt = (LAS bf16*)(lds + (cl * 2 + 0) * GP_TILE); LAS bf16* vt = (LAS bf16*)(lds + (cl * 2 + 1) * GP_TILE);
        kt[(2 * lane) * 66 + i] = (bf16)(kp & 0xffffu); kt[(2 * lane + 1) * 66 + i] = (bf16)(kp >> 16);
        vt[(2 * lane) * 66 + i] = (bf16)(vp & 0xffffu); vt[(2 * lane + 1) * 66 + i] = (bf16)(vp >> 16);
        if (lane < 4) {
            const float* pr = PGATE + (size_t)(b * LSEQ + l) * 32;
            float val;
            if (lane == 0) val = -expf(alf[h]) * softplus_f(pr[16 + h] + dtf[h]);
            else if (lane == 1) val = -expf(alb[h]) * softplus_f(pr[24 + h] + dtb[h]);
            else if (lane == 2) val = sigmoid_f(pr[h]);
            else val = sigmoid_f(pr[8 + h]);
            gates[lane * 256 + li] = val;
        }
#pragma unroll
        for (int x = 0; x < 3; ++x) { prv[x] = cur[x]; cur[x] = nxt[x]; }
    }
    __syncthreads();
    for (int it = wave; it < 8 * 64; it += 8) {
        const int tile = it >> 6, rp = it & 63, row = 2 * rp + (lane >> 5), cl = tile >> 1, which = tile & 1;
        const unsigned v = *(const LAS unsigned*)(lds + tile * GP_TILE + row * 132 + (lane & 31) * 4);
        ((unsigned*)(ws + (which ? WS_VT : WS_KT)))[((size_t)(cid0 + cl) * 128 + row) * 32 + (lane & 31)] = v;
    }
    asm volatile("s_waitcnt vmcnt(0)" ::: "memory");
    __syncthreads();
}
__device__ __forceinline__ void gdn_prep_wave(LAS unsigned char* lds, int wg, unsigned char* ws, int lane, int wave) {
    typedef pg8::bf16x8 bf16x8; typedef pg8::f32x4 f32x4;
    const int cl = wave >> 1, dir = wave & 1, bh = wg >> 4, cid = bh * 64 + 4 * (wg & 15) + cl; const size_t ci = (size_t)cid * 2 + dir;
    const int fr = lane & 15, fq = lane >> 4;
    LAS unsigned char* R = lds + wave * GP_WREG;
    LAS float* Am = (LAS float*)R; LAS float* gcA = (LAS float*)(R + 16384); LAS float* btA = gcA + 64;
    const LAS float* gates = (const LAS float*)(lds + GP_GATES);
    const bf16* QN = (const bf16*)(ws + WS_QN) + (size_t)cid * 64 * 128; const bf16* KN = (const bf16*)(ws + WS_KN) + (size_t)cid * 64 * 128;
    const bf16* KT = (const bf16*)(ws + WS_KT) + (size_t)cid * 128 * 64; const bf16* VT = (const bf16*)(ws + WS_VT) + (size_t)cid * 128 * 64;
    unsigned char* GW = ws + WS_GW + ci * GW_B; unsigned char* GQD = ws + WS_GQD + ci * GW_B; unsigned char* GKDT = ws + WS_GKDT + ci * GKDT_B;
    unsigned char* GQK = ws + WS_GQK + ci * GQK_B; unsigned char* GUT = ws + WS_GUT + ci * GUT_B;
#define RIDX(i) (dir ? 63 - (i) : (i))
    const float bt = gates[(2 + dir) * 256 + 64 * cl + RIDX(lane)];
    float gc = gates[dir * 256 + 64 * cl + RIDX(lane)];
#pragma unroll
    for (int o = 1; o < 64; o <<= 1) { const float t = __shfl_up(gc, o); if (lane >= o) gc += t; }
    const float gl = __shfl(gc, 63);
    gcA[lane] = gc; btA[lane] = bt;
    asm volatile("s_waitcnt lgkmcnt(0)" ::: "memory");
    if (lane == 0) ((float*)(ws + WS_GCD))[ci] = expf(gl);
#pragma unroll 1
    for (int mt = 0; mt < 4; ++mt) {
        bf16x8 af[4];
#pragma unroll
        for (int ks = 0; ks < 4; ++ks) af[ks] = *(const bf16x8*)(KN + (size_t)RIDX(16 * mt + fr) * 128 + 32 * ks + 8 * fq);
        const f32x4 gi = *(const LAS f32x4*)(gcA + 16 * mt + 4 * fq), bi = *(const LAS f32x4*)(btA + 16 * mt + 4 * fq);
#pragma unroll 1
        for (int nt = 0; nt <= mt; ++nt) {
            f32x4 c = (f32x4){0.f, 0.f, 0.f, 0.f};
#pragma unroll
            for (int ks = 0; ks < 4; ++ks) { const bf16x8 bfg = *(const bf16x8*)(KN + (size_t)RIDX(16 * nt + fr) * 128 + 32 * ks + 8 * fq); c = __builtin_amdgcn_mfma_f32_16x16x32_bf16(af[ks], bfg, c, 0, 0, 0); }
            const int j = 16 * nt + fr; const float gj = gcA[j];
#pragma unroll
            for (int r = 0; r < 4; ++r) { const int i = 16 * mt + 4 * fq + r; Am[i * 64 + j] = (j < i) ? bi[r] * c[r] * __expf(gi[r] - gj) : 0.f; }
        }
    }
#pragma unroll 1
    for (int it = 0; it < 4; ++it) {
        bf16x8 qf[4];
#pragma unroll
        for (int ks = 0; ks < 4; ++ks) qf[ks] = *(const bf16x8*)(QN + (size_t)RIDX(16 * it + fr) * 128 + 32 * ks + 8 * fq);
        const int i = 16 * it + fr; const float gi = gcA[i];
#pragma unroll 1
        for (int jt = 0; jt < 4; ++jt) {
            f32x4 c = (f32x4){0.f, 0.f, 0.f, 0.f};
            if (jt <= it) {
#pragma unroll
                for (int ks = 0; ks < 4; ++ks) { const bf16x8 kf = *(const bf16x8*)(KN + (size_t)RIDX(16 * jt + fr) * 128 + 32 * ks + 8 * fq); c = __builtin_amdgcn_mfma_f32_16x16x32_bf16(kf, qf[ks], c, 0, 0, 0); }
            }
            const f32x4 gj = *(const LAS f32x4*)(gcA + 16 * jt + 4 * fq);
            float v[4];
#pragma unroll
            for (int r = 0; r < 4; ++r) { const int j = 16 * jt + 4 * fq + r; v[r] = (j <= i) ? c[r] * __expf(gi - gj[r]) * 0.08838834764831845f : 0.f; }
            *(unsigned long long*)(GQK + i * 144 + (32 * (jt >> 1) + 8 * fq + 4 * (jt & 1)) * 2) = (unsigned long long)pg8::cvt_pk_bf16(v[0], v[1]) | ((unsigned long long)pg8::cvt_pk_bf16(v[2], v[3]) << 32);
        }
    }
    {
        const int L2 = lane & 31, m = 4 * L2, src = (m & ~31) + ((m & 4) ? 16 + 4 * ((m & 31) >> 3) : 4 * ((m & 31) >> 3));
#pragma unroll 1
        for (int rp = 0; rp < 32; ++rp) {
            const int i = 2 * rp + (lane >> 5);
            const unsigned long long q = *(const unsigned long long*)(QN + (size_t)RIDX(i) * 128 + src);
            const float sc = __expf(gcA[i]) * 0.08838834764831845f;
            const unsigned lo = (unsigned)q, hi = (unsigned)(q >> 32);
            const float a0 = __builtin_bit_cast(float, lo << 16) * sc, a1 = __builtin_bit_cast(float, lo & 0xffff0000u) * sc, a2 = __builtin_bit_cast(float, hi << 16) * sc, a3 = __builtin_bit_cast(float, hi & 0xffff0000u) * sc;
            *(unsigned long long*)(GQD + i * 272 + m * 2) = (unsigned long long)pg8::cvt_pk_bf16(a0, a1) | ((unsigned long long)pg8::cvt_pk_bf16(a2, a3) << 32);
        }
        const int L4 = lane & 15, mm = 4 * L4, isrc = (mm & ~31) + ((mm & 4) ? 16 + 4 * ((mm & 31) >> 3) : 4 * ((mm & 31) >> 3));
        const f32x4 gi4 = *(const LAS f32x4*)(gcA + isrc);
        float sc4[4];
#pragma unroll
        for (int r = 0; r < 4; ++r) sc4[r] = __expf(gl - gi4[r]);
#pragma unroll 1
        for (int rq = 0; rq < 32; ++rq) {
            const int dk = 4 * rq + (lane >> 4);
            const unsigned long long k = *(const unsigned long long*)(KT + (size_t)dk * 64 + (dir ? 60 - isrc : isrc));
            const unsigned lo = (unsigned)k, hi = (unsigned)(k >> 32);
            float e0 = __builtin_bit_cast(float, lo << 16), e1 = __builtin_bit_cast(float, lo & 0xffff0000u), e2 = __builtin_bit_cast(float, hi << 16), e3 = __builtin_bit_cast(float, hi & 0xffff0000u);
            if (dir) { float t = e0; e0 = e3; e3 = t; t = e1; e1 = e2; e2 = t; }
            *(unsigned long long*)(GKDT + dk * 144 + mm * 2) = (unsigned long long)pg8::cvt_pk_bf16(e0 * sc4[0], e1 * sc4[1]) | ((unsigned long long)pg8::cvt_pk_bf16(e2 * sc4[2], e3 * sc4[3]) << 32);
        }
    }
    asm volatile("s_waitcnt lgkmcnt(0)" ::: "memory");
    float Tr[64];
#pragma unroll
    for (int i = 0; i < 64; ++i) {
        float s0 = (lane == i) ? 1.f : 0.f, s1 = 0.f;
#pragma unroll
        for (int j4 = 0; j4 < (i + 3) / 4; ++j4) {
            const f32x4 a = *(const LAS f32x4*)(Am + i * 64 + 4 * j4);
#pragma unroll
            for (int e = 0; e < 4; ++e) { const int j = 4 * j4 + e; if (j < i) { if (e & 1) s1 = fmaf(-a[e], Tr[j], s1); else s0 = fmaf(-a[e], Tr[j], s0); } }
        }
        Tr[i] = s0 + s1;
    }
#pragma unroll
    for (int j = 0; j < 64; ++j) asm volatile("" : "+v"(Tr[j]));
    asm volatile("s_waitcnt lgkmcnt(0)" ::: "memory");
    {
        const float su = bt, sw = bt * __expf(gc);
        LAS bf16* Tw = (LAS bf16*)R; LAS bf16* Tu = (LAS bf16*)(R + 8192);
        const int cn = RIDX(lane);
#pragma unroll
        for (int j = 0; j < 64; ++j) { Tw[j * 64 + cn] = (bf16)f2bf(Tr[j] * sw); Tu[j * 64 + cn] = (bf16)f2bf(Tr[j] * su); }
    }
    asm volatile("s_waitcnt lgkmcnt(0)" ::: "memory");
#pragma unroll 1
    for (int it = 0; it < 4; ++it) {
        bf16x8 tf[2];
#pragma unroll
        for (int ks = 0; ks < 2; ++ks) tf[ks] = *(const LAS bf16x8*)(R + ((16 * it + fr) * 64 + 32 * ks + 8 * fq) * 2);
        const int i = 16 * it + fr;
#pragma unroll 1
        for (int dt = 0; dt < 8; ++dt) {
            f32x4 c = (f32x4){0.f, 0.f, 0.f, 0.f};
#pragma unroll
            for (int ks = 0; ks < 2; ++ks) { const bf16x8 kf = *(const bf16x8*)(KT + (size_t)(16 * dt + fr) * 64 + 32 * ks + 8 * fq); c = __builtin_amdgcn_mfma_f32_16x16x32_bf16(kf, tf[ks], c, 0, 0, 0); }
            *(unsigned long long*)(GW + i * 272 + (32 * (dt >> 1) + 8 * fq + 4 * (dt & 1)) * 2) = (unsigned long long)pg8::cvt_pk_bf16(c[0], c[1]) | ((unsigned long long)pg8::cvt_pk_bf16(c[2], c[3]) << 32);
        }
    }
#pragma unroll 1
    for (int it = 0; it < 4; ++it) {
        bf16x8 tf[2];
#pragma unroll
        for (int ks = 0; ks < 2; ++ks) tf[ks] = *(const LAS bf16x8*)(R + 8192 + ((16 * it + fr) * 64 + 32 * ks + 8 * fq) * 2);
#pragma unroll 1
        for (int vt = 0; vt < 8; ++vt) {
            f32x4 c = (f32x4){0.f, 0.f, 0.f, 0.f};
#pragma unroll
            for (int ks = 0; ks < 2; ++ks) { const bf16x8 vf = *(const bf16x8*)(VT + (size_t)(16 * vt + fr) * 64 + 32 * ks + 8 * fq); c = __builtin_amdgcn_mfma_f32_16x16x32_bf16(tf[ks], vf, c, 0, 0, 0); }
            *(unsigned long long*)(GUT + (16 * vt + fr) * 128 + (16 * it + 4 * fq) * 2) = (unsigned long long)pg8::cvt_pk_bf16(c[0], c[1]) | ((unsigned long long)pg8::cvt_pk_bf16(c[2], c[3]) << 32);
        }
    }
#undef RIDX
}

__host__ __device__ __forceinline__ int mperm32(int o) { return ((o & 15) >> 2) * 8 + (o >> 4) * 4 + (o & 3); }
__host__ __device__ __forceinline__ int mcol(int x) { return (x & ~31) + mperm32(x & 31); }
constexpr int SC_W = 0, SC_QD = 17408, SC_KDT = 34816, SC_QK = 53248, SC_UT = 62464, SC_STEP = 70656;
static_assert(2 * SC_STEP <= LDSCTL_OFF_C, "scan LDS");
__device__ __forceinline__ void gdn_scan(LAS unsigned char* lds, const unsigned char* ws, float* OF, float* OB, int vcu, int tid, int lane, int wave) {
    typedef pg8::bf16x8 bf16x8; typedef pg8::f32x4 f32x4;
    const int chain = vcu >> 1, half = vcu & 1, dir = chain & 1, bh = chain >> 1, b = bh >> 3, h = bh & 7;
    const int fr = lane & 15, fq = lane >> 4;
    const int dv0 = half * 64 + wave * 16;
    float* O = dir ? OB : OF;
    const float* CD = (const float*)(ws + WS_GCD);
    auto issue = [&](int s, int buf) {
        const int n = dir ? 63 - s : s; const size_t ci = ((size_t)(bh * 64 + n) * 2 + dir);
#pragma unroll
        for (int k = 0; k < 9; ++k) {
            const int p = wave + 8 * k;
            if (p < 69) {
                const unsigned char* g; int l;
                if (p < 17) { g = ws + WS_GW + ci * GW_B + p * 1024; l = SC_W + p * 1024; }
                else if (p < 34) { g = ws + WS_GQD + ci * GW_B + (p - 17) * 1024; l = SC_QD + (p - 17) * 1024; }
                else if (p < 52) { g = ws + WS_GKDT + ci * GKDT_B + (p - 34) * 1024; l = SC_KDT + (p - 34) * 1024; }
                else if (p < 61) { g = ws + WS_GQK + ci * GQK_B + (p - 52) * 1024; l = SC_QK + (p - 52) * 1024; }
                else { g = ws + WS_GUT + ci * GUT_B + half * 8192 + (p - 61) * 1024; l = SC_UT + (p - 61) * 1024; }
                __builtin_amdgcn_global_load_lds((const unsigned*)(g + lane * 16), (LAS unsigned*)(lds + buf * SC_STEP + l), 16, 0, 0);
            }
        }
    };
    f32x4 S[8];
#pragma unroll
    for (int i = 0; i < 8; ++i) S[i] = (f32x4){0.f, 0.f, 0.f, 0.f};
    issue(0, 0);
    asm volatile("s_waitcnt vmcnt(0)" ::: "memory"); __syncthreads();
    for (int s = 0; s < 64; ++s) {
        const int buf = s & 1;
        if (s + 1 < 64) issue(s + 1, buf ^ 1);
        if (wave < 4) {
            const LAS unsigned char* L = lds + buf * SC_STEP;
            const int n = dir ? 63 - s : s; const size_t ci = ((size_t)(bh * 64 + n) * 2 + dir);
            const float cd = CD[ci];
            bf16x8 Sb[4];
#pragma unroll
            for (int ks = 0; ks < 4; ++ks) { pg8::u32x4 w; w.x = pg8::cvt_pk_bf16(S[2 * ks][0], S[2 * ks][1]); w.y = pg8::cvt_pk_bf16(S[2 * ks][2], S[2 * ks][3]);
                w.z = pg8::cvt_pk_bf16(S[2 * ks + 1][0], S[2 * ks + 1][1]); w.w = pg8::cvt_pk_bf16(S[2 * ks + 1][2], S[2 * ks + 1][3]); Sb[ks] = __builtin_bit_cast(bf16x8, w); }
            f32x4 vn[4], o[4];
#pragma unroll
            for (int mt = 0; mt < 4; ++mt) {
                f32x4 a = (f32x4){0.f, 0.f, 0.f, 0.f}, q = (f32x4){0.f, 0.f, 0.f, 0.f};
#pragma unroll
                for (int ks = 0; ks < 4; ++ks) {
                    const bf16x8 wf = *(const LAS bf16x8*)(L + SC_W + (16 * mt + fr) * 272 + ks * 64 + fq * 16);
                    const bf16x8 qf = *(const LAS bf16x8*)(L + SC_QD + (16 * mt + fr) * 272 + ks * 64 + fq * 16);
                    a = __builtin_amdgcn_mfma_f32_16x16x32_bf16(wf, Sb[ks], a, 0, 0, 0);
                    q = __builtin_amdgcn_mfma_f32_16x16x32_bf16(qf, Sb[ks], q, 0, 0, 0);
                }
                const unsigned long long uu = *(const LAS unsigned long long*)(L + SC_UT + (wave * 16 + fr) * 128 + (16 * mt + 4 * fq) * 2);
                const unsigned ulo = (unsigned)uu, uhi = (unsigned)(uu >> 32);
                vn[mt][0] = __builtin_bit_cast(float, ulo << 16) - a[0]; vn[mt][1] = __builtin_bit_cast(float, ulo & 0xffff0000u) - a[1];
                vn[mt][2] = __builtin_bit_cast(float, uhi << 16) - a[2]; vn[mt][3] = __builtin_bit_cast(float, uhi & 0xffff0000u) - a[3];
                o[mt] = q;
            }
            bf16x8 vb[2];
#pragma unroll
            for (int ks = 0; ks < 2; ++ks) { pg8::u32x4 w; w.x = pg8::cvt_pk_bf16(vn[2 * ks][0], vn[2 * ks][1]); w.y = pg8::cvt_pk_bf16(vn[2 * ks][2], vn[2 * ks][3]);
                w.z = pg8::cvt_pk_bf16(vn[2 * ks + 1][0], vn[2 * ks + 1][1]); w.w = pg8::cvt_pk_bf16(vn[2 * ks + 1][2], vn[2 * ks + 1][3]); vb[ks] = __builtin_bit_cast(bf16x8, w); }
#pragma unroll
            for (int mt = 0; mt < 4; ++mt) {
#pragma unroll
                for (int ks = 0; ks < 2; ++ks) {
                    const bf16x8 kf = *(const LAS bf16x8*)(L + SC_QK + (16 * mt + fr) * 144 + ks * 64 + fq * 16);
                    o[mt] = __builtin_amdgcn_mfma_f32_16x16x32_bf16(kf, vb[ks], o[mt], 0, 0, 0);
                }
#pragma unroll
                for (int r = 0; r < 4; ++r) { const int i = 16 * mt + 4 * fq + r; const int l = 64 * n + (dir ? 63 - i : i);
                    O[((size_t)b * LSEQ + l) * DGD + h * 128 + dv0 + fr] = o[mt][r]; }
            }
#pragma unroll
            for (int dt = 0; dt < 8; ++dt) {
                f32x4 a = S[dt] * cd;
#pragma unroll
                for (int ks = 0; ks < 2; ++ks) {
                    const bf16x8 kf = *(const LAS bf16x8*)(L + SC_KDT + (16 * dt + fr) * 144 + ks * 64 + fq * 16);
                    a = __builtin_amdgcn_mfma_f32_16x16x32_bf16(kf, vb[ks], a, 0, 0, 0);
                }
                S[dt] = a;
            }
        }
        asm volatile("s_waitcnt vmcnt(0)" ::: "memory"); __syncthreads();
    }
}

constexpr int NWAVES = 8;
constexpr int LDS_BYTES = 147456, LDSCTL_OFF = LDS_BYTES - 256;

struct Args { const float* in[31]; float* out; unsigned char* ws; int ph_lo, ph_hi, li, pad; };

struct Epi1 {
    bf16* PG; float* PGATE; float* PT;
    __device__ __forceinline__ void operator()(const pg8::f32x4 (&acc)[2][2][4][2], const pg8::Unit& u, int wr, int wc, int fr, int fq) const {
        const int row0 = u.pm * 256 + wr * 64 + fr;
        if (u.kind == 0) {
            if (u.pn < 16) {
                const int col0 = u.pn * 256 + wc * 32 + 8 * fq;
#pragma unroll
                for (int ai = 0; ai < 2; ++ai)
#pragma unroll
                    for (int m = 0; m < 4; ++m) { bf16* rowp = PG + (size_t)(row0 + ai * 128 + m * 16) * 4096 + col0;
#pragma unroll
                        for (int bj = 0; bj < 2; ++bj) { const pg8::f32x4 v0 = acc[ai][bj][m][0], v1 = acc[ai][bj][m][1];
                            pg8::u32x4 w; w.x = pg8::cvt_pk_bf16(v0[0], v0[1]); w.y = pg8::cvt_pk_bf16(v0[2], v0[3]); w.z = pg8::cvt_pk_bf16(v1[0], v1[1]); w.w = pg8::cvt_pk_bf16(v1[2], v1[3]);
                            *(pg8::u32x4*)(rowp + bj * 128) = w; } }
            } else if (wc == 0) {
#pragma unroll
                for (int ai = 0; ai < 2; ++ai)
#pragma unroll
                    for (int m = 0; m < 4; ++m) { float* rowp = PGATE + (size_t)(row0 + ai * 128 + m * 16) * 32 + 8 * fq;
                        *(pg8::f32x4*)(rowp) = acc[ai][0][m][0]; *(pg8::f32x4*)(rowp + 4) = acc[ai][0][m][1]; }
            }
        } else {
            const int col0 = u.pn * 256 + wc * 32 + 8 * fq;
#pragma unroll
            for (int ai = 0; ai < 2; ++ai)
#pragma unroll
                for (int m = 0; m < 4; ++m) { float* rowp = PT + (size_t)(row0 + ai * 128 + m * 16) * T + col0;
#pragma unroll
                    for (int bj = 0; bj < 2; ++bj) { *(pg8::f32x4*)(rowp + bj * 128) = acc[ai][bj][m][0]; *(pg8::f32x4*)(rowp + bj * 128 + 4) = acc[ai][bj][m][1]; } }
        }
    }
};
struct Order1 {
    const char* Hb; const char* WinT; int G, c;
    __device__ __forceinline__ bool next(int i, pg8::Unit& u) const {
        const int L = i * G + c;
        if (L >= 928) return false;
        u.rows = nullptr;
        if (L < 544) { int pm, pn; pg8::tile_of(L, 32, 17, pm, pn); u.pm = pm; u.pn = pn; u.kind = 0;
            u.A = Hb + (size_t)pm * 256 * DM * 2; u.B = WinT + (size_t)(GOFF + pn * 256) * DM * 2; }
        else { int pm, pn; pg8::tile_of(L - 544, 12, 32, pm, pn); u.pm = pm; u.pn = pn; u.kind = 1;
            u.A = WinT + (size_t)pm * 256 * DM * 2; u.B = Hb + (size_t)pn * 256 * DM * 2; }
        return true;
    }
};

struct Epi2 {
    const float* x; float* X1;
    __device__ __forceinline__ void operator()(const pg8::f32x4 (&acc)[2][2][4][2], const pg8::Unit& u, int wr, int wc, int fr, int fq) const {
        const int row0 = u.pm * 256 + wr * 64 + fr, col0 = u.pn * 256 + wc * 32 + 8 * fq;
#pragma unroll
        for (int ai = 0; ai < 2; ++ai)
#pragma unroll
            for (int m = 0; m < 4; ++m) { const size_t off = (size_t)(row0 + ai * 128 + m * 16) * DM + col0;
#pragma unroll
                for (int bj = 0; bj < 2; ++bj) {
                    const pg8::f32x4 x0 = *(const pg8::f32x4*)(x + off + bj * 128), x1 = *(const pg8::f32x4*)(x + off + bj * 128 + 4);
                    *(pg8::f32x4*)(X1 + off + bj * 128) = x0 + acc[ai][bj][m][0]; *(pg8::f32x4*)(X1 + off + bj * 128 + 4) = x1 + acc[ai][bj][m][1]; }
                asm volatile("" ::: "memory"); }
    }
};
struct Order2 {
    const char* A2; const char* WoutT; int G, c;
    __device__ __forceinline__ bool next(int i, pg8::Unit& u) const {
        const int L = i * G + c; if (L >= 256) return false;
        int pm, pn; pg8::tile_of(L, 32, 8, pm, pn); u.pm = pm; u.pn = pn; u.kind = 0; u.rows = nullptr;
        u.A = A2 + (size_t)pm * 256 * DM * 2; u.B = WoutT + (size_t)pn * 256 * DM * 2; return true;
    }
};
struct Epi3 {
    bf16* HH;
    __device__ __forceinline__ void operator()(const pg8::f32x4 (&acc)[2][2][4][2], const pg8::Unit& u, int wr, int wc, int fr, int fq) const {
        const int row0 = u.pm * 256 + wr * 64 + fr, col0 = u.pn * 128 + wc * 32 + 8 * fq;
#pragma unroll
        for (int ai = 0; ai < 2; ++ai)
#pragma unroll
            for (int m = 0; m < 4; ++m) { bf16* rowp = HH + (size_t)(row0 + ai * 128 + m * 16) * DE + col0;
                float v[8];
#pragma unroll
                for (int n = 0; n < 2; ++n)
#pragma unroll
                    for (int j = 0; j < 4; ++j) { const float a = acc[ai][0][m][n][j], b = acc[ai][1][m][n][j]; v[n * 4 + j] = a / (1.f + __expf(-a)) * b; }
                pg8::u32x4 w; w.x = pg8::cvt_pk_bf16(v[0], v[1]); w.y = pg8::cvt_pk_bf16(v[2], v[3]); w.z = pg8::cvt_pk_bf16(v[4], v[5]); w.w = pg8::cvt_pk_bf16(v[6], v[7]);
                *(pg8::u32x4*)rowp = w; }
    }
};
struct Order3 {
    const char* Ub; const char* W13T; const int* slot_tok; const int* blk_exp; int nunits, G, c;
    __device__ __forceinline__ bool next(int i, pg8::Unit& u) const {
        const int L = i * G + c; if (L >= nunits) return false;
        const int b = L >> 2, j = L & 3; u.pm = b; u.pn = j; u.kind = 0; u.rows = slot_tok + b * 256; u.A = Ub;
        const int e = __hip_atomic_load(blk_exp + b, __ATOMIC_RELAXED, __HIP_MEMORY_SCOPE_AGENT);
        u.B = W13T + ((size_t)e * 1024 + j * 256) * DM * 2; return true;
    }
};
struct Epi4 {
    bf16* Y;
    __device__ __forceinline__ void operator()(const pg8::f32x4 (&acc)[2][2][4][2], const pg8::Unit& u, int wr, int wc, int fr, int fq) const {
        const int row0 = u.pm * 256 + wr * 64 + fr, col0 = u.pn * 256 + wc * 32 + 8 * fq;
#pragma unroll
        for (int ai = 0; ai < 2; ++ai)
#pragma unroll
            for (int m = 0; m < 4; ++m) { bf16* rowp = Y + (size_t)(row0 + ai * 128 + m * 16) * DM + col0;
#pragma unroll
                for (int bj = 0; bj < 2; ++bj) { const pg8::f32x4 v0 = acc[ai][bj][m][0], v1 = acc[ai][bj][m][1];
                    pg8::u32x4 w; w.x = pg8::cvt_pk_bf16(v0[0], v0[1]); w.y = pg8::cvt_pk_bf16(v0[2], v0[3]); w.z = pg8::cvt_pk_bf16(v1[0], v1[1]); w.w = pg8::cvt_pk_bf16(v1[2], v1[3]);
                    *(pg8::u32x4*)(rowp + bj * 128) = w; } }
    }
};
struct Order4 {
    const char* HH; const char* W2T; const int* blk_exp; int nunits, G, c;
    __device__ __forceinline__ bool next(int i, pg8::Unit& u) const {
        const int L = i * G + c; if (L >= nunits) return false;
        const int b = L >> 3, j = L & 7; u.pm = b; u.pn = j; u.kind = 0; u.rows = nullptr; u.A = HH + (size_t)b * 256 * DE * 2;
        const int e = __hip_atomic_load(blk_exp + b, __ATOMIC_RELAXED, __HIP_MEMORY_SCOPE_AGENT);
        u.B = W2T + ((size_t)e * DM + j * 256) * DE * 2; return true;
    }
};

__device__ __forceinline__ void tr_item(const float* W, int ldn, int k0, int n0, bf16* WT, size_t dst_row0, int ldk, LAS float* scr, int lane) {
#pragma unroll 8
    for (int i = 0; i < 32; ++i) { const int kk = 2 * i + (lane >> 5); scr[kk * 33 + (lane & 31)] = W[(size_t)(k0 + kk) * ldn + n0 + (lane & 31)]; }
    asm volatile("s_waitcnt lgkmcnt(0)" ::: "memory");
    const int c = lane & 7;
#pragma unroll
    for (int j = 0; j < 4; ++j) { const int n = (lane >> 3) + 8 * j; const LAS float* s = scr + (8 * c) * 33 + n;
        v4u o; o.x = pk2(s[0 * 33], s[1 * 33]); o.y = pk2(s[2 * 33], s[3 * 33]); o.z = pk2(s[4 * 33], s[5 * 33]); o.w = pk2(s[6 * 33], s[7 * 33]);
        *(GAS v4u*)(WT + (dst_row0 + n) * ldk + k0 + 8 * c) = o; }
    asm volatile("s_waitcnt lgkmcnt(0)" ::: "memory");
}
__device__ __forceinline__ void rms_row_to_bf16(const float* xrow, const float* w, bf16* orow, int lane) {
    const GAS pg8::f32x4* xr = (const GAS pg8::f32x4*)xrow + lane; const GAS pg8::f32x4* wr = (const GAS pg8::f32x4*)w + lane;
    pg8::f32x4 v[8]; float s = 0.f;
#pragma unroll
    for (int j = 0; j < 8; ++j) { v[j] = xr[64 * j]; s += (v[j].x * v[j].x + v[j].y * v[j].y) + (v[j].z * v[j].z + v[j].w * v[j].w); }
    const float r = rsqrtf(wave_sum(s) * (1.f / DM) + EPS);
    GAS unsigned long long* o8 = (GAS unsigned long long*)orow + lane;
#pragma unroll
    for (int j = 0; j < 8; ++j) { const pg8::f32x4 g = wr[64 * j];
        o8[64 * j] = (unsigned long long)pk2(v[j].x * r * g.x, v[j].y * r * g.y) | ((unsigned long long)pk2(v[j].z * r * g.z, v[j].w * r * g.w) << 32); }
}

__global__ void __launch_bounds__(NWAVES * 64, 2) fwd(Args args) {
    extern __shared__ __attribute__((aligned(16))) unsigned char lds_raw[];
    LAS unsigned char* lds = (LAS unsigned char*)lds_raw;
    const int tid = threadIdx.x, lane = tid & 63, wave = __builtin_amdgcn_readfirstlane(tid >> 6);
    const int G = gridDim.x; const int bx = blockIdx.x; const int vcu = (G % 8 == 0) ? (bx % 8) * (G / 8) + bx / 8 : bx;
    unsigned char* ws = args.ws;
    unsigned* ctl = (unsigned*)(ws + WS_CTL);
    for (int u = tid; u < (LDS_BYTES - LDSCTL_OFF) / 4; u += NWAVES * 64) ((LAS unsigned*)(lds + LDSCTL_OFF))[u] = 0u;
    __syncthreads();
    XcdBarrier bar = xcd_barrier_post(ctl + CW_BAR + args.li * XCD_BAR_WORDS, (volatile LAS unsigned*)(lds + LDSCTL_OFF + 64));
    static_assert(2 * FFT_BUF_BYTES <= LDSCTL_OFF && 1024 * 33 * 4 <= LDSCTL_OFF, "LDS map");
    const int lo = args.ph_lo, hi = args.ph_hi;
#define IN(k) (lo <= (k) && (k) < hi)
#define BOTH(k) (IN(k) && IN((k) + 1))
    bf16* WinT = (bf16*)(ws + WS_WINT); bf16* Hb = (bf16*)(ws + WS_HB);

    if (IN(0)) {
        LAS float* scr = (LAS float*)(lds + wave * 16384);
        const int gw = vcu * NWAVES + wave, NGW = G * NWAVES;
        const float* w_in = args.in[2];
        for (int it = gw; it < 32 * 225; it += NGW) { const int kb = it / 225, nb = it % 225; tr_item(w_in, NPROJ, 64 * kb, 32 * nb, WinT, (size_t)(32 * nb), DM, scr, lane); }
        for (int r = gw; r < NPROJ_PAD - NPROJ; r += NGW) { GAS v4u* o = (GAS v4u*)(WinT + (size_t)(NPROJ + r) * DM) + lane;
#pragma unroll
            for (int j = 0; j < 4; ++j) o[64 * j] = (v4u){0u, 0u, 0u, 0u}; }
        { bf16* WoutT = (bf16*)(ws + WS_WOUTT); const float* w_out = args.in[21];
          for (int it = gw; it < 32 * 64; it += NGW) { const int kb = it >> 6, nb = it & 63; tr_item(w_out, DM, 64 * kb, 32 * nb, WoutT, (size_t)(32 * nb), DM, scr, lane); } }
        { bf16* W13T = (bf16*)(ws + WS_W13T); bf16* W2T = (bf16*)(ws + WS_W2T);
          const float* ew1 = args.in[27]; const float* ew3 = args.in[28]; const float* ew2 = args.in[29];
          for (int it = gw; it < 3 * 32768; it += NGW) {
              const int which = it >> 15, r = it & 32767, e = r >> 9, q = r & 511;
              if (which < 2) { const int kb = q >> 4, nb = q & 15, n0 = 32 * nb;
                  tr_item((which ? ew3 : ew1) + (size_t)e * DM * DE, DE, 64 * kb, n0, W13T, (size_t)e * 1024 + (n0 >> 7) * 256 + which * 128 + (n0 & 127), DM, scr, lane); }
              else { const int kb = q >> 6, nb = q & 63;
                  tr_item(ew2 + (size_t)e * DE * DM, DM, 64 * kb, 32 * nb, W2T, (size_t)e * DM + 32 * nb, DE, scr, lane); }
          } }
        for (int it = bx; it < 256; it += G)
            hyena_filter_item(lds, it, args.in[5], args.in[6], args.in[7], args.in[8], args.in[9], args.in[10], args.in[11], args.in[12], (float*)(ws + WS_KC), tid, lane, wave);
        for (int m = gw; m < T; m += NGW) rms_row_to_bf16(args.in[0] + (size_t)m * DM, args.in[1], Hb + (size_t)m * DM, lane);
        if (BOTH(0)) xcd_barrier(bar);
    }
    if (IN(1)) {
        Order1 S{(const char*)Hb, (const char*)WinT, G, bx};
        Epi1 E{(bf16*)(ws + WS_PG), (float*)(ws + WS_PGATE), (float*)(ws + WS_PT)};
        pg8::gemm_phase<Epi1, Order1, false>(lds, DM, S, E);
        if (BOTH(1)) xcd_barrier(bar);
    }
    if (IN(2)) {
        hyena_phase(lds, (const float*)(ws + WS_PT), (const float*)(ws + WS_KC), args.in[3], args.in[4], args.in[13], (float*)(ws + WS_YHT), G, vcu);
        for (int wg = bx; wg < 256; wg += G) {
            gdn_pre(lds, wg, (const bf16*)(ws + WS_PG), (const float*)(ws + WS_PGATE), args.in[15], args.in[16], args.in[17], args.in[18], args.in[19], ws, tid, lane, wave);
            gdn_prep_wave(lds, wg, ws, lane, wave);
            __syncthreads();
        }
        if (BOTH(2)) xcd_barrier(bar);
    }
    if (IN(3)) {
        if (vcu < 64) gdn_scan(lds, ws, (float*)(ws + WS_OF), (float*)(ws + WS_OB), vcu, tid, lane, wave);
        if (BOTH(3)) xcd_barrier(bar);
    }
    if (IN(4)) {
        for (int tile = bx; tile < T / 32; tile += G) hyena_post_tile(lds, tile, (const float*)(ws + WS_YHT), args.in[14], (bf16*)(ws + WS_A2), tid, lane, wave);
        if (BOTH(4)) xcd_barrier(bar);
    }
    if (IN(5)) {
        Order2 S{(const char*)(ws + WS_A2), (const char*)(ws + WS_WOUTT), G, bx};
        Epi2 E{args.in[0], (float*)(ws + WS_X1)};
        pg8::gemm_phase<Epi2, Order2, false>(lds, DM, S, E);
        if (BOTH(5)) xcd_barrier(bar);
    }
    const int* slot_tok = (const int*)(ws + WS_SMALL + SM_SLOTTOK); const int* blk_exp = (const int*)(ws + WS_SMALL + SM_BLKEXP); const int* nblk_p = (const int*)(ws + WS_SMALL + SM_NBLK);
    if (IN(8)) {
        const int nblk = __hip_atomic_load(nblk_p, __ATOMIC_RELAXED, __HIP_MEMORY_SCOPE_AGENT);
        Order3 S{(const char*)(ws + WS_UB), (const char*)(ws + WS_W13T), slot_tok, blk_exp, nblk * 4, G, vcu};
        Epi3 E{(bf16*)(ws + WS_HH)};
        pg8::gemm_phase<Epi3, Order3, true>(lds, DM, S, E);
        if (BOTH(8)) xcd_barrier(bar);
    }
    if (IN(9)) {
        const int nblk = __hip_atomic_load(nblk_p, __ATOMIC_RELAXED, __HIP_MEMORY_SCOPE_AGENT);
        Order4 S{(const char*)(ws + WS_HH), (const char*)(ws + WS_W2T), blk_exp, nblk * 8, G, vcu};
        Epi4 E{(bf16*)(ws + WS_Y)};
        pg8::gemm_phase<Epi4, Order4, false>(lds, DE, S, E);
        if (BOTH(9)) xcd_barrier(bar);
    }
#undef IN
#undef BOTH
}

__global__ void k_rmsnorm(const float* __restrict__ x, const float* __restrict__ w, float* __restrict__ out, int D, int ldo, int rows) {
    const int row = blockIdx.x * 4 + (threadIdx.x >> 6), lane = threadIdx.x & 63;
    if (row >= rows) return;
    const float* xr = x + (size_t)row * D;
    float s = 0.f;
    for (int i = lane; i < D; i += 64) { float v = xr[i]; s += v * v; }
    s = wave_sum(s);
    const float r = rsqrtf(s / D + EPS);
    for (int i = lane; i < D; i += 64) out[(size_t)row * ldo + i] = xr[i] * r * w[i];
}
__global__ void k_rmsnorm_bf16(const float* __restrict__ x, const float* __restrict__ w, bf16* __restrict__ out, int D, int ldo, int rows) {
    const int row = blockIdx.x * 4 + (threadIdx.x >> 6), lane = threadIdx.x & 63;
    if (row >= rows) return;
    const float* xr = x + (size_t)row * D;
    float s = 0.f;
    for (int i = lane; i < D; i += 64) { float v = xr[i]; s += v * v; }
    s = wave_sum(s);
    const float r = rsqrtf(s / D + EPS);
    for (int i = lane; i < D; i += 64) out[(size_t)row * ldo + i] = (bf16)f2bf(xr[i] * r * w[i]);
}
template <int MODE>
__global__ void __launch_bounds__(256) k_sgemm(const float* __restrict__ A, int lda, const int* __restrict__ rowidx,
                                               const float* __restrict__ B, int ldb, float* __restrict__ C, int ldc,
                                               int M, int N, int K, const float* __restrict__ R,
                                               const int* __restrict__ blk_expert, size_t strideB, const int* __restrict__ nblk) {
    __shared__ float As[16][64 + 4];
    __shared__ float Bs[16][64 + 4];
    const int tm = blockIdx.y * 64, tn = blockIdx.x * 64;
    if (nblk && (tm / RB) >= *nblk) return;
    if (blk_expert) B += (size_t)blk_expert[tm / RB] * strideB;
    const int tid = threadIdx.x, tx = tid & 15, ty = tid >> 4;
    float acc[4][4];
#pragma unroll
    for (int i = 0; i < 4; ++i)
#pragma unroll
        for (int j = 0; j < 4; ++j) acc[i][j] = 0.f;
    const int ar = tid >> 2, ak = (tid & 3) * 4;
    int arow = tm + ar; const bool arow_ok = arow < M;
    if (arow_ok && rowidx) arow = rowidx[arow];
    const float* Ap = A + (size_t)(arow_ok ? arow : 0) * lda;
    const int bk = tid >> 4, bn = (tid & 15) * 4;
    for (int k0 = 0; k0 < K; k0 += 16) {
#pragma unroll
        for (int j = 0; j < 4; ++j) { const int kk = k0 + ak + j; As[ak + j][ar] = (arow_ok && kk < K) ? Ap[kk] : 0.f; }
#pragma unroll
        for (int j = 0; j < 4; ++j) { const int nn = tn + bn + j, kk = k0 + bk; Bs[bk][bn + j] = (nn < N && kk < K) ? B[(size_t)kk * ldb + nn] : 0.f; }
        __syncthreads();
#pragma unroll
        for (int kk = 0; kk < 16; ++kk) {
            float a[4], b[4];
#pragma unroll
            for (int i = 0; i < 4; ++i) a[i] = As[kk][ty * 4 + i];
#pragma unroll
            for (int j = 0; j < 4; ++j) b[j] = Bs[kk][tx * 4 + j];
#pragma unroll
            for (int i = 0; i < 4; ++i)
#pragma unroll
                for (int j = 0; j < 4; ++j) acc[i][j] = fmaf(a[i], b[j], acc[i][j]);
        }
        __syncthreads();
    }
#pragma unroll
    for (int i = 0; i < 4; ++i) {
        const int r = tm + ty * 4 + i; if (r >= M) continue;
#pragma unroll
        for (int j = 0; j < 4; ++j) {
            const int c = tn + tx * 4 + j; if (c >= N) continue;
            const size_t o = (size_t)r * ldc + c;
            float v = acc[i][j];
            if (MODE == 1) v += R[o];
            if (MODE == 2) v = silu_f(C[o]) * v;
            C[o] = v;
        }
    }
}
__global__ void __launch_bounds__(256) k_hy_filter(const float* __restrict__ w1, const float* __restrict__ b1, const float* __restrict__ w2, const float* __restrict__ b2,
                                                   const float* __restrict__ w3, const float* __restrict__ b3, const float* __restrict__ w4, const float* __restrict__ freq,
                                                   float* __restrict__ KK) {
    __shared__ float z[33], ha[64], hb[64];
    const int l = blockIdx.x, tid = threadIdx.x;
    const float t = (float)l / (float)(LSEQ - 1);
    if (tid == 0) z[0] = t;
    if (tid < 16) {
        const float omega = (2.0f * 3.14159265358979323846f / (float)LSEQ) * (float)l;
        const float fb = 1e-4f + (float)tid * ((15.0f - 1e-4f) / 15.0f);
        const float ang = omega * fb;
        z[1 + tid] = cosf(ang); z[17 + tid] = -sinf(ang);
    }
    __syncthreads();
    if (tid < 64) { float s = b1[tid]; for (int i = 0; i < 33; ++i) s += z[i] * w1[i * 64 + tid]; ha[tid] = sinf(freq[tid] * s); }
    __syncthreads();
    if (tid < 64) { float s = b2[tid]; for (int i = 0; i < 64; ++i) s += ha[i] * w2[i * 64 + tid]; hb[tid] = sinf(freq[tid] * s); }
    __syncthreads();
    if (tid < 64) { float s = b3[tid]; for (int i = 0; i < 64; ++i) s += hb[i] * w3[i * 64 + tid]; ha[tid] = sinf(freq[tid] * s); }
    __syncthreads();
    const float max_decay = logf(1e-2f) / 0.3f, min_decay = logf(1e-2f) / 1.5f;
    for (int c = tid; c < DHY; c += 256) {
        float sf = 0.f, sb = 0.f;
        for (int i = 0; i < 64; ++i) { sf += ha[i] * w4[i * 2048 + c]; sb += ha[i] * w4[i * 2048 + 1024 + c]; }
        const float delta = fabsf(min_decay + (float)c * ((max_decay - min_decay) / (float)(DHY - 1)));
        const float win = expf(-t * delta);
        sf *= win; sb *= win;
        if (l == 0) KK[(size_t)4095 * DHY + c] = sf + sb;
        else { KK[(size_t)(4095 + l) * DHY + c] = sf; KK[(size_t)(4095 - l) * DHY + c] = sb; }
    }
}
__global__ void k_hy_pre(const float* __restrict__ PT, const float* __restrict__ cw, const float* __restrict__ cb, float* __restrict__ X0, float* __restrict__ VG) {
    const size_t i = (size_t)blockIdx.x * 256 + threadIdx.x;
    const int c = (int)(i & 1023), tok = (int)(i >> 10), l = tok & (LSEQ - 1);
    float r[3];
#pragma unroll
    for (int part = 0; part < 3; ++part) {
        const int ch = part * 1024 + c;
        float s = cb[ch] + cw[1 * 3072 + ch] * PT[(size_t)ch * T + tok];
        if (l > 0) s += cw[0 * 3072 + ch] * PT[(size_t)ch * T + tok - 1];
        if (l < LSEQ - 1) s += cw[2 * 3072 + ch] * PT[(size_t)ch * T + tok + 1];
        r[part] = s;
    }
    X0[i] = r[0]; VG[i] = r[2] * r[1];
}
__global__ void __launch_bounds__(256) k_hy_conv(const float* __restrict__ KK, const float* __restrict__ VG, const float* __restrict__ X0, const float* __restrict__ skip, float* __restrict__ YH) {
    const int c = blockIdx.x * 256 + threadIdx.x;
    const int t0 = blockIdx.y * 8, b = blockIdx.z;
    float acc[8];
#pragma unroll
    for (int j = 0; j < 8; ++j) acc[j] = 0.f;
    float kk[8];
#pragma unroll
    for (int j = 0; j < 8; ++j) kk[j] = KK[(size_t)(t0 + j + 4095) * DHY + c];
    const float* vg = VG + (size_t)b * LSEQ * DHY + c;
    for (int s = 0; s < LSEQ; s += 8) {
#pragma unroll
        for (int u = 0; u < 8; ++u) {
            const float v = vg[(size_t)(s + u) * DHY];
#pragma unroll
            for (int j = 0; j < 8; ++j) acc[j] = fmaf(kk[(j - u) & 7], v, acc[j]);
            const int nl = t0 - (s + u + 1) + 4095;
            kk[(7 - u) & 7] = (nl >= 0) ? KK[(size_t)nl * DHY + c] : 0.f;
        }
    }
#pragma unroll
    for (int j = 0; j < 8; ++j) {
        const size_t o = ((size_t)b * LSEQ + t0 + j) * DHY + c;
        YH[o] = (acc[j] + VG[o] * skip[c]) * X0[o];
    }
}

__global__ void __launch_bounds__(256) k_gdn_post(const float* __restrict__ OF, const float* __restrict__ OB, const bf16* __restrict__ PG, const float* __restrict__ nw, bf16* __restrict__ A2) {
    const int w = blockIdx.x * 4 + (threadIdx.x >> 6), lane = threadIdx.x & 63;
    const int tok = w >> 3, h = w & 7;
    const size_t o = (size_t)tok * DGD + h * 128 + lane * 2;
    const float o0 = OF[o] + OB[o], o1 = OF[o + 1] + OB[o + 1];
    const float r = rsqrtf(wave_sum(o0 * o0 + o1 * o1) / 128.f + EPS);
    const bf16* z = PG + (size_t)tok * 4096 + 3072 + h * 128 + lane * 2;
    A2[(size_t)tok * DM + 1024 + h * 128 + lane * 2] = (bf16)f2bf(o0 * r * nw[lane * 2] * silu_f(bf2f(z[0])));
    A2[(size_t)tok * DM + 1024 + h * 128 + lane * 2 + 1] = (bf16)f2bf(o1 * r * nw[lane * 2 + 1] * silu_f(bf2f(z[1])));
}
__global__ void k_route(const float* __restrict__ logits, const float* __restrict__ gbias, const float* __restrict__ ebias, int* __restrict__ eid, float* __restrict__ gate, int* __restrict__ pos, int* __restrict__ cnt) {
    const int t = blockIdx.x * 256 + threadIdx.x; if (t >= T) return;
    const float* lg = logits + (size_t)t * 72;
    float g[8]; int gi = 0; float gm = -INFINITY;
#pragma unroll
    for (int i = 0; i < 8; ++i) { g[i] = lg[i] + gbias[i]; if (g[i] > gm) { gm = g[i]; gi = i; } }
    float gs = 0.f;
#pragma unroll
    for (int i = 0; i < 8; ++i) gs += expf(g[i] - gm);
    const float ggate = 1.f / gs;
    float e[8]; float em = -INFINITY;
#pragma unroll
    for (int i = 0; i < 8; ++i) { e[i] = lg[8 + gi * 8 + i] + ebias[gi * 8 + i]; em = fmaxf(em, e[i]); }
    float es = 0.f; float p[8];
#pragma unroll
    for (int i = 0; i < 8; ++i) { p[i] = expf(e[i] - em); es += p[i]; }
    int i1 = 0; float p1 = -1.f;
#pragma unroll
    for (int i = 0; i < 8; ++i) if (p[i] > p1) { p1 = p[i]; i1 = i; }
    int i2 = 0; float p2 = -1.f;
#pragma unroll
    for (int i = 0; i < 8; ++i) if (i != i1 && p[i] > p2) { p2 = p[i]; i2 = i; }
    const float q1 = p1 / es, q2 = p2 / es, qs = q1 + q2;
    const int e1 = gi * 8 + i1, e2 = gi * 8 + i2;
    eid[t * 2] = e1; eid[t * 2 + 1] = e2;
    gate[t * 2] = ggate * (q1 / qs); gate[t * 2 + 1] = ggate * (q2 / qs);
    pos[t * 2] = atomicAdd(&cnt[e1], 1); pos[t * 2 + 1] = atomicAdd(&cnt[e2], 1);
}
__global__ void k_scan(const int* __restrict__ cnt, int* __restrict__ slot_tok, int* __restrict__ blk_exp, int* __restrict__ pad_start, int* __restrict__ nblk) {
    __shared__ int ps[NE + 1];
    if (threadIdx.x == 0) { int s = 0; for (int e = 0; e < NE; ++e) { ps[e] = s; s += (cnt[e] + RB - 1) / RB * RB; } ps[NE] = s; }
    __syncthreads();
    const int b = blockIdx.x;
    slot_tok[b * RB + threadIdx.x] = T;
    if (threadIdx.x == 0) {
        int e = NE - 1;
        for (int i = 0; i < NE; ++i) if (b * RB >= ps[i] && b * RB < ps[i + 1]) { e = i; break; }
        blk_exp[b] = e;
        if (b == 0) { *nblk = ps[NE] / RB; for (int i = 0; i < NE; ++i) pad_start[i] = ps[i]; }
    }
}
__global__ void k_fill(const int* __restrict__ eid, const int* __restrict__ pos, const int* __restrict__ pad_start, int* __restrict__ slot_tok, int* __restrict__ tslot) {
    const int i = blockIdx.x * 256 + threadIdx.x; if (i >= T * 2) return;
    const int s = pad_start[eid[i]] + pos[i];
    slot_tok[s] = i >> 1; tslot[i] = s;
}
__global__ void __launch_bounds__(256) k_final(const float* __restrict__ X1, const bf16* __restrict__ Y, const int* __restrict__ tslot, const float* __restrict__ gate, const float* __restrict__ fw, float* __restrict__ out) {
    const int t = blockIdx.x * 4 + (threadIdx.x >> 6), lane = threadIdx.x & 63;
    const int s1 = tslot[t * 2], s2 = tslot[t * 2 + 1]; const float g1 = gate[t * 2], g2 = gate[t * 2 + 1];
    float v[32]; float ss = 0.f;
#pragma unroll
    for (int j = 0; j < 32; ++j) {
        const int c = lane + 64 * j;
        float y = g1 * bf2f(Y[(size_t)s1 * DM + c]); y += g2 * bf2f(Y[(size_t)s2 * DM + c]);
        v[j] = X1[(size_t)t * DM + c] + y; ss += v[j] * v[j];
    }
    const float r = rsqrtf(wave_sum(ss) / DM + EPS);
#pragma unroll
    for (int j = 0; j < 32; ++j) { const int c = lane + 64 * j; out[(size_t)t * DM + c] = v[j] * r * fw[c]; }
}
__global__ void k_zero(float* p, int n) { const int i = blockIdx.x * 256 + threadIdx.x; if (i < n) p[i] = 0.f; }
__global__ void k_zero16(bf16* p, int n) { const int i = blockIdx.x * 256 + threadIdx.x; if (i < n) p[i] = 0; }

extern "C" void kernel_launch(void* const* d_in, const int* in_sizes, int n_in, void* d_out, int out_size, void* d_ws, size_t ws_size, hipStream_t stream) {
    static int grid = 0;
    if (grid == 0) {
        int dev = 0, cus = 0;
        (void)hipGetDevice(&dev); (void)hipDeviceGetAttribute(&cus, hipDeviceAttributeMultiprocessorCount, dev);
        (void)hipFuncSetAttribute((const void*)fwd, hipFuncAttributeMaxDynamicSharedMemorySize, LDS_BYTES);
        int per_cu = 0; (void)hipOccupancyMaxActiveBlocksPerMultiprocessor(&per_cu, (const void*)fwd, NWAVES * 64, LDS_BYTES);
        (void)hipGetLastError();
        grid = cus > 0 ? cus : 256;
    }
    const float* x = (const float*)d_in[0];
    const float* hy_conv_w = (const float*)d_in[3]; const float* hy_conv_b = (const float*)d_in[4];
    const float* fw1 = (const float*)d_in[5]; const float* fb1 = (const float*)d_in[6]; const float* fw2 = (const float*)d_in[7]; const float* fb2 = (const float*)d_in[8];
    const float* fw3 = (const float*)d_in[9]; const float* fb3 = (const float*)d_in[10]; const float* fw4 = (const float*)d_in[11]; const float* sfreq = (const float*)d_in[12];
    const float* hy_skip = (const float*)d_in[13]; const float* hy_norm_w = (const float*)d_in[14]; const float* gdn_conv_w = (const float*)d_in[15];
    const float* alf = (const float*)d_in[16]; const float* alb = (const float*)d_in[17]; const float* dtf = (const float*)d_in[18]; const float* dtb = (const float*)d_in[19];
    const float* gdn_norm_w = (const float*)d_in[20]; const float* w_out = (const float*)d_in[21]; const float* norm2_w = (const float*)d_in[22];
    const float* rg_w = (const float*)d_in[23]; const float* rg_b = (const float*)d_in[24]; const float* re_w = (const float*)d_in[25]; const float* re_b = (const float*)d_in[26];
    const float* ew1 = (const float*)d_in[27]; const float* ew3 = (const float*)d_in[28]; const float* ew2 = (const float*)d_in[29]; const float* final_w = (const float*)d_in[30];
    float* out = (float*)d_out;
    char* ws = (char*)d_ws;
    int* cnt = (int*)(ws + WS_CTL) + CW_CNT;
    char* sm = ws + WS_SMALL;
    float* logits = (float*)(sm + SM_LOGITS); float* GB = (float*)(sm + SM_GB); int* eid = (int*)(sm + SM_EID); float* gate = (float*)(sm + SM_GATE);
    int* pos = (int*)(sm + SM_POS); int* tslot = (int*)(sm + SM_TSLOT); int* slot_tok = (int*)(sm + SM_SLOTTOK); int* blk_exp = (int*)(sm + SM_BLKEXP);
    int* pad_start = (int*)(sm + SM_PADSTART); int* nblk = (int*)(sm + SM_NBLK);
    float* PT = (float*)(ws + WS_PT); bf16* PG = (bf16*)(ws + WS_PG); float* PGATE = (float*)(ws + WS_PGATE);
    float* OF = (float*)(ws + WS_OF); float* OB = (float*)(ws + WS_OB);
    bf16* A2 = (bf16*)(ws + WS_A2); float* X1 = (float*)(ws + WS_X1); float* U = (float*)(ws + WS_U); bf16* Ub = (bf16*)(ws + WS_UB); bf16* Y = (bf16*)(ws + WS_Y);

    (void)hipMemsetAsync(ws + WS_CTL, 0, CTL_ZERO_BYTES, stream);
    Args a{};
    for (int i = 0; i < 31; ++i) a.in[i] = (const float*)d_in[i];
    a.out = out; a.ws = (unsigned char*)d_ws; a.ph_lo = 0; a.ph_hi = 2; a.li = 0;
    hipLaunchKernelGGL(fwd, dim3(grid), dim3(NWAVES * 64), LDS_BYTES, stream, a);
    a.ph_lo = 2; a.ph_hi = 3; a.li = 3;
    hipLaunchKernelGGL(fwd, dim3(grid), dim3(NWAVES * 64), LDS_BYTES, stream, a);
    a.ph_lo = 4; a.ph_hi = 5; a.li = 4;
    hipLaunchKernelGGL(fwd, dim3(grid), dim3(NWAVES * 64), LDS_BYTES, stream, a);
    a.ph_lo = 3; a.ph_hi = 4; a.li = 5;
    hipLaunchKernelGGL(fwd, dim3(grid), dim3(NWAVES * 64), LDS_BYTES, stream, a);
    k_gdn_post<<<T * 8 / 4, 256, 0, stream>>>(OF, OB, PG, gdn_norm_w, A2);
    a.ph_lo = 5; a.ph_hi = 6; a.li = 1;
    hipLaunchKernelGGL(fwd, dim3(grid), dim3(NWAVES * 64), LDS_BYTES, stream, a);
    k_rmsnorm<<<T / 4, 256, 0, stream>>>(X1, norm2_w, U, DM, DM, T);
    k_rmsnorm_bf16<<<T / 4, 256, 0, stream>>>(X1, norm2_w, Ub, DM, DM, T);
    k_zero16<<<DM / 256, 256, 0, stream>>>(Ub + (size_t)T * DM, DM);
    k_sgemm<0><<<dim3(1, T / 64), 256, 0, stream>>>(U, DM, nullptr, rg_w, NG, logits, 72, T, NG, DM, nullptr, nullptr, 0, nullptr);
    k_sgemm<0><<<dim3(1, T / 64), 256, 0, stream>>>(U, DM, nullptr, re_w, NE, logits + 8, 72, T, NE, DM, nullptr, nullptr, 0, nullptr);
    k_route<<<T / 256, 256, 0, stream>>>(logits, rg_b, re_b, eid, gate, pos, cnt);
    k_scan<<<NBLK_MAX, 256, 0, stream>>>(cnt, slot_tok, blk_exp, pad_start, nblk);
    k_fill<<<T * 2 / 256, 256, 0, stream>>>(eid, pos, pad_start, slot_tok, tslot);
    a.ph_lo = 8; a.ph_hi = 10; a.li = 2;
    hipLaunchKernelGGL(fwd, dim3(grid), dim3(NWAVES * 64), LDS_BYTES, stream, a);
    k_final<<<T / 4, 256, 0, stream>>>(X1, Y, tslot, gate, final_w, out);
}
```

```cpp
#include <hip/hip_runtime.h>
#include <cstdio>
#include <cstdint>
#include <cmath>

constexpr int BATCH = 2, LSEQ = 4096, DM = 2048, T = BATCH * LSEQ;
constexpr int DHY = 1024, DGD = 1024, NH = 8, HD = 128;
constexpr int NPROJ = 3 * DHY + 4 * DGD + 4 * NH;
constexpr int GOFF = 3 * DHY;
constexpr int NPROJ_PAD = 7424;
constexpr int NG = 8, EPG = 8, NE = 64, DE = 512;
constexpr int RB = 256, PMAX = 32768, NBLK_MAX = 128;
constexpr float EPS = 1e-6f;

constexpr size_t MiB = 1u << 20;
constexpr size_t WS_CTL = 0;
constexpr size_t CTL_ZERO_BYTES = 1 * MiB;
constexpr size_t WS_SMALL = 2 * MiB;
constexpr size_t WS_WINT = 16 * MiB;
constexpr size_t WS_WOUTT = 608 * MiB;
constexpr size_t WS_HB = 56 * MiB;
constexpr size_t WS_PT = 88 * MiB;
constexpr size_t WS_PG = 184 * MiB;
constexpr size_t WS_PGATE = 248 * MiB;
constexpr size_t WS_A2 = 250 * MiB;
constexpr size_t WS_KC = 282 * MiB;
constexpr size_t WS_YHT = 314 * MiB;
constexpr size_t WS_X0 = 314 * MiB, WS_VG = 346 * MiB, WS_YH = 378 * MiB;
constexpr size_t WS_QN = 16 * MiB, WS_KN = 32 * MiB, WS_KT = 48 * MiB, WS_VT = 64 * MiB;
constexpr size_t WS_V = 346 * MiB, WS_OF = 378 * MiB, WS_OB = 410 * MiB;
constexpr size_t GW_B = 64 * 272, GKDT_B = 128 * 144, GQK_B = 64 * 144, GUT_B = 128 * 128;
constexpr size_t WS_GW = 442 * MiB;
constexpr size_t WS_GQD = WS_GW + 2048 * GW_B;
constexpr size_t WS_GKDT = WS_GQD + 2048 * GW_B;
constexpr size_t WS_GQK = WS_GKDT + 2048 * GKDT_B;
constexpr size_t WS_GUT = WS_GQK + 2048 * GQK_B;
constexpr size_t WS_GCD = WS_GUT + 2048 * GUT_B + 4096;
static_assert(WS_GCD + 2048 * 4 <= 640 * MiB, "ws map");
constexpr size_t WS_W13T = 640 * MiB;
constexpr size_t WS_W2T = 896 * MiB;
constexpr size_t WS_X1 = 282 * MiB;
constexpr size_t WS_U = 346 * MiB;
constexpr size_t WS_UB = 412 * MiB;
constexpr size_t WS_HH = 446 * MiB;
constexpr size_t WS_Y = 88 * MiB;
constexpr int CW_CNT = 0;
constexpr int CW_BAR = 4096;
constexpr size_t SM_LOGITS = 0;
constexpr size_t SM_GB = SM_LOGITS + (size_t)T * 72 * 4;
constexpr size_t SM_EID = SM_GB + (size_t)4 * T * 8 * 4;
constexpr size_t SM_GATE = SM_EID + (size_t)T * 2 * 4;
constexpr size_t SM_POS = SM_GATE + (size_t)T * 2 * 4;
constexpr size_t SM_TSLOT = SM_POS + (size_t)T * 2 * 4;
constexpr size_t SM_SLOTTOK = SM_TSLOT + (size_t)T * 2 * 4;
constexpr size_t SM_BLKEXP = SM_SLOTTOK + (size_t)PMAX * 4;
constexpr size_t SM_PADSTART = SM_BLKEXP + NBLK_MAX * 4;
constexpr size_t SM_NBLK = SM_PADSTART + NE * 4;
constexpr size_t SM_RWT = (SM_NBLK + 256 + 255) / 256 * 256;
static_assert(SM_RWT + 2 * 80 * 2048 * 2 <= 14 * MiB, "small region");

#define LAS __attribute__((address_space(3)))
#define GAS __attribute__((address_space(1)))
typedef unsigned short bf16;
typedef unsigned v4u __attribute__((ext_vector_type(4)));

__device__ __forceinline__ float wave_sum(float v) {
#pragma unroll
    for (int o = 1; o < 64; o <<= 1) v += __shfl_xor(v, o);
    return v;
}
__device__ __forceinline__ float silu_f(float x) { return x / (1.f + expf(-x)); }
__device__ __forceinline__ float sigmoid_f(float x) { return 1.f / (1.f + expf(-x)); }
__device__ __forceinline__ float softplus_f(float x) { return fmaxf(x, 0.f) + log1pf(expf(-fabsf(x))); }
__device__ __forceinline__ unsigned f2bf(float f) { unsigned u = __builtin_bit_cast(unsigned, f); return (u + 0x7fffu + ((u >> 16) & 1u)) >> 16; }
__device__ __forceinline__ unsigned pk2(float lo, float hi) { return f2bf(lo) | (f2bf(hi) << 16); }
__device__ __forceinline__ float bf2f(bf16 b) { return __builtin_bit_cast(float, ((unsigned)b) << 16); }

constexpr int LDSCTL_OFF_C = 147456 - 256;
namespace pg8 {
#define PG8_LAS __attribute__((address_space(3)))
typedef unsigned short bf16_t;
typedef short bf16x8 __attribute__((ext_vector_type(8)));
typedef float f32x4 __attribute__((ext_vector_type(4)));
typedef unsigned u32x4 __attribute__((ext_vector_type(4)));
constexpr int BM = 256, BK = 64, HALF = 128, HTB = HALF * BK * 2  , STAGE_BYTES = 8 * HTB, NXCD = 8, WGM = 8;

__host__ __device__ __forceinline__ int lds_byte(int r, int c) { const int st = (r >> 4) * 2 + (c >> 5), rr = r & 15, cc = c & 31, ob = rr * 64 + cc * 2; return st * 1024 + (ob ^ (((ob >> 9) & 1) << 5)); }
__host__ __device__ __forceinline__ void stage_rc(int b, int& R, int& C) { const int st = b / 1024, sb = b % 1024, swz = sb ^ (((sb >> 9) & 1) << 5); R = (st >> 1) * 16 + swz / 64; C = (st & 1) * 32 + (swz % 64) / 2; }
__host__ __device__ __forceinline__ int perm32(int rho) { const int n = rho >> 4, i = rho & 15; return 8 * (i >> 2) + 4 * n + (i & 3); }

struct Unit { const char* A; const char* B; const int* rows; int pm, pn, kind; };

__device__ __forceinline__ void tile_of(int L, int nM, int nN, int& pm, int& pn) {
    const int nwg = nM * nN;
    int wgid = L; { const int q = nwg / NXCD, r = nwg % NXCD, xcd = wgid % NXCD, off = wgid / NXCD; wgid = (xcd < r ? xcd * (q + 1) : r * (q + 1) + (xcd - r) * q) + off; }
    const int nig = WGM * nN, gid = wgid / nig, fm = gid * WGM, gsz = (nM - fm) < WGM ? (nM - fm) : WGM;
    pm = fm + ((wgid % nig) % gsz); pn = (wgid % nig) / gsz;
}

typedef float cvt_f2 __attribute__((ext_vector_type(2)));
typedef __bf16 cvt_b2 __attribute__((ext_vector_type(2)));
__device__ __forceinline__ unsigned cvt_pk_bf16(float lo, float hi) { const cvt_f2 f = {lo, hi}; const cvt_b2 v = __builtin_convertvector(f, cvt_b2); return __builtin_bit_cast(unsigned, v); }

template <class Epi, class Sched, bool GATHER>
__device__ __forceinline__ void gemm_phase(PG8_LAS unsigned char* lds, const int K, const Sched& S, const Epi& E) {
    const int tid = threadIdx.x, wid = __builtin_amdgcn_readfirstlane(tid >> 6), lane = tid & 63, wr = wid >> 2, wc = wid & 3, fr = lane & 15, fq = lane >> 4;
    const int nt = K / BK;
    int Rr[2], Cc[2];
    unsigned voffB[2];
#pragma unroll
    for (int i = 0; i < 2; ++i) { stage_rc(tid * 16 + i * 8192, Rr[i], Cc[i]); const int Rb = (Rr[i] & ~31) + perm32(Rr[i] & 31); voffB[i] = (unsigned)(Rb * K + Cc[i]) * 2u; }
    const size_t kstep = (size_t)(BK * 2);
    const size_t hstep = (size_t)HALF * K * 2;
    const unsigned ldsw = (unsigned)wid * 1024u;
    const int aoff = lds_byte(wr * 64 + fr, fq * 8), boff = lds_byte(wc * 32 + fr, fq * 8);
#define PG8_SA(b, h) (((b) * 2 + (h)) * HTB)
#define PG8_SB(b, h) ((4 + (b) * 2 + (h)) * HTB)
#define PG8_STAGE2(bufoff, gbase, v0, v1) do { \
        __builtin_amdgcn_global_load_lds((const unsigned*)((const char*)(gbase) + (v0)), (PG8_LAS unsigned*)(lds + (bufoff) + ldsw), 16, 0, 0); \
        __builtin_amdgcn_global_load_lds((const unsigned*)((const char*)(gbase) + (v1)), (PG8_LAS unsigned*)(lds + (bufoff) + ldsw + 8192), 16, 0, 0); } while (0)
#define PG8_STAGEB(bufoff, gbase) PG8_STAGE2(bufoff, gbase, voffB[0], voffB[1])
#define PG8_LDA(dst, b, h) do { _Pragma("unroll") for (int m = 0; m < 4; ++m) _Pragma("unroll") for (int k = 0; k < 2; ++k) dst[m][k] = *(const PG8_LAS bf16x8*)(lds + PG8_SA(b, h) + aoff + m * 2048 + k * 1024); } while (0)
#define PG8_LDB(dst, b, h) do { _Pragma("unroll") for (int n = 0; n < 2; ++n) _Pragma("unroll") for (int k = 0; k < 2; ++k) dst[n][k] = *(const PG8_LAS bf16x8*)(lds + PG8_SB(b, h) + boff + n * 2048 + k * 1024); } while (0)
#define PG8_MMA(ai, bj, At, Bt) do { __builtin_amdgcn_s_setprio(1); _Pragma("unroll") for (int m = 0; m < 4; ++m) _Pragma("unroll") for (int n = 0; n < 2; ++n) _Pragma("unroll") for (int k = 0; k < 2; ++k) \
        acc[ai][bj][m][n] = __builtin_amdgcn_mfma_f32_16x16x32_bf16(Bt[n][k], At[m][k], acc[ai][bj][m][n], 0, 0, 0); __builtin_amdgcn_s_setprio(0); } while (0)
#define PG8_WAIT_V(n) asm volatile("s_waitcnt vmcnt(" #n ")" ::: "memory")
#define PG8_WAIT_L(n) asm volatile("s_waitcnt lgkmcnt(" #n ")" ::: "memory")
#define PG8_BAR __builtin_amdgcn_s_barrier()
#define PG8_SCHED __builtin_amdgcn_sched_barrier(0)
    Unit cur, nxt; int ui = 0;
    if (!S.next(0, cur)) return;
    f32x4 acc[2][2][4][2];
#pragma unroll
    for (int a = 0; a < 2; ++a)
#pragma unroll
        for (int b = 0; b < 2; ++b)
#pragma unroll
            for (int m = 0; m < 4; ++m)
#pragma unroll
                for (int n = 0; n < 2; ++n) acc[a][b][m][n] = (f32x4){0.f, 0.f, 0.f, 0.f};
    bf16x8 At[4][2], B0[2][2], B1[2][2];
    unsigned c00, c01, c10, c11, n00, n01, n10, n11;
    if constexpr (GATHER) {
        c00 = (unsigned)cur.rows[Rr[0]] * (unsigned)(K * 2) + (unsigned)Cc[0] * 2u; c01 = (unsigned)cur.rows[Rr[1]] * (unsigned)(K * 2) + (unsigned)Cc[1] * 2u;
        c10 = (unsigned)cur.rows[128 + Rr[0]] * (unsigned)(K * 2) + (unsigned)Cc[0] * 2u; c11 = (unsigned)cur.rows[128 + Rr[1]] * (unsigned)(K * 2) + (unsigned)Cc[1] * 2u;
    } else {
        c00 = (unsigned)(Rr[0] * K + Cc[0]) * 2u; c01 = (unsigned)(Rr[1] * K + Cc[1]) * 2u;
        c10 = c00 + (unsigned)hstep; c11 = c01 + (unsigned)hstep;
    }
    n00 = c00; n01 = c01; n10 = c10; n11 = c11;
    const char* cA = cur.A; const char* cB = cur.B;
    PG8_STAGEB(PG8_SB(0, 0), cB); PG8_STAGEB(PG8_SB(0, 1), cB + hstep); PG8_STAGE2(PG8_SA(0, 0), cA, c00, c01); PG8_STAGE2(PG8_SA(0, 1), cA, c10, c11);
    if (wr == 1) PG8_BAR;
    PG8_WAIT_V(2); PG8_BAR;
    PG8_STAGEB(PG8_SB(1, 0), cB + kstep); PG8_STAGE2(PG8_SA(1, 0), cA + kstep, c00, c01); PG8_STAGEB(PG8_SB(1, 1), cB + hstep + kstep);
    PG8_WAIT_V(6); PG8_BAR;
    for (;;) {
        const bool has_next = S.next(ui + 1, nxt);
        const char* nA = has_next ? nxt.A : cA; const char* nB = has_next ? nxt.B : cB;
        if constexpr (GATHER) {
            if (has_next) {
                n00 = (unsigned)nxt.rows[Rr[0]] * (unsigned)(K * 2) + (unsigned)Cc[0] * 2u; n01 = (unsigned)nxt.rows[Rr[1]] * (unsigned)(K * 2) + (unsigned)Cc[1] * 2u;
                n10 = (unsigned)nxt.rows[128 + Rr[0]] * (unsigned)(K * 2) + (unsigned)Cc[0] * 2u; n11 = (unsigned)nxt.rows[128 + Rr[1]] * (unsigned)(K * 2) + (unsigned)Cc[1] * 2u;
            } else { n00 = c00; n01 = c01; n10 = c10; n11 = c11; }
        }
        for (int t = 0; t < nt; t += 2) {
            const bool last = (t == nt - 2);
            const char* a1 = cA + (size_t)(t + 1) * kstep;
            const char* a2 = last ? nA : cA + (size_t)(t + 2) * kstep; const char* b2 = last ? nB : cB + (size_t)(t + 2) * kstep;
            const char* a3 = a2 + kstep; const char* b3 = b2 + kstep;
            unsigned e00, e01, e10, e11;
            if constexpr (GATHER) { e00 = last ? n00 : c00; e01 = last ? n01 : c01; e10 = last ? n10 : c10; e11 = last ? n11 : c11; } else { e00 = c00; e01 = c01; e10 = c10; e11 = c11; }
            PG8_LDB(B0, 0, 0); PG8_LDB(B1, 0, 1); PG8_SCHED; PG8_LDA(At, 0, 0); PG8_STAGE2(PG8_SA(1, 1), a1, c10, c11);
            PG8_WAIT_V(8); PG8_WAIT_L(0); PG8_BAR; PG8_MMA(0, 0, At, B0); PG8_MMA(0, 1, At, B1); PG8_BAR; PG8_SCHED;
            PG8_LDA(At, 0, 1); PG8_STAGEB(PG8_SB(0, 0), b2); PG8_STAGEB(PG8_SB(0, 1), b2 + hstep); PG8_STAGE2(PG8_SA(0, 0), a2, e00, e01);
            PG8_WAIT_V(8); PG8_WAIT_L(0); PG8_BAR; PG8_MMA(1, 0, At, B0); PG8_MMA(1, 1, At, B1); PG8_BAR; PG8_SCHED;
            PG8_LDB(B0, 1, 0); PG8_LDB(B1, 1, 1); PG8_SCHED; PG8_LDA(At, 1, 0); PG8_STAGE2(PG8_SA(0, 1), a2, e10, e11);
            PG8_WAIT_V(8); PG8_WAIT_L(0); PG8_BAR; PG8_MMA(0, 0, At, B0); PG8_MMA(0, 1, At, B1); PG8_BAR; PG8_SCHED;
            PG8_LDA(At, 1, 1); PG8_STAGEB(PG8_SB(1, 0), b3); PG8_STAGEB(PG8_SB(1, 1), b3 + hstep); PG8_STAGE2(PG8_SA(1, 0), a3, e00, e01);
            PG8_WAIT_V(8); PG8_WAIT_L(0); PG8_BAR; PG8_MMA(1, 0, At, B0); PG8_MMA(1, 1, At, B1); PG8_BAR; PG8_SCHED;
        }
        if (wr == 0) PG8_BAR;
        E(acc, cur, wr, wc, fr, fq);
        if (!has_next) break;
#pragma unroll
        for (int a = 0; a < 2; ++a)
#pragma unroll
            for (int b = 0; b < 2; ++b)
#pragma unroll
                for (int m = 0; m < 4; ++m)
#pragma unroll
                    for (int n = 0; n < 2; ++n) acc[a][b][m][n] = (f32x4){0.f, 0.f, 0.f, 0.f};
        cur = nxt; cA = nA; cB = nB; ++ui;
        if constexpr (GATHER) { c00 = n00; c01 = n01; c10 = n10; c11 = n11; }
        if (wr == 1) PG8_BAR;
    }
    PG8_WAIT_V(0);
    PG8_BAR;
#undef PG8_SA
#undef PG8_SB
#undef PG8_STAGE2
#undef PG8_STAGEB
#undef PG8_LDA
#undef PG8_LDB
#undef PG8_MMA
#undef PG8_WAIT_V
#undef PG8_WAIT_L
#undef PG8_BAR
#undef PG8_SCHED
}
}

#define XB_TMO      128
#define XB_XCNT(j)  (256  + 64 * (j))
#define XB_XSUB(j)  (1280 + 64 * (j))
#define XB_XGEN(j)  (2304 + 64 * (j))
#define XB_TOP      3328
#define XB_TOPGEN   3392
#define XCD_BAR_WORDS 3456
#define XB_SPIN_CAP (1u << 18)
__device__ __forceinline__ unsigned xb_ld(unsigned* p)              { return __hip_atomic_load(p, __ATOMIC_RELAXED, __HIP_MEMORY_SCOPE_AGENT); }
__device__ __forceinline__ unsigned xb_add(unsigned* p, unsigned v) { return __hip_atomic_fetch_add(p, v, __ATOMIC_RELAXED, __HIP_MEMORY_SCOPE_AGENT); }
__device__ __forceinline__ unsigned xb_xcc_id() { return (unsigned)__builtin_amdgcn_s_getreg((3 << 11) | 20) & 0xFu; }
#define XB_SPIN(cond, bar) do { unsigned _sp = 0; while (cond) { __builtin_amdgcn_s_sleep(1); \
    if ((++_sp & 255u) == 0u) { if (xb_ld(&(bar)[XB_TMO])) break; if (_sp > XB_SPIN_CAP) { atomicAdd(&(bar)[XB_TMO], 1u); break; } } } } while (0)
struct XcdBarrier { unsigned* bar; unsigned x; volatile LAS unsigned* st; };
__device__ __forceinline__ XcdBarrier xcd_barrier_post(unsigned* bar, volatile LAS unsigned* st) {
    XcdBarrier b; b.bar = bar; b.x = xb_xcc_id(); b.st = st;
    if (threadIdx.x == 0) (void)xb_add(&bar[XB_XCNT(b.x)], 1u);
    return b;
}
__device__ __forceinline__ void xcd_barrier_complete(unsigned* bar, unsigned x, unsigned& nloc, unsigned& nx) {
    const unsigned G = gridDim.x * gridDim.y * gridDim.z;
    unsigned sum, cnt, mine, sp = 0u;
    for (;;) {
        sum = 0u; cnt = 0u; mine = 0u;
#pragma unroll
        for (unsigned j = 0; j < 16; ++j) { const unsigned c = xb_ld(&bar[XB_XCNT(j)]); sum += c; cnt += (c > 0u) ? 1u : 0u; mine = (j == x) ? c : mine; }
        if (sum == G) break;
        __builtin_amdgcn_s_sleep(1);
        if ((++sp & 255u) == 0u) { if (xb_ld(&bar[XB_TMO])) break; if (sp > XB_SPIN_CAP) { atomicAdd(&bar[XB_TMO], 1u); break; } }
    }
    nloc = mine > 0u ? mine : 1u; nx = cnt > 0u ? cnt : 1u;
}
__device__ __forceinline__ void xcd_barrier(const XcdBarrier& b) {
    asm volatile("s_waitcnt vmcnt(0)" ::: "memory");
    __syncthreads();
    if (threadIdx.x == 0) {
        unsigned* bar = b.bar;
        __builtin_amdgcn_s_waitcnt(0);
        unsigned nloc = b.st[0], nx = b.st[1];
        if (nloc == 0u) { xcd_barrier_complete(bar, b.x, nloc, nx); b.st[0] = nloc; b.st[1] = nx; }
        const unsigned old = xb_add(&bar[XB_XSUB(b.x)], 1u);
        const unsigned gen = old / nloc;
        if (old + 1u == (gen + 1u) * nloc) {
            __builtin_amdgcn_fence(__ATOMIC_RELEASE, "agent");
            asm volatile("s_waitcnt vmcnt(0)" ::: "memory");
            const unsigned og = xb_add(&bar[XB_TOP], 1u);
            const unsigned tg = og / nx;
            if (og + 1u == (tg + 1u) * nx) xb_add(&bar[XB_TOPGEN], 1u);
            else XB_SPIN(xb_ld(&bar[XB_TOPGEN]) == tg, bar);
            __builtin_amdgcn_fence(__ATOMIC_ACQUIRE, "agent");
            xb_add(&bar[XB_XGEN(b.x)], 1u);
            asm volatile("s_waitcnt vmcnt(0)" ::: "memory");
        } else {
            XB_SPIN(xb_ld(&bar[XB_XGEN(b.x)]) == gen, bar);
            __builtin_amdgcn_fence(__ATOMIC_ACQUIRE, "agent");
            asm volatile("s_waitcnt vmcnt(0)" ::: "memory");
        }
    }
    __syncthreads();
}


#define HD __device__ __forceinline__
struct cpx { float x, y; };
HD cpx cadd(cpx a, cpx b) { return cpx{a.x + b.x, a.y + b.y}; }
HD cpx csub(cpx a, cpx b) { return cpx{a.x - b.x, a.y - b.y}; }
HD cpx cmul(cpx a, cpx b) { return cpx{a.x * b.x - a.y * b.y, a.x * b.y + a.y * b.x}; }
HD cpx cconj(cpx a) { return cpx{a.x, -a.y}; }
HD int fft_pp(int p) { return p + 2 * (p >> 5); }
constexpr int FFT_N = 8192, FFT_BUF_BYTES = (FFT_N + 2 * (FFT_N >> 5)) * 8;

template <bool INV> HD cpx mul_w16(cpx d, int k) {
    const float C1 = 0.92387953251128674f, S1 = 0.38268343236508977f, R2 = 0.70710678118654752f;
    float c, s;
    switch (k & 15) {
        case 0: return d;
        case 4: return INV ? cpx{-d.y, d.x} : cpx{d.y, -d.x};
        case 8: return cpx{-d.x, -d.y};
        case 12: return INV ? cpx{d.y, -d.x} : cpx{-d.y, d.x};
        case 1: c = C1; s = S1; break;
        case 2: c = R2; s = R2; break;
        case 3: c = S1; s = C1; break;
        case 5: c = -S1; s = C1; break;
        case 6: c = -R2; s = R2; break;
        case 7: c = -C1; s = S1; break;
        case 9: c = -C1; s = -S1; break;
        case 10: c = -R2; s = -R2; break;
        case 11: c = -S1; s = -C1; break;
        case 13: c = S1; s = -C1; break;
        case 14: c = R2; s = -R2; break;
        default: c = C1; s = -S1; break;
    }
    if (INV) s = -s;
    return cpx{d.x * c + d.y * s, d.y * c - d.x * s};
}
template <bool INV, int HALF> HD void dft16_stage(cpx (&v)[16]) {
#pragma unroll
    for (int g = 0; g < 16; g += 2 * HALF) {
#pragma unroll
        for (int i = 0; i < HALF; ++i) {
            const cpx a = v[g + i], b = v[g + i + HALF];
            v[g + i] = cadd(a, b);
            v[g + i + HALF] = mul_w16<INV>(csub(a, b), i * (8 / HALF));
        }
    }
}
template <bool INV> HD void dft16(cpx (&v)[16]) {
    dft16_stage<INV, 8>(v); dft16_stage<INV, 4>(v); dft16_stage<INV, 2>(v); dft16_stage<INV, 1>(v);
    cpx t;
    t = v[1]; v[1] = v[8]; v[8] = t;   t = v[2]; v[2] = v[4]; v[4] = t;   t = v[3]; v[3] = v[12]; v[12] = t;
    t = v[5]; v[5] = v[10]; v[10] = t; t = v[7]; v[7] = v[14]; v[14] = t; t = v[11]; v[11] = v[13]; v[13] = t;
}
template <bool INV> HD void twiddle16(cpx (&v)[16], float frac) {
    float s, c;
    asm volatile("" : "+v"(frac));
#if defined(__HIP_DEVICE_COMPILE__)
    sincospif(2.0f * frac, &s, &c);
#else
    s = sinf(6.283185307179586f * frac); c = cosf(6.283185307179586f * frac);
#endif
    const cpx w1 = INV ? cpx{c, s} : cpx{c, -s};
    cpx w = w1;
#pragma unroll
    for (int q = 1; q < 16; ++q) { v[q] = cmul(v[q], w); if (q < 15) w = cmul(w, w1); }
}
HD int fft_k_of_p(int p) { return (p >> 9) + 16 * ((p >> 5) & 15) + 256 * (p & 31); }
HD int fft_p_of_k(int k) { return (k & 15) * 512 + ((k >> 4) & 15) * 32 + (k >> 8); }

typedef float f2v __attribute__((ext_vector_type(2)));
__device__ __forceinline__ cpx ldc(const LAS cpx* b, int i) { const f2v v = ((const LAS f2v*)b)[i]; return cpx{v.x, v.y}; }
__device__ __forceinline__ void stc(LAS cpx* b, int i, cpx v) { ((LAS f2v*)b)[i] = (f2v){v.x, v.y}; }
__device__ __forceinline__ float dpp_xor1(float v) { return __builtin_bit_cast(float, __builtin_amdgcn_update_dpp(0, __builtin_bit_cast(int, v), 0xB1, 0xF, 0xF, true)); }
__device__ __forceinline__ void fft_fwd_pass2(LAS cpx* buf, int t) {
    const int blk = t >> 5, r2 = t & 31; cpx v[16];
#pragma unroll
    for (int j = 0; j < 16; ++j) v[j] = ldc(buf, fft_pp(blk * 512 + j * 32 + r2));
    dft16<false>(v); twiddle16<false>(v, (float)r2 * (1.f / 512.f));
#pragma unroll
    for (int q = 0; q < 16; ++q) stc(buf, fft_pp(blk * 512 + q * 32 + r2), v[q]);
}
__device__ __forceinline__ void fft_fwd_pass3(const LAS cpx* buf, int t, cpx (&v)[16]) {
    const int b = t >> 1, r = t & 1;
#pragma unroll
    for (int j = 0; j < 16; ++j) v[j] = ldc(buf, fft_pp(b * 32 + 2 * j + r));
    dft16<false>(v); twiddle16<false>(v, (float)r * (1.f / 32.f));
#pragma unroll
    for (int q = 0; q < 16; ++q) { const float px = dpp_xor1(v[q].x), py = dpp_xor1(v[q].y);
        v[q] = r ? cpx{px - v[q].x, py - v[q].y} : cpx{v[q].x + px, v[q].y + py}; }
}
__device__ __forceinline__ float bload(__amdgpu_buffer_rsrc_t rs, int voff, int soff) { return __builtin_bit_cast(float, __builtin_amdgcn_raw_buffer_load_b32(rs, voff, soff, 0)); }
__device__ __forceinline__ float conv3_b(__amdgpu_buffer_rsrc_t rs, int voff, int e0, float w0, float w1, float w2, float bias, bool lo_ok, bool hi_ok) {
    const float xm = (e0 > 0) ? bload(rs, voff, e0 * 4 - 4) : bload(rs, voff - 4, 0);
    const float xc = bload(rs, voff, e0 * 4), xp = bload(rs, voff + 4, e0 * 4);
    return bias + w1 * xc + (lo_ok ? w0 * xm : 0.f) + (hi_ok ? w2 * xp : 0.f);
}
__device__ __forceinline__ void hyena_phase(LAS unsigned char* lds, const float* PT, const float* KC, const float* cw, const float* cb, const float* skip, float* YHT, int G, int vcu) {
    LAS cpx* Wb = (LAS cpx*)lds;
    LAS cpx* Lb = (LAS cpx*)(lds + FFT_BUF_BYTES);
    const int t = threadIdx.x;
    for (int pair = vcu; pair < 512; pair += G) {
        const int c0 = 2 * pair;
        {
            const __amdgpu_buffer_rsrc_t rsk = __builtin_amdgcn_make_buffer_rsrc((void*)(KC + (size_t)c0 * 8192), 0, 65536, 0x00020000);
            cpx v[16];
#pragma unroll
            for (int j = 0; j < 16; ++j) v[j] = cpx{bload(rsk, t * 4, j * 2048), bload(rsk, t * 4, 32768 + j * 2048)};
            dft16<false>(v); twiddle16<false>(v, (float)t * (1.f / 8192.f));
#pragma unroll
            for (int q = 0; q < 16; ++q) stc(Wb, fft_pp(q * 512 + t), v[q]);
        }
        __syncthreads();
        fft_fwd_pass2(Wb, t);
        __syncthreads();
        { cpx v[16]; fft_fwd_pass3(Wb, t, v); __syncthreads();
          const int b = t >> 1, r = t & 1;
#pragma unroll
          for (int q = 0; q < 16; ++q) stc(Wb, fft_pp(b * 32 + 16 * r + q), v[q]); }
        __syncthreads();
#pragma unroll 1
        for (int ch = 0; ch < 2; ++ch) {
            const int c = c0 + ch;
            float vg[2][8];
            {
                const __amdgpu_buffer_rsrc_t rs1 = __builtin_amdgcn_make_buffer_rsrc((void*)(PT + (size_t)(1024 + c) * T), 0, T * 4, 0x00020000);
                const __amdgpu_buffer_rsrc_t rs2 = __builtin_amdgcn_make_buffer_rsrc((void*)(PT + (size_t)(2048 + c) * T), 0, T * 4, 0x00020000);
                const float a0 = cw[1024 + c], a1 = cw[3072 + 1024 + c], a2 = cw[6144 + 1024 + c], ab = cb[1024 + c];
                const float v0 = cw[2048 + c], v1 = cw[3072 + 2048 + c], v2 = cw[6144 + 2048 + c], vb = cb[2048 + c];
#pragma unroll
                for (int b = 0; b < 2; ++b)
#pragma unroll
                    for (int j = 0; j < 8; ++j) { const bool lo = (j > 0) || (t > 0), hi = (j < 7) || (t < 511);
                        vg[b][j] = conv3_b(rs2, t * 4, b * LSEQ + j * 512, v0, v1, v2, vb, lo, hi) * conv3_b(rs1, t * 4, b * LSEQ + j * 512, a0, a1, a2, ab, lo, hi);
                        if (j & 1) asm volatile("" ::: "memory"); }
                cpx v[16];
#pragma unroll
                for (int j = 0; j < 8; ++j) { v[j] = cpx{vg[0][j], vg[1][j]}; v[8 + j] = cpx{0.f, 0.f}; }
                dft16<false>(v); twiddle16<false>(v, (float)t * (1.f / 8192.f));
#pragma unroll
                for (int q = 0; q < 16; ++q) stc(Lb, fft_pp(q * 512 + t), v[q]);
            }
            __syncthreads();
            fft_fwd_pass2(Lb, t);
            __syncthreads();
            {
                cpx v[16]; fft_fwd_pass3(Lb, t, v);
                const int b = t >> 1, r = t & 1;
                const float sc = 0.5f / 8192.f;
#pragma unroll
                for (int q = 0; q < 16; ++q) {
                    const int p = b * 32 + 16 * r + q, k = fft_k_of_p(p), km = (8192 - k) & 8191, pm = fft_p_of_k(km);
                    const cpx Wk = ldc(Wb, fft_pp(p)), Wm = ldc(Wb, fft_pp(pm));
                    cpx H;
                    if (ch == 0) H = cpx{(Wk.x + Wm.x) * sc, (Wk.y - Wm.y) * sc};
                    else H = cpx{(Wk.y + Wm.y) * sc, (Wm.x - Wk.x) * sc};
                    v[q] = cmul(v[q], H);
                }
#pragma unroll
                for (int q = 0; q < 16; ++q) { const float px = dpp_xor1(v[q].x), py = dpp_xor1(v[q].y);
                    v[q] = r ? cpx{px - v[q].x, py - v[q].y} : cpx{v[q].x + px, v[q].y + py}; }
                twiddle16<true>(v, (float)r * (1.f / 32.f)); dft16<true>(v);
                __syncthreads();
#pragma unroll
                for (int j = 0; j < 16; ++j) stc(Lb, fft_pp(b * 32 + 2 * j + r), v[j]);
            }
            __syncthreads();
            {
                const int blk = t >> 5, r2 = t & 31; cpx v[16];
#pragma unroll
                for (int q = 0; q < 16; ++q) v[q] = ldc(Lb, fft_pp(blk * 512 + q * 32 + r2));
                twiddle16<true>(v, (float)r2 * (1.f / 512.f)); dft16<true>(v);
                __syncthreads();
#pragma unroll
                for (int j = 0; j < 16; ++j) stc(Lb, fft_pp(blk * 512 + j * 32 + r2), v[j]);
            }
            __syncthreads();
            {
                cpx v[16];
#pragma unroll
                for (int q = 0; q < 16; ++q) v[q] = ldc(Lb, fft_pp(q * 512 + t));
                twiddle16<true>(v, (float)t * (1.f / 8192.f)); dft16<true>(v);
                const __amdgpu_buffer_rsrc_t rs0 = __builtin_amdgcn_make_buffer_rsrc((void*)(PT + (size_t)c * T), 0, T * 4, 0x00020000);
                const __amdgpu_buffer_rsrc_t rsy = __builtin_amdgcn_make_buffer_rsrc((void*)(YHT + (size_t)c * T), 0, T * 4, 0x00020000);
                const float x0 = cw[c], x1 = cw[3072 + c], x2 = cw[6144 + c], xb = cb[c], sk = skip[c];
#pragma unroll
                for (int j = 0; j < 8; ++j) { const bool lo = (j > 0) || (t > 0), hi = (j < 7) || (t < 511);
                    const float o0 = (v[j].x + vg[0][j] * sk) * conv3_b(rs0, t * 4, j * 512, x0, x1, x2, xb, lo, hi);
                    const float o1 = (v[j].y + vg[1][j] * sk) * conv3_b(rs0, t * 4, LSEQ + j * 512, x0, x1, x2, xb, lo, hi);
                    __builtin_amdgcn_raw_buffer_store_b32(__builtin_bit_cast(unsigned, o0), rsy, t * 4, j * 2048, 0);
                    __builtin_amdgcn_raw_buffer_store_b32(__builtin_bit_cast(unsigned, o1), rsy, t * 4, (LSEQ + j * 512) * 4, 0);
                    if (j & 1) asm volatile("" ::: "memory"); }
            }
            __syncthreads();
        }
    }
}
__device__ __forceinline__ void hyena_filter_item(LAS unsigned char* lds, int item, const float* w1, const float* b1, const float* w2, const float* b2, const float* w3, const float* b3,
                                                  const float* w4, const float* freq, float* KC, int tid, int lane, int wave) {
    LAS float* H3 = (LAS float*)lds;
    LAS float* sc = (LAS float*)(lds + 4096) + wave * 128;
    const int l0 = item * 16;
    __syncthreads();
#pragma unroll 1
    for (int pp = 0; pp < 2; ++pp) {
        const int li = wave * 2 + pp, l = l0 + li;
        const float tt = (float)l / (float)(LSEQ - 1);
        if (lane == 0) sc[0] = tt;
        if (lane < 16) { const float omega = (2.0f * 3.14159265358979323846f / (float)LSEQ) * (float)l; const float fb = 1e-4f + (float)lane * ((15.0f - 1e-4f) / 15.0f); const float ang = omega * fb;
            sc[1 + lane] = cosf(ang); sc[17 + lane] = -sinf(ang); }
        asm volatile("s_waitcnt lgkmcnt(0)" ::: "memory");
        const float fr = freq[lane];
        float s = b1[lane];
#pragma unroll 3
        for (int i = 0; i < 33; ++i) s += sc[i] * w1[i * 64 + lane];
        float h = sinf(fr * s);
        asm volatile("s_waitcnt lgkmcnt(0)" ::: "memory"); sc[64 + lane] = h; asm volatile("s_waitcnt lgkmcnt(0)" ::: "memory");
        s = b2[lane];
#pragma unroll 4
        for (int i = 0; i < 64; ++i) s += sc[64 + i] * w2[i * 64 + lane];
        h = sinf(fr * s);
        asm volatile("s_waitcnt lgkmcnt(0)" ::: "memory"); sc[lane] = h; asm volatile("s_waitcnt lgkmcnt(0)" ::: "memory");
        s = b3[lane];
#pragma unroll 4
        for (int i = 0; i < 64; ++i) s += sc[i] * w3[i * 64 + lane];
        h = sinf(fr * s);
        H3[lane * 16 + li] = h;
        asm volatile("s_waitcnt lgkmcnt(0)" ::: "memory");
    }
    __syncthreads();
    const float max_decay = logf(1e-2f) / 0.3f, min_decay = logf(1e-2f) / 1.5f;
#pragma unroll 1
    for (int cc = 0; cc < 2; ++cc) {
        const int c = tid + 512 * cc;
        float hf[16], hb[16];
#pragma unroll
        for (int l = 0; l < 16; ++l) { hf[l] = 0.f; hb[l] = 0.f; }
#pragma unroll 2
        for (int i = 0; i < 64; ++i) {
            const float wf = w4[i * 2048 + c], wb = w4[i * 2048 + 1024 + c];
#pragma unroll
            for (int l = 0; l < 16; ++l) { const float hv = H3[i * 16 + l]; hf[l] = fmaf(hv, wf, hf[l]); hb[l] = fmaf(hv, wb, hb[l]); }
        }
        const float delta = fabsf(min_decay + (float)c * ((max_decay - min_decay) / (float)(DHY - 1)));
        float* kc = KC + (size_t)c * 8192;
#pragma unroll
        for (int l = 0; l < 16; ++l) {
            const int ll = l0 + l; const float win = expf(-((float)ll / (float)(LSEQ - 1)) * delta);
            const float f = hf[l] * win, bb = hb[l] * win;
            if (ll == 0) { kc[0] = f + bb; kc[4096] = 0.f; } else { kc[ll] = f; kc[8192 - ll] = bb; }
        }
    }
    __syncthreads();
}
__device__ __forceinline__ void hyena_post_tile(LAS unsigned char* lds, int tile, const float* YHT, const float* nw, bf16* A2, int tid, int lane, int wave) {
    LAS float* tl = (LAS float*)lds;
    const int tok0 = tile * 32, tk = tid & 31, cg = tid >> 5;
    for (int i = 0; i < 64; ++i) { const int c = cg + 16 * i; tl[c * 33 + tk] = YHT[(size_t)c * T + tok0 + tk]; }
    __syncthreads();
    for (int q = 0; q < 4; ++q) {
        const int tq = wave * 4 + q; float v[16]; float ss = 0.f;
#pragma unroll
        for (int i = 0; i < 16; ++i) { v[i] = tl[(lane + 64 * i) * 33 + tq]; ss += v[i] * v[i]; }
        const float r = rsqrtf(wave_sum(ss) * (1.f / DHY) + EPS);
#pragma unroll
        for (int i = 0; i < 16; ++i) { const int c = lane + 64 * i; A2[(size_t)(tok0 + tq) * DM + c] = (bf16)f2bf(v[i] * r * nw[c]); }
    }
    __syncthreads();
}


constexpr int GP_TILE = 128 * 132;
constexpr int GP_GATES = 139264;
constexpr int GP_WREG = 16896;
static_assert(8 * GP_TILE <= GP_GATES && 8 * GP_WREG <= GP_GATES && GP_GATES + 4096 <= LDSCTL_OFF_C, "gdn prep LDS");
__device__ __forceinline__ void gdn_pre(LAS unsigned char* lds, int wg, const bf16* PG, const float* PGATE, const float* cw, const float* alf, const float* alb, const float* dtf, const float* dtb,
                                        unsigned char* ws, int tid, int lane, int wave) {
    const int bh = wg >> 4, b = bh >> 3, h = bh & 7, l0 = 256 * (wg & 15), cid0 = bh * 64 + 4 * (wg & 15);
    LAS float* gates = (LAS float*)(lds + GP_GATES);
    float w[3][3][2];
#pragma unroll
    for (int x = 0; x < 3; ++x)
#pragma unroll
        for (int tp = 0; tp < 3; ++tp)
#pragma unroll
            for (int e = 0; e < 2; ++e) w[x][tp][e] = cw[tp * 3072 + x * 1024 + h * 128 + 2 * lane + e];
    const int lw = l0 + 32 * wave;
    const unsigned* pgw = (const unsigned*)PG;
    auto ldraw = [&](int l, int x) -> unsigned { return (l >= 0 && l < LSEQ) ? pgw[((size_t)(b * LSEQ + l) * 4096 + x * 1024 + h * 128) / 2 + lane] : 0u; };
    unsigned prv[3], cur[3], nxt[3];
#pragma unroll
    for (int x = 0; x < 3; ++x) { prv[x] = ldraw(lw - 1, x); cur[x] = ldraw(lw, x); }
    for (int tt = 0; tt < 32; ++tt) {
        const int l = lw + tt, li = 32 * wave + tt, cl = li >> 6, i = li & 63;
#pragma unroll
        for (int x = 0; x < 3; ++x) nxt[x] = ldraw(l + 1, x);
        float r[3][2];
#pragma unroll
        for (int x = 0; x < 3; ++x) {
            const float p0 = __builtin_bit_cast(float, prv[x] << 16), p1 = __builtin_bit_cast(float, prv[x] & 0xffff0000u);
            const float c0 = __builtin_bit_cast(float, cur[x] << 16), c1 = __builtin_bit_cast(float, cur[x] & 0xffff0000u);
            const float n0 = __builtin_bit_cast(float, nxt[x] << 16), n1 = __builtin_bit_cast(float, nxt[x] & 0xffff0000u);
            r[x][0] = silu_f(w[x][0][0] * p0 + w[x][1][0] * c0 + w[x][2][0] * n0);
            r[x][1] = silu_f(w[x][0][1] * p1 + w[x][1][1] * c1 + w[x][2][1] * n1);
        }
        const float qs = rsqrtf(wave_sum(r[0][0] * r[0][0] + r[0][1] * r[0][1]) + EPS);
        const float ks = rsqrtf(wave_sum(r[1][0] * r[1][0] + r[1][1] * r[1][1]) + EPS);
        const unsigned qp = pk2(r[0][0] * qs, r[0][1] * qs), kp = pk2(r[1][0] * ks, r[1][1] * ks), vp = pk2(r[2][0], r[2][1]);
        const size_t rowoff = ((size_t)(cid0 + cl) * 64 + i) * 64 + lane;
        ((unsigned*)(ws + WS_QN))[rowoff] = qp; ((unsigned*)(ws + WS_KN))[rowoff] = kp;
        LAS bf16* kt = (LAS bf16*)(lds + (cl * 2 + 0) * GP_TILE); LAS bf16* vt = (LAS bf16*)(lds + (cl * 2 + 1) * GP_TILE);
        kt[(2 * lane) * 66 + i] = (bf16)(kp & 0xffffu); kt[(2 * lane + 1) * 66 + i] = (bf16)(kp >> 16);
        vt[(2 * lane) * 66 + i] = (bf16)(vp & 0xffffu); vt[(2 * lane + 1) * 66 + i] = (bf16)(vp >> 16);
        if (lane < 4) {
            const float* pr = PGATE + (size_t)(b * LSEQ + l) * 32;
            float val;
            if (lane == 0) val = -expf(alf[h]) * softplus_f(pr[16 + h] + dtf[h]);
            else if (lane == 1) val = -expf(alb[h]) * softplus_f(pr[24 + h] + dtb[h]);
            else if (lane == 2) val = sigmoid_f(pr[h]);
            else val = sigmoid_f(pr[8 + h]);
            gates[lane * 256 + li] = val;
        }
#pragma unroll
        for (int x = 0; x < 3; ++x) { prv[x] = cur[x]; cur[x] = nxt[x]; }
    }
    __syncthreads();
    for (int it = wave; it < 8 * 64; it += 8) {
        const int tile = it >> 6, rp = it & 63, row = 2 * rp + (lane >> 5), cl = tile >> 1, which = tile & 1;
        const unsigned v = *(const LAS unsigned*)(lds + tile * GP_TILE + row * 132 + (lane & 31) * 4);
        ((unsigned*)(ws + (which ? WS_VT : WS_KT)))[((size_t)(cid0 + cl) * 128 + row) * 32 + (lane & 31)] = v;
    }
    asm volatile("s_waitcnt vmcnt(0)" ::: "memory");
    __syncthreads();
}
__device__ __forceinline__ void gdn_prep_wave(LAS unsigned char* lds, int wg, unsigned char* ws, int lane, int wave) {
    typedef pg8::bf16x8 bf16x8; typedef pg8::f32x4 f32x4;
    const int cl = wave >> 1, dir = wave & 1, bh = wg >> 4, cid = bh * 64 + 4 * (wg & 15) + cl; const size_t ci = (size_t)cid * 2 + dir;
    const int fr = lane & 15, fq = lane >> 4;
    LAS unsigned char* R = lds + wave * GP_WREG;
    LAS float* Am = (LAS float*)R; LAS float* gcA = (LAS float*)(R + 16384); LAS float* btA = gcA + 64;
    const LAS float* gates = (const LAS float*)(lds + GP_GATES);
    const bf16* QN = (const bf16*)(ws + WS_QN) + (size_t)cid * 64 * 128; const bf16* KN = (const bf16*)(ws + WS_KN) + (size_t)cid * 64 * 128;
    const bf16* KT = (const bf16*)(ws + WS_KT) + (size_t)cid * 128 * 64; const bf16* VT = (const bf16*)(ws + WS_VT) + (size_t)cid * 128 * 64;
    unsigned char* GW = ws + WS_GW + ci * GW_B; unsigned char* GQD = ws + WS_GQD + ci * GW_B; unsigned char* GKDT = ws + WS_GKDT + ci * GKDT_B;
    unsigned char* GQK = ws + WS_GQK + ci * GQK_B; unsigned char* GUT = ws + WS_GUT + ci * GUT_B;
#define RIDX(i) (dir ? 63 - (i) : (i))
    const float bt = gates[(2 + dir) * 256 + 64 * cl + RIDX(lane)];
    float gc = gates[dir * 256 + 64 * cl + RIDX(lane)];
#pragma unroll
    for (int o = 1; o < 64; o <<= 1) { const float t = __shfl_up(gc, o); if (lane >= o) gc += t; }
    const float gl = __shfl(gc, 63);
    gcA[lane] = gc; btA[lane] = bt;
    asm volatile("s_waitcnt lgkmcnt(0)" ::: "memory");
    if (lane == 0) ((float*)(ws + WS_GCD))[ci] = expf(gl);
#pragma unroll 1
    for (int mt = 0; mt < 4; ++mt) {
        bf16x8 af[4];
#pragma unroll
        for (int ks = 0; ks < 4; ++ks) af[ks] = *(const bf16x8*)(KN + (size_t)RIDX(16 * mt + fr) * 128 + 32 * ks + 8 * fq);
        const f32x4 gi = *(const LAS f32x4*)(gcA + 16 * mt + 4 * fq), bi = *(const LAS f32x4*)(btA + 16 * mt + 4 * fq);
#pragma unroll 1
        for (int nt = 0; nt <= mt; ++nt) {
            f32x4 c = (f32x4){0.f, 0.f, 0.f, 0.f};
#pragma unroll
            for (int ks = 0; ks < 4; ++ks) { const bf16x8 bfg = *(const bf16x8*)(KN + (size_t)RIDX(16 * nt + fr) * 128 + 32 * ks + 8 * fq); c = __builtin_amdgcn_mfma_f32_16x16x32_bf16(af[ks], bfg, c, 0, 0, 0); }
            const int j = 16 * nt + fr; const float gj = gcA[j];
#pragma unroll
            for (int r = 0; r < 4; ++r) { const int i = 16 * mt + 4 * fq + r; Am[i * 64 + j] = (j < i) ? bi[r] * c[r] * __expf(gi[r] - gj) : 0.f; }
        }
    }
#pragma unroll 1
    for (int it = 0; it < 4; ++it) {
        bf16x8 qf[4];
#pragma unroll
        for (int ks = 0; ks < 4; ++ks) qf[ks] = *(const bf16x8*)(QN + (size_t)RIDX(16 * it + fr) * 128 + 32 * ks + 8 * fq);
        const int i = 16 * it + fr; const float gi = gcA[i];
#pragma unroll 1
        for (int jt = 0; jt < 4; ++jt) {
            f32x4 c = (f32x4){0.f, 0.f, 0.f, 0.f};
            if (jt <= it) {
#pragma unroll
                for (int ks = 0; ks < 4; ++ks) { const bf16x8 kf = *(const bf16x8*)(KN + (size_t)RIDX(16 * jt + fr) * 128 + 32 * ks + 8 * fq); c = __builtin_amdgcn_mfma_f32_16x16x32_bf16(kf, qf[ks], c, 0, 0, 0); }
            }
            const f32x4 gj = *(const LAS f32x4*)(gcA + 16 * jt + 4 * fq);
            float v[4];
#pragma unroll
            for (int r = 0; r < 4; ++r) { const int j = 16 * jt + 4 * fq + r; v[r] = (j <= i) ? c[r] * __expf(gi - gj[r]) * 0.08838834764831845f : 0.f; }
            *(unsigned long long*)(GQK + i * 144 + (32 * (jt >> 1) + 8 * fq + 4 * (jt & 1)) * 2) = (unsigned long long)pg8::cvt_pk_bf16(v[0], v[1]) | ((unsigned long long)pg8::cvt_pk_bf16(v[2], v[3]) << 32);
        }
    }
    {
        const int L2 = lane & 31, m = 4 * L2, src = (m & ~31) + ((m & 4) ? 16 + 4 * ((m & 31) >> 3) : 4 * ((m & 31) >> 3));
#pragma unroll 1
        for (int rp = 0; rp < 32; ++rp) {
            const int i = 2 * rp + (lane >> 5);
            const unsigned long long q = *(const unsigned long long*)(QN + (size_t)RIDX(i) * 128 + src);
            const float sc = __expf(gcA[i]) * 0.08838834764831845f;
            const unsigned lo = (unsigned)q, hi = (unsigned)(q >> 32);
            const float a0 = __builtin_bit_cast(float, lo << 16) * sc, a1 = __builtin_bit_cast(float, lo & 0xffff0000u) * sc, a2 = __builtin_bit_cast(float, hi << 16) * sc, a3 = __builtin_bit_cast(float, hi & 0xffff0000u) * sc;
            *(unsigned long long*)(GQD + i * 272 + m * 2) = (unsigned long long)pg8::cvt_pk_bf16(a0, a1) | ((unsigned long long)pg8::cvt_pk_bf16(a2, a3) << 32);
        }
        const int L4 = lane & 15, mm = 4 * L4, isrc = (mm & ~31) + ((mm & 4) ? 16 + 4 * ((mm & 31) >> 3) : 4 * ((mm & 31) >> 3));
        const f32x4 gi4 = *(const LAS f32x4*)(gcA + isrc);
        float sc4[4];
#pragma unroll
        for (int r = 0; r < 4; ++r) sc4[r] = __expf(gl - gi4[r]);
#pragma unroll 1
        for (int rq = 0; rq < 32; ++rq) {
            const int dk = 4 * rq + (lane >> 4);
            const unsigned long long k = *(const unsigned long long*)(KT + (size_t)dk * 64 + (dir ? 60 - isrc : isrc));
            const unsigned lo = (unsigned)k, hi = (unsigned)(k >> 32);
            float e0 = __builtin_bit_cast(float, lo << 16), e1 = __builtin_bit_cast(float, lo & 0xffff0000u), e2 = __builtin_bit_cast(float, hi << 16), e3 = __builtin_bit_cast(float, hi & 0xffff0000u);
            if (dir) { float t = e0; e0 = e3; e3 = t; t = e1; e1 = e2; e2 = t; }
            *(unsigned long long*)(GKDT + dk * 144 + mm * 2) = (unsigned long long)pg8::cvt_pk_bf16(e0 * sc4[0], e1 * sc4[1]) | ((unsigned long long)pg8::cvt_pk_bf16(e2 * sc4[2], e3 * sc4[3]) << 32);
        }
    }
    asm volatile("s_waitcnt lgkmcnt(0)" ::: "memory");
    float Tr[64];
#pragma unroll
    for (int i = 0; i < 64; ++i) {
        float s0 = (lane == i) ? 1.f : 0.f, s1 = 0.f;
#pragma unroll
        for (int j4 = 0; j4 < (i + 3) / 4; ++j4) {
            const f32x4 a = *(const LAS f32x4*)(Am + i * 64 + 4 * j4);
#pragma unroll
            for (int e = 0; e < 4; ++e) { const int j = 4 * j4 + e; if (j < i) { if (e & 1) s1 = fmaf(-a[e], Tr[j], s1); else s0 = fmaf(-a[e], Tr[j], s0); } }
        }
        Tr[i] = s0 + s1;
    }
#pragma unroll
    for (int j = 0; j < 64; ++j) asm volatile("" : "+v"(Tr[j]));
    asm volatile("s_waitcnt lgkmcnt(0)" ::: "memory");
    {
        const float su = bt, sw = bt * __expf(gc);
        LAS bf16* Tw = (LAS bf16*)R; LAS bf16* Tu = (LAS bf16*)(R + 8192);
        const int cn = RIDX(lane);
#pragma unroll
        for (int j = 0; j < 64; ++j) { Tw[j * 64 + cn] = (bf16)f2bf(Tr[j] * sw); Tu[j * 64 + cn] = (bf16)f2bf(Tr[j] * su); }
    }
    asm volatile("s_waitcnt lgkmcnt(0)" ::: "memory");
#pragma unroll 1
    for (int it = 0; it < 4; ++it) {
        bf16x8 tf[2];
#pragma unroll
        for (int ks = 0; ks < 2; ++ks) tf[ks] = *(const LAS bf16x8*)(R + ((16 * it + fr) * 64 + 32 * ks + 8 * fq) * 2);
        const int i = 16 * it + fr;
#pragma unroll 1
        for (int dt = 0; dt < 8; ++dt) {
            f32x4 c = (f32x4){0.f, 0.f, 0.f, 0.f};
#pragma unroll
            for (int ks = 0; ks < 2; ++ks) { const bf16x8 kf = *(const bf16x8*)(KT + (size_t)(16 * dt + fr) * 64 + 32 * ks + 8 * fq); c = __builtin_amdgcn_mfma_f32_16x16x32_bf16(kf, tf[ks], c, 0, 0, 0); }
            *(unsigned long long*)(GW + i * 272 + (32 * (dt >> 1) + 8 * fq + 4 * (dt & 1)) * 2) = (unsigned long long)pg8::cvt_pk_bf16(c[0], c[1]) | ((unsigned long long)pg8::cvt_pk_bf16(c[2], c[3]) << 32);
        }
    }
#pragma unroll 1
    for (int it = 0; it < 4; ++it) {
        bf16x8 tf[2];
#pragma unroll
        for (int ks = 0; ks < 2; ++ks) tf[ks] = *(const LAS bf16x8*)(R + 8192 + ((16 * it + fr) * 64 + 32 * ks + 8 * fq) * 2);
#pragma unroll 1
        for (int vt = 0; vt < 8; ++vt) {
            f32x4 c = (f32x4){0.f, 0.f, 0.f, 0.f};
#pragma unroll
            for (int ks = 0; ks < 2; ++ks) { const bf16x8 vf = *(const bf16x8*)(VT + (size_t)(16 * vt + fr) * 64 + 32 * ks + 8 * fq); c = __builtin_amdgcn_mfma_f32_16x16x32_bf16(tf[ks], vf, c, 0, 0, 0); }
            *(unsigned long long*)(GUT + (16 * vt + fr) * 128 + (16 * it + 4 * fq) * 2) = (unsigned long long)pg8::cvt_pk_bf16(c[0], c[1]) | ((unsigned long long)pg8::cvt_pk_bf16(c[2], c[3]) << 32);
        }
    }
#undef RIDX
}

__host__ __device__ __forceinline__ int mperm32(int o) { return ((o & 15) >> 2) * 8 + (o >> 4) * 4 + (o & 3); }
__host__ __device__ __forceinline__ int mcol(int x) { return (x & ~31) + mperm32(x & 31); }
constexpr int SC_W = 0, SC_QD = 17408, SC_KDT = 34816, SC_QK = 53248, SC_UT = 62464, SC_STEP = 70656;
static_assert(2 * SC_STEP <= LDSCTL_OFF_C, "scan LDS");
__device__ __forceinline__ void gdn_scan(LAS unsigned char* lds, const unsigned char* ws, float* OF, float* OB, int vcu, int tid, int lane, int wave) {
    typedef pg8::bf16x8 bf16x8; typedef pg8::f32x4 f32x4;
    const int chain = vcu >> 1, half = vcu & 1, dir = chain & 1, bh = chain >> 1, b = bh >> 3, h = bh & 7;
    const int fr = lane & 15, fq = lane >> 4;
    const int dv0 = half * 64 + wave * 16;
    float* O = dir ? OB : OF;
    const float* CD = (const float*)(ws + WS_GCD);
    auto issue = [&](int s, int buf) {
        const int n = dir ? 63 - s : s; const size_t ci = ((size_t)(bh * 64 + n) * 2 + dir);
#pragma unroll
        for (int k = 0; k < 9; ++k) {
            const int p = wave + 8 * k;
            if (p < 69) {
                const unsigned char* g; int l;
                if (p < 17) { g = ws + WS_GW + ci * GW_B + p * 1024; l = SC_W + p * 1024; }
                else if (p < 34) { g = ws + WS_GQD + ci * GW_B + (p - 17) * 1024; l = SC_QD + (p - 17) * 1024; }
                else if (p < 52) { g = ws + WS_GKDT + ci * GKDT_B + (p - 34) * 1024; l = SC_KDT + (p - 34) * 1024; }
                else if (p < 61) { g = ws + WS_GQK + ci * GQK_B + (p - 52) * 1024; l = SC_QK + (p - 52) * 1024; }
                else { g = ws + WS_GUT + ci * GUT_B + half * 8192 + (p - 61) * 1024; l = SC_UT + (p - 61) * 1024; }
                __builtin_amdgcn_global_load_lds((const unsigned*)(g + lane * 16), (LAS unsigned*)(lds + buf * SC_STEP + l), 16, 0, 0);
            }
        }
    };
    f32x4 S[8];
#pragma unroll
    for (int i = 0; i < 8; ++i) S[i] = (f32x4){0.f, 0.f, 0.f, 0.f};
    issue(0, 0);
    asm volatile("s_waitcnt vmcnt(0)" ::: "memory"); __syncthreads();
    for (int s = 0; s < 64; ++s) {
        const int buf = s & 1;
        if (s + 1 < 64) issue(s + 1, buf ^ 1);
        if (wave < 4) {
            const LAS unsigned char* L = lds + buf * SC_STEP;
            const int n = dir ? 63 - s : s; const size_t ci = ((size_t)(bh * 64 + n) * 2 + dir);
            const float cd = CD[ci];
            bf16x8 Sb[4];
#pragma unroll
            for (int ks = 0; ks < 4; ++ks) { pg8::u32x4 w; w.x = pg8::cvt_pk_bf16(S[2 * ks][0], S[2 * ks][1]); w.y = pg8::cvt_pk_bf16(S[2 * ks][2], S[2 * ks][3]);
                w.z = pg8::cvt_pk_bf16(S[2 * ks + 1][0], S[2 * ks + 1][1]); w.w = pg8::cvt_pk_bf16(S[2 * ks + 1][2], S[2 * ks + 1][3]); Sb[ks] = __builtin_bit_cast(bf16x8, w); }
            f32x4 vn[4], o[4];
#pragma unroll
            for (int mt = 0; mt < 4; ++mt) {
                f32x4 a = (f32x4){0.f, 0.f, 0.f, 0.f}, q = (f32x4){0.f, 0.f, 0.f, 0.f};
#pragma unroll
                for (int ks = 0; ks < 4; ++ks) {
                    const bf16x8 wf = *(const LAS bf16x8*)(L + SC_W + (16 * mt + fr) * 272 + ks * 64 + fq * 16);
                    const bf16x8 qf = *(const LAS bf16x8*)(L + SC_QD + (16 * mt + fr) * 272 + ks * 64 + fq * 16);
                    a = __builtin_amdgcn_mfma_f32_16x16x32_bf16(wf, Sb[ks], a, 0, 0, 0);
                    q = __builtin_amdgcn_mfma_f32_16x16x32_bf16(qf, Sb[ks], q, 0, 0, 0);
                }
                const unsigned long long uu = *(const LAS unsigned long long*)(L + SC_UT + (wave * 16 + fr) * 128 + (16 * mt + 4 * fq) * 2);
                const unsigned ulo = (unsigned)uu, uhi = (unsigned)(uu >> 32);
                vn[mt][0] = __builtin_bit_cast(float, ulo << 16) - a[0]; vn[mt][1] = __builtin_bit_cast(float, ulo & 0xffff0000u) - a[1];
                vn[mt][2] = __builtin_bit_cast(float, uhi << 16) - a[2]; vn[mt][3] = __builtin_bit_cast(float, uhi & 0xffff0000u) - a[3];
                o[mt] = q;
            }
            bf16x8 vb[2];
#pragma unroll
            for (int ks = 0; ks < 2; ++ks) { pg8::u32x4 w; w.x = pg8::cvt_pk_bf16(vn[2 * ks][0], vn[2 * ks][1]); w.y = pg8::cvt_pk_bf16(vn[2 * ks][2], vn[2 * ks][3]);
                w.z = pg8::cvt_pk_bf16(vn[2 * ks + 1][0], vn[2 * ks + 1][1]); w.w = pg8::cvt_pk_bf16(vn[2 * ks + 1][2], vn[2 * ks + 1][3]); vb[ks] = __builtin_bit_cast(bf16x8, w); }
#pragma unroll
            for (int mt = 0; mt < 4; ++mt) {
#pragma unroll
                for (int ks = 0; ks < 2; ++ks) {
                    const bf16x8 kf = *(const LAS bf16x8*)(L + SC_QK + (16 * mt + fr) * 144 + ks * 64 + fq * 16);
                    o[mt] = __builtin_amdgcn_mfma_f32_16x16x32_bf16(kf, vb[ks], o[mt], 0, 0, 0);
                }
#pragma unroll
                for (int r = 0; r < 4; ++r) { const int i = 16 * mt + 4 * fq + r; const int l = 64 * n + (dir ? 63 - i : i);
                    O[((size_t)b * LSEQ + l) * DGD + h * 128 + dv0 + fr] = o[mt][r]; }
            }
#pragma unroll
            for (int dt = 0; dt < 8; ++dt) {
                f32x4 a = S[dt] * cd;
#pragma unroll
                for (int ks = 0; ks < 2; ++ks) {
                    const bf16x8 kf = *(const LAS bf16x8*)(L + SC_KDT + (16 * dt + fr) * 144 + ks * 64 + fq * 16);
                    a = __builtin_amdgcn_mfma_f32_16x16x32_bf16(kf, vb[ks], a, 0, 0, 0);
                }
                S[dt] = a;
            }
        }
        asm volatile("s_waitcnt vmcnt(0)" ::: "memory"); __syncthreads();
    }
}


__device__ __forceinline__ void gdn_post_item(int item, const float* OF, const float* OB, const bf16* PG, const float* nw, bf16* A2, int lane) {
    const int tok = item >> 3, h = item & 7;
    const size_t o = (size_t)tok * DGD + h * 128 + lane * 2;
    const float2 a = *(const float2*)(OF + o), b = *(const float2*)(OB + o);
    const float o0 = a.x + b.x, o1 = a.y + b.y;
    const float r = rsqrtf(wave_sum(o0 * o0 + o1 * o1) * (1.f / 128.f) + EPS);
    const unsigned zz = *(const unsigned*)(PG + (size_t)tok * 4096 + 3072 + h * 128 + lane * 2);
    const float z0 = __builtin_bit_cast(float, zz << 16), z1 = __builtin_bit_cast(float, zz & 0xffff0000u);
    const float2 g = *(const float2*)(nw + lane * 2);
    *(unsigned*)(A2 + (size_t)tok * DM + 1024 + h * 128 + lane * 2) = pk2(o0 * r * g.x * silu_f(z0), o1 * r * g.y * silu_f(z1));
}
constexpr int RT_PART = 0, RT_LG = 81920, RT_RS = 81920 + 32 * 80 * 4;
__device__ __forceinline__ void route_phase(LAS unsigned char* lds, int wg, const float* X1, const float* nw, const float* gbias, const float* ebias, unsigned char* ws, unsigned* cnt, int tid, int lane, int wave) {
    typedef pg8::bf16x8 bf16x8; typedef pg8::f32x4 f32x4;
    const int tok0 = wg * 32, fr = lane & 15, fq = lane >> 4;
    LAS float* part = (LAS float*)(lds + RT_PART); LAS float* lg = (LAS float*)(lds + RT_LG); LAS float* rs = (LAS float*)(lds + RT_RS);
    bf16* Ub = (bf16*)(ws + WS_UB);
    for (int q = 0; q < 4; ++q) {
        const int t = 4 * wave + q; const float* xrow = X1 + (size_t)(tok0 + t) * DM;
        const GAS f32x4* xr = (const GAS f32x4*)xrow + lane; const GAS f32x4* wr = (const GAS f32x4*)nw + lane;
        f32x4 v[8]; float s = 0.f;
#pragma unroll
        for (int j = 0; j < 8; ++j) { v[j] = xr[64 * j]; s += (v[j].x * v[j].x + v[j].y * v[j].y) + (v[j].z * v[j].z + v[j].w * v[j].w); }
        const float r = rsqrtf(wave_sum(s) * (1.f / DM) + EPS);
        GAS unsigned long long* o8 = (GAS unsigned long long*)(Ub + (size_t)(tok0 + t) * DM) + lane;
#pragma unroll
        for (int j = 0; j < 8; ++j) { const f32x4 g = wr[64 * j];
            o8[64 * j] = (unsigned long long)pk2(v[j].x * r * g.x, v[j].y * r * g.y) | ((unsigned long long)pk2(v[j].z * r * g.z, v[j].w * r * g.w) << 32); }
        if (lane == 0) rs[t] = r;
    }
    if (wg == 0) { GAS unsigned long long* z = (GAS unsigned long long*)(Ub + (size_t)T * DM); z[tid] = 0ull; }
    { int* slot_tok = (int*)(ws + WS_SMALL + SM_SLOTTOK); if (tid < PMAX / 256) slot_tok[wg * (PMAX / 256) + tid] = T; }
    __syncthreads();
    const bf16* RWh = (const bf16*)(ws + WS_SMALL + SM_RWT); const bf16* RWl = RWh + 80 * 2048;
    f32x4 acc[2][5];
#pragma unroll
    for (int mt = 0; mt < 2; ++mt)
#pragma unroll
        for (int nt = 0; nt < 5; ++nt) acc[mt][nt] = (f32x4){0.f, 0.f, 0.f, 0.f};
#pragma unroll 1
    for (int ks = 0; ks < 8; ++ks) {
        const int k0 = 256 * wave + 32 * ks + 8 * fq;
        const f32x4 g0 = *(const f32x4*)(nw + k0), g1 = *(const f32x4*)(nw + k0 + 4);
        bf16x8 ah[2], al[2];
#pragma unroll
        for (int mt = 0; mt < 2; ++mt) {
            const float* xp = X1 + (size_t)(tok0 + 16 * mt + fr) * DM + k0; const float r = rs[16 * mt + fr];
            const f32x4 x0 = *(const f32x4*)xp, x1 = *(const f32x4*)(xp + 4);
            float u[8], hf[8];
#pragma unroll
            for (int j = 0; j < 4; ++j) { u[j] = x0[j] * r * g0[j]; u[4 + j] = x1[j] * r * g1[j]; }
            pg8::u32x4 wh, wl;
            wh.x = pg8::cvt_pk_bf16(u[0], u[1]); wh.y = pg8::cvt_pk_bf16(u[2], u[3]); wh.z = pg8::cvt_pk_bf16(u[4], u[5]); wh.w = pg8::cvt_pk_bf16(u[6], u[7]);
            hf[0] = __builtin_bit_cast(float, wh.x << 16); hf[1] = __builtin_bit_cast(float, wh.x & 0xffff0000u); hf[2] = __builtin_bit_cast(float, wh.y << 16); hf[3] = __builtin_bit_cast(float, wh.y & 0xffff0000u);
            hf[4] = __builtin_bit_cast(float, wh.z << 16); hf[5] = __builtin_bit_cast(float, wh.z & 0xffff0000u); hf[6] = __builtin_bit_cast(float, wh.w << 16); hf[7] = __builtin_bit_cast(float, wh.w & 0xffff0000u);
            wl.x = pg8::cvt_pk_bf16(u[0] - hf[0], u[1] - hf[1]); wl.y = pg8::cvt_pk_bf16(u[2] - hf[2], u[3] - hf[3]); wl.z = pg8::cvt_pk_bf16(u[4] - hf[4], u[5] - hf[5]); wl.w = pg8::cvt_pk_bf16(u[6] - hf[6], u[7] - hf[7]);
            ah[mt] = __builtin_bit_cast(bf16x8, wh); al[mt] = __builtin_bit_cast(bf16x8, wl);
        }
#pragma unroll
        for (int nt = 0; nt < 5; ++nt) {
            const bf16x8 bh = *(const bf16x8*)(RWh + (size_t)(16 * nt + fr) * 2048 + k0), bl = *(const bf16x8*)(RWl + (size_t)(16 * nt + fr) * 2048 + k0);
#pragma unroll
            for (int mt = 0; mt < 2; ++mt) {
                acc[mt][nt] = __builtin_amdgcn_mfma_f32_16x16x32_bf16(ah[mt], bh, acc[mt][nt], 0, 0, 0);
                acc[mt][nt] = __builtin_amdgcn_mfma_f32_16x16x32_bf16(al[mt], bh, acc[mt][nt], 0, 0, 0);
                acc[mt][nt] = __builtin_amdgcn_mfma_f32_16x16x32_bf16(ah[mt], bl, acc[mt][nt], 0, 0, 0);
            }
        }
    }
#pragma unroll
    for (int mt = 0; mt < 2; ++mt)
#pragma unroll
        for (int nt = 0; nt < 5; ++nt) *(LAS f32x4*)(part + ((wave * 10 + mt * 5 + nt) * 64 + lane) * 4) = acc[mt][nt];
    __syncthreads();
    for (int o = tid; o < 32 * 80; o += 512) {
        const int t = o / 80, col = o % 80, mt = t >> 4, tr = t & 15, nt = col >> 4, ln = (tr >> 2) * 16 + (col & 15), rg = tr & 3;
        float s = 0.f;
#pragma unroll
        for (int w = 0; w < 8; ++w) s += part[((w * 10 + mt * 5 + nt) * 64 + ln) * 4 + rg];
        lg[t * 80 + col] = s;
    }
    __syncthreads();
    if (tid < 32) {
        const int t = tok0 + tid; const LAS float* l = lg + tid * 80;
        float g[8]; int gi = 0; float gm = -INFINITY;
#pragma unroll
        for (int i = 0; i < 8; ++i) { g[i] = l[i] + gbias[i]; if (g[i] > gm) { gm = g[i]; gi = i; } }
        float gs = 0.f;
#pragma unroll
        for (int i = 0; i < 8; ++i) gs += expf(g[i] - gm);
        const float ggate = 1.f / gs;
        float e[8]; float em = -INFINITY;
#pragma unroll
        for (int i = 0; i < 8; ++i) { e[i] = l[8 + gi * 8 + i] + ebias[gi * 8 + i]; em = fmaxf(em, e[i]); }
        float es = 0.f; float p[8];
#pragma unroll
        for (int i = 0; i < 8; ++i) { p[i] = expf(e[i] - em); es += p[i]; }
        int i1 = 0; float p1 = -1.f;
#pragma unroll
        for (int i = 0; i < 8; ++i) if (p[i] > p1) { p1 = p[i]; i1 = i; }
        int i2 = 0; float p2 = -1.f;
#pragma unroll
        for (int i = 0; i < 8; ++i) if (i != i1 && p[i] > p2) { p2 = p[i]; i2 = i; }
        const float q1 = p1 / es, q2 = p2 / es, qs = q1 + q2;
        const int e1 = gi * 8 + i1, e2 = gi * 8 + i2;
        int* eid = (int*)(ws + WS_SMALL + SM_EID); float* gate = (float*)(ws + WS_SMALL + SM_GATE); int* pos = (int*)(ws + WS_SMALL + SM_POS);
        eid[t * 2] = e1; eid[t * 2 + 1] = e2;
        gate[t * 2] = ggate * (q1 / qs); gate[t * 2 + 1] = ggate * (q2 / qs);
        pos[t * 2] = (int)__hip_atomic_fetch_add(cnt + e1, 1u, __ATOMIC_RELAXED, __HIP_MEMORY_SCOPE_AGENT);
        pos[t * 2 + 1] = (int)__hip_atomic_fetch_add(cnt + e2, 1u, __ATOMIC_RELAXED, __HIP_MEMORY_SCOPE_AGENT);
    }
}
__device__ __forceinline__ void fill_phase(LAS unsigned char* lds, int wg, unsigned char* ws, unsigned* cnt, int tid) {
    LAS int* ps = (LAS int*)lds;
    if (tid == 0) { int s = 0; for (int e = 0; e < NE; ++e) { ps[e] = s; s += ((int)__hip_atomic_load(cnt + e, __ATOMIC_RELAXED, __HIP_MEMORY_SCOPE_AGENT) + RB - 1) / RB * RB; } ps[NE] = s; }
    __syncthreads();
    char* sm = (char*)(ws + WS_SMALL);
    if (wg == 0) {
        int* blk_exp = (int*)(sm + SM_BLKEXP); int* nblk = (int*)(sm + SM_NBLK);
        if (tid < NBLK_MAX) { int e = NE - 1; for (int i = 0; i < NE; ++i) if (tid * RB >= ps[i] && tid * RB < ps[i + 1]) { e = i; break; } blk_exp[tid] = e; }
        if (tid == 0) *nblk = ps[NE] / RB;
    }
    if (tid < 64) {
        const int i = wg * 64 + tid; const int* eid = (const int*)(sm + SM_EID); const int* pos = (const int*)(sm + SM_POS);
        const int s = ps[eid[i]] + pos[i];
        ((int*)(sm + SM_SLOTTOK))[s] = i >> 1; ((int*)(sm + SM_TSLOT))[i] = s;
    }
    __syncthreads();
}
__device__ __forceinline__ void final_row(int t, const float* X1, const bf16* Y, unsigned char* ws, const float* fw, float* out, int lane) {
    typedef pg8::f32x4 f32x4;
    const char* sm = (const char*)(ws + WS_SMALL);
    const int s1 = ((const int*)(sm + SM_TSLOT))[t * 2], s2 = ((const int*)(sm + SM_TSLOT))[t * 2 + 1];
    const float g1 = ((const float*)(sm + SM_GATE))[t * 2], g2 = ((const float*)(sm + SM_GATE))[t * 2 + 1];
    const GAS f32x4* xr = (const GAS f32x4*)(X1 + (size_t)t * DM) + lane; const GAS f32x4* wr = (const GAS f32x4*)fw + lane;
    const GAS unsigned long long* y1 = (const GAS unsigned long long*)(Y + (size_t)s1 * DM) + lane; const GAS unsigned long long* y2 = (const GAS unsigned long long*)(Y + (size_t)s2 * DM) + lane;
    f32x4 v[8]; float ss = 0.f;
#pragma unroll
    for (int j = 0; j < 8; ++j) {
        const f32x4 x = xr[64 * j]; const unsigned long long a = y1[64 * j], b = y2[64 * j];
        const unsigned alo = (unsigned)a, ahi = (unsigned)(a >> 32), blo = (unsigned)b, bhi = (unsigned)(b >> 32);
        f32x4 r;
        r.x = x.x + (g1 * __builtin_bit_cast(float, alo << 16) + g2 * __builtin_bit_cast(float, blo << 16));
        r.y = x.y + (g1 * __builtin_bit_cast(float, alo & 0xffff0000u) + g2 * __builtin_bit_cast(float, blo & 0xffff0000u));
        r.z = x.z + (g1 * __builtin_bit_cast(float, ahi << 16) + g2 * __builtin_bit_cast(float, bhi << 16));
        r.w = x.w + (g1 * __builtin_bit_cast(float, ahi & 0xffff0000u) + g2 * __builtin_bit_cast(float, bhi & 0xffff0000u));
        v[j] = r; ss += (r.x * r.x + r.y * r.y) + (r.z * r.z + r.w * r.w);
    }
    const float rr = rsqrtf(wave_sum(ss) * (1.f / DM) + EPS);
    GAS f32x4* o = (GAS f32x4*)(out + (size_t)t * DM) + lane;
#pragma unroll
    for (int j = 0; j < 8; ++j) { const f32x4 g = wr[64 * j]; o[64 * j] = v[j] * rr * g; }
}

constexpr int NWAVES = 8;
constexpr int LDS_BYTES = 147456, LDSCTL_OFF = LDS_BYTES - 256;

struct Args { const float* in[31]; float* out; unsigned char* ws; int ph_lo, ph_hi, li, pad; };

struct Epi1 {
    bf16* PG; float* PGATE; float* PT;
    __device__ __forceinline__ void operator()(const pg8::f32x4 (&acc)[2][2][4][2], const pg8::Unit& u, int wr, int wc, int fr, int fq) const {
        const int row0 = u.pm * 256 + wr * 64 + fr;
        if (u.kind == 0) {
            if (u.pn < 16) {
                const int col0 = u.pn * 256 + wc * 32 + 8 * fq;
#pragma unroll
                for (int ai = 0; ai < 2; ++ai)
#pragma unroll
                    for (int m = 0; m < 4; ++m) { bf16* rowp = PG + (size_t)(row0 + ai * 128 + m * 16) * 4096 + col0;
#pragma unroll
                        for (int bj = 0; bj < 2; ++bj) { const pg8::f32x4 v0 = acc[ai][bj][m][0], v1 = acc[ai][bj][m][1];
                            pg8::u32x4 w; w.x = pg8::cvt_pk_bf16(v0[0], v0[1]); w.y = pg8::cvt_pk_bf16(v0[2], v0[3]); w.z = pg8::cvt_pk_bf16(v1[0], v1[1]); w.w = pg8::cvt_pk_bf16(v1[2], v1[3]);
                            *(pg8::u32x4*)(rowp + bj * 128) = w; } }
            } else if (wc == 0) {
#pragma unroll
                for (int ai = 0; ai < 2; ++ai)
#pragma unroll
                    for (int m = 0; m < 4; ++m) { float* rowp = PGATE + (size_t)(row0 + ai * 128 + m * 16) * 32 + 8 * fq;
                        *(pg8::f32x4*)(rowp) = acc[ai][0][m][0]; *(pg8::f32x4*)(rowp + 4) = acc[ai][0][m][1]; }
            }
        } else {
            const int col0 = u.pn * 256 + wc * 32 + 8 * fq;
#pragma unroll
            for (int ai = 0; ai < 2; ++ai)
#pragma unroll
                for (int m = 0; m < 4; ++m) { float* rowp = PT + (size_t)(row0 + ai * 128 + m * 16) * T + col0;
#pragma unroll
                    for (int bj = 0; bj < 2; ++bj) { *(pg8::f32x4*)(rowp + bj * 128) = acc[ai][bj][m][0]; *(pg8::f32x4*)(rowp + bj * 128 + 4) = acc[ai][bj][m][1]; } }
        }
    }
};
struct Order1 {
    const char* Hb; const char* WinT; int G, c;
    __device__ __forceinline__ bool next(int i, pg8::Unit& u) const {
        const int L = i * G + c;
        if (L >= 928) return false;
        u.rows = nullptr;
        if (L < 544) { int pm, pn; pg8::tile_of(L, 32, 17, pm, pn); u.pm = pm; u.pn = pn; u.kind = 0;
            u.A = Hb + (size_t)pm * 256 * DM * 2; u.B = WinT + (size_t)(GOFF + pn * 256) * DM * 2; }
        else { int pm, pn; pg8::tile_of(L - 544, 12, 32, pm, pn); u.pm = pm; u.pn = pn; u.kind = 1;
            u.A = WinT + (size_t)pm * 256 * DM * 2; u.B = Hb + (size_t)pn * 256 * DM * 2; }
        return true;
    }
};

struct Epi2 {
    const float* x; float* X1;
    __device__ __forceinline__ void operator()(const pg8::f32x4 (&acc)[2][2][4][2], const pg8::Unit& u, int wr, int wc, int fr, int fq) const {
        const int row0 = u.pm * 256 + wr * 64 + fr, col0 = u.pn * 256 + wc * 32 + 8 * fq;
#pragma unroll
        for (int ai = 0; ai < 2; ++ai)
#pragma unroll
            for (int m = 0; m < 4; ++m) { const size_t off = (size_t)(row0 + ai * 128 + m * 16) * DM + col0;
#pragma unroll
                for (int bj = 0; bj < 2; ++bj) {
                    const pg8::f32x4 x0 = *(const pg8::f32x4*)(x + off + bj * 128), x1 = *(const pg8::f32x4*)(x + off + bj * 128 + 4);
                    *(pg8::f32x4*)(X1 + off + bj * 128) = x0 + acc[ai][bj][m][0]; *(pg8::f32x4*)(X1 + off + bj * 128 + 4) = x1 + acc[ai][bj][m][1]; }
                asm volatile("" ::: "memory"); }
    }
};
struct Order2 {
    const char* A2; const char* WoutT; int G, c;
    __device__ __forceinline__ bool next(int i, pg8::Unit& u) const {
        const int L = i * G + c; if (L >= 256) return false;
        int pm, pn; pg8::tile_of(L, 32, 8, pm, pn); u.pm = pm; u.pn = pn; u.kind = 0; u.rows = nullptr;
        u.A = A2 + (size_t)pm * 256 * DM * 2; u.B = WoutT + (size_t)pn * 256 * DM * 2; return true;
    }
};
struct Epi3 {
    bf16* HH;
    __device__ __forceinline__ void operator()(const pg8::f32x4 (&acc)[2][2][4][2], const pg8::Unit& u, int wr, int wc, int fr, int fq) const {
        const int row0 = u.pm * 256 + wr * 64 + fr, col0 = u.pn * 128 + wc * 32 + 8 * fq;
#pragma unroll
        for (int ai = 0; ai < 2; ++ai)
#pragma unroll
            for (int m = 0; m < 4; ++m) { bf16* rowp = HH + (size_t)(row0 + ai * 128 + m * 16) * DE + col0;
                float v[8];
#pragma unroll
                for (int n = 0; n < 2; ++n)
#pragma unroll
                    for (int j = 0; j < 4; ++j) { const float a = acc[ai][0][m][n][j], b = acc[ai][1][m][n][j]; v[n * 4 + j] = a / (1.f + __expf(-a)) * b; }
                pg8::u32x4 w; w.x = pg8::cvt_pk_bf16(v[0], v[1]); w.y = pg8::cvt_pk_bf16(v[2], v[3]); w.z = pg8::cvt_pk_bf16(v[4], v[5]); w.w = pg8::cvt_pk_bf16(v[6], v[7]);
                *(pg8::u32x4*)rowp = w; }
    }
};
struct Order3 {
    const char* Ub; const char* W13T; const int* slot_tok; const int* blk_exp; int nunits, G, c;
    __device__ __forceinline__ bool next(int i, pg8::Unit& u) const {
        const int L = i * G + c; if (L >= nunits) return false;
        const int b = L >> 2, j = L & 3; u.pm = b; u.pn = j; u.kind = 0; u.rows = slot_tok + b * 256; u.A = Ub;
        const int e = __hip_atomic_load(blk_exp + b, __ATOMIC_RELAXED, __HIP_MEMORY_SCOPE_AGENT);
        u.B = W13T + ((size_t)e * 1024 + j * 256) * DM * 2; return true;
    }
};
struct Epi4 {
    bf16* Y;
    __device__ __forceinline__ void operator()(const pg8::f32x4 (&acc)[2][2][4][2], const pg8::Unit& u, int wr, int wc, int fr, int fq) const {
        const int row0 = u.pm * 256 + wr * 64 + fr, col0 = u.pn * 256 + wc * 32 + 8 * fq;
#pragma unroll
        for (int ai = 0; ai < 2; ++ai)
#pragma unroll
            for (int m = 0; m < 4; ++m) { bf16* rowp = Y + (size_t)(row0 + ai * 128 + m * 16) * DM + col0;
#pragma unroll
                for (int bj = 0; bj < 2; ++bj) { const pg8::f32x4 v0 = acc[ai][bj][m][0], v1 = acc[ai][bj][m][1];
                    pg8::u32x4 w; w.x = pg8::cvt_pk_bf16(v0[0], v0[1]); w.y = pg8::cvt_pk_bf16(v0[2], v0[3]); w.z = pg8::cvt_pk_bf16(v1[0], v1[1]); w.w = pg8::cvt_pk_bf16(v1[2], v1[3]);
                    *(pg8::u32x4*)(rowp + bj * 128) = w; } }
    }
};
struct Order4 {
    const char* HH; const char* W2T; const int* blk_exp; int nunits, G, c;
    __device__ __forceinline__ bool next(int i, pg8::Unit& u) const {
        const int L = i * G + c; if (L >= nunits) return false;
        const int b = L >> 3, j = L & 7; u.pm = b; u.pn = j; u.kind = 0; u.rows = nullptr; u.A = HH + (size_t)b * 256 * DE * 2;
        const int e = __hip_atomic_load(blk_exp + b, __ATOMIC_RELAXED, __HIP_MEMORY_SCOPE_AGENT);
        u.B = W2T + ((size_t)e * DM + j * 256) * DE * 2; return true;
    }
};

__device__ __forceinline__ void tr_item(const float* W, int ldn, int k0, int n0, bf16* WT, size_t dst_row0, int ldk, LAS float* scr, int lane) {
#pragma unroll 8
    for (int i = 0; i < 32; ++i) { const int kk = 2 * i + (lane >> 5); scr[kk * 33 + (lane & 31)] = W[(size_t)(k0 + kk) * ldn + n0 + (lane & 31)]; }
    asm volatile("s_waitcnt lgkmcnt(0)" ::: "memory");
    const int c = lane & 7;
#pragma unroll
    for (int j = 0; j < 4; ++j) { const int n = (lane >> 3) + 8 * j; const LAS float* s = scr + (8 * c) * 33 + n;
        v4u o; o.x = pk2(s[0 * 33], s[1 * 33]); o.y = pk2(s[2 * 33], s[3 * 33]); o.z = pk2(s[4 * 33], s[5 * 33]); o.w = pk2(s[6 * 33], s[7 * 33]);
        *(GAS v4u*)(WT + (dst_row0 + n) * ldk + k0 + 8 * c) = o; }
    asm volatile("s_waitcnt lgkmcnt(0)" ::: "memory");
}
__device__ __forceinline__ void rms_row_to_bf16(const float* xrow, const float* w, bf16* orow, int lane) {
    const GAS pg8::f32x4* xr = (const GAS pg8::f32x4*)xrow + lane; const GAS pg8::f32x4* wr = (const GAS pg8::f32x4*)w + lane;
    pg8::f32x4 v[8]; float s = 0.f;
#pragma unroll
    for (int j = 0; j < 8; ++j) { v[j] = xr[64 * j]; s += (v[j].x * v[j].x + v[j].y * v[j].y) + (v[j].z * v[j].z + v[j].w * v[j].w); }
    const float r = rsqrtf(wave_sum(s) * (1.f / DM) + EPS);
    GAS unsigned long long* o8 = (GAS unsigned long long*)orow + lane;
#pragma unroll
    for (int j = 0; j < 8; ++j) { const pg8::f32x4 g = wr[64 * j];
        o8[64 * j] = (unsigned long long)pk2(v[j].x * r * g.x, v[j].y * r * g.y) | ((unsigned long long)pk2(v[j].z * r * g.z, v[j].w * r * g.w) << 32); }
}

__global__ void __launch_bounds__(NWAVES * 64, 2) fwd(Args args) {
    extern __shared__ __attribute__((aligned(16))) unsigned char lds_raw[];
    LAS unsigned char* lds = (LAS unsigned char*)lds_raw;
    const int tid = threadIdx.x, lane = tid & 63, wave = __builtin_amdgcn_readfirstlane(tid >> 6);
    const int G = gridDim.x; const int bx = blockIdx.x; const int vcu = (G % 8 == 0) ? (bx % 8) * (G / 8) + bx / 8 : bx;
    unsigned char* ws = args.ws;
    unsigned* ctl = (unsigned*)(ws + WS_CTL);
    for (int u = tid; u < (LDS_BYTES - LDSCTL_OFF) / 4; u += NWAVES * 64) ((LAS unsigned*)(lds + LDSCTL_OFF))[u] = 0u;
    __syncthreads();
    XcdBarrier bar = xcd_barrier_post(ctl + CW_BAR + args.li * XCD_BAR_WORDS, (volatile LAS unsigned*)(lds + LDSCTL_OFF + 64));
    static_assert(2 * FFT_BUF_BYTES <= LDSCTL_OFF && 1024 * 33 * 4 <= LDSCTL_OFF, "LDS map");
    const int lo = args.ph_lo, hi = args.ph_hi;
#define IN(k) (lo <= (k) && (k) < hi)
#define BOTH(k) (IN(k) && IN((k) + 1))
    bf16* WinT = (bf16*)(ws + WS_WINT); bf16* Hb = (bf16*)(ws + WS_HB);

    if (IN(0)) {
        LAS float* scr = (LAS float*)(lds + wave * 16384);
        const int gw = vcu * NWAVES + wave, NGW = G * NWAVES;
        const float* w_in = args.in[2];
        for (int it = gw; it < 32 * 225; it += NGW) { const int kb = it / 225, nb = it % 225; tr_item(w_in, NPROJ, 64 * kb, 32 * nb, WinT, (size_t)(32 * nb), DM, scr, lane); }
        for (int r = gw; r < NPROJ_PAD - NPROJ; r += NGW) { GAS v4u* o = (GAS v4u*)(WinT + (size_t)(NPROJ + r) * DM) + lane;
#pragma unroll
            for (int j = 0; j < 4; ++j) o[64 * j] = (v4u){0u, 0u, 0u, 0u}; }
        { bf16* WoutT = (bf16*)(ws + WS_WOUTT); const float* w_out = args.in[21];
          for (int it = gw; it < 32 * 64; it += NGW) { const int kb = it >> 6, nb = it & 63; tr_item(w_out, DM, 64 * kb, 32 * nb, WoutT, (size_t)(32 * nb), DM, scr, lane); } }
        { bf16* W13T = (bf16*)(ws + WS_W13T); bf16* W2T = (bf16*)(ws + WS_W2T);
          const float* ew1 = args.in[27]; const float* ew3 = args.in[28]; const float* ew2 = args.in[29];
          for (int it = gw; it < 3 * 32768; it += NGW) {
              const int which = it >> 15, r = it & 32767, e = r >> 9, q = r & 511;
              if (which < 2) { const int kb = q >> 4, nb = q & 15, n0 = 32 * nb;
                  tr_item((which ? ew3 : ew1) + (size_t)e * DM * DE, DE, 64 * kb, n0, W13T, (size_t)e * 1024 + (n0 >> 7) * 256 + which * 128 + (n0 & 127), DM, scr, lane); }
              else { const int kb = q >> 6, nb = q & 63;
                  tr_item(ew2 + (size_t)e * DE * DM, DM, 64 * kb, 32 * nb, W2T, (size_t)e * DM + 32 * nb, DE, scr, lane); }
          } }
        for (int it = bx; it < 256; it += G)
            hyena_filter_item(lds, it, args.in[5], args.in[6], args.in[7], args.in[8], args.in[9], args.in[10], args.in[11], args.in[12], (float*)(ws + WS_KC), tid, lane, wave);
        { bf16* RWh = (bf16*)(ws + WS_SMALL + SM_RWT); bf16* RWl = RWh + 80 * 2048; const float* rgw = args.in[23]; const float* rew = args.in[25];
          for (int i = vcu * 512 + tid; i < 80 * 2048; i += G * 512) { const int n = i >> 11, k = i & 2047;
              const float w = n < 8 ? rgw[k * 8 + n] : (n < 72 ? rew[k * 64 + n - 8] : 0.f); const unsigned h = f2bf(w); const float hf = __builtin_bit_cast(float, h << 16);
              RWh[i] = (bf16)h; RWl[i] = (bf16)f2bf(w - hf); } }
        for (int m = gw; m < T; m += NGW) rms_row_to_bf16(args.in[0] + (size_t)m * DM, args.in[1], Hb + (size_t)m * DM, lane);
        if (BOTH(0)) xcd_barrier(bar);
    }
    if (IN(1)) {
        Order1 S{(const char*)Hb, (const char*)WinT, G, bx};
        Epi1 E{(bf16*)(ws + WS_PG), (float*)(ws + WS_PGATE), (float*)(ws + WS_PT)};
        pg8::gemm_phase<Epi1, Order1, false>(lds, DM, S, E);
        if (BOTH(1)) xcd_barrier(bar);
    }
    if (IN(2)) {
        hyena_phase(lds, (const float*)(ws + WS_PT), (const float*)(ws + WS_KC), args.in[3], args.in[4], args.in[13], (float*)(ws + WS_YHT), G, vcu);
        for (int wg = bx; wg < 256; wg += G) {
            gdn_pre(lds, wg, (const bf16*)(ws + WS_PG), (const float*)(ws + WS_PGATE), args.in[15], args.in[16], args.in[17], args.in[18], args.in[19], ws, tid, lane, wave);
            gdn_prep_wave(lds, wg, ws, lane, wave);
            __syncthreads();
        }
        if (BOTH(2)) xcd_barrier(bar);
    }
    if (IN(3)) {
        if (vcu < 64) gdn_scan(lds, ws, (float*)(ws + WS_OF), (float*)(ws + WS_OB), vcu, tid, lane, wave);
        if (BOTH(3)) xcd_barrier(bar);
    }
    if (IN(4)) {
        for (int tile = bx; tile < T / 32; tile += G) hyena_post_tile(lds, tile, (const float*)(ws + WS_YHT), args.in[14], (bf16*)(ws + WS_A2), tid, lane, wave);
        for (int it = vcu * NWAVES + wave; it < T * 8; it += G * NWAVES) gdn_post_item(it, (const float*)(ws + WS_OF), (const float*)(ws + WS_OB), (const bf16*)(ws + WS_PG), args.in[20], (bf16*)(ws + WS_A2), lane);
        if (BOTH(4)) xcd_barrier(bar);
    }
    if (IN(5)) {
        Order2 S{(const char*)(ws + WS_A2), (const char*)(ws + WS_WOUTT), G, bx};
        Epi2 E{args.in[0], (float*)(ws + WS_X1)};
        pg8::gemm_phase<Epi2, Order2, false>(lds, DM, S, E);
        if (BOTH(5)) xcd_barrier(bar);
    }
    if (IN(6)) {
        for (int wg = bx; wg < 256; wg += G) { route_phase(lds, wg, (const float*)(ws + WS_X1), args.in[22], args.in[24], args.in[26], ws, ctl + CW_CNT, tid, lane, wave); __syncthreads(); }
        if (BOTH(6)) xcd_barrier(bar);
    }
    if (IN(7)) {
        for (int wg = bx; wg < 256; wg += G) fill_phase(lds, wg, ws, ctl + CW_CNT, tid);
        if (BOTH(7)) xcd_barrier(bar);
    }
    const int* slot_tok = (const int*)(ws + WS_SMALL + SM_SLOTTOK); const int* blk_exp = (const int*)(ws + WS_SMALL + SM_BLKEXP); const int* nblk_p = (const int*)(ws + WS_SMALL + SM_NBLK);
    if (IN(8)) {
        const int nblk = __hip_atomic_load(nblk_p, __ATOMIC_RELAXED, __HIP_MEMORY_SCOPE_AGENT);
        Order3 S{(const char*)(ws + WS_UB), (const char*)(ws + WS_W13T), slot_tok, blk_exp, nblk * 4, G, vcu};
        Epi3 E{(bf16*)(ws + WS_HH)};
        pg8::gemm_phase<Epi3, Order3, true>(lds, DM, S, E);
        if (BOTH(8)) xcd_barrier(bar);
    }
    if (IN(9)) {
        const int nblk = __hip_atomic_load(nblk_p, __ATOMIC_RELAXED, __HIP_MEMORY_SCOPE_AGENT);
        Order4 S{(const char*)(ws + WS_HH), (const char*)(ws + WS_W2T), blk_exp, nblk * 8, G, vcu};
        Epi4 E{(bf16*)(ws + WS_Y)};
        pg8::gemm_phase<Epi4, Order4, false>(lds, DE, S, E);
        if (BOTH(9)) xcd_barrier(bar);
    }
    if (IN(10)) {
        for (int t = vcu * NWAVES + wave; t < T; t += G * NWAVES) final_row(t, (const float*)(ws + WS_X1), (const bf16*)(ws + WS_Y), ws, args.in[30], args.out, lane);
    }
#undef IN
#undef BOTH
}

#ifndef MK_PER_PHASE
#define MK_PER_PHASE 0
#endif
constexpr int N_PHASES = 11;
extern "C" void kernel_launch(void* const* d_in, const int* in_sizes, int n_in, void* d_out, int out_size, void* d_ws, size_t ws_size, hipStream_t stream) {
    static int grid = 0;
    if (grid == 0) {
        int dev = 0, cus = 0;
        (void)hipGetDevice(&dev); (void)hipDeviceGetAttribute(&cus, hipDeviceAttributeMultiprocessorCount, dev);
        (void)hipFuncSetAttribute((const void*)fwd, hipFuncAttributeMaxDynamicSharedMemorySize, LDS_BYTES);
        int per_cu = 0; (void)hipOccupancyMaxActiveBlocksPerMultiprocessor(&per_cu, (const void*)fwd, NWAVES * 64, LDS_BYTES);
        (void)hipGetLastError();
        grid = cus > 0 ? cus : 256;
    }
    (void)hipMemsetAsync((char*)d_ws + WS_CTL, 0, CTL_ZERO_BYTES, stream);
    Args a{};
    for (int i = 0; i < 31; ++i) a.in[i] = (const float*)d_in[i];
    a.out = (float*)d_out; a.ws = (unsigned char*)d_ws;
#if MK_PER_PHASE
    for (int p = 0; p < N_PHASES; ++p) { a.ph_lo = p; a.ph_hi = p + 1; a.li = 0; hipLaunchKernelGGL(fwd, dim3(grid), dim3(NWAVES * 64), LDS_BYTES, stream, a); }
#else
    a.ph_lo = 0; a.ph_hi = N_PHASES; a.li = 0;
    hipLaunchKernelGGL(fwd, dim3(grid), dim3(NWAVES * 64), LDS_BYTES, stream, a);
#endif
}
```

```cpp
#include <hip/hip_runtime.h>
#include <cstdio>
#include <cstdint>
#include <cmath>

constexpr int BATCH = 2, LSEQ = 4096, DM = 2048, T = BATCH * LSEQ;
constexpr int DHY = 1024, DGD = 1024, NH = 8, HD = 128;
constexpr int NPROJ = 3 * DHY + 4 * DGD + 4 * NH;
constexpr int GOFF = 3 * DHY;
constexpr int NPROJ_PAD = 7424;
constexpr int NG = 8, EPG = 8, NE = 64, DE = 512;
constexpr int RB = 256, PMAX = 32768, NBLK_MAX = 128;
constexpr float EPS = 1e-6f;

constexpr size_t MiB = 1u << 20;
constexpr size_t WS_CTL = 0;
constexpr size_t CTL_ZERO_BYTES = 1 * MiB;
constexpr size_t WS_SMALL = 2 * MiB;
constexpr size_t WS_WINT = 16 * MiB;
constexpr size_t WS_WOUTT = 608 * MiB;
constexpr size_t WS_HB = 56 * MiB;
constexpr size_t WS_PT = 88 * MiB;
constexpr size_t WS_PG = 184 * MiB;
constexpr size_t WS_PGATE = 248 * MiB;
constexpr size_t WS_A2 = 250 * MiB;
constexpr size_t WS_KC = 282 * MiB;
constexpr size_t WS_YHT = 314 * MiB;
constexpr size_t WS_X0 = 314 * MiB, WS_VG = 346 * MiB, WS_YH = 378 * MiB;
constexpr size_t WS_QN = 16 * MiB, WS_KN = 32 * MiB, WS_KT = 48 * MiB, WS_VT = 64 * MiB;
constexpr size_t WS_V = 346 * MiB, WS_OF = 378 * MiB, WS_OB = 410 * MiB;
constexpr size_t GW_B = 64 * 272, GKDT_B = 128 * 144, GQK_B = 64 * 144, GUT_B = 128 * 128;
constexpr size_t WS_GW = 442 * MiB;
constexpr size_t WS_GQD = WS_GW + 2048 * GW_B;
constexpr size_t WS_GKDT = WS_GQD + 2048 * GW_B;
constexpr size_t WS_GQK = WS_GKDT + 2048 * GKDT_B;
constexpr size_t WS_GUT = WS_GQK + 2048 * GQK_B;
constexpr size_t WS_GCD = WS_GUT + 2048 * GUT_B + 4096;
static_assert(WS_GCD + 2048 * 4 <= 640 * MiB, "ws map");
constexpr size_t WS_W13T = 640 * MiB;
constexpr size_t WS_W2T = 896 * MiB;
constexpr size_t WS_X1 = 282 * MiB;
constexpr size_t WS_U = 346 * MiB;
constexpr size_t WS_UB = 412 * MiB;
constexpr size_t WS_HH = 446 * MiB;
constexpr size_t WS_Y = 88 * MiB;
constexpr int CW_CNT = 0;
constexpr int CW_BAR = 4096;
constexpr size_t SM_LOGITS = 0;
constexpr size_t SM_GB = SM_LOGITS + (size_t)T * 72 * 4;
constexpr size_t SM_EID = SM_GB + (size_t)4 * T * 8 * 4;
constexpr size_t SM_GATE = SM_EID + (size_t)T * 2 * 4;
constexpr size_t SM_POS = SM_GATE + (size_t)T * 2 * 4;
constexpr size_t SM_TSLOT = SM_POS + (size_t)T * 2 * 4;
constexpr size_t SM_SLOTTOK = SM_TSLOT + (size_t)T * 2 * 4;
constexpr size_t SM_BLKEXP = SM_SLOTTOK + (size_t)PMAX * 4;
constexpr size_t SM_PADSTART = SM_BLKEXP + NBLK_MAX * 4;
constexpr size_t SM_NBLK = SM_PADSTART + NE * 4;
constexpr size_t SM_RWT = (SM_NBLK + 256 + 255) / 256 * 256;
static_assert(SM_RWT + 2 * 80 * 2048 * 2 <= 14 * MiB, "small region");

#define LAS __attribute__((address_space(3)))
#define GAS __attribute__((address_space(1)))
typedef unsigned short bf16;
typedef unsigned v4u __attribute__((ext_vector_type(4)));

__device__ __forceinline__ float dpp_f(float v, const int ctrl_unused) { return v; }
#define WS_DPP(v, ctrl) __builtin_bit_cast(float, __builtin_amdgcn_update_dpp(0, __builtin_bit_cast(int, (v)), (ctrl), 0xF, 0xF, true))
__device__ __forceinline__ float wave_sum(float v) {
    v += WS_DPP(v, 0xB1);
    v += WS_DPP(v, 0x4E);
    v += WS_DPP(v, 0x141);
    v += WS_DPP(v, 0x140);
    v += __shfl_xor(v, 16); v += __shfl_xor(v, 32);
    return v;
}
__device__ __forceinline__ float silu_f(float x) { return x / (1.f + expf(-x)); }
__device__ __forceinline__ float sigmoid_f(float x) { return 1.f / (1.f + expf(-x)); }
__device__ __forceinline__ float softplus_f(float x) { return fmaxf(x, 0.f) + log1pf(expf(-fabsf(x))); }
__device__ __forceinline__ unsigned f2bf(float f) { unsigned u = __builtin_bit_cast(unsigned, f); return (u + 0x7fffu + ((u >> 16) & 1u)) >> 16; }
__device__ __forceinline__ unsigned pk2(float lo, float hi) { return f2bf(lo) | (f2bf(hi) << 16); }
__device__ __forceinline__ float bf2f(bf16 b) { return __builtin_bit_cast(float, ((unsigned)b) << 16); }

#ifndef MK_DUP_MASK
#define MK_DUP_MASK 0
#endif
#define REP(k) _Pragma("unroll 1") for (int rep_ = 0; rep_ < (((MK_DUP_MASK) >> (k)) & 1) + 1; ++rep_)
constexpr int LDSCTL_OFF_C = 147456 - 256;
namespace pg8 {
#define PG8_LAS __attribute__((address_space(3)))
typedef unsigned short bf16_t;
typedef short bf16x8 __attribute__((ext_vector_type(8)));
typedef float f32x4 __attribute__((ext_vector_type(4)));
typedef unsigned u32x4 __attribute__((ext_vector_type(4)));
constexpr int BM = 256, BK = 64, HALF = 128, HTB = HALF * BK * 2  , STAGE_BYTES = 8 * HTB, NXCD = 8, WGM = 8;

__host__ __device__ __forceinline__ int lds_byte(int r, int c) { const int st = (r >> 4) * 2 + (c >> 5), rr = r & 15, cc = c & 31, ob = rr * 64 + cc * 2; return st * 1024 + (ob ^ (((ob >> 9) & 1) << 5)); }
__host__ __device__ __forceinline__ void stage_rc(int b, int& R, int& C) { const int st = b / 1024, sb = b % 1024, swz = sb ^ (((sb >> 9) & 1) << 5); R = (st >> 1) * 16 + swz / 64; C = (st & 1) * 32 + (swz % 64) / 2; }
__host__ __device__ __forceinline__ int perm32(int rho) { const int n = rho >> 4, i = rho & 15; return 8 * (i >> 2) + 4 * n + (i & 3); }

struct Unit { const char* A; const char* B; const int* rows; int pm, pn, kind; };

__device__ __forceinline__ void tile_of(int L, int nM, int nN, int& pm, int& pn) {
    const int nwg = nM * nN;
    int wgid = L; { const int q = nwg / NXCD, r = nwg % NXCD, xcd = wgid % NXCD, off = wgid / NXCD; wgid = (xcd < r ? xcd * (q + 1) : r * (q + 1) + (xcd - r) * q) + off; }
    const int nig = WGM * nN, gid = wgid / nig, fm = gid * WGM, gsz = (nM - fm) < WGM ? (nM - fm) : WGM;
    pm = fm + ((wgid % nig) % gsz); pn = (wgid % nig) / gsz;
}

typedef float cvt_f2 __attribute__((ext_vector_type(2)));
typedef __bf16 cvt_b2 __attribute__((ext_vector_type(2)));
__device__ __forceinline__ unsigned cvt_pk_bf16(float lo, float hi) { const cvt_f2 f = {lo, hi}; const cvt_b2 v = __builtin_convertvector(f, cvt_b2); return __builtin_bit_cast(unsigned, v); }

template <class Epi, class Sched, bool GATHER>
__device__ __forceinline__ void gemm_phase(PG8_LAS unsigned char* lds, const int K, const Sched& S, const Epi& E, const int tid) {
    const int wid = __builtin_amdgcn_readfirstlane(tid >> 6), lane = tid & 63, wr = wid >> 2, wc = wid & 3, fr = lane & 15, fq = lane >> 4;
    const int nt = K / BK;
    int Rr[2], Cc[2];
    unsigned voffB[2];
#pragma unroll
    for (int i = 0; i < 2; ++i) { stage_rc(tid * 16 + i * 8192, Rr[i], Cc[i]); const int Rb = (Rr[i] & ~31) + perm32(Rr[i] & 31); voffB[i] = (unsigned)(Rb * K + Cc[i]) * 2u; }
    const size_t kstep = (size_t)(BK * 2);
    const size_t hstep = (size_t)HALF * K * 2;
    const unsigned ldsw = (unsigned)wid * 1024u;
    const int aoff = lds_byte(wr * 64 + fr, fq * 8), boff = lds_byte(wc * 32 + fr, fq * 8);
#define PG8_SA(b, h) (((b) * 2 + (h)) * HTB)
#define PG8_SB(b, h) ((4 + (b) * 2 + (h)) * HTB)
#define PG8_STAGE2(bufoff, gbase, v0, v1) do { \
        __builtin_amdgcn_global_load_lds((const unsigned*)((const char*)(gbase) + (v0)), (PG8_LAS unsigned*)(lds + (bufoff) + ldsw), 16, 0, 0); \
        __builtin_amdgcn_global_load_lds((const unsigned*)((const char*)(gbase) + (v1)), (PG8_LAS unsigned*)(lds + (bufoff) + ldsw + 8192), 16, 0, 0); } while (0)
#define PG8_STAGEB(bufoff, gbase) PG8_STAGE2(bufoff, gbase, voffB[0], voffB[1])
#define PG8_LDA(dst, b, h) do { _Pragma("unroll") for (int m = 0; m < 4; ++m) _Pragma("unroll") for (int k = 0; k < 2; ++k) dst[m][k] = *(const PG8_LAS bf16x8*)(lds + PG8_SA(b, h) + aoff + m * 2048 + k * 1024); } while (0)
#define PG8_LDB(dst, b, h) do { _Pragma("unroll") for (int n = 0; n < 2; ++n) _Pragma("unroll") for (int k = 0; k < 2; ++k) dst[n][k] = *(const PG8_LAS bf16x8*)(lds + PG8_SB(b, h) + boff + n * 2048 + k * 1024); } while (0)
#define PG8_MMA(ai, bj, At, Bt) do { __builtin_amdgcn_s_setprio(1); _Pragma("unroll") for (int m = 0; m < 4; ++m) _Pragma("unroll") for (int n = 0; n < 2; ++n) _Pragma("unroll") for (int k = 0; k < 2; ++k) \
        acc[ai][bj][m][n] = __builtin_amdgcn_mfma_f32_16x16x32_bf16(Bt[n][k], At[m][k], acc[ai][bj][m][n], 0, 0, 0); __builtin_amdgcn_s_setprio(0); } while (0)
#define PG8_WAIT_V(n) asm volatile("s_waitcnt vmcnt(" #n ")" ::: "memory")
#define PG8_WAIT_L(n) asm volatile("s_waitcnt lgkmcnt(" #n ")" ::: "memory")
#define PG8_BAR __builtin_amdgcn_s_barrier()
#define PG8_SCHED __builtin_amdgcn_sched_barrier(0)
    Unit cur, nxt; int ui = 0;
    if (!S.next(0, cur)) return;
    f32x4 acc[2][2][4][2];
#pragma unroll
    for (int a = 0; a < 2; ++a)
#pragma unroll
        for (int b = 0; b < 2; ++b)
#pragma unroll
            for (int m = 0; m < 4; ++m)
#pragma unroll
                for (int n = 0; n < 2; ++n) acc[a][b][m][n] = (f32x4){0.f, 0.f, 0.f, 0.f};
    bf16x8 At[4][2], B0[2][2], B1[2][2];
    unsigned c00, c01, c10, c11, n00, n01, n10, n11;
    if constexpr (GATHER) {
        c00 = (unsigned)cur.rows[Rr[0]] * (unsigned)(K * 2) + (unsigned)Cc[0] * 2u; c01 = (unsigned)cur.rows[Rr[1]] * (unsigned)(K * 2) + (unsigned)Cc[1] * 2u;
        c10 = (unsigned)cur.rows[128 + Rr[0]] * (unsigned)(K * 2) + (unsigned)Cc[0] * 2u; c11 = (unsigned)cur.rows[128 + Rr[1]] * (unsigned)(K * 2) + (unsigned)Cc[1] * 2u;
    } else {
        c00 = (unsigned)(Rr[0] * K + Cc[0]) * 2u; c01 = (unsigned)(Rr[1] * K + Cc[1]) * 2u;
        c10 = c00 + (unsigned)hstep; c11 = c01 + (unsigned)hstep;
    }
    n00 = c00; n01 = c01; n10 = c10; n11 = c11;
    const char* cA = cur.A; const char* cB = cur.B;
    PG8_STAGEB(PG8_SB(0, 0), cB); PG8_STAGEB(PG8_SB(0, 1), cB + hstep); PG8_STAGE2(PG8_SA(0, 0), cA, c00, c01); PG8_STAGE2(PG8_SA(0, 1), cA, c10, c11);
    if (wr == 1) PG8_BAR;
    PG8_WAIT_V(2); PG8_BAR;
    PG8_STAGEB(PG8_SB(1, 0), cB + kstep); PG8_STAGE2(PG8_SA(1, 0), cA + kstep, c00, c01); PG8_STAGEB(PG8_SB(1, 1), cB + hstep + kstep);
    PG8_WAIT_V(6); PG8_BAR;
    for (;;) {
        const bool has_next = S.next(ui + 1, nxt);
        const char* nA = has_next ? nxt.A : cA; const char* nB = has_next ? nxt.B : cB;
        if constexpr (GATHER) {
            if (has_next) {
                n00 = (unsigned)nxt.rows[Rr[0]] * (unsigned)(K * 2) + (unsigned)Cc[0] * 2u; n01 = (unsigned)nxt.rows[Rr[1]] * (unsigned)(K * 2) + (unsigned)Cc[1] * 2u;
                n10 = (unsigned)nxt.rows[128 + Rr[0]] * (unsigned)(K * 2) + (unsigned)Cc[0] * 2u; n11 = (unsigned)nxt.rows[128 + Rr[1]] * (unsigned)(K * 2) + (unsigned)Cc[1] * 2u;
            } else { n00 = c00; n01 = c01; n10 = c10; n11 = c11; }
        }
        for (int t = 0; t < nt; t += 2) {
            const bool last = (t == nt - 2);
            const char* a1 = cA + (size_t)(t + 1) * kstep;
            const char* a2 = last ? nA : cA + (size_t)(t + 2) * kstep; const char* b2 = last ? nB : cB + (size_t)(t + 2) * kstep;
            const char* a3 = a2 + kstep; const char* b3 = b2 + kstep;
            unsigned e00, e01, e10, e11;
            if constexpr (GATHER) { e00 = last ? n00 : c00; e01 = last ? n01 : c01; e10 = last ? n10 : c10; e11 = last ? n11 : c11; } else { e00 = c00; e01 = c01; e10 = c10; e11 = c11; }
            PG8_LDB(B0, 0, 0); PG8_LDB(B1, 0, 1); PG8_SCHED; PG8_LDA(At, 0, 0); PG8_STAGE2(PG8_SA(1, 1), a1, c10, c11);
            PG8_WAIT_V(8); PG8_WAIT_L(0); PG8_BAR; PG8_MMA(0, 0, At, B0); PG8_MMA(0, 1, At, B1); PG8_BAR; PG8_SCHED;
            PG8_LDA(At, 0, 1); PG8_STAGEB(PG8_SB(0, 0), b2); PG8_STAGEB(PG8_SB(0, 1), b2 + hstep); PG8_STAGE2(PG8_SA(0, 0), a2, e00, e01);
            PG8_WAIT_V(8); PG8_WAIT_L(0); PG8_BAR; PG8_MMA(1, 0, At, B0); PG8_MMA(1, 1, At, B1); PG8_BAR; PG8_SCHED;
            PG8_LDB(B0, 1, 0); PG8_LDB(B1, 1, 1); PG8_SCHED; PG8_LDA(At, 1, 0); PG8_STAGE2(PG8_SA(0, 1), a2, e10, e11);
            PG8_WAIT_V(8); PG8_WAIT_L(0); PG8_BAR; PG8_MMA(0, 0, At, B0); PG8_MMA(0, 1, At, B1); PG8_BAR; PG8_SCHED;
            PG8_LDA(At, 1, 1); PG8_STAGEB(PG8_SB(1, 0), b3); PG8_STAGEB(PG8_SB(1, 1), b3 + hstep); PG8_STAGE2(PG8_SA(1, 0), a3, e00, e01);
            PG8_WAIT_V(8); PG8_WAIT_L(0); PG8_BAR; PG8_MMA(1, 0, At, B0); PG8_MMA(1, 1, At, B1); PG8_BAR; PG8_SCHED;
        }
        if (wr == 0) PG8_BAR;
        E(acc, cur, wr, wc, fr, fq);
        if (!has_next) break;
#pragma unroll
        for (int a = 0; a < 2; ++a)
#pragma unroll
            for (int b = 0; b < 2; ++b)
#pragma unroll
                for (int m = 0; m < 4; ++m)
#pragma unroll
                    for (int n = 0; n < 2; ++n) acc[a][b][m][n] = (f32x4){0.f, 0.f, 0.f, 0.f};
        cur = nxt; cA = nA; cB = nB; ++ui;
        if constexpr (GATHER) { c00 = n00; c01 = n01; c10 = n10; c11 = n11; }
        if (wr == 1) PG8_BAR;
    }
    PG8_WAIT_V(0);
    PG8_BAR;
#undef PG8_SA
#undef PG8_SB
#undef PG8_STAGE2
#undef PG8_STAGEB
#undef PG8_LDA
#undef PG8_LDB
#undef PG8_MMA
#undef PG8_WAIT_V
#undef PG8_WAIT_L
#undef PG8_BAR
#undef PG8_SCHED
}
}

#define XB_TMO      128
#define XB_XCNT(j)  (256  + 64 * (j))
#define XB_XSUB(j)  (1280 + 64 * (j))
#define XB_XGEN(j)  (2304 + 64 * (j))
#define XB_TOP      3328
#define XB_TOPGEN   3392
#define XCD_BAR_WORDS 3456
#define XB_SPIN_CAP (1u << 18)
__device__ __forceinline__ unsigned xb_ld(unsigned* p)              { return __hip_atomic_load(p, __ATOMIC_RELAXED, __HIP_MEMORY_SCOPE_AGENT); }
__device__ __forceinline__ unsigned xb_add(unsigned* p, unsigned v) { return __hip_atomic_fetch_add(p, v, __ATOMIC_RELAXED, __HIP_MEMORY_SCOPE_AGENT); }
__device__ __forceinline__ unsigned xb_xcc_id() { return (unsigned)__builtin_amdgcn_s_getreg((3 << 11) | 20) & 0xFu; }
#define XB_SPIN(cond, bar) do { unsigned _sp = 0; while (cond) { __builtin_amdgcn_s_sleep(1); \
    if ((++_sp & 255u) == 0u) { if (xb_ld(&(bar)[XB_TMO])) break; if (_sp > XB_SPIN_CAP) { atomicAdd(&(bar)[XB_TMO], 1u); break; } } } } while (0)
struct XcdBarrier { unsigned* bar; unsigned x; volatile LAS unsigned* st; };
__device__ __forceinline__ XcdBarrier xcd_barrier_post(unsigned* bar, volatile LAS unsigned* st) {
    XcdBarrier b; b.bar = bar; b.x = xb_xcc_id(); b.st = st;
    if (threadIdx.x == 0) (void)xb_add(&bar[XB_XCNT(b.x)], 1u);
    return b;
}
__device__ __forceinline__ void xcd_barrier_complete(unsigned* bar, unsigned x, unsigned& nloc, unsigned& nx) {
    const unsigned G = gridDim.x * gridDim.y * gridDim.z;
    unsigned sum, cnt, mine, sp = 0u;
    for (;;) {
        sum = 0u; cnt = 0u; mine = 0u;
#pragma unroll
        for (unsigned j = 0; j < 16; ++j) { const unsigned c = xb_ld(&bar[XB_XCNT(j)]); sum += c; cnt += (c > 0u) ? 1u : 0u; mine = (j == x) ? c : mine; }
        if (sum == G) break;
        __builtin_amdgcn_s_sleep(1);
        if ((++sp & 255u) == 0u) { if (xb_ld(&bar[XB_TMO])) break; if (sp > XB_SPIN_CAP) { atomicAdd(&bar[XB_TMO], 1u); break; } }
    }
    nloc = mine > 0u ? mine : 1u; nx = cnt > 0u ? cnt : 1u;
}
__device__ __forceinline__ void xcd_barrier(const XcdBarrier& b) {
    asm volatile("s_waitcnt vmcnt(0)" ::: "memory");
    __syncthreads();
    if (threadIdx.x == 0) {
        unsigned* bar = b.bar;
        __builtin_amdgcn_s_waitcnt(0);
        unsigned nloc = b.st[0], nx = b.st[1];
        if (nloc == 0u) { xcd_barrier_complete(bar, b.x, nloc, nx); b.st[0] = nloc; b.st[1] = nx; }
        const unsigned old = xb_add(&bar[XB_XSUB(b.x)], 1u);
        const unsigned gen = old / nloc;
        if (old + 1u == (gen + 1u) * nloc) {
            __builtin_amdgcn_fence(__ATOMIC_RELEASE, "agent");
            asm volatile("s_waitcnt vmcnt(0)" ::: "memory");
            const unsigned og = xb_add(&bar[XB_TOP], 1u);
            const unsigned tg = og / nx;
            if (og + 1u == (tg + 1u) * nx) xb_add(&bar[XB_TOPGEN], 1u);
            else XB_SPIN(xb_ld(&bar[XB_TOPGEN]) == tg, bar);
            __builtin_amdgcn_fence(__ATOMIC_ACQUIRE, "agent");
            xb_add(&bar[XB_XGEN(b.x)], 1u);
            asm volatile("s_waitcnt vmcnt(0)" ::: "memory");
        } else {
            XB_SPIN(xb_ld(&bar[XB_XGEN(b.x)]) == gen, bar);
            __builtin_amdgcn_fence(__ATOMIC_ACQUIRE, "agent");
            asm volatile("s_waitcnt vmcnt(0)" ::: "memory");
        }
    }
    __syncthreads();
}


#define HD __device__ __forceinline__
struct cpx { float x, y; };
HD cpx cadd(cpx a, cpx b) { return cpx{a.x + b.x, a.y + b.y}; }
HD cpx csub(cpx a, cpx b) { return cpx{a.x - b.x, a.y - b.y}; }
HD cpx cmul(cpx a, cpx b) { return cpx{a.x * b.x - a.y * b.y, a.x * b.y + a.y * b.x}; }
HD cpx cconj(cpx a) { return cpx{a.x, -a.y}; }
HD int fft_pp(int p) { return p + 2 * (p >> 5); }
constexpr int FFT_N = 8192, FFT_BUF_BYTES = (FFT_N + 2 * (FFT_N >> 5)) * 8;

template <bool INV> HD cpx mul_w16(cpx d, int k) {
    const float C1 = 0.92387953251128674f, S1 = 0.38268343236508977f, R2 = 0.70710678118654752f;
    float c, s;
    switch (k & 15) {
        case 0: return d;
        case 4: return INV ? cpx{-d.y, d.x} : cpx{d.y, -d.x};
        case 8: return cpx{-d.x, -d.y};
        case 12: return INV ? cpx{d.y, -d.x} : cpx{-d.y, d.x};
        case 1: c = C1; s = S1; break;
        case 2: c = R2; s = R2; break;
        case 3: c = S1; s = C1; break;
        case 5: c = -S1; s = C1; break;
        case 6: c = -R2; s = R2; break;
        case 7: c = -C1; s = S1; break;
        case 9: c = -C1; s = -S1; break;
        case 10: c = -R2; s = -R2; break;
        case 11: c = -S1; s = -C1; break;
        case 13: c = S1; s = -C1; break;
        case 14: c = R2; s = -R2; break;
        default: c = C1; s = -S1; break;
    }
    if (INV) s = -s;
    return cpx{d.x * c + d.y * s, d.y * c - d.x * s};
}
template <bool INV, int HALF> HD void dft16_stage(cpx (&v)[16]) {
#pragma unroll
    for (int g = 0; g < 16; g += 2 * HALF) {
#pragma unroll
        for (int i = 0; i < HALF; ++i) {
            const cpx a = v[g + i], b = v[g + i + HALF];
            v[g + i] = cadd(a, b);
            v[g + i + HALF] = mul_w16<INV>(csub(a, b), i * (8 / HALF));
        }
    }
}
template <bool INV> HD void dft16(cpx (&v)[16]) {
    dft16_stage<INV, 8>(v); dft16_stage<INV, 4>(v); dft16_stage<INV, 2>(v); dft16_stage<INV, 1>(v);
    cpx t;
    t = v[1]; v[1] = v[8]; v[8] = t;   t = v[2]; v[2] = v[4]; v[4] = t;   t = v[3]; v[3] = v[12]; v[12] = t;
    t = v[5]; v[5] = v[10]; v[10] = t; t = v[7]; v[7] = v[14]; v[14] = t; t = v[11]; v[11] = v[13]; v[13] = t;
}
template <bool INV> HD void twiddle16(cpx (&v)[16], float frac) {
    float s, c;
    asm volatile("" : "+v"(frac));
#if defined(__HIP_DEVICE_COMPILE__)
    sincospif(2.0f * frac, &s, &c);
#else
    s = sinf(6.283185307179586f * frac); c = cosf(6.283185307179586f * frac);
#endif
    const cpx w1 = INV ? cpx{c, s} : cpx{c, -s};
    cpx w = w1;
#pragma unroll
    for (int q = 1; q < 16; ++q) { v[q] = cmul(v[q], w); if (q < 15) w = cmul(w, w1); }
}
HD int fft_k_of_p(int p) { return (p >> 9) + 16 * ((p >> 5) & 15) + 256 * (p & 31); }
HD int fft_p_of_k(int k) { return (k & 15) * 512 + ((k >> 4) & 15) * 32 + (k >> 8); }

typedef float f2v __attribute__((ext_vector_type(2)));
__device__ __forceinline__ cpx ldc(const LAS cpx* b, int i) { const f2v v = ((const LAS f2v*)b)[i]; return cpx{v.x, v.y}; }
__device__ __forceinline__ void stc(LAS cpx* b, int i, cpx v) { ((LAS f2v*)b)[i] = (f2v){v.x, v.y}; }
__device__ __forceinline__ float dpp_xor1(float v) { return __builtin_bit_cast(float, __builtin_amdgcn_update_dpp(0, __builtin_bit_cast(int, v), 0xB1, 0xF, 0xF, true)); }
__device__ __forceinline__ void fft_fwd_pass2(LAS cpx* buf, int t) {
    const int blk = t >> 5, r2 = t & 31; cpx v[16];
#pragma unroll
    for (int j = 0; j < 16; ++j) v[j] = ldc(buf, fft_pp(blk * 512 + j * 32 + r2));
    dft16<false>(v); twiddle16<false>(v, (float)r2 * (1.f / 512.f));
#pragma unroll
    for (int q = 0; q < 16; ++q) stc(buf, fft_pp(blk * 512 + q * 32 + r2), v[q]);
}
__device__ __forceinline__ void fft_fwd_pass3(const LAS cpx* buf, int t, cpx (&v)[16]) {
    const int b = t >> 1, r = t & 1;
#pragma unroll
    for (int j = 0; j < 16; ++j) v[j] = ldc(buf, fft_pp(b * 32 + 2 * j + r));
    dft16<false>(v); twiddle16<false>(v, (float)r * (1.f / 32.f));
#pragma unroll
    for (int q = 0; q < 16; ++q) { const float px = dpp_xor1(v[q].x), py = dpp_xor1(v[q].y);
        v[q] = r ? cpx{px - v[q].x, py - v[q].y} : cpx{v[q].x + px, v[q].y + py}; }
}
__device__ __forceinline__ float bload(__amdgpu_buffer_rsrc_t rs, int voff, int soff) { return __builtin_bit_cast(float, __builtin_amdgcn_raw_buffer_load_b32(rs, voff, soff, 0)); }
__device__ __forceinline__ float conv3_b(__amdgpu_buffer_rsrc_t rs, int voff, int e0, float w0, float w1, float w2, float bias, bool lo_ok, bool hi_ok) {
    const float xm = (e0 > 0) ? bload(rs, voff, e0 * 4 - 4) : bload(rs, voff - 4, 0);
    const float xc = bload(rs, voff, e0 * 4), xp = bload(rs, voff + 4, e0 * 4);
    return bias + w1 * xc + (lo_ok ? w0 * xm : 0.f) + (hi_ok ? w2 * xp : 0.f);
}
__device__ __forceinline__ void hyena_phase(LAS unsigned char* lds, const float* PT, const float* KC, const float* cw, const float* cb, const float* skip, float* YHT, int G, int vcu) {
    LAS cpx* Wb = (LAS cpx*)lds;
    LAS cpx* Lb = (LAS cpx*)(lds + FFT_BUF_BYTES);
    const int t0 = threadIdx.x;
#define HY_T() int t = t0; asm volatile("" : "+v"(t))
    for (int pair = vcu; pair < 512; pair += G) {
        const int c0 = 2 * pair;
        {
            HY_T();
            const __amdgpu_buffer_rsrc_t rsk = __builtin_amdgcn_make_buffer_rsrc((void*)(KC + (size_t)c0 * 8192), 0, 65536, 0x00020000);
            cpx v[16];
#pragma unroll
            for (int j = 0; j < 16; ++j) v[j] = cpx{bload(rsk, t * 4, j * 2048), bload(rsk, t * 4, 32768 + j * 2048)};
            dft16<false>(v); twiddle16<false>(v, (float)t * (1.f / 8192.f));
#pragma unroll
            for (int q = 0; q < 16; ++q) stc(Wb, fft_pp(q * 512 + t), v[q]);
        }
        __syncthreads();
        { HY_T(); fft_fwd_pass2(Wb, t); }
        __syncthreads();
        { HY_T(); cpx v[16]; fft_fwd_pass3(Wb, t, v); __syncthreads();
          const int b = t >> 1, r = t & 1;
#pragma unroll
          for (int q = 0; q < 16; ++q) stc(Wb, fft_pp(b * 32 + 16 * r + q), v[q]); }
        __syncthreads();
#pragma unroll 1
        for (int ch = 0; ch < 2; ++ch) {
            const int c = c0 + ch;
            float vg[2][8];
            {
                HY_T();
                const __amdgpu_buffer_rsrc_t rs1 = __builtin_amdgcn_make_buffer_rsrc((void*)(PT + (size_t)(1024 + c) * T), 0, T * 4, 0x00020000);
                const __amdgpu_buffer_rsrc_t rs2 = __builtin_amdgcn_make_buffer_rsrc((void*)(PT + (size_t)(2048 + c) * T), 0, T * 4, 0x00020000);
                const float a0 = cw[1024 + c], a1 = cw[3072 + 1024 + c], a2 = cw[6144 + 1024 + c], ab = cb[1024 + c];
                const float v0 = cw[2048 + c], v1 = cw[3072 + 2048 + c], v2 = cw[6144 + 2048 + c], vb = cb[2048 + c];
#pragma unroll
                for (int b = 0; b < 2; ++b)
#pragma unroll
                    for (int j = 0; j < 8; ++j) { const bool lo = (j > 0) || (t > 0), hi = (j < 7) || (t < 511);
                        int vo = t * 4;
                        if (j == 0) asm volatile("" : "+v"(vo));
                        vg[b][j] = conv3_b(rs2, vo, b * LSEQ + j * 512, v0, v1, v2, vb, lo, hi) * conv3_b(rs1, vo, b * LSEQ + j * 512, a0, a1, a2, ab, lo, hi);
                        if (j == 7) asm volatile("" : "+v"(vg[b][0]), "+v"(vg[b][1]), "+v"(vg[b][2]), "+v"(vg[b][3]), "+v"(vg[b][4]), "+v"(vg[b][5]), "+v"(vg[b][6]), "+v"(vg[b][7])); }
                cpx v[16];
#pragma unroll
                for (int j = 0; j < 8; ++j) { v[j] = cpx{vg[0][j], vg[1][j]}; v[8 + j] = cpx{0.f, 0.f}; }
                dft16<false>(v); twiddle16<false>(v, (float)t * (1.f / 8192.f));
#pragma unroll
                for (int q = 0; q < 16; ++q) stc(Lb, fft_pp(q * 512 + t), v[q]);
            }
            __syncthreads();
            { HY_T(); fft_fwd_pass2(Lb, t); }
            __syncthreads();
            {
                HY_T();
                cpx v[16]; fft_fwd_pass3(Lb, t, v);
                const int b = t >> 1, r = t & 1;
                const float sc = 0.5f / 8192.f;
#pragma unroll
                for (int q = 0; q < 16; ++q) {
                    const int p = b * 32 + 16 * r + q, k = fft_k_of_p(p), km = (8192 - k) & 8191, pm = fft_p_of_k(km);
                    const cpx Wk = ldc(Wb, fft_pp(p)), Wm = ldc(Wb, fft_pp(pm));
                    cpx H;
                    if (ch == 0) H = cpx{(Wk.x + Wm.x) * sc, (Wk.y - Wm.y) * sc};
                    else H = cpx{(Wk.y + Wm.y) * sc, (Wm.x - Wk.x) * sc};
                    v[q] = cmul(v[q], H);
                    if ((q & 3) == 3) asm volatile("" ::: "memory");
                }
#pragma unroll
                for (int q = 0; q < 16; ++q) { const float px = dpp_xor1(v[q].x), py = dpp_xor1(v[q].y);
                    v[q] = r ? cpx{px - v[q].x, py - v[q].y} : cpx{v[q].x + px, v[q].y + py}; }
                twiddle16<true>(v, (float)r * (1.f / 32.f)); dft16<true>(v);
                __syncthreads();
#pragma unroll
                for (int j = 0; j < 16; ++j) stc(Lb, fft_pp(b * 32 + 2 * j + r), v[j]);
            }
            __syncthreads();
            {
                HY_T();
                const int blk = t >> 5, r2 = t & 31; cpx v[16];
#pragma unroll
                for (int q = 0; q < 16; ++q) v[q] = ldc(Lb, fft_pp(blk * 512 + q * 32 + r2));
                twiddle16<true>(v, (float)r2 * (1.f / 512.f)); dft16<true>(v);
                __syncthreads();
#pragma unroll
                for (int j = 0; j < 16; ++j) stc(Lb, fft_pp(blk * 512 + j * 32 + r2), v[j]);
            }
            __syncthreads();
            {
                HY_T();
                cpx v[16];
#pragma unroll
                for (int q = 0; q < 16; ++q) v[q] = ldc(Lb, fft_pp(q * 512 + t));
                twiddle16<true>(v, (float)t * (1.f / 8192.f)); dft16<true>(v);
                const __amdgpu_buffer_rsrc_t rs0 = __builtin_amdgcn_make_buffer_rsrc((void*)(PT + (size_t)c * T), 0, T * 4, 0x00020000);
                const __amdgpu_buffer_rsrc_t rsy = __builtin_amdgcn_make_buffer_rsrc((void*)(YHT + (size_t)c * T), 0, T * 4, 0x00020000);
                const float x0 = cw[c], x1 = cw[3072 + c], x2 = cw[6144 + c], xb = cb[c], sk = skip[c];
#pragma unroll
                for (int j = 0; j < 8; ++j) { const bool lo = (j > 0) || (t > 0), hi = (j < 7) || (t < 511);
                    int vo = t * 4;
                    if ((j & 3) == 0) asm volatile("" : "+v"(vo));
                    float o0 = (v[j].x + vg[0][j] * sk) * conv3_b(rs0, vo, j * 512, x0, x1, x2, xb, lo, hi);
                    float o1 = (v[j].y + vg[1][j] * sk) * conv3_b(rs0, vo, LSEQ + j * 512, x0, x1, x2, xb, lo, hi);
                    if ((j & 3) == 3) asm volatile("" : "+v"(o0), "+v"(o1));
                    __builtin_amdgcn_raw_buffer_store_b32(__builtin_bit_cast(unsigned, o0), rsy, t * 4, j * 2048, 0);
                    __builtin_amdgcn_raw_buffer_store_b32(__builtin_bit_cast(unsigned, o1), rsy, t * 4, (LSEQ + j * 512) * 4, 0); }
            }
            __syncthreads();
        }
    }
}
#undef HY_T
__device__ __forceinline__ void hyena_filter_item(LAS unsigned char* lds, int item, const float* w1, const float* b1, const float* w2, const float* b2, const float* w3, const float* b3,
                                                  const float* w4, const float* freq, float* KC, int tid, int lane, int wave) {
    LAS float* H3 = (LAS float*)lds;
    LAS float* sc = (LAS float*)(lds + 4096) + wave * 128;
    const int l0 = item * 16;
    __syncthreads();
#pragma unroll 1
    for (int pp = 0; pp < 2; ++pp) {
        const int li = wave * 2 + pp, l = l0 + li;
        const float tt = (float)l / (float)(LSEQ - 1);
        if (lane == 0) sc[0] = tt;
        if (lane < 16) { const float omega = (2.0f * 3.14159265358979323846f / (float)LSEQ) * (float)l; const float fb = 1e-4f + (float)lane * ((15.0f - 1e-4f) / 15.0f); const float ang = omega * fb;
            sc[1 + lane] = cosf(ang); sc[17 + lane] = -sinf(ang); }
        asm volatile("s_waitcnt lgkmcnt(0)" ::: "memory");
        const float fr = freq[lane];
        float s = b1[lane];
#pragma unroll 3
        for (int i = 0; i < 33; ++i) s += sc[i] * w1[i * 64 + lane];
        float h = sinf(fr * s);
        asm volatile("s_waitcnt lgkmcnt(0)" ::: "memory"); sc[64 + lane] = h; asm volatile("s_waitcnt lgkmcnt(0)" ::: "memory");
        s = b2[lane];
#pragma unroll 4
        for (int i = 0; i < 64; ++i) s += sc[64 + i] * w2[i * 64 + lane];
        h = sinf(fr * s);
        asm volatile("s_waitcnt lgkmcnt(0)" ::: "memory"); sc[lane] = h; asm volatile("s_waitcnt lgkmcnt(0)" ::: "memory");
        s = b3[lane];
#pragma unroll 4
        for (int i = 0; i < 64; ++i) s += sc[i] * w3[i * 64 + lane];
        h = sinf(fr * s);
        H3[lane * 16 + li] = h;
        asm volatile("s_waitcnt lgkmcnt(0)" ::: "memory");
    }
    __syncthreads();
    const float max_decay = logf(1e-2f) / 0.3f, min_decay = logf(1e-2f) / 1.5f;
#pragma unroll 1
    for (int cc = 0; cc < 2; ++cc) {
        const int c = tid + 512 * cc;
        float hf[16], hb[16];
#pragma unroll
        for (int l = 0; l < 16; ++l) { hf[l] = 0.f; hb[l] = 0.f; }
#pragma unroll 2
        for (int i = 0; i < 64; ++i) {
            const float wf = w4[i * 2048 + c], wb = w4[i * 2048 + 1024 + c];
#pragma unroll
            for (int l = 0; l < 16; ++l) { const float hv = H3[i * 16 + l]; hf[l] = fmaf(hv, wf, hf[l]); hb[l] = fmaf(hv, wb, hb[l]); }
        }
        const float delta = fabsf(min_decay + (float)c * ((max_decay - min_decay) / (float)(DHY - 1)));
        float* kc = KC + (size_t)c * 8192;
#pragma unroll
        for (int l = 0; l < 16; ++l) {
            const int ll = l0 + l; const float win = expf(-((float)ll / (float)(LSEQ - 1)) * delta);
            const float f = hf[l] * win, bb = hb[l] * win;
            if (ll == 0) { kc[0] = f + bb; kc[4096] = 0.f; } else { kc[ll] = f; kc[8192 - ll] = bb; }
        }
    }
    __syncthreads();
}
__device__ __forceinline__ void hyena_post_tile(LAS unsigned char* lds, int tile, const float* YHT, const float* nw, bf16* A2, int tid, int lane, int wave) {
    LAS float* tl = (LAS float*)lds;
    const int tok0 = tile * 32, tk = tid & 31, cg = tid >> 5;
    for (int i = 0; i < 64; ++i) { const int c = cg + 16 * i; tl[c * 33 + tk] = YHT[(size_t)c * T + tok0 + tk]; }
    __syncthreads();
    for (int q = 0; q < 4; ++q) {
        const int tq = wave * 4 + q; float v[16]; float ss = 0.f;
#pragma unroll
        for (int i = 0; i < 16; ++i) { v[i] = tl[(lane + 64 * i) * 33 + tq]; ss += v[i] * v[i]; }
        const float r = rsqrtf(wave_sum(ss) * (1.f / DHY) + EPS);
#pragma unroll
        for (int i = 0; i < 16; ++i) { const int c = lane + 64 * i; A2[(size_t)(tok0 + tq) * DM + c] = (bf16)f2bf(v[i] * r * nw[c]); }
    }
    __syncthreads();
}


constexpr int GP_TILE = 128 * 132;
constexpr int GP_GATES = 143104;
constexpr int GP_WREG2 = 8448 + 512;
constexpr int GP_TT = 64 * 68 * 4;
__device__ __forceinline__ int aoff_fn(int i) { const int q = i >> 2, r = i & 3; return 4 * (2 * q * q + q + (r >= 1 ? q : 0) + (r >= 2 ? q + 1 : 0) + (r >= 3 ? q + 1 : 0)); }
static_assert(8 * GP_TILE <= GP_GATES && 8 * GP_WREG2 + 4 * GP_TT <= GP_GATES && GP_GATES + 4096 <= LDSCTL_OFF_C, "gdn prep LDS");
__device__ __forceinline__ void gdn_pre(LAS unsigned char* lds, int wg, const bf16* PG, const float* PGATE, const float* cw, const float* alf, const float* alb, const float* dtf, const float* dtb,
                                        unsigned char* ws, int tid, int lane, int wave) {
    const int bh = wg >> 4, b = bh >> 3, h = bh & 7, l0 = 256 * (wg & 15), cid0 = bh * 64 + 4 * (wg & 15);
    LAS float* gates = (LAS float*)(lds + GP_GATES);
    float w[3][3][2];
#pragma unroll
    for (int x = 0; x < 3; ++x)
#pragma unroll
        for (int tp = 0; tp < 3; ++tp)
#pragma unroll
            for (int e = 0; e < 2; ++e) w[x][tp][e] = cw[tp * 3072 + x * 1024 + h * 128 + 2 * lane + e];
    const int lw = l0 + 32 * wave;
    const unsigned* pgw = (const unsigned*)PG;
    auto ldraw = [&](int l, int x) -> unsigned { return (l >= 0 && l < LSEQ) ? pgw[((size_t)(b * LSEQ + l) * 4096 + x * 1024 + h * 128) / 2 + lane] : 0u; };
    if (lane < 32) {
        const int l = lw + lane, li = 32 * wave + lane; const float* pr = PGATE + (size_t)(b * LSEQ + l) * 32;
        gates[0 * 256 + li] = -expf(alf[h]) * softplus_f(pr[16 + h] + dtf[h]);
        gates[1 * 256 + li] = -expf(alb[h]) * softplus_f(pr[24 + h] + dtb[h]);
        gates[2 * 256 + li] = sigmoid_f(pr[h]);
        gates[3 * 256 + li] = sigmoid_f(pr[8 + h]);
    }
#pragma unroll 1
    for (int bt8 = 0; bt8 < 4; ++bt8) {
        unsigned raw[3][10];
#pragma unroll
        for (int x = 0; x < 3; ++x)
#pragma unroll
            for (int k = 0; k < 10; ++k) raw[x][k] = ldraw(lw + 8 * bt8 - 1 + k, x);
#pragma unroll
        for (int k = 0; k < 8; ++k) {
            const int tt = 8 * bt8 + k, li = 32 * wave + tt, cl = li >> 6, i = li & 63;
            float r[3][2];
#pragma unroll
            for (int x = 0; x < 3; ++x) {
                const unsigned pv = raw[x][k], cv = raw[x][k + 1], nv = raw[x][k + 2];
                const float p0 = __builtin_bit_cast(float, pv << 16), p1 = __builtin_bit_cast(float, pv & 0xffff0000u);
                const float c0 = __builtin_bit_cast(float, cv << 16), c1 = __builtin_bit_cast(float, cv & 0xffff0000u);
                const float n0 = __builtin_bit_cast(float, nv << 16), n1 = __builtin_bit_cast(float, nv & 0xffff0000u);
                r[x][0] = silu_f(w[x][0][0] * p0 + w[x][1][0] * c0 + w[x][2][0] * n0);
                r[x][1] = silu_f(w[x][0][1] * p1 + w[x][1][1] * c1 + w[x][2][1] * n1);
            }
            const float qs = rsqrtf(wave_sum(r[0][0] * r[0][0] + r[0][1] * r[0][1]) + EPS);
            const float ks = rsqrtf(wave_sum(r[1][0] * r[1][0] + r[1][1] * r[1][1]) + EPS);
            const unsigned qp = pk2(r[0][0] * qs, r[0][1] * qs), kp = pk2(r[1][0] * ks, r[1][1] * ks), vp = pk2(r[2][0], r[2][1]);
            const size_t rowoff = ((size_t)(cid0 + cl) * 64 + i) * 64 + lane;
            ((unsigned*)(ws + WS_QN))[rowoff] = qp; ((unsigned*)(ws + WS_KN))[rowoff] = kp;
            LAS bf16* kt = (LAS bf16*)(lds + (cl * 2 + 0) * GP_TILE); LAS bf16* vt = (LAS bf16*)(lds + (cl * 2 + 1) * GP_TILE);
            kt[(2 * lane) * 66 + i] = (bf16)(kp & 0xffffu); kt[(2 * lane + 1) * 66 + i] = (bf16)(kp >> 16);
            vt[(2 * lane) * 66 + i] = (bf16)(vp & 0xffffu); vt[(2 * lane + 1) * 66 + i] = (bf16)(vp >> 16);
        }
    }
    __syncthreads();
    for (int it = wave; it < 8 * 64; it += 8) {
        const int tile = it >> 6, rp = it & 63, row = 2 * rp + (lane >> 5), cl = tile >> 1, which = tile & 1;
        const unsigned v = *(const LAS unsigned*)(lds + tile * GP_TILE + row * 132 + (lane & 31) * 4);
        ((unsigned*)(ws + (which ? WS_VT : WS_KT)))[((size_t)(cid0 + cl) * 128 + row) * 32 + (lane & 31)] = v;
    }
    asm volatile("s_waitcnt vmcnt(0)" ::: "memory");
    __syncthreads();
}
__device__ __forceinline__ void gdn_prep_wave(LAS unsigned char* lds, int wg, unsigned char* ws, int lane, int wave) {
    typedef pg8::bf16x8 bf16x8; typedef pg8::f32x4 f32x4;
    const int cl = wave >> 1, dir = wave & 1, bh = wg >> 4, cid = bh * 64 + 4 * (wg & 15) + cl; const size_t ci = (size_t)cid * 2 + dir;
    const int fr = lane & 15, fq = lane >> 4;
    LAS unsigned char* R = lds + wave * GP_WREG2;
    LAS float* Tt = (LAS float*)(lds + 8 * GP_WREG2 + (wave & 3) * GP_TT);
    LAS float* Ap = (LAS float*)R;
    LAS float* gcA = (LAS float*)(R + 8448); LAS float* btA = gcA + 64;
    const LAS float* gates = (const LAS float*)(lds + GP_GATES);
    const bf16* QN = (const bf16*)(ws + WS_QN) + (size_t)cid * 64 * 128; const bf16* KN = (const bf16*)(ws + WS_KN) + (size_t)cid * 64 * 128;
    const bf16* KT = (const bf16*)(ws + WS_KT) + (size_t)cid * 128 * 64; const bf16* VT = (const bf16*)(ws + WS_VT) + (size_t)cid * 128 * 64;
    unsigned char* GW = ws + WS_GW + ci * GW_B; unsigned char* GQD = ws + WS_GQD + ci * GW_B; unsigned char* GKDT = ws + WS_GKDT + ci * GKDT_B;
    unsigned char* GQK = ws + WS_GQK + ci * GQK_B; unsigned char* GUT = ws + WS_GUT + ci * GUT_B;
#define RIDX(i) (dir ? 63 - (i) : (i))
    const float bt = gates[(2 + dir) * 256 + 64 * cl + RIDX(lane)];
    float gc = gates[dir * 256 + 64 * cl + RIDX(lane)];
#pragma unroll
    for (int o = 1; o < 64; o <<= 1) { const float t = __shfl_up(gc, o); if (lane >= o) gc += t; }
    const float gl = __shfl(gc, 63);
    gcA[lane] = gc; btA[lane] = bt;
    asm volatile("s_waitcnt lgkmcnt(0)" ::: "memory");
    if (lane == 0) ((float*)(ws + WS_GCD))[ci] = expf(gl);
    {
    bf16x8 kfr[4][4];
#pragma unroll
    for (int t4 = 0; t4 < 4; ++t4)
#pragma unroll
        for (int ks = 0; ks < 4; ++ks) kfr[t4][ks] = *(const bf16x8*)(KN + (size_t)RIDX(16 * t4 + fr) * 128 + 32 * ks + 8 * fq);
    __builtin_amdgcn_sched_barrier(0);
#pragma unroll
    for (int mt = 0; mt < 4; ++mt) {
        const f32x4 gi = *(const LAS f32x4*)(gcA + 16 * mt + 4 * fq), bi = *(const LAS f32x4*)(btA + 16 * mt + 4 * fq);
#pragma unroll
        for (int nt = 0; nt <= mt; ++nt) {
            f32x4 c = (f32x4){0.f, 0.f, 0.f, 0.f};
#pragma unroll
            for (int ks = 0; ks < 4; ++ks) c = __builtin_amdgcn_mfma_f32_16x16x32_bf16(kfr[mt][ks], kfr[nt][ks], c, 0, 0, 0);
            const int j = 16 * nt + fr; const float gj = gcA[j];
#pragma unroll
            for (int r = 0; r < 4; ++r) { const int i = 16 * mt + 4 * fq + r; if (j < ((i + 3) & ~3)) Ap[aoff_fn(i) + j] = (j < i) ? bi[r] * c[r] * __expf(gi[r] - gj) : 0.f; }
        }
    }
#pragma unroll 1
    for (int ih = 0; ih < 2; ++ih) {
        bf16x8 qfr[2][4];
#pragma unroll
        for (int t2 = 0; t2 < 2; ++t2)
#pragma unroll
            for (int ks = 0; ks < 4; ++ks) qfr[t2][ks] = *(const bf16x8*)(QN + (size_t)RIDX(16 * (2 * ih + t2) + fr) * 128 + 32 * ks + 8 * fq);
        __builtin_amdgcn_sched_barrier(0);
#pragma unroll
        for (int i2 = 0; i2 < 2; ++i2) {
            const int it = 2 * ih + i2;
            const int i = 16 * it + fr; const float gi = gcA[i];
#pragma unroll
            for (int jt = 0; jt < 4; ++jt) {
                f32x4 c = (f32x4){0.f, 0.f, 0.f, 0.f};
                if (jt <= it) {
#pragma unroll
                    for (int ks = 0; ks < 4; ++ks) c = __builtin_amdgcn_mfma_f32_16x16x32_bf16(kfr[jt][ks], qfr[i2][ks], c, 0, 0, 0);
                }
                const f32x4 gj = *(const LAS f32x4*)(gcA + 16 * jt + 4 * fq);
                float v[4];
#pragma unroll
                for (int r = 0; r < 4; ++r) { const int j = 16 * jt + 4 * fq + r; v[r] = (j <= i) ? c[r] * __expf(gi - gj[r]) * 0.08838834764831845f : 0.f; }
                *(unsigned long long*)(GQK + i * 144 + (32 * (jt >> 1) + 8 * fq + 4 * (jt & 1)) * 2) = (unsigned long long)pg8::cvt_pk_bf16(v[0], v[1]) | ((unsigned long long)pg8::cvt_pk_bf16(v[2], v[3]) << 32);
            }
        }
    }
    }
    {
    {
        const int L2 = lane & 31, m = 4 * L2, src = (m & ~31) + ((m & 4) ? 16 + 4 * ((m & 31) >> 3) : 4 * ((m & 31) >> 3));
#pragma unroll 8
        for (int rp = 0; rp < 32; ++rp) {
            const int i = 2 * rp + (lane >> 5);
            const unsigned long long q = *(const unsigned long long*)(QN + (size_t)RIDX(i) * 128 + src);
            const float sc = __expf(gcA[i]) * 0.08838834764831845f;
            const unsigned lo = (unsigned)q, hi = (unsigned)(q >> 32);
            const float a0 = __builtin_bit_cast(float, lo << 16) * sc, a1 = __builtin_bit_cast(float, lo & 0xffff0000u) * sc, a2 = __builtin_bit_cast(float, hi << 16) * sc, a3 = __builtin_bit_cast(float, hi & 0xffff0000u) * sc;
            *(unsigned long long*)(GQD + i * 272 + m * 2) = (unsigned long long)pg8::cvt_pk_bf16(a0, a1) | ((unsigned long long)pg8::cvt_pk_bf16(a2, a3) << 32);
        }
        const int L4 = lane & 15, mm = 4 * L4, isrc = (mm & ~31) + ((mm & 4) ? 16 + 4 * ((mm & 31) >> 3) : 4 * ((mm & 31) >> 3));
        const f32x4 gi4 = *(const LAS f32x4*)(gcA + isrc);
        float sc4[4];
#pragma unroll
        for (int r = 0; r < 4; ++r) sc4[r] = __expf(gl - gi4[r]);
#pragma unroll 8
        for (int rq = 0; rq < 32; ++rq) {
            const int dk = 4 * rq + (lane >> 4);
            const unsigned long long k = *(const unsigned long long*)(KT + (size_t)dk * 64 + (dir ? 60 - isrc : isrc));
            const unsigned lo = (unsigned)k, hi = (unsigned)(k >> 32);
            float e0 = __builtin_bit_cast(float, lo << 16), e1 = __builtin_bit_cast(float, lo & 0xffff0000u), e2 = __builtin_bit_cast(float, hi << 16), e3 = __builtin_bit_cast(float, hi & 0xffff0000u);
            const float f0 = dir ? e3 : e0, f1 = dir ? e2 : e1, f2 = dir ? e1 : e2, f3 = dir ? e0 : e3;
            *(unsigned long long*)(GKDT + dk * 144 + mm * 2) = (unsigned long long)pg8::cvt_pk_bf16(f0 * sc4[0], f1 * sc4[1]) | ((unsigned long long)pg8::cvt_pk_bf16(f2 * sc4[2], f3 * sc4[3]) << 32);
        }
    }
    asm volatile("s_waitcnt lgkmcnt(0)" ::: "memory");
    }
    asm volatile("s_waitcnt lgkmcnt(0)" ::: "memory");
    __syncthreads();
    const float s_u = bt, s_w = bt * __expf(gc);
    const int cn = RIDX(lane);
#pragma unroll 1
    for (int round = 0; round < 2; ++round) {
        if ((wave >> 2) == round) {
            LAS float* trow = Tt + lane * 68;
#pragma unroll
            for (int q = 0; q < 16; ++q) *(LAS f32x4*)(trow + 4 * q) = (f32x4){(4 * q == lane) ? 1.f : 0.f, (4 * q + 1 == lane) ? 1.f : 0.f, (4 * q + 2 == lane) ? 1.f : 0.f, (4 * q + 3 == lane) ? 1.f : 0.f};
            asm volatile("s_waitcnt lgkmcnt(0)" ::: "memory");
            int ao = 0;
            for (int i = 1; i < 64; ++i) {
                const LAS float* ar = Ap + ao;
                f32x4 acc4 = (f32x4){0.f, 0.f, 0.f, 0.f};
                const int n4 = (i + 3) >> 2;
                for (int q = 0; q < n4; ++q) { const f32x4 a4 = *(const LAS f32x4*)(ar + 4 * q), t4 = *(const LAS f32x4*)(trow + 4 * q); acc4 += a4 * t4; }
                const float sv = (acc4[0] + acc4[1]) + (acc4[2] + acc4[3]);
                if (lane < i) trow[i] = -sv;
                asm volatile("s_waitcnt lgkmcnt(0)" ::: "memory");
                ao += 4 * n4;
            }
#define GP_WRITE_T(scale) do { LAS bf16* Tq = (LAS bf16*)R; \
                for (int j0 = 0; j0 < 64; j0 += 8) { const f32x4 ta = *(const LAS f32x4*)(trow + j0), tb = *(const LAS f32x4*)(trow + j0 + 4); \
                    _Pragma("unroll") for (int e = 0; e < 4; ++e) { Tq[(j0 + e) * 64 + cn] = (bf16)f2bf(ta[e] * (scale)); Tq[(j0 + 4 + e) * 64 + cn] = (bf16)f2bf(tb[e] * (scale)); } } \
                asm volatile("s_waitcnt lgkmcnt(0)" ::: "memory"); } while (0)
            GP_WRITE_T(s_w);
#pragma unroll 1
            for (int dh = 0; dh < 2; ++dh) {
                bf16x8 ktf[4][2];
#pragma unroll
                for (int d4 = 0; d4 < 4; ++d4)
#pragma unroll
                    for (int ks = 0; ks < 2; ++ks) ktf[d4][ks] = *(const bf16x8*)(KT + (size_t)(16 * (4 * dh + d4) + fr) * 64 + 32 * ks + 8 * fq);
                __builtin_amdgcn_sched_barrier(0);
#pragma unroll 1
                for (int it = 0; it < 4; ++it) {
                    bf16x8 tf[2];
#pragma unroll
                    for (int ks = 0; ks < 2; ++ks) tf[ks] = *(const LAS bf16x8*)(R + ((16 * it + fr) * 64 + 32 * ks + 8 * fq) * 2);
                    const int i = 16 * it + fr;
#pragma unroll
                    for (int d4 = 0; d4 < 4; ++d4) {
                        const int dt = 4 * dh + d4;
                        f32x4 c = (f32x4){0.f, 0.f, 0.f, 0.f};
#pragma unroll
                        for (int ks = 0; ks < 2; ++ks) c = __builtin_amdgcn_mfma_f32_16x16x32_bf16(ktf[d4][ks], tf[ks], c, 0, 0, 0);
                        *(unsigned long long*)(GW + i * 272 + (32 * (dt >> 1) + 8 * fq + 4 * (dt & 1)) * 2) = (unsigned long long)pg8::cvt_pk_bf16(c[0], c[1]) | ((unsigned long long)pg8::cvt_pk_bf16(c[2], c[3]) << 32);
                    }
                }
            }
            asm volatile("s_waitcnt lgkmcnt(0)" ::: "memory");
            GP_WRITE_T(s_u);
#pragma unroll 1
            for (int vh = 0; vh < 2; ++vh) {
                bf16x8 vtf[4][2];
#pragma unroll
                for (int v4 = 0; v4 < 4; ++v4)
#pragma unroll
                    for (int ks = 0; ks < 2; ++ks) vtf[v4][ks] = *(const bf16x8*)(VT + (size_t)(16 * (4 * vh + v4) + fr) * 64 + 32 * ks + 8 * fq);
                __builtin_amdgcn_sched_barrier(0);
#pragma unroll 1
                for (int it = 0; it < 4; ++it) {
                    bf16x8 tf[2];
#pragma unroll
                    for (int ks = 0; ks < 2; ++ks) tf[ks] = *(const LAS bf16x8*)(R + ((16 * it + fr) * 64 + 32 * ks + 8 * fq) * 2);
#pragma unroll
                    for (int v4 = 0; v4 < 4; ++v4) {
                        const int vt = 4 * vh + v4;
                        f32x4 c = (f32x4){0.f, 0.f, 0.f, 0.f};
#pragma unroll
                        for (int ks = 0; ks < 2; ++ks) c = __builtin_amdgcn_mfma_f32_16x16x32_bf16(tf[ks], vtf[v4][ks], c, 0, 0, 0);
                        *(unsigned long long*)(GUT + (16 * vt + fr) * 128 + (16 * it + 4 * fq) * 2) = (unsigned long long)pg8::cvt_pk_bf16(c[0], c[1]) | ((unsigned long long)pg8::cvt_pk_bf16(c[2], c[3]) << 32);
                    }
                }
            }
#undef GP_WRITE_T
        }
        __syncthreads();
    }
#undef RIDX
}

__host__ __device__ __forceinline__ int mperm32(int o) { return ((o & 15) >> 2) * 8 + (o >> 4) * 4 + (o & 3); }
__host__ __device__ __forceinline__ int mcol(int x) { return (x & ~31) + mperm32(x & 31); }
constexpr int SC_W = 0, SC_QD = 17408, SC_KDT = 34816, SC_QK = 53248, SC_UT = 62464, SC_STEP = 64512;
static_assert(2 * SC_STEP <= LDSCTL_OFF_C, "scan LDS");
__device__ __forceinline__ void gdn_scan(LAS unsigned char* lds, const unsigned char* ws, float* OF, float* OB, int vcu, int tid, int lane, int wave) {
    typedef pg8::bf16x8 bf16x8; typedef pg8::f32x4 f32x4;
    const int chain = vcu >> 3, slice = vcu & 7, dir = chain & 1, bh = chain >> 1, b = bh >> 3, h = bh & 7;
    const int fr = lane & 15, fq = lane >> 4;
    const int dv0 = slice * 16;
    float* O = dir ? OB : OF;
    auto issue = [&](int s, int buf) {
        const int n = dir ? 63 - s : s; const size_t ci = ((size_t)(bh * 64 + n) * 2 + dir);
#pragma unroll
        for (int k = 0; k < 8; ++k) {
            const int p = wave + 8 * k;
            if (p < 63) {
                const unsigned char* g; int l;
                if (p < 17) { g = ws + WS_GW + ci * GW_B + p * 1024; l = SC_W + p * 1024; }
                else if (p < 34) { g = ws + WS_GQD + ci * GW_B + (p - 17) * 1024; l = SC_QD + (p - 17) * 1024; }
                else if (p < 52) { g = ws + WS_GKDT + ci * GKDT_B + (p - 34) * 1024; l = SC_KDT + (p - 34) * 1024; }
                else if (p < 61) { g = ws + WS_GQK + ci * GQK_B + (p - 52) * 1024; l = SC_QK + (p - 52) * 1024; }
                else { g = ws + WS_GUT + ci * GUT_B + slice * 2048 + (p - 61) * 1024; l = SC_UT + (p - 61) * 1024; }
                __builtin_amdgcn_global_load_lds((const unsigned*)(g + lane * 16), (LAS unsigned*)(lds + buf * SC_STEP + l), 16, 0, 0);
            }
        }
    };
    f32x4 S[8];
#pragma unroll
    for (int i = 0; i < 8; ++i) S[i] = (f32x4){0.f, 0.f, 0.f, 0.f};
    LAS float* cdl = (LAS float*)(lds + 2 * SC_STEP);
    if (wave == 0) { const int n = dir ? 63 - lane : lane; cdl[lane] = __builtin_bit_cast(float, __hip_atomic_load((const unsigned*)(ws + WS_GCD) + ((size_t)(bh * 64 + n) * 2 + dir), __ATOMIC_RELAXED, __HIP_MEMORY_SCOPE_AGENT)); }
    issue(0, 0);
    asm volatile("s_waitcnt vmcnt(0)" ::: "memory"); __syncthreads();
    for (int s = 0; s < 64; ++s) {
        const int buf = s & 1;
        if (s + 1 < 64) issue(s + 1, buf ^ 1);
        if (wave == 0) {
            const LAS unsigned char* L = lds + buf * SC_STEP;
            const int n = dir ? 63 - s : s;
            const float cd = cdl[s];
#define SC_RD(dst, addr, off) asm volatile("ds_read_b128 %0, %1 offset:%2" : "=v"(dst) : "v"(addr), "i"(off))
#define SC_WAIT(n, f) do { asm volatile("s_waitcnt lgkmcnt(" #n ")" : "+v"(f[0]), "+v"(f[1]), "+v"(f[2]), "+v"(f[3]), "+v"(f[4]), "+v"(f[5]), "+v"(f[6]), "+v"(f[7])); __builtin_amdgcn_sched_barrier(0); } while (0)
#define SC_LD_WQ(dst, mt) do { SC_RD(dst[0], wb, SC_W + (mt) * 4352); SC_RD(dst[1], wb, SC_W + (mt) * 4352 + 64); SC_RD(dst[2], wb, SC_W + (mt) * 4352 + 128); SC_RD(dst[3], wb, SC_W + (mt) * 4352 + 192); \
                SC_RD(dst[4], wb, SC_QD + (mt) * 4352); SC_RD(dst[5], wb, SC_QD + (mt) * 4352 + 64); SC_RD(dst[6], wb, SC_QD + (mt) * 4352 + 128); SC_RD(dst[7], wb, SC_QD + (mt) * 4352 + 192); } while (0)
#define SC_LD_K(dst, base, t0) do { SC_RD(dst[0], kb, (base) + (t0) * 2304); SC_RD(dst[1], kb, (base) + (t0) * 2304 + 64); SC_RD(dst[2], kb, (base) + ((t0) + 1) * 2304); SC_RD(dst[3], kb, (base) + ((t0) + 1) * 2304 + 64); \
                SC_RD(dst[4], kb, (base) + ((t0) + 2) * 2304); SC_RD(dst[5], kb, (base) + ((t0) + 2) * 2304 + 64); SC_RD(dst[6], kb, (base) + ((t0) + 3) * 2304); SC_RD(dst[7], kb, (base) + ((t0) + 3) * 2304 + 64); } while (0)
            const unsigned wb = (unsigned)(size_t)(L + fr * 272 + fq * 16), kb = (unsigned)(size_t)(L + fr * 144 + fq * 16);
            bf16x8 Sb[4];
#pragma unroll
            for (int ks = 0; ks < 4; ++ks) { pg8::u32x4 w; w.x = pg8::cvt_pk_bf16(S[2 * ks][0], S[2 * ks][1]); w.y = pg8::cvt_pk_bf16(S[2 * ks][2], S[2 * ks][3]);
                w.z = pg8::cvt_pk_bf16(S[2 * ks + 1][0], S[2 * ks + 1][1]); w.w = pg8::cvt_pk_bf16(S[2 * ks + 1][2], S[2 * ks + 1][3]); Sb[ks] = __builtin_bit_cast(bf16x8, w); }
            unsigned long long uu[4];
#pragma unroll
            for (int mt = 0; mt < 4; ++mt) uu[mt] = *(const LAS unsigned long long*)(L + SC_UT + fr * 128 + (16 * mt + 4 * fq) * 2);
            asm volatile("s_waitcnt lgkmcnt(0)" : "+v"(uu[0]), "+v"(uu[1]), "+v"(uu[2]), "+v"(uu[3]));
            __builtin_amdgcn_sched_barrier(0);
            bf16x8 fa[8], fb[8];
            f32x4 vn[4], o[4];
#define SC_MMA_WQ(src, mt) do { f32x4 a_ = (f32x4){0.f, 0.f, 0.f, 0.f}, q_ = (f32x4){0.f, 0.f, 0.f, 0.f}; \
                _Pragma("unroll") for (int ks = 0; ks < 4; ++ks) { a_ = __builtin_amdgcn_mfma_f32_16x16x32_bf16(src[ks], Sb[ks], a_, 0, 0, 0); q_ = __builtin_amdgcn_mfma_f32_16x16x32_bf16(src[4 + ks], Sb[ks], q_, 0, 0, 0); } \
                const unsigned ulo = (unsigned)uu[mt], uhi = (unsigned)(uu[mt] >> 32); \
                vn[mt][0] = __builtin_bit_cast(float, ulo << 16) - a_[0]; vn[mt][1] = __builtin_bit_cast(float, ulo & 0xffff0000u) - a_[1]; \
                vn[mt][2] = __builtin_bit_cast(float, uhi << 16) - a_[2]; vn[mt][3] = __builtin_bit_cast(float, uhi & 0xffff0000u) - a_[3]; o[mt] = q_; } while (0)
            SC_LD_WQ(fa, 0); SC_LD_WQ(fb, 1);
            SC_WAIT(8, fa); SC_MMA_WQ(fa, 0); __builtin_amdgcn_sched_barrier(0);
            SC_LD_WQ(fa, 2); SC_WAIT(8, fb); SC_MMA_WQ(fb, 1); __builtin_amdgcn_sched_barrier(0);
            SC_LD_WQ(fb, 3); SC_WAIT(8, fa); SC_MMA_WQ(fa, 2); __builtin_amdgcn_sched_barrier(0);
            SC_LD_K(fa, SC_QK, 0); SC_WAIT(8, fb); SC_MMA_WQ(fb, 3); __builtin_amdgcn_sched_barrier(0);
            bf16x8 vb[2];
#pragma unroll
            for (int ks = 0; ks < 2; ++ks) { pg8::u32x4 w; w.x = pg8::cvt_pk_bf16(vn[2 * ks][0], vn[2 * ks][1]); w.y = pg8::cvt_pk_bf16(vn[2 * ks][2], vn[2 * ks][3]);
                w.z = pg8::cvt_pk_bf16(vn[2 * ks + 1][0], vn[2 * ks + 1][1]); w.w = pg8::cvt_pk_bf16(vn[2 * ks + 1][2], vn[2 * ks + 1][3]); vb[ks] = __builtin_bit_cast(bf16x8, w); }
            __builtin_amdgcn_sched_barrier(0);
            SC_LD_K(fb, SC_KDT, 0); SC_WAIT(8, fa);
#pragma unroll
            for (int mt = 0; mt < 4; ++mt) {
#pragma unroll
                for (int ks = 0; ks < 2; ++ks) o[mt] = __builtin_amdgcn_mfma_f32_16x16x32_bf16(fa[2 * mt + ks], vb[ks], o[mt], 0, 0, 0);
            }
            __builtin_amdgcn_sched_barrier(0);
            SC_LD_K(fa, SC_KDT, 4); SC_WAIT(8, fb);
#pragma unroll
            for (int dt = 0; dt < 4; ++dt) { f32x4 a_ = S[dt] * cd;
#pragma unroll
                for (int ks = 0; ks < 2; ++ks) a_ = __builtin_amdgcn_mfma_f32_16x16x32_bf16(fb[2 * dt + ks], vb[ks], a_, 0, 0, 0);
                S[dt] = a_; }
            __builtin_amdgcn_sched_barrier(0);
            SC_WAIT(0, fa);
#pragma unroll
            for (int dt = 0; dt < 4; ++dt) { f32x4 a_ = S[4 + dt] * cd;
#pragma unroll
                for (int ks = 0; ks < 2; ++ks) a_ = __builtin_amdgcn_mfma_f32_16x16x32_bf16(fa[2 * dt + ks], vb[ks], a_, 0, 0, 0);
                S[4 + dt] = a_; }
#pragma unroll
            for (int mt = 0; mt < 4; ++mt)
#pragma unroll
                for (int r = 0; r < 4; ++r) { const int i = 16 * mt + 4 * fq + r; const int l = 64 * n + (dir ? 63 - i : i);
                    O[((size_t)b * LSEQ + l) * DGD + h * 128 + dv0 + fr] = o[mt][r]; }
#undef SC_RD
#undef SC_WAIT
#undef SC_LD_WQ
#undef SC_LD_K
#undef SC_MMA_WQ
            asm volatile("s_waitcnt vmcnt(16)" ::: "memory");
        } else asm volatile("s_waitcnt vmcnt(0)" ::: "memory");
        asm volatile("s_waitcnt lgkmcnt(0)" ::: "memory"); __builtin_amdgcn_s_barrier(); asm volatile("" ::: "memory");
    }
    asm volatile("s_waitcnt vmcnt(0)" ::: "memory"); __syncthreads();
}

__device__ __forceinline__ void gdn_post_batch(int item0, const float* OF, const float* OB, const bf16* PG, const float* nw, bf16* A2, int lane) {
    float2 a[8], b[8]; unsigned zz[8];
#pragma unroll
    for (int k = 0; k < 8; ++k) { const int item = item0 + k, tok = item >> 3, h = item & 7; const size_t o = (size_t)tok * DGD + h * 128 + lane * 2;
        a[k] = *(const float2*)(OF + o); b[k] = *(const float2*)(OB + o); zz[k] = *(const unsigned*)(PG + (size_t)tok * 4096 + 3072 + h * 128 + lane * 2); }
    const float2 g = *(const float2*)(nw + lane * 2);
#pragma unroll
    for (int k = 0; k < 8; ++k) { const int item = item0 + k, tok = item >> 3, h = item & 7;
        const float o0 = a[k].x + b[k].x, o1 = a[k].y + b[k].y;
        const float r = rsqrtf(wave_sum(o0 * o0 + o1 * o1) * (1.f / 128.f) + EPS);
        const float z0 = __builtin_bit_cast(float, zz[k] << 16), z1 = __builtin_bit_cast(float, zz[k] & 0xffff0000u);
        *(unsigned*)(A2 + (size_t)tok * DM + 1024 + h * 128 + lane * 2) = pk2(o0 * r * g.x * silu_f(z0), o1 * r * g.y * silu_f(z1)); }
}
constexpr int RT_PART = 0, RT_LG = 81920, RT_RS = 81920 + 32 * 80 * 4;
__device__ __forceinline__ void route_phase(LAS unsigned char* lds, int wg, const float* X1, const float* nw, const float* gbias, const float* ebias, unsigned char* ws, unsigned* cnt, int tid, int lane, int wave) {
    typedef pg8::bf16x8 bf16x8; typedef pg8::f32x4 f32x4;
    const int tok0 = wg * 32, fr = lane & 15, fq = lane >> 4;
    LAS float* part = (LAS float*)(lds + RT_PART); LAS float* lg = (LAS float*)(lds + RT_LG); LAS float* rs = (LAS float*)(lds + RT_RS);
    bf16* Ub = (bf16*)(ws + WS_UB);
    for (int q = 0; q < 4; ++q) {
        const int t = 4 * wave + q; const float* xrow = X1 + (size_t)(tok0 + t) * DM;
        const GAS f32x4* xr = (const GAS f32x4*)xrow + lane; const GAS f32x4* wr = (const GAS f32x4*)nw + lane;
        f32x4 v[8]; float s = 0.f;
#pragma unroll
        for (int j = 0; j < 8; ++j) { v[j] = xr[64 * j]; s += (v[j].x * v[j].x + v[j].y * v[j].y) + (v[j].z * v[j].z + v[j].w * v[j].w); }
        const float r = rsqrtf(wave_sum(s) * (1.f / DM) + EPS);
        GAS unsigned long long* o8 = (GAS unsigned long long*)(Ub + (size_t)(tok0 + t) * DM) + lane;
#pragma unroll
        for (int j = 0; j < 8; ++j) { const f32x4 g = wr[64 * j];
            o8[64 * j] = (unsigned long long)pk2(v[j].x * r * g.x, v[j].y * r * g.y) | ((unsigned long long)pk2(v[j].z * r * g.z, v[j].w * r * g.w) << 32); }
        if (lane == 0) rs[t] = r;
    }
    if (wg == 0) { GAS unsigned long long* z = (GAS unsigned long long*)(Ub + (size_t)T * DM); z[tid] = 0ull; }
    { int* slot_tok = (int*)(ws + WS_SMALL + SM_SLOTTOK); if (tid < PMAX / 256) slot_tok[wg * (PMAX / 256) + tid] = T; }
    __syncthreads();
    const bf16* RWh = (const bf16*)(ws + WS_SMALL + SM_RWT); const bf16* RWl = RWh + 80 * 2048;
    f32x4 acc[2][5];
#pragma unroll
    for (int mt = 0; mt < 2; ++mt)
#pragma unroll
        for (int nt = 0; nt < 5; ++nt) acc[mt][nt] = (f32x4){0.f, 0.f, 0.f, 0.f};
#pragma unroll 2
    for (int ks = 0; ks < 8; ++ks) {
        const int k0 = 256 * wave + 32 * ks + 8 * fq;
        const f32x4 g0 = *(const f32x4*)(nw + k0), g1 = *(const f32x4*)(nw + k0 + 4);
        bf16x8 ah[2], al[2];
#pragma unroll
        for (int mt = 0; mt < 2; ++mt) {
            const float* xp = X1 + (size_t)(tok0 + 16 * mt + fr) * DM + k0; const float r = rs[16 * mt + fr];
            const f32x4 x0 = *(const f32x4*)xp, x1 = *(const f32x4*)(xp + 4);
            float u[8], hf[8];
#pragma unroll
            for (int j = 0; j < 4; ++j) { u[j] = x0[j] * r * g0[j]; u[4 + j] = x1[j] * r * g1[j]; }
            pg8::u32x4 wh, wl;
            wh.x = pg8::cvt_pk_bf16(u[0], u[1]); wh.y = pg8::cvt_pk_bf16(u[2], u[3]); wh.z = pg8::cvt_pk_bf16(u[4], u[5]); wh.w = pg8::cvt_pk_bf16(u[6], u[7]);
            hf[0] = __builtin_bit_cast(float, wh.x << 16); hf[1] = __builtin_bit_cast(float, wh.x & 0xffff0000u); hf[2] = __builtin_bit_cast(float, wh.y << 16); hf[3] = __builtin_bit_cast(float, wh.y & 0xffff0000u);
            hf[4] = __builtin_bit_cast(float, wh.z << 16); hf[5] = __builtin_bit_cast(float, wh.z & 0xffff0000u); hf[6] = __builtin_bit_cast(float, wh.w << 16); hf[7] = __builtin_bit_cast(float, wh.w & 0xffff0000u);
            wl.x = pg8::cvt_pk_bf16(u[0] - hf[0], u[1] - hf[1]); wl.y = pg8::cvt_pk_bf16(u[2] - hf[2], u[3] - hf[3]); wl.z = pg8::cvt_pk_bf16(u[4] - hf[4], u[5] - hf[5]); wl.w = pg8::cvt_pk_bf16(u[6] - hf[6], u[7] - hf[7]);
            ah[mt] = __builtin_bit_cast(bf16x8, wh); al[mt] = __builtin_bit_cast(bf16x8, wl);
        }
#pragma unroll
        for (int nt = 0; nt < 5; ++nt) {
            const bf16x8 bh = *(const bf16x8*)(RWh + (size_t)(16 * nt + fr) * 2048 + k0), bl = *(const bf16x8*)(RWl + (size_t)(16 * nt + fr) * 2048 + k0);
#pragma unroll
            for (int mt = 0; mt < 2; ++mt) {
                acc[mt][nt] = __builtin_amdgcn_mfma_f32_16x16x32_bf16(ah[mt], bh, acc[mt][nt], 0, 0, 0);
                acc[mt][nt] = __builtin_amdgcn_mfma_f32_16x16x32_bf16(al[mt], bh, acc[mt][nt], 0, 0, 0);
                acc[mt][nt] = __builtin_amdgcn_mfma_f32_16x16x32_bf16(ah[mt], bl, acc[mt][nt], 0, 0, 0);
            }
        }
    }
#pragma unroll
    for (int mt = 0; mt < 2; ++mt)
#pragma unroll
        for (int nt = 0; nt < 5; ++nt) *(LAS f32x4*)(part + ((wave * 10 + mt * 5 + nt) * 64 + lane) * 4) = acc[mt][nt];
    __syncthreads();
    for (int o = tid; o < 32 * 80; o += 512) {
        const int t = o / 80, col = o % 80, mt = t >> 4, tr = t & 15, nt = col >> 4, ln = (tr >> 2) * 16 + (col & 15), rg = tr & 3;
        float s = 0.f;
#pragma unroll
        for (int w = 0; w < 8; ++w) s += part[((w * 10 + mt * 5 + nt) * 64 + ln) * 4 + rg];
        lg[t * 80 + col] = s;
    }
    __syncthreads();
    if (tid < 32) {
        const int t = tok0 + tid; const LAS float* l = lg + tid * 80;
        float g[8]; int gi = 0; float gm = -INFINITY;
#pragma unroll
        for (int i = 0; i < 8; ++i) { g[i] = l[i] + gbias[i]; if (g[i] > gm) { gm = g[i]; gi = i; } }
        float gs = 0.f;
#pragma unroll
        for (int i = 0; i < 8; ++i) gs += expf(g[i] - gm);
        const float ggate = 1.f / gs;
        float e[8]; float em = -INFINITY;
#pragma unroll
        for (int i = 0; i < 8; ++i) { e[i] = l[8 + gi * 8 + i] + ebias[gi * 8 + i]; em = fmaxf(em, e[i]); }
        float es = 0.f; float p[8];
#pragma unroll
        for (int i = 0; i < 8; ++i) { p[i] = expf(e[i] - em); es += p[i]; }
        int i1 = 0; float p1 = -1.f;
#pragma unroll
        for (int i = 0; i < 8; ++i) if (p[i] > p1) { p1 = p[i]; i1 = i; }
        int i2 = 0; float p2 = -1.f;
#pragma unroll
        for (int i = 0; i < 8; ++i) if (i != i1 && p[i] > p2) { p2 = p[i]; i2 = i; }
        const float q1 = p1 / es, q2 = p2 / es, qs = q1 + q2;
        const int e1 = gi * 8 + i1, e2 = gi * 8 + i2;
        int* eid = (int*)(ws + WS_SMALL + SM_EID); float* gate = (float*)(ws + WS_SMALL + SM_GATE); int* pos = (int*)(ws + WS_SMALL + SM_POS);
        eid[t * 2] = e1; eid[t * 2 + 1] = e2;
        gate[t * 2] = ggate * (q1 / qs); gate[t * 2 + 1] = ggate * (q2 / qs);
        pos[t * 2] = (int)__hip_atomic_fetch_add(cnt + e1, 1u, __ATOMIC_RELAXED, __HIP_MEMORY_SCOPE_AGENT);
        pos[t * 2 + 1] = (int)__hip_atomic_fetch_add(cnt + e2, 1u, __ATOMIC_RELAXED, __HIP_MEMORY_SCOPE_AGENT);
    }
}
__device__ __forceinline__ void fill_phase(LAS unsigned char* lds, int wg, unsigned char* ws, unsigned* cnt, int tid) {
    LAS int* ps = (LAS int*)lds;
    if (tid < 64) {
        const int padded = ((int)__hip_atomic_load(cnt + tid, __ATOMIC_RELAXED, __HIP_MEMORY_SCOPE_AGENT) + RB - 1) / RB * RB;
        int inc = padded;
#pragma unroll
        for (int o = 1; o < 64; o <<= 1) { const int t = __shfl_up(inc, o); if (tid >= o) inc += t; }
        ps[tid] = inc - padded; if (tid == 63) ps[NE] = inc;
    }
    __syncthreads();
    char* sm = (char*)(ws + WS_SMALL);
    if (wg == 0) {
        int* blk_exp = (int*)(sm + SM_BLKEXP); int* nblk = (int*)(sm + SM_NBLK);
        if (tid < NBLK_MAX) { int e = NE - 1; for (int i = 0; i < NE; ++i) if (tid * RB >= ps[i] && tid * RB < ps[i + 1]) { e = i; break; } blk_exp[tid] = e; }
        if (tid == 0) *nblk = ps[NE] / RB;
    }
    if (tid < 64) {
        const int i = wg * 64 + tid; const int* eid = (const int*)(sm + SM_EID); const int* pos = (const int*)(sm + SM_POS);
        const int s = ps[eid[i]] + pos[i];
        ((int*)(sm + SM_SLOTTOK))[s] = i >> 1; ((int*)(sm + SM_TSLOT))[i] = s;
    }
    __syncthreads();
}
__device__ __forceinline__ void final_rows(int t0, const float* X1, const bf16* Y, unsigned char* ws, const float* fw, float* out, int lane) {
    typedef pg8::f32x4 f32x4;
    const char* sm = (const char*)(ws + WS_SMALL);
    const int4 sl = *(const int4*)((const int*)(sm + SM_TSLOT) + t0 * 2); const float4 gt = *(const float4*)((const float*)(sm + SM_GATE) + t0 * 2);
    const int ss[4] = {sl.x, sl.y, sl.z, sl.w}; const float gg[4] = {gt.x, gt.y, gt.z, gt.w};
    f32x4 x[2][8]; unsigned long long ya[2][8], yb[2][8];
#pragma unroll
    for (int q = 0; q < 2; ++q) {
        const GAS f32x4* xr = (const GAS f32x4*)(X1 + (size_t)(t0 + q) * DM) + lane;
        const GAS unsigned long long* y1 = (const GAS unsigned long long*)(Y + (size_t)ss[2 * q] * DM) + lane; const GAS unsigned long long* y2 = (const GAS unsigned long long*)(Y + (size_t)ss[2 * q + 1] * DM) + lane;
#pragma unroll
        for (int j = 0; j < 8; ++j) { x[q][j] = xr[64 * j]; ya[q][j] = y1[64 * j]; yb[q][j] = y2[64 * j]; }
    }
    const GAS f32x4* wr = (const GAS f32x4*)fw + lane;
#pragma unroll
    for (int q = 0; q < 2; ++q) {
        const float g1 = gg[2 * q], g2 = gg[2 * q + 1]; float sq = 0.f;
#pragma unroll
        for (int j = 0; j < 8; ++j) {
            const unsigned alo = (unsigned)ya[q][j], ahi = (unsigned)(ya[q][j] >> 32), blo = (unsigned)yb[q][j], bhi = (unsigned)(yb[q][j] >> 32);
            f32x4 r = x[q][j];
            r.x += g1 * __builtin_bit_cast(float, alo << 16) + g2 * __builtin_bit_cast(float, blo << 16);
            r.y += g1 * __builtin_bit_cast(float, alo & 0xffff0000u) + g2 * __builtin_bit_cast(float, blo & 0xffff0000u);
            r.z += g1 * __builtin_bit_cast(float, ahi << 16) + g2 * __builtin_bit_cast(float, bhi << 16);
            r.w += g1 * __builtin_bit_cast(float, ahi & 0xffff0000u) + g2 * __builtin_bit_cast(float, bhi & 0xffff0000u);
            x[q][j] = r; sq += (r.x * r.x + r.y * r.y) + (r.z * r.z + r.w * r.w);
        }
        const float rr = rsqrtf(wave_sum(sq) * (1.f / DM) + EPS);
        GAS f32x4* o = (GAS f32x4*)(out + (size_t)(t0 + q) * DM) + lane;
#pragma unroll
        for (int j = 0; j < 8; ++j) { const f32x4 g = wr[64 * j]; o[64 * j] = x[q][j] * rr * g; }
    }
}

constexpr int NWAVES = 8;
constexpr int LDS_BYTES = 147456, LDSCTL_OFF = LDS_BYTES - 256;

struct Args { const float* in[31]; float* out; unsigned char* ws; int ph_lo, ph_hi, li, pad; };

struct Epi1 {
    bf16* PG; float* PGATE; float* PT;
    __device__ __forceinline__ void operator()(const pg8::f32x4 (&acc)[2][2][4][2], const pg8::Unit& u, int wr, int wc, int fr, int fq) const {
        const int row0 = u.pm * 256 + wr * 64 + fr;
        if (u.kind == 0) {
            if (u.pn < 16) {
                const int col0 = u.pn * 256 + wc * 32 + 8 * fq;
#pragma unroll
                for (int ai = 0; ai < 2; ++ai)
#pragma unroll
                    for (int m = 0; m < 4; ++m) { bf16* rowp = PG + (size_t)(row0 + ai * 128 + m * 16) * 4096 + col0;
#pragma unroll
                        for (int bj = 0; bj < 2; ++bj) { const pg8::f32x4 v0 = acc[ai][bj][m][0], v1 = acc[ai][bj][m][1];
                            pg8::u32x4 w; w.x = pg8::cvt_pk_bf16(v0[0], v0[1]); w.y = pg8::cvt_pk_bf16(v0[2], v0[3]); w.z = pg8::cvt_pk_bf16(v1[0], v1[1]); w.w = pg8::cvt_pk_bf16(v1[2], v1[3]);
                            *(pg8::u32x4*)(rowp + bj * 128) = w; } }
            } else if (wc == 0) {
#pragma unroll
                for (int ai = 0; ai < 2; ++ai)
#pragma unroll
                    for (int m = 0; m < 4; ++m) { float* rowp = PGATE + (size_t)(row0 + ai * 128 + m * 16) * 32 + 8 * fq;
                        *(pg8::f32x4*)(rowp) = acc[ai][0][m][0]; *(pg8::f32x4*)(rowp + 4) = acc[ai][0][m][1]; }
            }
        } else {
            const int col0 = u.pn * 256 + wc * 32 + 8 * fq;
#pragma unroll
            for (int ai = 0; ai < 2; ++ai)
#pragma unroll
                for (int m = 0; m < 4; ++m) { float* rowp = PT + (size_t)(row0 + ai * 128 + m * 16) * T + col0;
#pragma unroll
                    for (int bj = 0; bj < 2; ++bj) { *(pg8::f32x4*)(rowp + bj * 128) = acc[ai][bj][m][0]; *(pg8::f32x4*)(rowp + bj * 128 + 4) = acc[ai][bj][m][1]; } }
        }
    }
};
struct Order1 {
    const char* Hb; const char* WinT; int G, c;
    __device__ __forceinline__ bool next(int i, pg8::Unit& u) const {
        const int L = i * G + c;
        if (L >= 928) return false;
        u.rows = nullptr;
        if (L < 544) { int pm, pn; pg8::tile_of(L, 32, 17, pm, pn); u.pm = pm; u.pn = pn; u.kind = 0;
            u.A = Hb + (size_t)pm * 256 * DM * 2; u.B = WinT + (size_t)(GOFF + pn * 256) * DM * 2; }
        else { int pm, pn; pg8::tile_of(L - 544, 12, 32, pm, pn); u.pm = pm; u.pn = pn; u.kind = 1;
            u.A = WinT + (size_t)pm * 256 * DM * 2; u.B = Hb + (size_t)pn * 256 * DM * 2; }
        return true;
    }
};

struct Epi2 {
    const float* x; float* X1;
    __device__ __forceinline__ void operator()(const pg8::f32x4 (&acc)[2][2][4][2], const pg8::Unit& u, int wr, int wc, int fr, int fq) const {
        const int row0 = u.pm * 256 + wr * 64 + fr, col0 = u.pn * 256 + wc * 32 + 8 * fq;
#pragma unroll
        for (int ai = 0; ai < 2; ++ai)
#pragma unroll
            for (int m = 0; m < 4; ++m) { const size_t off = (size_t)(row0 + ai * 128 + m * 16) * DM + col0;
#pragma unroll
                for (int bj = 0; bj < 2; ++bj) {
                    const pg8::f32x4 x0 = *(const pg8::f32x4*)(x + off + bj * 128), x1 = *(const pg8::f32x4*)(x + off + bj * 128 + 4);
                    *(pg8::f32x4*)(X1 + off + bj * 128) = x0 + acc[ai][bj][m][0]; *(pg8::f32x4*)(X1 + off + bj * 128 + 4) = x1 + acc[ai][bj][m][1]; }
                asm volatile("" ::: "memory"); }
    }
};
struct Order2 {
    const char* A2; const char* WoutT; int G, c;
    __device__ __forceinline__ bool next(int i, pg8::Unit& u) const {
        const int L = i * G + c; if (L >= 256) return false;
        int pm, pn; pg8::tile_of(L, 32, 8, pm, pn); u.pm = pm; u.pn = pn; u.kind = 0; u.rows = nullptr;
        u.A = A2 + (size_t)pm * 256 * DM * 2; u.B = WoutT + (size_t)pn * 256 * DM * 2; return true;
    }
};
struct Epi3 {
    bf16* HH;
    __device__ __forceinline__ void operator()(const pg8::f32x4 (&acc)[2][2][4][2], const pg8::Unit& u, int wr, int wc, int fr, int fq) const {
        const int row0 = u.pm * 256 + wr * 64 + fr, col0 = u.pn * 128 + wc * 32 + 8 * fq;
#pragma unroll
        for (int ai = 0; ai < 2; ++ai)
#pragma unroll
            for (int m = 0; m < 4; ++m) { bf16* rowp = HH + (size_t)(row0 + ai * 128 + m * 16) * DE + col0;
                float v[8];
#pragma unroll
                for (int n = 0; n < 2; ++n)
#pragma unroll
                    for (int j = 0; j < 4; ++j) { const float a = acc[ai][0][m][n][j], b = acc[ai][1][m][n][j]; v[n * 4 + j] = a / (1.f + __expf(-a)) * b; }
                pg8::u32x4 w; w.x = pg8::cvt_pk_bf16(v[0], v[1]); w.y = pg8::cvt_pk_bf16(v[2], v[3]); w.z = pg8::cvt_pk_bf16(v[4], v[5]); w.w = pg8::cvt_pk_bf16(v[6], v[7]);
                *(pg8::u32x4*)rowp = w; }
    }
};
struct Order3 {
    const char* Ub; const char* W13T; const int* slot_tok; const int* blk_exp; int nunits, G, c;
    __device__ __forceinline__ bool next(int i, pg8::Unit& u) const {
        const int L = i * G + c; if (L >= nunits) return false;
        const int b = L >> 2, j = L & 3; u.pm = b; u.pn = j; u.kind = 0; u.rows = slot_tok + b * 256; u.A = Ub;
        const int e = __hip_atomic_load(blk_exp + b, __ATOMIC_RELAXED, __HIP_MEMORY_SCOPE_AGENT);
        u.B = W13T + ((size_t)e * 1024 + j * 256) * DM * 2; return true;
    }
};
struct Epi4 {
    bf16* Y;
    __device__ __forceinline__ void operator()(const pg8::f32x4 (&acc)[2][2][4][2], const pg8::Unit& u, int wr, int wc, int fr, int fq) const {
        const int row0 = u.pm * 256 + wr * 64 + fr, col0 = u.pn * 256 + wc * 32 + 8 * fq;
#pragma unroll
        for (int ai = 0; ai < 2; ++ai)
#pragma unroll
            for (int m = 0; m < 4; ++m) { bf16* rowp = Y + (size_t)(row0 + ai * 128 + m * 16) * DM + col0;
#pragma unroll
                for (int bj = 0; bj < 2; ++bj) { const pg8::f32x4 v0 = acc[ai][bj][m][0], v1 = acc[ai][bj][m][1];
                    pg8::u32x4 w; w.x = pg8::cvt_pk_bf16(v0[0], v0[1]); w.y = pg8::cvt_pk_bf16(v0[2], v0[3]); w.z = pg8::cvt_pk_bf16(v1[0], v1[1]); w.w = pg8::cvt_pk_bf16(v1[2], v1[3]);
                    *(pg8::u32x4*)(rowp + bj * 128) = w; } }
    }
};
struct Order4 {
    const char* HH; const char* W2T; const int* blk_exp; int nunits, G, c;
    __device__ __forceinline__ bool next(int i, pg8::Unit& u) const {
        const int L = i * G + c; if (L >= nunits) return false;
        const int b = L >> 3, j = L & 7; u.pm = b; u.pn = j; u.kind = 0; u.rows = nullptr; u.A = HH + (size_t)b * 256 * DE * 2;
        const int e = __hip_atomic_load(blk_exp + b, __ATOMIC_RELAXED, __HIP_MEMORY_SCOPE_AGENT);
        u.B = W2T + ((size_t)e * DM + j * 256) * DE * 2; return true;
    }
};

struct TrItem { const float* W; int ldn, k0, n0; bf16* WT; size_t dst_row0; int ldk; };
__device__ __forceinline__ void tr_store(const TrItem& I, LAS float* scr, const float (&tv)[32], int lane) {
#pragma unroll
    for (int i = 0; i < 32; ++i) { const int kk = 2 * i + (lane >> 5); scr[kk * 33 + (lane & 31)] = tv[i]; }
    asm volatile("s_waitcnt lgkmcnt(0)" ::: "memory");
    const int c = lane & 7;
#pragma unroll
    for (int j = 0; j < 4; ++j) { const int n = (lane >> 3) + 8 * j; const LAS float* s = scr + (8 * c) * 33 + n;
        v4u o; o.x = pg8::cvt_pk_bf16(s[0 * 33], s[1 * 33]); o.y = pg8::cvt_pk_bf16(s[2 * 33], s[3 * 33]); o.z = pg8::cvt_pk_bf16(s[4 * 33], s[5 * 33]); o.w = pg8::cvt_pk_bf16(s[6 * 33], s[7 * 33]);
        *(GAS v4u*)(I.WT + (I.dst_row0 + n) * I.ldk + I.k0 + 8 * c) = o; }
    asm volatile("s_waitcnt lgkmcnt(0)" ::: "memory");
}
__device__ __forceinline__ void tr_pair(const TrItem& A, const TrItem& B, bool hasB, LAS float* scr, int lane) {
    float ta[32], tb[32];
    const float* pa = A.W + (size_t)(A.k0 + (lane >> 5)) * A.ldn + A.n0 + (lane & 31);
    const float* pb = (hasB ? B.W + (size_t)(B.k0 + (lane >> 5)) * B.ldn + B.n0 : A.W + (size_t)(A.k0 + (lane >> 5)) * A.ldn + A.n0) + (lane & 31);
    const size_t sa = (size_t)2 * A.ldn, sb = (size_t)2 * (hasB ? B.ldn : A.ldn);
#pragma unroll
    for (int i = 0; i < 32; ++i) { ta[i] = pa[i * sa]; tb[i] = pb[i * sb]; }
    tr_store(A, scr, ta, lane);
    if (hasB) tr_store(B, scr, tb, lane);
}
__device__ __forceinline__ void tr_item(const float* W, int ldn, int k0, int n0, bf16* WT, size_t dst_row0, int ldk, LAS float* scr, int lane) {
    const TrItem A{W, ldn, k0, n0, WT, dst_row0, ldk}; tr_pair(A, A, false, scr, lane);
}
__device__ __forceinline__ void rms_row_to_bf16(const float* xrow, const float* w, bf16* orow, int lane) {
    const GAS pg8::f32x4* xr = (const GAS pg8::f32x4*)xrow + lane; const GAS pg8::f32x4* wr = (const GAS pg8::f32x4*)w + lane;
    pg8::f32x4 v[8]; float s = 0.f;
#pragma unroll
    for (int j = 0; j < 8; ++j) { v[j] = xr[64 * j]; s += (v[j].x * v[j].x + v[j].y * v[j].y) + (v[j].z * v[j].z + v[j].w * v[j].w); }
    const float r = rsqrtf(wave_sum(s) * (1.f / DM) + EPS);
    GAS unsigned long long* o8 = (GAS unsigned long long*)orow + lane;
#pragma unroll
    for (int j = 0; j < 8; ++j) { const pg8::f32x4 g = wr[64 * j];
        o8[64 * j] = (unsigned long long)pk2(v[j].x * r * g.x, v[j].y * r * g.y) | ((unsigned long long)pk2(v[j].z * r * g.z, v[j].w * r * g.w) << 32); }
}

__global__ void __launch_bounds__(NWAVES * 64, 2) fwd(Args args) {
    extern __shared__ __attribute__((aligned(16))) unsigned char lds_raw[];
    LAS unsigned char* lds = (LAS unsigned char*)lds_raw;
    const int tid = threadIdx.x, lane = tid & 63, wave = __builtin_amdgcn_readfirstlane(tid >> 6);
    const int G = gridDim.x; const int bx = blockIdx.x; const int vcu = (G % 8 == 0) ? (bx % 8) * (G / 8) + bx / 8 : bx;
    unsigned char* ws = args.ws;
    unsigned* ctl = (unsigned*)(ws + WS_CTL);
    for (int u = tid; u < (LDS_BYTES - LDSCTL_OFF) / 4; u += NWAVES * 64) ((LAS unsigned*)(lds + LDSCTL_OFF))[u] = 0u;
    __syncthreads();
    XcdBarrier bar = xcd_barrier_post(ctl + CW_BAR + args.li * XCD_BAR_WORDS, (volatile LAS unsigned*)(lds + LDSCTL_OFF + 64));
    static_assert(2 * FFT_BUF_BYTES <= LDSCTL_OFF && 1024 * 33 * 4 <= LDSCTL_OFF, "LDS map");
    const int lo = args.ph_lo, hi = args.ph_hi;
#if 0
#define MK_DUP_MASK 0
#endif
#define IN(k) (lo <= (k) && (k) < hi)
#define BOTH(k) (IN(k) && IN((k) + 1))
    bf16* WinT = (bf16*)(ws + WS_WINT); bf16* Hb = (bf16*)(ws + WS_HB);

    if (IN(0)) { REP(0) {
        int tid_p = tid; asm volatile("" : "+v"(tid_p)); const int lane_p = tid_p & 63; (void)lane_p;
        LAS float* scr = (LAS float*)(lds + wave * 16384);
        const int gw = vcu * NWAVES + wave, NGW = G * NWAVES;
        const float* w_in = args.in[2];
        for (int it = gw; it < 32 * 225; it += NGW) { const int kb = it / 225, nb = it % 225; tr_item(w_in, NPROJ, 64 * kb, 32 * nb, WinT, (size_t)(32 * nb), DM, scr, lane); }
        for (int r = gw; r < NPROJ_PAD - NPROJ; r += NGW) { GAS v4u* o = (GAS v4u*)(WinT + (size_t)(NPROJ + r) * DM) + lane;
#pragma unroll
            for (int j = 0; j < 4; ++j) o[64 * j] = (v4u){0u, 0u, 0u, 0u}; }
        { bf16* WoutT = (bf16*)(ws + WS_WOUTT); const float* w_out = args.in[21];
          for (int it = gw; it < 32 * 64; it += NGW) { const int kb = it >> 6, nb = it & 63; tr_item(w_out, DM, 64 * kb, 32 * nb, WoutT, (size_t)(32 * nb), DM, scr, lane); } }
        { bf16* W13T = (bf16*)(ws + WS_W13T); bf16* W2T = (bf16*)(ws + WS_W2T);
          const float* ew1 = args.in[27]; const float* ew3 = args.in[28]; const float* ew2 = args.in[29];
          auto mk = [&](int it) -> TrItem {
              const int which = it >> 15, r = it & 32767, e = r >> 9, q = r & 511;
              if (which < 2) { const int kb = q >> 4, nb = q & 15, n0 = 32 * nb;
                  return TrItem{(which ? ew3 : ew1) + (size_t)e * DM * DE, DE, 64 * kb, n0, W13T, (size_t)e * 1024 + (n0 >> 7) * 256 + which * 128 + (n0 & 127), DM}; }
              const int kb = q >> 6, nb = q & 63;
              return TrItem{ew2 + (size_t)e * DE * DM, DM, 64 * kb, 32 * nb, W2T, (size_t)e * DM + 32 * nb, DE}; };
          for (int it = gw; it < 3 * 32768; it += 2 * NGW) { const bool hasB = it + NGW < 3 * 32768; const TrItem A = mk(it), B = mk(hasB ? it + NGW : it); tr_pair(A, B, hasB, scr, lane); } }
        for (int it = bx; it < 256; it += G)
            hyena_filter_item(lds, it, args.in[5], args.in[6], args.in[7], args.in[8], args.in[9], args.in[10], args.in[11], args.in[12], (float*)(ws + WS_KC), tid_p, lane_p, wave);
        { bf16* RWh = (bf16*)(ws + WS_SMALL + SM_RWT); bf16* RWl = RWh + 80 * 2048; const float* rgw = args.in[23]; const float* rew = args.in[25];
          for (int i = vcu * 512 + tid; i < 80 * 2048; i += G * 512) { const int n = i >> 11, k = i & 2047;
              const float w = n < 8 ? rgw[k * 8 + n] : (n < 72 ? rew[k * 64 + n - 8] : 0.f); const unsigned h = f2bf(w); const float hf = __builtin_bit_cast(float, h << 16);
              RWh[i] = (bf16)h; RWl[i] = (bf16)f2bf(w - hf); } }
        for (int m = gw; m < T; m += NGW) rms_row_to_bf16(args.in[0] + (size_t)m * DM, args.in[1], Hb + (size_t)m * DM, lane);
        }
        if (BOTH(0)) xcd_barrier(bar);
    }
    if (IN(1)) { REP(1) {
        int tid_p = tid; asm volatile("" : "+v"(tid_p)); const int lane_p = tid_p & 63; (void)lane_p;
        Order1 S{(const char*)Hb, (const char*)WinT, G, bx};
        Epi1 E{(bf16*)(ws + WS_PG), (float*)(ws + WS_PGATE), (float*)(ws + WS_PT)};
        pg8::gemm_phase<Epi1, Order1, false>(lds, DM, S, E, tid_p);
        }
        if (BOTH(1)) xcd_barrier(bar);
    }
    if (IN(2)) { REP(2) {
        int tid_p = tid; asm volatile("" : "+v"(tid_p)); const int lane_p = tid_p & 63; (void)lane_p;
        REP(11) hyena_phase(lds, (const float*)(ws + WS_PT), (const float*)(ws + WS_KC), args.in[3], args.in[4], args.in[13], (float*)(ws + WS_YHT), G, vcu);
        REP(12) for (int wg = bx; wg < 256; wg += G) {
            int tid_i = tid_p; asm volatile("" : "+v"(tid_i)); const int lane_i = tid_i & 63;
            gdn_pre(lds, wg, (const bf16*)(ws + WS_PG), (const float*)(ws + WS_PGATE), args.in[15], args.in[16], args.in[17], args.in[18], args.in[19], ws, tid_i, lane_i, wave);
            gdn_prep_wave(lds, wg, ws, lane_i, wave);
            __syncthreads();
        }
        }
        if (BOTH(2)) xcd_barrier(bar);
    }
    if (IN(3)) { REP(3) {
        int tid_p = tid; asm volatile("" : "+v"(tid_p)); const int lane_p = tid_p & 63; (void)lane_p;
        for (int v = vcu; v < 256; v += G) gdn_scan(lds, ws, (float*)(ws + WS_OF), (float*)(ws + WS_OB), v, tid_p, lane_p, wave);
        }
        if (BOTH(3)) xcd_barrier(bar);
    }
    if (IN(4)) { REP(4) {
        int tid_p = tid; asm volatile("" : "+v"(tid_p)); const int lane_p = tid_p & 63; (void)lane_p;
        for (int tile = bx; tile < T / 32; tile += G) hyena_post_tile(lds, tile, (const float*)(ws + WS_YHT), args.in[14], (bf16*)(ws + WS_A2), tid_p, lane_p, wave);
        for (int it = (vcu * NWAVES + wave) * 8; it < T * 8; it += G * NWAVES * 8) gdn_post_batch(it, (const float*)(ws + WS_OF), (const float*)(ws + WS_OB), (const bf16*)(ws + WS_PG), args.in[20], (bf16*)(ws + WS_A2), lane_p);
        }
        if (BOTH(4)) xcd_barrier(bar);
    }
    if (IN(5)) { REP(5) {
        int tid_p = tid; asm volatile("" : "+v"(tid_p)); const int lane_p = tid_p & 63; (void)lane_p;
        Order2 S{(const char*)(ws + WS_A2), (const char*)(ws + WS_WOUTT), G, bx};
        Epi2 E{args.in[0], (float*)(ws + WS_X1)};
        pg8::gemm_phase<Epi2, Order2, false>(lds, DM, S, E, tid_p);
        }
        if (BOTH(5)) xcd_barrier(bar);
    }
    if (IN(6)) {
        int tid_p = tid; asm volatile("" : "+v"(tid_p)); const int lane_p = tid_p & 63; (void)lane_p;
        for (int wg = bx; wg < 256; wg += G) { route_phase(lds, wg, (const float*)(ws + WS_X1), args.in[22], args.in[24], args.in[26], ws, ctl + CW_CNT, tid_p, lane_p, wave); __syncthreads(); }
        if (BOTH(6)) xcd_barrier(bar);
    }
    if (IN(7)) {
        int tid_p = tid; asm volatile("" : "+v"(tid_p)); const int lane_p = tid_p & 63; (void)lane_p;
        for (int wg = bx; wg < 256; wg += G) fill_phase(lds, wg, ws, ctl + CW_CNT, tid_p);
        if (BOTH(7)) xcd_barrier(bar);
    }
    const int* slot_tok = (const int*)(ws + WS_SMALL + SM_SLOTTOK); const int* blk_exp = (const int*)(ws + WS_SMALL + SM_BLKEXP); const int* nblk_p = (const int*)(ws + WS_SMALL + SM_NBLK);
    if (IN(8)) { REP(8) {
        int tid_p = tid; asm volatile("" : "+v"(tid_p)); const int lane_p = tid_p & 63; (void)lane_p;
        const int nblk = __hip_atomic_load(nblk_p, __ATOMIC_RELAXED, __HIP_MEMORY_SCOPE_AGENT);
        Order3 S{(const char*)(ws + WS_UB), (const char*)(ws + WS_W13T), slot_tok, blk_exp, nblk * 4, G, vcu};
        Epi3 E{(bf16*)(ws + WS_HH)};
        pg8::gemm_phase<Epi3, Order3, true>(lds, DM, S, E, tid_p);
        }
        if (BOTH(8)) xcd_barrier(bar);
    }
    if (IN(9)) { REP(9) {
        int tid_p = tid; asm volatile("" : "+v"(tid_p)); const int lane_p = tid_p & 63; (void)lane_p;
        const int nblk = __hip_atomic_load(nblk_p, __ATOMIC_RELAXED, __HIP_MEMORY_SCOPE_AGENT);
        Order4 S{(const char*)(ws + WS_HH), (const char*)(ws + WS_W2T), blk_exp, nblk * 8, G, vcu};
        Epi4 E{(bf16*)(ws + WS_Y)};
        pg8::gemm_phase<Epi4, Order4, false>(lds, DE, S, E, tid_p);
        }
        if (BOTH(9)) xcd_barrier(bar);
    }
    if (IN(10)) { REP(10) {
        int tid_p = tid; asm volatile("" : "+v"(tid_p)); const int lane_p = tid_p & 63; (void)lane_p;
        for (int t = (vcu * NWAVES + wave) * 2; t < T; t += G * NWAVES * 2) final_rows(t, (const float*)(ws + WS_X1), (const bf16*)(ws + WS_Y), ws, args.in[30], args.out, lane_p);
    }
    }
#undef IN
#undef BOTH
}

#ifndef MK_PER_PHASE
#define MK_PER_PHASE 0
#endif
constexpr int N_PHASES = 11;
extern "C" void kernel_launch(void* const* d_in, const int* in_sizes, int n_in, void* d_out, int out_size, void* d_ws, size_t ws_size, hipStream_t stream) {
    static int grid = 0;
    if (grid == 0) {
        int dev = 0, cus = 0;
        (void)hipGetDevice(&dev); (void)hipDeviceGetAttribute(&cus, hipDeviceAttributeMultiprocessorCount, dev);
        (void)hipFuncSetAttribute((const void*)fwd, hipFuncAttributeMaxDynamicSharedMemorySize, LDS_BYTES);
        int per_cu = 0; (void)hipOccupancyMaxActiveBlocksPerMultiprocessor(&per_cu, (const void*)fwd, NWAVES * 64, LDS_BYTES);
        (void)hipGetLastError();
        grid = cus > 0 ? cus : 256;
    }
    (void)hipMemsetAsync((char*)d_ws + WS_CTL, 0, CTL_ZERO_BYTES, stream);
    Args a{};
    for (int i = 0; i < 31; ++i) a.in[i] = (const float*)d_in[i];
    a.out = (float*)d_out; a.ws = (unsigned char*)d_ws;
#if MK_PER_PHASE
    for (int p = 0; p < N_PHASES; ++p) { a.ph_lo = p; a.ph_hi = p + 1; a.li = 0; hipLaunchKernelGGL(fwd, dim3(grid), dim3(NWAVES * 64), LDS_BYTES, stream, a); }
#else
    a.ph_lo = 0; a.ph_hi = N_PHASES; a.li = 0;
    hipLaunchKernelGGL(fwd, dim3(grid), dim3(NWAVES * 64), LDS_BYTES, stream, a);
#endif
}
```

```cpp
#include <hip/hip_runtime.h>
#include <cstdio>
#include <cstdint>
#include <cmath>

constexpr int BATCH = 2, LSEQ = 4096, DM = 2048, T = BATCH * LSEQ;
constexpr int DHY = 1024, DGD = 1024, NH = 8, HD = 128;
constexpr int NPROJ = 3 * DHY + 4 * DGD + 4 * NH;
constexpr int GOFF = 3 * DHY;
constexpr int NPROJ_PAD = 7424;
constexpr int NG = 8, EPG = 8, NE = 64, DE = 512;
constexpr int RB = 256, PMAX = 32768, NBLK_MAX = 128;
constexpr float EPS = 1e-6f;

constexpr size_t MiB = 1u << 20;
constexpr size_t WS_CTL = 0;
constexpr size_t CTL_ZERO_BYTES = 1 * MiB;
constexpr size_t WS_SMALL = 2 * MiB;
constexpr size_t WS_WINT = 16 * MiB;
constexpr size_t WS_WOUTT = 608 * MiB;
constexpr size_t WS_HB = 56 * MiB;
constexpr size_t WS_PT = 88 * MiB;
constexpr size_t WS_PG = 184 * MiB;
constexpr size_t WS_PGATE = 248 * MiB;
constexpr size_t WS_A2 = 250 * MiB;
constexpr size_t WS_KC = 282 * MiB;
constexpr size_t WS_YHT = 314 * MiB;
constexpr size_t WS_X0 = 314 * MiB, WS_VG = 346 * MiB, WS_YH = 378 * MiB;
constexpr size_t WS_QN = 16 * MiB, WS_KN = 32 * MiB, WS_KT = 48 * MiB, WS_VT = 64 * MiB;
constexpr size_t WS_V = 346 * MiB, WS_OF = 378 * MiB, WS_OB = 410 * MiB;
constexpr size_t GW_B = 64 * 272, GKDT_B = 128 * 144, GQK_B = 64 * 144, GUT_B = 128 * 128;
constexpr size_t WS_GW = 442 * MiB;
constexpr size_t WS_GQD = WS_GW + 2048 * GW_B;
constexpr size_t WS_GKDT = WS_GQD + 2048 * GW_B;
constexpr size_t WS_GQK = WS_GKDT + 2048 * GKDT_B;
constexpr size_t WS_GUT = WS_GQK + 2048 * GQK_B;
constexpr size_t WS_GCD = WS_GUT + 2048 * GUT_B + 4096;
static_assert(WS_GCD + 2048 * 4 <= 640 * MiB, "ws map");
constexpr size_t WS_W13T = 640 * MiB;
constexpr size_t WS_W2T = 896 * MiB;
constexpr size_t WS_X1 = 282 * MiB;
constexpr size_t WS_U = 346 * MiB;
constexpr size_t WS_UB = 412 * MiB;
constexpr size_t WS_HH = 446 * MiB;
constexpr size_t WS_Y = 88 * MiB;
constexpr int CW_CNT = 0;
constexpr int CW_Q8 = 1024, CW_Q9 = 2048;
constexpr int CW_BAR = 4096;
constexpr size_t SM_LOGITS = 0;
constexpr size_t SM_GB = SM_LOGITS + (size_t)T * 72 * 4;
constexpr size_t SM_EID = SM_GB + (size_t)4 * T * 8 * 4;
constexpr size_t SM_GATE = SM_EID + (size_t)T * 2 * 4;
constexpr size_t SM_POS = SM_GATE + (size_t)T * 2 * 4;
constexpr size_t SM_TSLOT = SM_POS + (size_t)T * 2 * 4;
constexpr size_t SM_SLOTTOK = SM_TSLOT + (size_t)T * 2 * 4;
constexpr size_t SM_BLKEXP = SM_SLOTTOK + (size_t)PMAX * 4;
constexpr size_t SM_PADSTART = SM_BLKEXP + NBLK_MAX * 4;
constexpr size_t SM_NBLK = SM_PADSTART + NE * 4;
constexpr size_t SM_RWT = (SM_NBLK + 256 + 255) / 256 * 256;
static_assert(SM_RWT + 2 * 80 * 2048 * 2 <= 14 * MiB, "small region");

#define LAS __attribute__((address_space(3)))
#define GAS __attribute__((address_space(1)))
typedef unsigned short bf16;
typedef unsigned v4u __attribute__((ext_vector_type(4)));

__device__ __forceinline__ float dpp_f(float v, const int ctrl_unused) { return v; }
#define WS_DPP(v, ctrl) __builtin_bit_cast(float, __builtin_amdgcn_update_dpp(0, __builtin_bit_cast(int, (v)), (ctrl), 0xF, 0xF, true))
__device__ __forceinline__ float wave_sum(float v) {
    v += WS_DPP(v, 0xB1);
    v += WS_DPP(v, 0x4E);
    v += WS_DPP(v, 0x141);
    v += WS_DPP(v, 0x140);
    v += __shfl_xor(v, 16); v += __shfl_xor(v, 32);
    return v;
}
__device__ __forceinline__ float silu_f(float x) { return x / (1.f + expf(-x)); }
__device__ __forceinline__ float sigmoid_f(float x) { return 1.f / (1.f + expf(-x)); }
__device__ __forceinline__ float softplus_f(float x) { return fmaxf(x, 0.f) + log1pf(expf(-fabsf(x))); }
__device__ __forceinline__ unsigned f2bf(float f) { unsigned u = __builtin_bit_cast(unsigned, f); return (u + 0x7fffu + ((u >> 16) & 1u)) >> 16; }
__device__ __forceinline__ unsigned pk2(float lo, float hi) { return f2bf(lo) | (f2bf(hi) << 16); }
__device__ __forceinline__ float bf2f(bf16 b) { return __builtin_bit_cast(float, ((unsigned)b) << 16); }

#ifndef MK_DUP_MASK
#define MK_DUP_MASK 0
#endif
#define REP(k) _Pragma("unroll 1") for (int rep_ = 0; rep_ < (((MK_DUP_MASK) >> (k)) & 1) + 1; ++rep_)
constexpr int LDSCTL_OFF_C = 147456 - 256;
namespace pg8 {
#define PG8_LAS __attribute__((address_space(3)))
typedef unsigned short bf16_t;
typedef short bf16x8 __attribute__((ext_vector_type(8)));
typedef float f32x4 __attribute__((ext_vector_type(4)));
typedef unsigned u32x4 __attribute__((ext_vector_type(4)));
constexpr int BM = 256, BK = 64, HALF = 128, HTB = HALF * BK * 2  , STAGE_BYTES = 8 * HTB, NXCD = 8, WGM = 8;

__host__ __device__ __forceinline__ int lds_byte(int r, int c) { const int st = (r >> 4) * 2 + (c >> 5), rr = r & 15, cc = c & 31, ob = rr * 64 + cc * 2; return st * 1024 + (ob ^ (((ob >> 9) & 1) << 5)); }
__host__ __device__ __forceinline__ void stage_rc(int b, int& R, int& C) { const int st = b / 1024, sb = b % 1024, swz = sb ^ (((sb >> 9) & 1) << 5); R = (st >> 1) * 16 + swz / 64; C = (st & 1) * 32 + (swz % 64) / 2; }
__host__ __device__ __forceinline__ int perm32(int rho) { const int n = rho >> 4, i = rho & 15; return 8 * (i >> 2) + 4 * n + (i & 3); }

struct Unit { const char* A; const char* B; const int* rows; int pm, pn, kind; };

__device__ __forceinline__ void tile_of(int L, int nM, int nN, int& pm, int& pn) {
    const int nwg = nM * nN;
    int wgid = L; { const int q = nwg / NXCD, r = nwg % NXCD, xcd = wgid % NXCD, off = wgid / NXCD; wgid = (xcd < r ? xcd * (q + 1) : r * (q + 1) + (xcd - r) * q) + off; }
    const int nig = WGM * nN, gid = wgid / nig, fm = gid * WGM, gsz = (nM - fm) < WGM ? (nM - fm) : WGM;
    pm = fm + ((wgid % nig) % gsz); pn = (wgid % nig) / gsz;
}

typedef float cvt_f2 __attribute__((ext_vector_type(2)));
typedef __bf16 cvt_b2 __attribute__((ext_vector_type(2)));
__device__ __forceinline__ unsigned cvt_pk_bf16(float lo, float hi) { const cvt_f2 f = {lo, hi}; const cvt_b2 v = __builtin_convertvector(f, cvt_b2); return __builtin_bit_cast(unsigned, v); }

template <class Epi, class Sched, bool GATHER>
__device__ __forceinline__ void gemm_phase(PG8_LAS unsigned char* lds, const int K, const Sched& S, const Epi& E, const int tid) {
    const int wid = __builtin_amdgcn_readfirstlane(tid >> 6), lane = tid & 63, wr = wid >> 2, wc = wid & 3, fr = lane & 15, fq = lane >> 4;
    const int nt = K / BK;
    int Rr[2], Cc[2];
    unsigned voffB[2];
#pragma unroll
    for (int i = 0; i < 2; ++i) { stage_rc(tid * 16 + i * 8192, Rr[i], Cc[i]); const int Rb = (Rr[i] & ~31) + perm32(Rr[i] & 31); voffB[i] = (unsigned)(Rb * K + Cc[i]) * 2u; }
    const size_t kstep = (size_t)(BK * 2);
    const size_t hstep = (size_t)HALF * K * 2;
    const unsigned ldsw = (unsigned)wid * 1024u;
    const int aoff = lds_byte(wr * 64 + fr, fq * 8), boff = lds_byte(wc * 32 + fr, fq * 8);
#define PG8_SA(b, h) (((b) * 2 + (h)) * HTB)
#define PG8_SB(b, h) ((4 + (b) * 2 + (h)) * HTB)
#define PG8_STAGE2(bufoff, gbase, v0, v1) do { \
        __builtin_amdgcn_global_load_lds((const unsigned*)((const char*)(gbase) + (v0)), (PG8_LAS unsigned*)(lds + (bufoff) + ldsw), 16, 0, 0); \
        __builtin_amdgcn_global_load_lds((const unsigned*)((const char*)(gbase) + (v1)), (PG8_LAS unsigned*)(lds + (bufoff) + ldsw + 8192), 16, 0, 0); } while (0)
#define PG8_STAGEB(bufoff, gbase) PG8_STAGE2(bufoff, gbase, voffB[0], voffB[1])
#define PG8_LDA(dst, b, h) do { _Pragma("unroll") for (int m = 0; m < 4; ++m) _Pragma("unroll") for (int k = 0; k < 2; ++k) dst[m][k] = *(const PG8_LAS bf16x8*)(lds + PG8_SA(b, h) + aoff + m * 2048 + k * 1024); } while (0)
#define PG8_LDB(dst, b, h) do { _Pragma("unroll") for (int n = 0; n < 2; ++n) _Pragma("unroll") for (int k = 0; k < 2; ++k) dst[n][k] = *(const PG8_LAS bf16x8*)(lds + PG8_SB(b, h) + boff + n * 2048 + k * 1024); } while (0)
#define PG8_MMA(ai, bj, At, Bt) do { __builtin_amdgcn_s_setprio(1); _Pragma("unroll") for (int m = 0; m < 4; ++m) _Pragma("unroll") for (int n = 0; n < 2; ++n) _Pragma("unroll") for (int k = 0; k < 2; ++k) \
        acc[ai][bj][m][n] = __builtin_amdgcn_mfma_f32_16x16x32_bf16(Bt[n][k], At[m][k], acc[ai][bj][m][n], 0, 0, 0); __builtin_amdgcn_s_setprio(0); } while (0)
#define PG8_WAIT_V(n) asm volatile("s_waitcnt vmcnt(" #n ")" ::: "memory")
#define PG8_WAIT_L(n) asm volatile("s_waitcnt lgkmcnt(" #n ")" ::: "memory")
#define PG8_BAR __builtin_amdgcn_s_barrier()
#define PG8_SCHED __builtin_amdgcn_sched_barrier(0)
    Unit cur, nxt; int ui = 0;
    if (!S.next(0, cur)) return;
    f32x4 acc[2][2][4][2];
#pragma unroll
    for (int a = 0; a < 2; ++a)
#pragma unroll
        for (int b = 0; b < 2; ++b)
#pragma unroll
            for (int m = 0; m < 4; ++m)
#pragma unroll
                for (int n = 0; n < 2; ++n) acc[a][b][m][n] = (f32x4){0.f, 0.f, 0.f, 0.f};
    bf16x8 At[4][2], B0[2][2], B1[2][2];
    unsigned c00, c01, c10, c11, n00, n01, n10, n11;
    if constexpr (GATHER) {
        c00 = (unsigned)cur.rows[Rr[0]] * (unsigned)(K * 2) + (unsigned)Cc[0] * 2u; c01 = (unsigned)cur.rows[Rr[1]] * (unsigned)(K * 2) + (unsigned)Cc[1] * 2u;
        c10 = (unsigned)cur.rows[128 + Rr[0]] * (unsigned)(K * 2) + (unsigned)Cc[0] * 2u; c11 = (unsigned)cur.rows[128 + Rr[1]] * (unsigned)(K * 2) + (unsigned)Cc[1] * 2u;
    } else {
        c00 = (unsigned)(Rr[0] * K + Cc[0]) * 2u; c01 = (unsigned)(Rr[1] * K + Cc[1]) * 2u;
        c10 = c00 + (unsigned)hstep; c11 = c01 + (unsigned)hstep;
    }
    n00 = c00; n01 = c01; n10 = c10; n11 = c11;
    const char* cA = cur.A; const char* cB = cur.B;
    PG8_STAGEB(PG8_SB(0, 0), cB); PG8_STAGEB(PG8_SB(0, 1), cB + hstep); PG8_STAGE2(PG8_SA(0, 0), cA, c00, c01); PG8_STAGE2(PG8_SA(0, 1), cA, c10, c11);
    if (wr == 1) PG8_BAR;
    PG8_WAIT_V(2); PG8_BAR;
    PG8_STAGEB(PG8_SB(1, 0), cB + kstep); PG8_STAGE2(PG8_SA(1, 0), cA + kstep, c00, c01); PG8_STAGEB(PG8_SB(1, 1), cB + hstep + kstep);
    PG8_WAIT_V(6); PG8_BAR;
    for (;;) {
        const bool has_next = S.next(ui + 1, nxt);
        const char* nA = has_next ? nxt.A : cA; const char* nB = has_next ? nxt.B : cB;
        if constexpr (GATHER) {
            if (has_next) {
                n00 = (unsigned)nxt.rows[Rr[0]] * (unsigned)(K * 2) + (unsigned)Cc[0] * 2u; n01 = (unsigned)nxt.rows[Rr[1]] * (unsigned)(K * 2) + (unsigned)Cc[1] * 2u;
                n10 = (unsigned)nxt.rows[128 + Rr[0]] * (unsigned)(K * 2) + (unsigned)Cc[0] * 2u; n11 = (unsigned)nxt.rows[128 + Rr[1]] * (unsigned)(K * 2) + (unsigned)Cc[1] * 2u;
            } else { n00 = c00; n01 = c01; n10 = c10; n11 = c11; }
        }
        for (int t = 0; t < nt; t += 2) {
            const bool last = (t == nt - 2);
            const char* a1 = cA + (size_t)(t + 1) * kstep;
            const char* a2 = last ? nA : cA + (size_t)(t + 2) * kstep; const char* b2 = last ? nB : cB + (size_t)(t + 2) * kstep;
            const char* a3 = a2 + kstep; const char* b3 = b2 + kstep;
            unsigned e00, e01, e10, e11;
            if constexpr (GATHER) { e00 = last ? n00 : c00; e01 = last ? n01 : c01; e10 = last ? n10 : c10; e11 = last ? n11 : c11; } else { e00 = c00; e01 = c01; e10 = c10; e11 = c11; }
            PG8_LDB(B0, 0, 0); PG8_LDB(B1, 0, 1); PG8_SCHED; PG8_LDA(At, 0, 0); PG8_STAGE2(PG8_SA(1, 1), a1, c10, c11);
            PG8_WAIT_V(8); PG8_WAIT_L(0); PG8_BAR; PG8_MMA(0, 0, At, B0); PG8_MMA(0, 1, At, B1); PG8_BAR; PG8_SCHED;
            PG8_LDA(At, 0, 1); PG8_STAGEB(PG8_SB(0, 0), b2); PG8_STAGEB(PG8_SB(0, 1), b2 + hstep); PG8_STAGE2(PG8_SA(0, 0), a2, e00, e01);
            PG8_WAIT_V(8); PG8_WAIT_L(0); PG8_BAR; PG8_MMA(1, 0, At, B0); PG8_MMA(1, 1, At, B1); PG8_BAR; PG8_SCHED;
            PG8_LDB(B0, 1, 0); PG8_LDB(B1, 1, 1); PG8_SCHED; PG8_LDA(At, 1, 0); PG8_STAGE2(PG8_SA(0, 1), a2, e10, e11);
            PG8_WAIT_V(8); PG8_WAIT_L(0); PG8_BAR; PG8_MMA(0, 0, At, B0); PG8_MMA(0, 1, At, B1); PG8_BAR; PG8_SCHED;
            PG8_LDA(At, 1, 1); PG8_STAGEB(PG8_SB(1, 0), b3); PG8_STAGEB(PG8_SB(1, 1), b3 + hstep); PG8_STAGE2(PG8_SA(1, 0), a3, e00, e01);
            PG8_WAIT_V(8); PG8_WAIT_L(0); PG8_BAR; PG8_MMA(1, 0, At, B0); PG8_MMA(1, 1, At, B1); PG8_BAR; PG8_SCHED;
        }
        if (wr == 0) PG8_BAR;
        E(acc, cur, wr, wc, fr, fq);
        if (!has_next) break;
#pragma unroll
        for (int a = 0; a < 2; ++a)
#pragma unroll
            for (int b = 0; b < 2; ++b)
#pragma unroll
                for (int m = 0; m < 4; ++m)
#pragma unroll
                    for (int n = 0; n < 2; ++n) acc[a][b][m][n] = (f32x4){0.f, 0.f, 0.f, 0.f};
        cur = nxt; cA = nA; cB = nB; ++ui;
        if constexpr (GATHER) { c00 = n00; c01 = n01; c10 = n10; c11 = n11; }
        if (wr == 1) PG8_BAR;
    }
    PG8_WAIT_V(0);
    PG8_BAR;
#undef PG8_SA
#undef PG8_SB
#undef PG8_STAGE2
#undef PG8_STAGEB
#undef PG8_LDA
#undef PG8_LDB
#undef PG8_MMA
#undef PG8_WAIT_V
#undef PG8_WAIT_L
#undef PG8_BAR
#undef PG8_SCHED
}
}

#define XB_TMO      128
#define XB_XCNT(j)  (256  + 64 * (j))
#define XB_XSUB(j)  (1280 + 64 * (j))
#define XB_XGEN(j)  (2304 + 64 * (j))
#define XB_TOP      3328
#define XB_TOPGEN   3392
#define XCD_BAR_WORDS 3456
#define XB_SPIN_CAP (1u << 18)
__device__ __forceinline__ unsigned xb_ld(unsigned* p)              { return __hip_atomic_load(p, __ATOMIC_RELAXED, __HIP_MEMORY_SCOPE_AGENT); }
__device__ __forceinline__ unsigned xb_add(unsigned* p, unsigned v) { return __hip_atomic_fetch_add(p, v, __ATOMIC_RELAXED, __HIP_MEMORY_SCOPE_AGENT); }
__device__ __forceinline__ unsigned xb_xcc_id() { return (unsigned)__builtin_amdgcn_s_getreg((3 << 11) | 20) & 0xFu; }
#define XB_SPIN(cond, bar) do { unsigned _sp = 0; while (cond) { __builtin_amdgcn_s_sleep(1); \
    if ((++_sp & 255u) == 0u) { if (xb_ld(&(bar)[XB_TMO])) break; if (_sp > XB_SPIN_CAP) { atomicAdd(&(bar)[XB_TMO], 1u); break; } } } } while (0)
struct XcdBarrier { unsigned* bar; unsigned x; volatile LAS unsigned* st; };
__device__ __forceinline__ XcdBarrier xcd_barrier_post(unsigned* bar, volatile LAS unsigned* st) {
    XcdBarrier b; b.bar = bar; b.x = xb_xcc_id(); b.st = st;
    if (threadIdx.x == 0) (void)xb_add(&bar[XB_XCNT(b.x)], 1u);
    return b;
}
__device__ __forceinline__ void xcd_barrier_complete(unsigned* bar, unsigned x, unsigned& nloc, unsigned& nx) {
    const unsigned G = gridDim.x * gridDim.y * gridDim.z;
    unsigned sum, cnt, mine, sp = 0u;
    for (;;) {
        sum = 0u; cnt = 0u; mine = 0u;
#pragma unroll
        for (unsigned j = 0; j < 16; ++j) { const unsigned c = xb_ld(&bar[XB_XCNT(j)]); sum += c; cnt += (c > 0u) ? 1u : 0u; mine = (j == x) ? c : mine; }
        if (sum == G) break;
        __builtin_amdgcn_s_sleep(1);
        if ((++sp & 255u) == 0u) { if (xb_ld(&bar[XB_TMO])) break; if (sp > XB_SPIN_CAP) { atomicAdd(&bar[XB_TMO], 1u); break; } }
    }
    nloc = mine > 0u ? mine : 1u; nx = cnt > 0u ? cnt : 1u;
}
__device__ __forceinline__ void xcd_barrier(const XcdBarrier& b) {
    asm volatile("s_waitcnt vmcnt(0)" ::: "memory");
    __syncthreads();
    if (threadIdx.x == 0) {
        unsigned* bar = b.bar;
        __builtin_amdgcn_s_waitcnt(0);
        unsigned nloc = b.st[0], nx = b.st[1];
        if (nloc == 0u) { xcd_barrier_complete(bar, b.x, nloc, nx); b.st[0] = nloc; b.st[1] = nx; }
        const unsigned old = xb_add(&bar[XB_XSUB(b.x)], 1u);
        const unsigned gen = old / nloc;
        if (old + 1u == (gen + 1u) * nloc) {
            __builtin_amdgcn_fence(__ATOMIC_RELEASE, "agent");
            asm volatile("s_waitcnt vmcnt(0)" ::: "memory");
            const unsigned og = xb_add(&bar[XB_TOP], 1u);
            const unsigned tg = og / nx;
            if (og + 1u == (tg + 1u) * nx) xb_add(&bar[XB_TOPGEN], 1u);
            else XB_SPIN(xb_ld(&bar[XB_TOPGEN]) == tg, bar);
            __builtin_amdgcn_fence(__ATOMIC_ACQUIRE, "agent");
            xb_add(&bar[XB_XGEN(b.x)], 1u);
            asm volatile("s_waitcnt vmcnt(0)" ::: "memory");
        } else {
            XB_SPIN(xb_ld(&bar[XB_XGEN(b.x)]) == gen, bar);
            __builtin_amdgcn_fence(__ATOMIC_ACQUIRE, "agent");
            asm volatile("s_waitcnt vmcnt(0)" ::: "memory");
        }
    }
    __syncthreads();
}


#define HD __device__ __forceinline__
struct cpx { float x, y; };
HD cpx cadd(cpx a, cpx b) { return cpx{a.x + b.x, a.y + b.y}; }
HD cpx csub(cpx a, cpx b) { return cpx{a.x - b.x, a.y - b.y}; }
HD cpx cmul(cpx a, cpx b) { return cpx{a.x * b.x - a.y * b.y, a.x * b.y + a.y * b.x}; }
HD cpx cconj(cpx a) { return cpx{a.x, -a.y}; }
HD int fft_pp(int p) { return p + 2 * (p >> 5); }
constexpr int FFT_N = 8192, FFT_BUF_BYTES = (FFT_N + 2 * (FFT_N >> 5)) * 8;

template <bool INV> HD cpx mul_w16(cpx d, int k) {
    const float C1 = 0.92387953251128674f, S1 = 0.38268343236508977f, R2 = 0.70710678118654752f;
    float c, s;
    switch (k & 15) {
        case 0: return d;
        case 4: return INV ? cpx{-d.y, d.x} : cpx{d.y, -d.x};
        case 8: return cpx{-d.x, -d.y};
        case 12: return INV ? cpx{d.y, -d.x} : cpx{-d.y, d.x};
        case 1: c = C1; s = S1; break;
        case 2: c = R2; s = R2; break;
        case 3: c = S1; s = C1; break;
        case 5: c = -S1; s = C1; break;
        case 6: c = -R2; s = R2; break;
        case 7: c = -C1; s = S1; break;
        case 9: c = -C1; s = -S1; break;
        case 10: c = -R2; s = -R2; break;
        case 11: c = -S1; s = -C1; break;
        case 13: c = S1; s = -C1; break;
        case 14: c = R2; s = -R2; break;
        default: c = C1; s = -S1; break;
    }
    if (INV) s = -s;
    return cpx{d.x * c + d.y * s, d.y * c - d.x * s};
}
template <bool INV, int HALF> HD void dft16_stage(cpx (&v)[16]) {
#pragma unroll
    for (int g = 0; g < 16; g += 2 * HALF) {
#pragma unroll
        for (int i = 0; i < HALF; ++i) {
            const cpx a = v[g + i], b = v[g + i + HALF];
            v[g + i] = cadd(a, b);
            v[g + i + HALF] = mul_w16<INV>(csub(a, b), i * (8 / HALF));
        }
    }
}
template <bool INV> HD void dft16(cpx (&v)[16]) {
    dft16_stage<INV, 8>(v); dft16_stage<INV, 4>(v); dft16_stage<INV, 2>(v); dft16_stage<INV, 1>(v);
    cpx t;
    t = v[1]; v[1] = v[8]; v[8] = t;   t = v[2]; v[2] = v[4]; v[4] = t;   t = v[3]; v[3] = v[12]; v[12] = t;
    t = v[5]; v[5] = v[10]; v[10] = t; t = v[7]; v[7] = v[14]; v[14] = t; t = v[11]; v[11] = v[13]; v[13] = t;
}
template <bool INV> HD void twiddle16(cpx (&v)[16], float frac) {
    float s, c;
    asm volatile("" : "+v"(frac));
#if defined(__HIP_DEVICE_COMPILE__)
    sincospif(2.0f * frac, &s, &c);
#else
    s = sinf(6.283185307179586f * frac); c = cosf(6.283185307179586f * frac);
#endif
    const cpx w1 = INV ? cpx{c, s} : cpx{c, -s};
    cpx w = w1;
#pragma unroll
    for (int q = 1; q < 16; ++q) { v[q] = cmul(v[q], w); if (q < 15) w = cmul(w, w1); }
}
HD int fft_k_of_p(int p) { return (p >> 9) + 16 * ((p >> 5) & 15) + 256 * (p & 31); }
HD int fft_p_of_k(int k) { return (k & 15) * 512 + ((k >> 4) & 15) * 32 + (k >> 8); }

typedef float f2v __attribute__((ext_vector_type(2)));
__device__ __forceinline__ cpx ldc(const LAS cpx* b, int i) { const f2v v = ((const LAS f2v*)b)[i]; return cpx{v.x, v.y}; }
__device__ __forceinline__ void stc(LAS cpx* b, int i, cpx v) { ((LAS f2v*)b)[i] = (f2v){v.x, v.y}; }
__device__ __forceinline__ float dpp_xor1(float v) { return __builtin_bit_cast(float, __builtin_amdgcn_update_dpp(0, __builtin_bit_cast(int, v), 0xB1, 0xF, 0xF, true)); }
__device__ __forceinline__ void fft_fwd_pass2(LAS cpx* buf, int t) {
    const int blk = t >> 5, r2 = t & 31; cpx v[16];
#pragma unroll
    for (int j = 0; j < 16; ++j) v[j] = ldc(buf, fft_pp(blk * 512 + j * 32 + r2));
    dft16<false>(v); twiddle16<false>(v, (float)r2 * (1.f / 512.f));
#pragma unroll
    for (int q = 0; q < 16; ++q) stc(buf, fft_pp(blk * 512 + q * 32 + r2), v[q]);
}
__device__ __forceinline__ void fft_fwd_pass3(const LAS cpx* buf, int t, cpx (&v)[16]) {
    const int b = t >> 1, r = t & 1;
#pragma unroll
    for (int j = 0; j < 16; ++j) v[j] = ldc(buf, fft_pp(b * 32 + 2 * j + r));
    dft16<false>(v); twiddle16<false>(v, (float)r * (1.f / 32.f));
#pragma unroll
    for (int q = 0; q < 16; ++q) { const float px = dpp_xor1(v[q].x), py = dpp_xor1(v[q].y);
        v[q] = r ? cpx{px - v[q].x, py - v[q].y} : cpx{v[q].x + px, v[q].y + py}; }
}
__device__ __forceinline__ float bload(__amdgpu_buffer_rsrc_t rs, int voff, int soff) { return __builtin_bit_cast(float, __builtin_amdgcn_raw_buffer_load_b32(rs, voff, soff, 0)); }
__device__ __forceinline__ float conv3_b(__amdgpu_buffer_rsrc_t rs, int voff, int e0, float w0, float w1, float w2, float bias, bool lo_ok, bool hi_ok) {
    const float xm = (e0 > 0) ? bload(rs, voff, e0 * 4 - 4) : bload(rs, voff - 4, 0);
    const float xc = bload(rs, voff, e0 * 4), xp = bload(rs, voff + 4, e0 * 4);
    return bias + w1 * xc + (lo_ok ? w0 * xm : 0.f) + (hi_ok ? w2 * xp : 0.f);
}
__device__ __forceinline__ void hyena_phase(LAS unsigned char* lds, const float* PT, const float* KC, const float* cw, const float* cb, const float* skip, float* YHT, int G, int vcu) {
    LAS cpx* Wb = (LAS cpx*)lds;
    LAS cpx* Lb = (LAS cpx*)(lds + FFT_BUF_BYTES);
    const int t0 = threadIdx.x;
#define HY_T() int t = t0; asm volatile("" : "+v"(t))
    for (int pair = vcu; pair < 512; pair += G) {
        const int c0 = 2 * pair;
        {
            HY_T();
            const __amdgpu_buffer_rsrc_t rsk = __builtin_amdgcn_make_buffer_rsrc((void*)(KC + (size_t)c0 * 8192), 0, 65536, 0x00020000);
            cpx v[16];
#pragma unroll
            for (int j = 0; j < 16; ++j) v[j] = cpx{bload(rsk, t * 4, j * 2048), bload(rsk, t * 4, 32768 + j * 2048)};
            dft16<false>(v); twiddle16<false>(v, (float)t * (1.f / 8192.f));
#pragma unroll
            for (int q = 0; q < 16; ++q) stc(Wb, fft_pp(q * 512 + t), v[q]);
        }
        __syncthreads();
        { HY_T(); fft_fwd_pass2(Wb, t); }
        __syncthreads();
        { HY_T(); cpx v[16]; fft_fwd_pass3(Wb, t, v); __syncthreads();
          const int b = t >> 1, r = t & 1;
#pragma unroll
          for (int q = 0; q < 16; ++q) stc(Wb, fft_pp(b * 32 + 16 * r + q), v[q]); }
        __syncthreads();
#pragma unroll 1
        for (int ch = 0; ch < 2; ++ch) {
            const int c = c0 + ch;
            float vg[2][8];
            {
                HY_T();
                const __amdgpu_buffer_rsrc_t rs1 = __builtin_amdgcn_make_buffer_rsrc((void*)(PT + (size_t)(1024 + c) * T), 0, T * 4, 0x00020000);
                const __amdgpu_buffer_rsrc_t rs2 = __builtin_amdgcn_make_buffer_rsrc((void*)(PT + (size_t)(2048 + c) * T), 0, T * 4, 0x00020000);
                const float a0 = cw[1024 + c], a1 = cw[3072 + 1024 + c], a2 = cw[6144 + 1024 + c], ab = cb[1024 + c];
                const float v0 = cw[2048 + c], v1 = cw[3072 + 2048 + c], v2 = cw[6144 + 2048 + c], vb = cb[2048 + c];
#pragma unroll
                for (int b = 0; b < 2; ++b)
#pragma unroll
                    for (int j = 0; j < 8; ++j) { const bool lo = (j > 0) || (t > 0), hi = (j < 7) || (t < 511);
                        int vo = t * 4;
                        if (j == 0) asm volatile("" : "+v"(vo));
                        vg[b][j] = conv3_b(rs2, vo, b * LSEQ + j * 512, v0, v1, v2, vb, lo, hi) * conv3_b(rs1, vo, b * LSEQ + j * 512, a0, a1, a2, ab, lo, hi);
                        if (j == 7) asm volatile("" : "+v"(vg[b][0]), "+v"(vg[b][1]), "+v"(vg[b][2]), "+v"(vg[b][3]), "+v"(vg[b][4]), "+v"(vg[b][5]), "+v"(vg[b][6]), "+v"(vg[b][7])); }
                cpx v[16];
#pragma unroll
                for (int j = 0; j < 8; ++j) { v[j] = cpx{vg[0][j], vg[1][j]}; v[8 + j] = cpx{0.f, 0.f}; }
                dft16<false>(v); twiddle16<false>(v, (float)t * (1.f / 8192.f));
#pragma unroll
                for (int q = 0; q < 16; ++q) stc(Lb, fft_pp(q * 512 + t), v[q]);
            }
            __syncthreads();
            { HY_T(); fft_fwd_pass2(Lb, t); }
            __syncthreads();
            {
                HY_T();
                cpx v[16]; fft_fwd_pass3(Lb, t, v);
                const int b = t >> 1, r = t & 1;
                const float sc = 0.5f / 8192.f;
#pragma unroll
                for (int q = 0; q < 16; ++q) {
                    const int p = b * 32 + 16 * r + q, k = fft_k_of_p(p), km = (8192 - k) & 8191, pm = fft_p_of_k(km);
                    const cpx Wk = ldc(Wb, fft_pp(p)), Wm = ldc(Wb, fft_pp(pm));
                    cpx H;
                    if (ch == 0) H = cpx{(Wk.x + Wm.x) * sc, (Wk.y - Wm.y) * sc};
                    else H = cpx{(Wk.y + Wm.y) * sc, (Wm.x - Wk.x) * sc};
                    v[q] = cmul(v[q], H);
                    if ((q & 3) == 3) asm volatile("" ::: "memory");
                }
#pragma unroll
                for (int q = 0; q < 16; ++q) { const float px = dpp_xor1(v[q].x), py = dpp_xor1(v[q].y);
                    v[q] = r ? cpx{px - v[q].x, py - v[q].y} : cpx{v[q].x + px, v[q].y + py}; }
                twiddle16<true>(v, (float)r * (1.f / 32.f)); dft16<true>(v);
                __syncthreads();
#pragma unroll
                for (int j = 0; j < 16; ++j) stc(Lb, fft_pp(b * 32 + 2 * j + r), v[j]);
            }
            __syncthreads();
            {
                HY_T();
                const int blk = t >> 5, r2 = t & 31; cpx v[16];
#pragma unroll
                for (int q = 0; q < 16; ++q) v[q] = ldc(Lb, fft_pp(blk * 512 + q * 32 + r2));
                twiddle16<true>(v, (float)r2 * (1.f / 512.f)); dft16<true>(v);
                __syncthreads();
#pragma unroll
                for (int j = 0; j < 16; ++j) stc(Lb, fft_pp(blk * 512 + j * 32 + r2), v[j]);
            }
            __syncthreads();
            {
                HY_T();
                cpx v[16];
#pragma unroll
                for (int q = 0; q < 16; ++q) v[q] = ldc(Lb, fft_pp(q * 512 + t));
                twiddle16<true>(v, (float)t * (1.f / 8192.f)); dft16<true>(v);
                const __amdgpu_buffer_rsrc_t rs0 = __builtin_amdgcn_make_buffer_rsrc((void*)(PT + (size_t)c * T), 0, T * 4, 0x00020000);
                const __amdgpu_buffer_rsrc_t rsy = __builtin_amdgcn_make_buffer_rsrc((void*)(YHT + (size_t)c * T), 0, T * 4, 0x00020000);
                const float x0 = cw[c], x1 = cw[3072 + c], x2 = cw[6144 + c], xb = cb[c], sk = skip[c];
#pragma unroll
                for (int j = 0; j < 8; ++j) { const bool lo = (j > 0) || (t > 0), hi = (j < 7) || (t < 511);
                    int vo = t * 4;
                    if ((j & 3) == 0) asm volatile("" : "+v"(vo));
                    float o0 = (v[j].x + vg[0][j] * sk) * conv3_b(rs0, vo, j * 512, x0, x1, x2, xb, lo, hi);
                    float o1 = (v[j].y + vg[1][j] * sk) * conv3_b(rs0, vo, LSEQ + j * 512, x0, x1, x2, xb, lo, hi);
                    if ((j & 3) == 3) asm volatile("" : "+v"(o0), "+v"(o1));
                    __builtin_amdgcn_raw_buffer_store_b32(__builtin_bit_cast(unsigned, o0), rsy, t * 4, j * 2048, 0);
                    __builtin_amdgcn_raw_buffer_store_b32(__builtin_bit_cast(unsigned, o1), rsy, t * 4, (LSEQ + j * 512) * 4, 0); }
            }
            __syncthreads();
        }
    }
}
#undef HY_T
__device__ __forceinline__ void hyena_filter_item(LAS unsigned char* lds, int item, const float* w1, const float* b1, const float* w2, const float* b2, const float* w3, const float* b3,
                                                  const float* w4, const float* freq, float* KC, int tid, int lane, int wave) {
    LAS float* H3 = (LAS float*)lds;
    LAS float* sc = (LAS float*)(lds + 4096) + wave * 128;
    const int l0 = item * 16;
    __syncthreads();
#pragma unroll 1
    for (int pp = 0; pp < 2; ++pp) {
        const int li = wave * 2 + pp, l = l0 + li;
        const float tt = (float)l / (float)(LSEQ - 1);
        if (lane == 0) sc[0] = tt;
        if (lane < 16) { const float omega = (2.0f * 3.14159265358979323846f / (float)LSEQ) * (float)l; const float fb = 1e-4f + (float)lane * ((15.0f - 1e-4f) / 15.0f); const float ang = omega * fb;
            sc[1 + lane] = cosf(ang); sc[17 + lane] = -sinf(ang); }
        asm volatile("s_waitcnt lgkmcnt(0)" ::: "memory");
        const float fr = freq[lane];
        float s = b1[lane];
#pragma unroll 3
        for (int i = 0; i < 33; ++i) s += sc[i] * w1[i * 64 + lane];
        float h = sinf(fr * s);
        asm volatile("s_waitcnt lgkmcnt(0)" ::: "memory"); sc[64 + lane] = h; asm volatile("s_waitcnt lgkmcnt(0)" ::: "memory");
        s = b2[lane];
#pragma unroll 4
        for (int i = 0; i < 64; ++i) s += sc[64 + i] * w2[i * 64 + lane];
        h = sinf(fr * s);
        asm volatile("s_waitcnt lgkmcnt(0)" ::: "memory"); sc[lane] = h; asm volatile("s_waitcnt lgkmcnt(0)" ::: "memory");
        s = b3[lane];
#pragma unroll 4
        for (int i = 0; i < 64; ++i) s += sc[i] * w3[i * 64 + lane];
        h = sinf(fr * s);
        H3[lane * 16 + li] = h;
        asm volatile("s_waitcnt lgkmcnt(0)" ::: "memory");
    }
    __syncthreads();
    const float max_decay = logf(1e-2f) / 0.3f, min_decay = logf(1e-2f) / 1.5f;
#pragma unroll 1
    for (int cc = 0; cc < 2; ++cc) {
        const int c = tid + 512 * cc;
        float hf[16], hb[16];
#pragma unroll
        for (int l = 0; l < 16; ++l) { hf[l] = 0.f; hb[l] = 0.f; }
#pragma unroll 2
        for (int i = 0; i < 64; ++i) {
            const float wf = w4[i * 2048 + c], wb = w4[i * 2048 + 1024 + c];
#pragma unroll
            for (int l = 0; l < 16; ++l) { const float hv = H3[i * 16 + l]; hf[l] = fmaf(hv, wf, hf[l]); hb[l] = fmaf(hv, wb, hb[l]); }
        }
        const float delta = fabsf(min_decay + (float)c * ((max_decay - min_decay) / (float)(DHY - 1)));
        float* kc = KC + (size_t)c * 8192;
#pragma unroll
        for (int l = 0; l < 16; ++l) {
            const int ll = l0 + l; const float win = expf(-((float)ll / (float)(LSEQ - 1)) * delta);
            const float f = hf[l] * win, bb = hb[l] * win;
            if (ll == 0) { kc[0] = f + bb; kc[4096] = 0.f; } else { kc[ll] = f; kc[8192 - ll] = bb; }
        }
    }
    __syncthreads();
}
__device__ __forceinline__ void hyena_post_tile(LAS unsigned char* lds, int tile, const float* YHT, const float* nw, bf16* A2, int tid, int lane, int wave) {
    LAS float* tl = (LAS float*)lds;
    const int tok0 = tile * 32, tk = tid & 31, cg = tid >> 5;
    for (int i = 0; i < 64; ++i) { const int c = cg + 16 * i; tl[c * 33 + tk] = YHT[(size_t)c * T + tok0 + tk]; }
    __syncthreads();
    for (int q = 0; q < 4; ++q) {
        const int tq = wave * 4 + q; float v[16]; float ss = 0.f;
#pragma unroll
        for (int i = 0; i < 16; ++i) { v[i] = tl[(lane + 64 * i) * 33 + tq]; ss += v[i] * v[i]; }
        const float r = rsqrtf(wave_sum(ss) * (1.f / DHY) + EPS);
#pragma unroll
        for (int i = 0; i < 16; ++i) { const int c = lane + 64 * i; A2[(size_t)(tok0 + tq) * DM + c] = (bf16)f2bf(v[i] * r * nw[c]); }
    }
    __syncthreads();
}


constexpr int GP_TILE = 128 * 132;
constexpr int GP_GATES = 143104;
constexpr int GP_WREG2 = 8448 + 512;
constexpr int GP_TT = 64 * 68 * 4;
__device__ __forceinline__ int aoff_fn(int i) { const int q = i >> 2, r = i & 3; return 4 * (2 * q * q + q + (r >= 1 ? q : 0) + (r >= 2 ? q + 1 : 0) + (r >= 3 ? q + 1 : 0)); }
static_assert(8 * GP_TILE <= GP_GATES && 8 * GP_WREG2 + 4 * GP_TT <= GP_GATES && GP_GATES + 4096 <= LDSCTL_OFF_C, "gdn prep LDS");
__device__ __forceinline__ void gdn_pre(LAS unsigned char* lds, int wg, const bf16* PG, const float* PGATE, const float* cw, const float* alf, const float* alb, const float* dtf, const float* dtb,
                                        unsigned char* ws, int tid, int lane, int wave) {
    const int bh = wg >> 4, b = bh >> 3, h = bh & 7, l0 = 256 * (wg & 15), cid0 = bh * 64 + 4 * (wg & 15);
    LAS float* gates = (LAS float*)(lds + GP_GATES);
    float w[3][3][2];
#pragma unroll
    for (int x = 0; x < 3; ++x)
#pragma unroll
        for (int tp = 0; tp < 3; ++tp)
#pragma unroll
            for (int e = 0; e < 2; ++e) w[x][tp][e] = cw[tp * 3072 + x * 1024 + h * 128 + 2 * lane + e];
    const int lw = l0 + 32 * wave;
    const unsigned* pgw = (const unsigned*)PG;
    auto ldraw = [&](int l, int x) -> unsigned { return (l >= 0 && l < LSEQ) ? pgw[((size_t)(b * LSEQ + l) * 4096 + x * 1024 + h * 128) / 2 + lane] : 0u; };
    if (lane < 32) {
        const int l = lw + lane, li = 32 * wave + lane; const float* pr = PGATE + (size_t)(b * LSEQ + l) * 32;
        gates[0 * 256 + li] = -expf(alf[h]) * softplus_f(pr[16 + h] + dtf[h]);
        gates[1 * 256 + li] = -expf(alb[h]) * softplus_f(pr[24 + h] + dtb[h]);
        gates[2 * 256 + li] = sigmoid_f(pr[h]);
        gates[3 * 256 + li] = sigmoid_f(pr[8 + h]);
    }
#pragma unroll 1
    for (int bt8 = 0; bt8 < 4; ++bt8) {
        unsigned raw[3][10];
#pragma unroll
        for (int x = 0; x < 3; ++x)
#pragma unroll
            for (int k = 0; k < 10; ++k) raw[x][k] = ldraw(lw + 8 * bt8 - 1 + k, x);
#pragma unroll
        for (int k = 0; k < 8; ++k) {
            const int tt = 8 * bt8 + k, li = 32 * wave + tt, cl = li >> 6, i = li & 63;
            float r[3][2];
#pragma unroll
            for (int x = 0; x < 3; ++x) {
                const unsigned pv = raw[x][k], cv = raw[x][k + 1], nv = raw[x][k + 2];
                const float p0 = __builtin_bit_cast(float, pv << 16), p1 = __builtin_bit_cast(float, pv & 0xffff0000u);
                const float c0 = __builtin_bit_cast(float, cv << 16), c1 = __builtin_bit_cast(float, cv & 0xffff0000u);
                const float n0 = __builtin_bit_cast(float, nv << 16), n1 = __builtin_bit_cast(float, nv & 0xffff0000u);
                r[x][0] = silu_f(w[x][0][0] * p0 + w[x][1][0] * c0 + w[x][2][0] * n0);
                r[x][1] = silu_f(w[x][0][1] * p1 + w[x][1][1] * c1 + w[x][2][1] * n1);
            }
            const float qs = rsqrtf(wave_sum(r[0][0] * r[0][0] + r[0][1] * r[0][1]) + EPS);
            const float ks = rsqrtf(wave_sum(r[1][0] * r[1][0] + r[1][1] * r[1][1]) + EPS);
            const unsigned qp = pk2(r[0][0] * qs, r[0][1] * qs), kp = pk2(r[1][0] * ks, r[1][1] * ks), vp = pk2(r[2][0], r[2][1]);
            const size_t rowoff = ((size_t)(cid0 + cl) * 64 + i) * 64 + lane;
            ((unsigned*)(ws + WS_QN))[rowoff] = qp; ((unsigned*)(ws + WS_KN))[rowoff] = kp;
            LAS bf16* kt = (LAS bf16*)(lds + (cl * 2 + 0) * GP_TILE); LAS bf16* vt = (LAS bf16*)(lds + (cl * 2 + 1) * GP_TILE);
            kt[(2 * lane) * 66 + i] = (bf16)(kp & 0xffffu); kt[(2 * lane + 1) * 66 + i] = (bf16)(kp >> 16);
            vt[(2 * lane) * 66 + i] = (bf16)(vp & 0xffffu); vt[(2 * lane + 1) * 66 + i] = (bf16)(vp >> 16);
        }
    }
    __syncthreads();
    for (int it = wave; it < 8 * 64; it += 8) {
        const int tile = it >> 6, rp = it & 63, row = 2 * rp + (lane >> 5), cl = tile >> 1, which = tile & 1;
        const unsigned v = *(const LAS unsigned*)(lds + tile * GP_TILE + row * 132 + (lane & 31) * 4);
        ((unsigned*)(ws + (which ? WS_VT : WS_KT)))[((size_t)(cid0 + cl) * 128 + row) * 32 + (lane & 31)] = v;
    }
    asm volatile("s_waitcnt vmcnt(0)" ::: "memory");
    __syncthreads();
}
__device__ __forceinline__ void gdn_prep_wave(LAS unsigned char* lds, int wg, unsigned char* ws, int lane, int wave) {
    typedef pg8::bf16x8 bf16x8; typedef pg8::f32x4 f32x4;
    const int cl = wave >> 1, dir = wave & 1, bh = wg >> 4, cid = bh * 64 + 4 * (wg & 15) + cl; const size_t ci = (size_t)cid * 2 + dir;
    const int fr = lane & 15, fq = lane >> 4;
    LAS unsigned char* R = lds + wave * GP_WREG2;
    LAS float* Tt = (LAS float*)(lds + 8 * GP_WREG2 + (wave & 3) * GP_TT);
    LAS float* Ap = (LAS float*)R;
    LAS float* gcA = (LAS float*)(R + 8448); LAS float* btA = gcA + 64;
    const LAS float* gates = (const LAS float*)(lds + GP_GATES);
    const bf16* QN = (const bf16*)(ws + WS_QN) + (size_t)cid * 64 * 128; const bf16* KN = (const bf16*)(ws + WS_KN) + (size_t)cid * 64 * 128;
    const bf16* KT = (const bf16*)(ws + WS_KT) + (size_t)cid * 128 * 64; const bf16* VT = (const bf16*)(ws + WS_VT) + (size_t)cid * 128 * 64;
    unsigned char* GW = ws + WS_GW + ci * GW_B; unsigned char* GQD = ws + WS_GQD + ci * GW_B; unsigned char* GKDT = ws + WS_GKDT + ci * GKDT_B;
    unsigned char* GQK = ws + WS_GQK + ci * GQK_B; unsigned char* GUT = ws + WS_GUT + ci * GUT_B;
#define RIDX(i) (dir ? 63 - (i) : (i))
    const float bt = gates[(2 + dir) * 256 + 64 * cl + RIDX(lane)];
    float gc = gates[dir * 256 + 64 * cl + RIDX(lane)];
#pragma unroll
    for (int o = 1; o < 64; o <<= 1) { const float t = __shfl_up(gc, o); if (lane >= o) gc += t; }
    const float gl = __shfl(gc, 63);
    gcA[lane] = gc; btA[lane] = bt;
    asm volatile("s_waitcnt lgkmcnt(0)" ::: "memory");
    if (lane == 0) ((float*)(ws + WS_GCD))[ci] = expf(gl);
    {
    bf16x8 kfr[4][4];
#pragma unroll
    for (int t4 = 0; t4 < 4; ++t4)
#pragma unroll
        for (int ks = 0; ks < 4; ++ks) kfr[t4][ks] = *(const bf16x8*)(KN + (size_t)RIDX(16 * t4 + fr) * 128 + 32 * ks + 8 * fq);
    __builtin_amdgcn_sched_barrier(0);
#pragma unroll
    for (int mt = 0; mt < 4; ++mt) {
        const f32x4 gi = *(const LAS f32x4*)(gcA + 16 * mt + 4 * fq), bi = *(const LAS f32x4*)(btA + 16 * mt + 4 * fq);
#pragma unroll
        for (int nt = 0; nt <= mt; ++nt) {
            f32x4 c = (f32x4){0.f, 0.f, 0.f, 0.f};
#pragma unroll
            for (int ks = 0; ks < 4; ++ks) c = __builtin_amdgcn_mfma_f32_16x16x32_bf16(kfr[mt][ks], kfr[nt][ks], c, 0, 0, 0);
            const int j = 16 * nt + fr; const float gj = gcA[j];
#pragma unroll
            for (int r = 0; r < 4; ++r) { const int i = 16 * mt + 4 * fq + r; if (j < ((i + 3) & ~3)) Ap[aoff_fn(i) + j] = (j < i) ? bi[r] * c[r] * __expf(gi[r] - gj) : 0.f; }
        }
    }
#pragma unroll 1
    for (int ih = 0; ih < 2; ++ih) {
        bf16x8 qfr[2][4];
#pragma unroll
        for (int t2 = 0; t2 < 2; ++t2)
#pragma unroll
            for (int ks = 0; ks < 4; ++ks) qfr[t2][ks] = *(const bf16x8*)(QN + (size_t)RIDX(16 * (2 * ih + t2) + fr) * 128 + 32 * ks + 8 * fq);
        __builtin_amdgcn_sched_barrier(0);
#pragma unroll
        for (int i2 = 0; i2 < 2; ++i2) {
            const int it = 2 * ih + i2;
            const int i = 16 * it + fr; const float gi = gcA[i];
#pragma unroll
            for (int jt = 0; jt < 4; ++jt) {
                f32x4 c = (f32x4){0.f, 0.f, 0.f, 0.f};
                if (jt <= it) {
#pragma unroll
                    for (int ks = 0; ks < 4; ++ks) c = __builtin_amdgcn_mfma_f32_16x16x32_bf16(kfr[jt][ks], qfr[i2][ks], c, 0, 0, 0);
                }
                const f32x4 gj = *(const LAS f32x4*)(gcA + 16 * jt + 4 * fq);
                float v[4];
#pragma unroll
                for (int r = 0; r < 4; ++r) { const int j = 16 * jt + 4 * fq + r; v[r] = (j <= i) ? c[r] * __expf(gi - gj[r]) * 0.08838834764831845f : 0.f; }
                *(unsigned long long*)(GQK + i * 144 + (32 * (jt >> 1) + 8 * fq + 4 * (jt & 1)) * 2) = (unsigned long long)pg8::cvt_pk_bf16(v[0], v[1]) | ((unsigned long long)pg8::cvt_pk_bf16(v[2], v[3]) << 32);
            }
        }
    }
    }
    {
    {
        const int L2 = lane & 31, m = 4 * L2, src = (m & ~31) + ((m & 4) ? 16 + 4 * ((m & 31) >> 3) : 4 * ((m & 31) >> 3));
#pragma unroll 8
        for (int rp = 0; rp < 32; ++rp) {
            const int i = 2 * rp + (lane >> 5);
            const unsigned long long q = *(const unsigned long long*)(QN + (size_t)RIDX(i) * 128 + src);
            const float sc = __expf(gcA[i]) * 0.08838834764831845f;
            const unsigned lo = (unsigned)q, hi = (unsigned)(q >> 32);
            const float a0 = __builtin_bit_cast(float, lo << 16) * sc, a1 = __builtin_bit_cast(float, lo & 0xffff0000u) * sc, a2 = __builtin_bit_cast(float, hi << 16) * sc, a3 = __builtin_bit_cast(float, hi & 0xffff0000u) * sc;
            *(unsigned long long*)(GQD + i * 272 + m * 2) = (unsigned long long)pg8::cvt_pk_bf16(a0, a1) | ((unsigned long long)pg8::cvt_pk_bf16(a2, a3) << 32);
        }
        const int L4 = lane & 15, mm = 4 * L4, isrc = (mm & ~31) + ((mm & 4) ? 16 + 4 * ((mm & 31) >> 3) : 4 * ((mm & 31) >> 3));
        const f32x4 gi4 = *(const LAS f32x4*)(gcA + isrc);
        float sc4[4];
#pragma unroll
        for (int r = 0; r < 4; ++r) sc4[r] = __expf(gl - gi4[r]);
#pragma unroll 8
        for (int rq = 0; rq < 32; ++rq) {
            const int dk = 4 * rq + (lane >> 4);
            const unsigned long long k = *(const unsigned long long*)(KT + (size_t)dk * 64 + (dir ? 60 - isrc : isrc));
            const unsigned lo = (unsigned)k, hi = (unsigned)(k >> 32);
            float e0 = __builtin_bit_cast(float, lo << 16), e1 = __builtin_bit_cast(float, lo & 0xffff0000u), e2 = __builtin_bit_cast(float, hi << 16), e3 = __builtin_bit_cast(float, hi & 0xffff0000u);
            const float f0 = dir ? e3 : e0, f1 = dir ? e2 : e1, f2 = dir ? e1 : e2, f3 = dir ? e0 : e3;
            *(unsigned long long*)(GKDT + dk * 144 + mm * 2) = (unsigned long long)pg8::cvt_pk_bf16(f0 * sc4[0], f1 * sc4[1]) | ((unsigned long long)pg8::cvt_pk_bf16(f2 * sc4[2], f3 * sc4[3]) << 32);
        }
    }
    asm volatile("s_waitcnt lgkmcnt(0)" ::: "memory");
    }
    asm volatile("s_waitcnt lgkmcnt(0)" ::: "memory");
    __syncthreads();
    const float s_u = bt, s_w = bt * __expf(gc);
    const int cn = RIDX(lane);
#pragma unroll 1
    for (int round = 0; round < 2; ++round) {
        if ((wave >> 2) == round) {
            LAS float* trow = Tt + lane * 68;
#pragma unroll
            for (int q = 0; q < 16; ++q) *(LAS f32x4*)(trow + 4 * q) = (f32x4){(4 * q == lane) ? 1.f : 0.f, (4 * q + 1 == lane) ? 1.f : 0.f, (4 * q + 2 == lane) ? 1.f : 0.f, (4 * q + 3 == lane) ? 1.f : 0.f};
            asm volatile("s_waitcnt lgkmcnt(0)" ::: "memory");
            int ao = 0;
            for (int i = 1; i < 64; ++i) {
                const LAS float* ar = Ap + ao;
                f32x4 acc4 = (f32x4){0.f, 0.f, 0.f, 0.f};
                const int n4 = (i + 3) >> 2;
                for (int q = 0; q < n4; ++q) { const f32x4 a4 = *(const LAS f32x4*)(ar + 4 * q), t4 = *(const LAS f32x4*)(trow + 4 * q); acc4 += a4 * t4; }
                const float sv = (acc4[0] + acc4[1]) + (acc4[2] + acc4[3]);
                if (lane < i) trow[i] = -sv;
                asm volatile("s_waitcnt lgkmcnt(0)" ::: "memory");
                ao += 4 * n4;
            }
#define GP_WRITE_T(scale) do { LAS bf16* Tq = (LAS bf16*)R; \
                for (int j0 = 0; j0 < 64; j0 += 8) { const f32x4 ta = *(const LAS f32x4*)(trow + j0), tb = *(const LAS f32x4*)(trow + j0 + 4); \
                    _Pragma("unroll") for (int e = 0; e < 4; ++e) { Tq[(j0 + e) * 64 + cn] = (bf16)f2bf(ta[e] * (scale)); Tq[(j0 + 4 + e) * 64 + cn] = (bf16)f2bf(tb[e] * (scale)); } } \
                asm volatile("s_waitcnt lgkmcnt(0)" ::: "memory"); } while (0)
            GP_WRITE_T(s_w);
#pragma unroll 1
            for (int dh = 0; dh < 2; ++dh) {
                bf16x8 ktf[4][2];
#pragma unroll
                for (int d4 = 0; d4 < 4; ++d4)
#pragma unroll
                    for (int ks = 0; ks < 2; ++ks) ktf[d4][ks] = *(const bf16x8*)(KT + (size_t)(16 * (4 * dh + d4) + fr) * 64 + 32 * ks + 8 * fq);
                __builtin_amdgcn_sched_barrier(0);
#pragma unroll 1
                for (int it = 0; it < 4; ++it) {
                    bf16x8 tf[2];
#pragma unroll
                    for (int ks = 0; ks < 2; ++ks) tf[ks] = *(const LAS bf16x8*)(R + ((16 * it + fr) * 64 + 32 * ks + 8 * fq) * 2);
                    const int i = 16 * it + fr;
#pragma unroll
                    for (int d4 = 0; d4 < 4; ++d4) {
                        const int dt = 4 * dh + d4;
                        f32x4 c = (f32x4){0.f, 0.f, 0.f, 0.f};
#pragma unroll
                        for (int ks = 0; ks < 2; ++ks) c = __builtin_amdgcn_mfma_f32_16x16x32_bf16(ktf[d4][ks], tf[ks], c, 0, 0, 0);
                        *(unsigned long long*)(GW + i * 272 + (32 * (dt >> 1) + 8 * fq + 4 * (dt & 1)) * 2) = (unsigned long long)pg8::cvt_pk_bf16(c[0], c[1]) | ((unsigned long long)pg8::cvt_pk_bf16(c[2], c[3]) << 32);
                    }
                }
            }
            asm volatile("s_waitcnt lgkmcnt(0)" ::: "memory");
            GP_WRITE_T(s_u);
#pragma unroll 1
            for (int vh = 0; vh < 2; ++vh) {
                bf16x8 vtf[4][2];
#pragma unroll
                for (int v4 = 0; v4 < 4; ++v4)
#pragma unroll
                    for (int ks = 0; ks < 2; ++ks) vtf[v4][ks] = *(const bf16x8*)(VT + (size_t)(16 * (4 * vh + v4) + fr) * 64 + 32 * ks + 8 * fq);
                __builtin_amdgcn_sched_barrier(0);
#pragma unroll 1
                for (int it = 0; it < 4; ++it) {
                    bf16x8 tf[2];
#pragma unroll
                    for (int ks = 0; ks < 2; ++ks) tf[ks] = *(const LAS bf16x8*)(R + ((16 * it + fr) * 64 + 32 * ks + 8 * fq) * 2);
#pragma unroll
                    for (int v4 = 0; v4 < 4; ++v4) {
                        const int vt = 4 * vh + v4;
                        f32x4 c = (f32x4){0.f, 0.f, 0.f, 0.f};
#pragma unroll
                        for (int ks = 0; ks < 2; ++ks) c = __builtin_amdgcn_mfma_f32_16x16x32_bf16(tf[ks], vtf[v4][ks], c, 0, 0, 0);
                        *(unsigned long long*)(GUT + (16 * vt + fr) * 128 + (16 * it + 4 * fq) * 2) = (unsigned long long)pg8::cvt_pk_bf16(c[0], c[1]) | ((unsigned long long)pg8::cvt_pk_bf16(c[2], c[3]) << 32);
                    }
                }
            }
#undef GP_WRITE_T
        }
        __syncthreads();
    }
#undef RIDX
}

__host__ __device__ __forceinline__ int mperm32(int o) { return ((o & 15) >> 2) * 8 + (o >> 4) * 4 + (o & 3); }
__host__ __device__ __forceinline__ int mcol(int x) { return (x & ~31) + mperm32(x & 31); }
constexpr int SC_W = 0, SC_QD = 17408, SC_KDT = 34816, SC_QK = 53248, SC_UT = 62464, SC_STEP = 64512;
static_assert(2 * SC_STEP <= LDSCTL_OFF_C, "scan LDS");
__device__ __forceinline__ void gdn_scan(LAS unsigned char* lds, const unsigned char* ws, bf16* OF, bf16* OB, int vcu, int tid, int lane, int wave) {
    typedef pg8::bf16x8 bf16x8; typedef pg8::f32x4 f32x4;
    const int chain = vcu >> 3, slice = vcu & 7, dir = chain & 1, bh = chain >> 1, b = bh >> 3, h = bh & 7;
    const int fr = lane & 15, fq = lane >> 4;
    const int dv0 = slice * 16;
    bf16* O = dir ? OB : OF;
    auto issue = [&](int s, int buf) {
        const int n = dir ? 63 - s : s; const size_t ci = ((size_t)(bh * 64 + n) * 2 + dir);
#pragma unroll
        for (int k = 0; k < 8; ++k) {
            const int p = wave + 8 * k;
            if (p < 63) {
                const unsigned char* g; int l;
                if (p < 17) { g = ws + WS_GW + ci * GW_B + p * 1024; l = SC_W + p * 1024; }
                else if (p < 34) { g = ws + WS_GQD + ci * GW_B + (p - 17) * 1024; l = SC_QD + (p - 17) * 1024; }
                else if (p < 52) { g = ws + WS_GKDT + ci * GKDT_B + (p - 34) * 1024; l = SC_KDT + (p - 34) * 1024; }
                else if (p < 61) { g = ws + WS_GQK + ci * GQK_B + (p - 52) * 1024; l = SC_QK + (p - 52) * 1024; }
                else { g = ws + WS_GUT + ci * GUT_B + slice * 2048 + (p - 61) * 1024; l = SC_UT + (p - 61) * 1024; }
                __builtin_amdgcn_global_load_lds((const unsigned*)(g + lane * 16), (LAS unsigned*)(lds + buf * SC_STEP + l), 16, 0, 0);
            }
        }
    };
    f32x4 S[8];
#pragma unroll
    for (int i = 0; i < 8; ++i) S[i] = (f32x4){0.f, 0.f, 0.f, 0.f};
    LAS float* cdl = (LAS float*)(lds + 2 * SC_STEP);
    if (wave == 0) { const int n = dir ? 63 - lane : lane; cdl[lane] = __builtin_bit_cast(float, __hip_atomic_load((const unsigned*)(ws + WS_GCD) + ((size_t)(bh * 64 + n) * 2 + dir), __ATOMIC_RELAXED, __HIP_MEMORY_SCOPE_AGENT)); }
    issue(0, 0);
    asm volatile("s_waitcnt vmcnt(0)" ::: "memory"); __syncthreads();
    for (int s = 0; s < 64; ++s) {
        const int buf = s & 1;
        if (s + 1 < 64) issue(s + 1, buf ^ 1);
        if (wave == 0) {
            const LAS unsigned char* L = lds + buf * SC_STEP;
            const int n = dir ? 63 - s : s;
            const float cd = cdl[s];
#define SC_RD(dst, addr, off) asm volatile("ds_read_b128 %0, %1 offset:%2" : "=v"(dst) : "v"(addr), "i"(off))
#define SC_WAIT(n, f) do { asm volatile("s_waitcnt lgkmcnt(" #n ")" : "+v"(f[0]), "+v"(f[1]), "+v"(f[2]), "+v"(f[3]), "+v"(f[4]), "+v"(f[5]), "+v"(f[6]), "+v"(f[7])); __builtin_amdgcn_sched_barrier(0); } while (0)
#define SC_LD_WQ(dst, mt) do { SC_RD(dst[0], wb, SC_W + (mt) * 4352); SC_RD(dst[1], wb, SC_W + (mt) * 4352 + 64); SC_RD(dst[2], wb, SC_W + (mt) * 4352 + 128); SC_RD(dst[3], wb, SC_W + (mt) * 4352 + 192); \
                SC_RD(dst[4], wb, SC_QD + (mt) * 4352); SC_RD(dst[5], wb, SC_QD + (mt) * 4352 + 64); SC_RD(dst[6], wb, SC_QD + (mt) * 4352 + 128); SC_RD(dst[7], wb, SC_QD + (mt) * 4352 + 192); } while (0)
#define SC_LD_K(dst, base, t0) do { SC_RD(dst[0], kb, (base) + (t0) * 2304); SC_RD(dst[1], kb, (base) + (t0) * 2304 + 64); SC_RD(dst[2], kb, (base) + ((t0) + 1) * 2304); SC_RD(dst[3], kb, (base) + ((t0) + 1) * 2304 + 64); \
                SC_RD(dst[4], kb, (base) + ((t0) + 2) * 2304); SC_RD(dst[5], kb, (base) + ((t0) + 2) * 2304 + 64); SC_RD(dst[6], kb, (base) + ((t0) + 3) * 2304); SC_RD(dst[7], kb, (base) + ((t0) + 3) * 2304 + 64); } while (0)
            const unsigned wb = (unsigned)(size_t)(L + fr * 272 + fq * 16), kb = (unsigned)(size_t)(L + fr * 144 + fq * 16);
            bf16x8 Sb[4];
#pragma unroll
            for (int ks = 0; ks < 4; ++ks) { pg8::u32x4 w; w.x = pg8::cvt_pk_bf16(S[2 * ks][0], S[2 * ks][1]); w.y = pg8::cvt_pk_bf16(S[2 * ks][2], S[2 * ks][3]);
                w.z = pg8::cvt_pk_bf16(S[2 * ks + 1][0], S[2 * ks + 1][1]); w.w = pg8::cvt_pk_bf16(S[2 * ks + 1][2], S[2 * ks + 1][3]); Sb[ks] = __builtin_bit_cast(bf16x8, w); }
            unsigned long long uu[4];
#pragma unroll
            for (int mt = 0; mt < 4; ++mt) uu[mt] = *(const LAS unsigned long long*)(L + SC_UT + fr * 128 + (16 * mt + 4 * fq) * 2);
            asm volatile("s_waitcnt lgkmcnt(0)" : "+v"(uu[0]), "+v"(uu[1]), "+v"(uu[2]), "+v"(uu[3]));
            __builtin_amdgcn_sched_barrier(0);
            bf16x8 fa[8], fb[8];
            f32x4 vn[4], o[4];
#define SC_MMA_WQ(src, mt) do { f32x4 a_ = (f32x4){0.f, 0.f, 0.f, 0.f}, q_ = (f32x4){0.f, 0.f, 0.f, 0.f}; \
                _Pragma("unroll") for (int ks = 0; ks < 4; ++ks) { a_ = __builtin_amdgcn_mfma_f32_16x16x32_bf16(src[ks], Sb[ks], a_, 0, 0, 0); q_ = __builtin_amdgcn_mfma_f32_16x16x32_bf16(src[4 + ks], Sb[ks], q_, 0, 0, 0); } \
                const unsigned ulo = (unsigned)uu[mt], uhi = (unsigned)(uu[mt] >> 32); \
                vn[mt][0] = __builtin_bit_cast(float, ulo << 16) - a_[0]; vn[mt][1] = __builtin_bit_cast(float, ulo & 0xffff0000u) - a_[1]; \
                vn[mt][2] = __builtin_bit_cast(float, uhi << 16) - a_[2]; vn[mt][3] = __builtin_bit_cast(float, uhi & 0xffff0000u) - a_[3]; o[mt] = q_; } while (0)
            SC_LD_WQ(fa, 0); SC_LD_WQ(fb, 1);
            SC_WAIT(8, fa); SC_MMA_WQ(fa, 0); __builtin_amdgcn_sched_barrier(0);
            SC_LD_WQ(fa, 2); SC_WAIT(8, fb); SC_MMA_WQ(fb, 1); __builtin_amdgcn_sched_barrier(0);
            SC_LD_WQ(fb, 3); SC_WAIT(8, fa); SC_MMA_WQ(fa, 2); __builtin_amdgcn_sched_barrier(0);
            SC_LD_K(fa, SC_QK, 0); SC_WAIT(8, fb); SC_MMA_WQ(fb, 3); __builtin_amdgcn_sched_barrier(0);
            bf16x8 vb[2];
#pragma unroll
            for (int ks = 0; ks < 2; ++ks) { pg8::u32x4 w; w.x = pg8::cvt_pk_bf16(vn[2 * ks][0], vn[2 * ks][1]); w.y = pg8::cvt_pk_bf16(vn[2 * ks][2], vn[2 * ks][3]);
                w.z = pg8::cvt_pk_bf16(vn[2 * ks + 1][0], vn[2 * ks + 1][1]); w.w = pg8::cvt_pk_bf16(vn[2 * ks + 1][2], vn[2 * ks + 1][3]); vb[ks] = __builtin_bit_cast(bf16x8, w); }
            __builtin_amdgcn_sched_barrier(0);
            SC_LD_K(fb, SC_KDT, 0); SC_WAIT(8, fa);
#pragma unroll
            for (int mt = 0; mt < 4; ++mt) {
#pragma unroll
                for (int ks = 0; ks < 2; ++ks) o[mt] = __builtin_amdgcn_mfma_f32_16x16x32_bf16(fa[2 * mt + ks], vb[ks], o[mt], 0, 0, 0);
            }
            __builtin_amdgcn_sched_barrier(0);
            SC_LD_K(fa, SC_KDT, 4); SC_WAIT(8, fb);
#pragma unroll
            for (int dt = 0; dt < 4; ++dt) { f32x4 a_ = S[dt] * cd;
#pragma unroll
                for (int ks = 0; ks < 2; ++ks) a_ = __builtin_amdgcn_mfma_f32_16x16x32_bf16(fb[2 * dt + ks], vb[ks], a_, 0, 0, 0);
                S[dt] = a_; }
            __builtin_amdgcn_sched_barrier(0);
            SC_WAIT(0, fa);
#pragma unroll
            for (int dt = 0; dt < 4; ++dt) { f32x4 a_ = S[4 + dt] * cd;
#pragma unroll
                for (int ks = 0; ks < 2; ++ks) a_ = __builtin_amdgcn_mfma_f32_16x16x32_bf16(fa[2 * dt + ks], vb[ks], a_, 0, 0, 0);
                S[4 + dt] = a_; }
#pragma unroll
            for (int mt = 0; mt < 4; ++mt)
#pragma unroll
                for (int r = 0; r < 4; ++r) { const int i = 16 * mt + 4 * fq + r; const int l = 64 * n + (dir ? 63 - i : i);
                    O[((size_t)b * LSEQ + l) * DGD + h * 128 + dv0 + fr] = (bf16)f2bf(o[mt][r]); }
#undef SC_RD
#undef SC_WAIT
#undef SC_LD_WQ
#undef SC_LD_K
#undef SC_MMA_WQ
            asm volatile("s_waitcnt vmcnt(16)" ::: "memory");
        } else asm volatile("s_waitcnt vmcnt(0)" ::: "memory");
        asm volatile("s_waitcnt lgkmcnt(0)" ::: "memory"); __builtin_amdgcn_s_barrier(); asm volatile("" ::: "memory");
    }
    asm volatile("s_waitcnt vmcnt(0)" ::: "memory"); __syncthreads();
}

__device__ __forceinline__ void gdn_post_batch(int item0, const bf16* OF, const bf16* OB, const bf16* PG, const float* nw, bf16* A2, int lane) {
    unsigned a[8], b[8], zz[8];
#pragma unroll
    for (int k = 0; k < 8; ++k) { const int item = item0 + k, tok = item >> 3, h = item & 7; const size_t o = (size_t)tok * DGD + h * 128 + lane * 2;
        a[k] = *(const unsigned*)(OF + o); b[k] = *(const unsigned*)(OB + o); zz[k] = *(const unsigned*)(PG + (size_t)tok * 4096 + 3072 + h * 128 + lane * 2); }
    const float2 g = *(const float2*)(nw + lane * 2);
#pragma unroll
    for (int k = 0; k < 8; ++k) { const int item = item0 + k, tok = item >> 3, h = item & 7;
        const float o0 = __builtin_bit_cast(float, a[k] << 16) + __builtin_bit_cast(float, b[k] << 16), o1 = __builtin_bit_cast(float, a[k] & 0xffff0000u) + __builtin_bit_cast(float, b[k] & 0xffff0000u);
        const float r = rsqrtf(wave_sum(o0 * o0 + o1 * o1) * (1.f / 128.f) + EPS);
        const float z0 = __builtin_bit_cast(float, zz[k] << 16), z1 = __builtin_bit_cast(float, zz[k] & 0xffff0000u);
        *(unsigned*)(A2 + (size_t)tok * DM + 1024 + h * 128 + lane * 2) = pk2(o0 * r * g.x * silu_f(z0), o1 * r * g.y * silu_f(z1)); }
}
constexpr int RT_PART = 0, RT_LG = 81920, RT_RS = 81920 + 32 * 80 * 4;
__device__ __forceinline__ void route_phase(LAS unsigned char* lds, int wg, const float* X1, const float* nw, const float* gbias, const float* ebias, unsigned char* ws, unsigned* cnt, int tid, int lane, int wave) {
    typedef pg8::bf16x8 bf16x8; typedef pg8::f32x4 f32x4;
    const int tok0 = wg * 32, fr = lane & 15, fq = lane >> 4;
    LAS float* part = (LAS float*)(lds + RT_PART); LAS float* lg = (LAS float*)(lds + RT_LG); LAS float* rs = (LAS float*)(lds + RT_RS);
    bf16* Ub = (bf16*)(ws + WS_UB);
    for (int q = 0; q < 4; ++q) {
        const int t = 4 * wave + q; const float* xrow = X1 + (size_t)(tok0 + t) * DM;
        const GAS f32x4* xr = (const GAS f32x4*)xrow + lane; const GAS f32x4* wr = (const GAS f32x4*)nw + lane;
        f32x4 v[8]; float s = 0.f;
#pragma unroll
        for (int j = 0; j < 8; ++j) { v[j] = xr[64 * j]; s += (v[j].x * v[j].x + v[j].y * v[j].y) + (v[j].z * v[j].z + v[j].w * v[j].w); }
        const float r = rsqrtf(wave_sum(s) * (1.f / DM) + EPS);
        GAS unsigned long long* o8 = (GAS unsigned long long*)(Ub + (size_t)(tok0 + t) * DM) + lane;
#pragma unroll
        for (int j = 0; j < 8; ++j) { const f32x4 g = wr[64 * j];
            o8[64 * j] = (unsigned long long)pk2(v[j].x * r * g.x, v[j].y * r * g.y) | ((unsigned long long)pk2(v[j].z * r * g.z, v[j].w * r * g.w) << 32); }
        if (lane == 0) rs[t] = r;
    }
    if (wg == 0) { GAS unsigned long long* z = (GAS unsigned long long*)(Ub + (size_t)T * DM); z[tid] = 0ull; }
    { int* slot_tok = (int*)(ws + WS_SMALL + SM_SLOTTOK); if (tid < PMAX / 256) slot_tok[wg * (PMAX / 256) + tid] = T; }
    __syncthreads();
    const bf16* RWh = (const bf16*)(ws + WS_SMALL + SM_RWT); const bf16* RWl = RWh + 80 * 2048;
    f32x4 acc[2][5];
#pragma unroll
    for (int mt = 0; mt < 2; ++mt)
#pragma unroll
        for (int nt = 0; nt < 5; ++nt) acc[mt][nt] = (f32x4){0.f, 0.f, 0.f, 0.f};
#pragma unroll 2
    for (int ks = 0; ks < 8; ++ks) {
        const int k0 = 256 * wave + 32 * ks + 8 * fq;
        const f32x4 g0 = *(const f32x4*)(nw + k0), g1 = *(const f32x4*)(nw + k0 + 4);
        bf16x8 ah[2], al[2];
#pragma unroll
        for (int mt = 0; mt < 2; ++mt) {
            const float* xp = X1 + (size_t)(tok0 + 16 * mt + fr) * DM + k0; const float r = rs[16 * mt + fr];
            const f32x4 x0 = *(const f32x4*)xp, x1 = *(const f32x4*)(xp + 4);
            float u[8], hf[8];
#pragma unroll
            for (int j = 0; j < 4; ++j) { u[j] = x0[j] * r * g0[j]; u[4 + j] = x1[j] * r * g1[j]; }
            pg8::u32x4 wh, wl;
            wh.x = pg8::cvt_pk_bf16(u[0], u[1]); wh.y = pg8::cvt_pk_bf16(u[2], u[3]); wh.z = pg8::cvt_pk_bf16(u[4], u[5]); wh.w = pg8::cvt_pk_bf16(u[6], u[7]);
            hf[0] = __builtin_bit_cast(float, wh.x << 16); hf[1] = __builtin_bit_cast(float, wh.x & 0xffff0000u); hf[2] = __builtin_bit_cast(float, wh.y << 16); hf[3] = __builtin_bit_cast(float, wh.y & 0xffff0000u);
            hf[4] = __builtin_bit_cast(float, wh.z << 16); hf[5] = __builtin_bit_cast(float, wh.z & 0xffff0000u); hf[6] = __builtin_bit_cast(float, wh.w << 16); hf[7] = __builtin_bit_cast(float, wh.w & 0xffff0000u);
            wl.x = pg8::cvt_pk_bf16(u[0] - hf[0], u[1] - hf[1]); wl.y = pg8::cvt_pk_bf16(u[2] - hf[2], u[3] - hf[3]); wl.z = pg8::cvt_pk_bf16(u[4] - hf[4], u[5] - hf[5]); wl.w = pg8::cvt_pk_bf16(u[6] - hf[6], u[7] - hf[7]);
            ah[mt] = __builtin_bit_cast(bf16x8, wh); al[mt] = __builtin_bit_cast(bf16x8, wl);
        }
#pragma unroll
        for (int nt = 0; nt < 5; ++nt) {
            const bf16x8 bh = *(const bf16x8*)(RWh + (size_t)(16 * nt + fr) * 2048 + k0), bl = *(const bf16x8*)(RWl + (size_t)(16 * nt + fr) * 2048 + k0);
#pragma unroll
            for (int mt = 0; mt < 2; ++mt) {
                acc[mt][nt] = __builtin_amdgcn_mfma_f32_16x16x32_bf16(ah[mt], bh, acc[mt][nt], 0, 0, 0);
                acc[mt][nt] = __builtin_amdgcn_mfma_f32_16x16x32_bf16(al[mt], bh, acc[mt][nt], 0, 0, 0);
                acc[mt][nt] = __builtin_amdgcn_mfma_f32_16x16x32_bf16(ah[mt], bl, acc[mt][nt], 0, 0, 0);
            }
        }
    }
#pragma unroll
    for (int mt = 0; mt < 2; ++mt)
#pragma unroll
        for (int nt = 0; nt < 5; ++nt) *(LAS f32x4*)(part + ((wave * 10 + mt * 5 + nt) * 64 + lane) * 4) = acc[mt][nt];
    __syncthreads();
    for (int o = tid; o < 32 * 80; o += 512) {
        const int t = o / 80, col = o % 80, mt = t >> 4, tr = t & 15, nt = col >> 4, ln = (tr >> 2) * 16 + (col & 15), rg = tr & 3;
        float s = 0.f;
#pragma unroll
        for (int w = 0; w < 8; ++w) s += part[((w * 10 + mt * 5 + nt) * 64 + ln) * 4 + rg];
        lg[t * 80 + col] = s;
    }
    __syncthreads();
    if (tid < 32) {
        const int t = tok0 + tid; const LAS float* l = lg + tid * 80;
        float g[8]; int gi = 0; float gm = -INFINITY;
#pragma unroll
        for (int i = 0; i < 8; ++i) { g[i] = l[i] + gbias[i]; if (g[i] > gm) { gm = g[i]; gi = i; } }
        float gs = 0.f;
#pragma unroll
        for (int i = 0; i < 8; ++i) gs += expf(g[i] - gm);
        const float ggate = 1.f / gs;
        float e[8]; float em = -INFINITY;
#pragma unroll
        for (int i = 0; i < 8; ++i) { e[i] = l[8 + gi * 8 + i] + ebias[gi * 8 + i]; em = fmaxf(em, e[i]); }
        float es = 0.f; float p[8];
#pragma unroll
        for (int i = 0; i < 8; ++i) { p[i] = expf(e[i] - em); es += p[i]; }
        int i1 = 0; float p1 = -1.f;
#pragma unroll
        for (int i = 0; i < 8; ++i) if (p[i] > p1) { p1 = p[i]; i1 = i; }
        int i2 = 0; float p2 = -1.f;
#pragma unroll
        for (int i = 0; i < 8; ++i) if (i != i1 && p[i] > p2) { p2 = p[i]; i2 = i; }
        const float q1 = p1 / es, q2 = p2 / es, qs = q1 + q2;
        const int e1 = gi * 8 + i1, e2 = gi * 8 + i2;
        int* eid = (int*)(ws + WS_SMALL + SM_EID); float* gate = (float*)(ws + WS_SMALL + SM_GATE); int* pos = (int*)(ws + WS_SMALL + SM_POS);
        eid[t * 2] = e1; eid[t * 2 + 1] = e2;
        gate[t * 2] = ggate * (q1 / qs); gate[t * 2 + 1] = ggate * (q2 / qs);
        pos[t * 2] = (int)__hip_atomic_fetch_add(cnt + e1, 1u, __ATOMIC_RELAXED, __HIP_MEMORY_SCOPE_AGENT);
        pos[t * 2 + 1] = (int)__hip_atomic_fetch_add(cnt + e2, 1u, __ATOMIC_RELAXED, __HIP_MEMORY_SCOPE_AGENT);
    }
}
__device__ __forceinline__ void fill_phase(LAS unsigned char* lds, int wg, unsigned char* ws, unsigned* cnt, int tid) {
    LAS int* ps = (LAS int*)lds;
    if (tid < 64) {
        const int padded = ((int)__hip_atomic_load(cnt + tid, __ATOMIC_RELAXED, __HIP_MEMORY_SCOPE_AGENT) + RB - 1) / RB * RB;
        int inc = padded;
#pragma unroll
        for (int o = 1; o < 64; o <<= 1) { const int t = __shfl_up(inc, o); if (tid >= o) inc += t; }
        ps[tid] = inc - padded; if (tid == 63) ps[NE] = inc;
    }
    __syncthreads();
    char* sm = (char*)(ws + WS_SMALL);
    if (wg == 0) {
        int* blk_exp = (int*)(sm + SM_BLKEXP); int* nblk = (int*)(sm + SM_NBLK);
        if (tid < NBLK_MAX) { int e = NE - 1; for (int i = 0; i < NE; ++i) if (tid * RB >= ps[i] && tid * RB < ps[i + 1]) { e = i; break; } blk_exp[tid] = e; }
        if (tid == 0) *nblk = ps[NE] / RB;
    }
    if (tid < 64) {
        const int i = wg * 64 + tid; const int* eid = (const int*)(sm + SM_EID); const int* pos = (const int*)(sm + SM_POS);
        const int s = ps[eid[i]] + pos[i];
        ((int*)(sm + SM_SLOTTOK))[s] = i >> 1; ((int*)(sm + SM_TSLOT))[i] = s;
    }
    __syncthreads();
}
__device__ __forceinline__ void final_rows(int t0, const float* X1, const bf16* Y, unsigned char* ws, const float* fw, float* out, int lane) {
    typedef pg8::f32x4 f32x4;
    const char* sm = (const char*)(ws + WS_SMALL);
    const int4 sl = *(const int4*)((const int*)(sm + SM_TSLOT) + t0 * 2); const float4 gt = *(const float4*)((const float*)(sm + SM_GATE) + t0 * 2);
    const int ss[4] = {sl.x, sl.y, sl.z, sl.w}; const float gg[4] = {gt.x, gt.y, gt.z, gt.w};
    f32x4 x[2][8]; unsigned long long ya[2][8], yb[2][8];
#pragma unroll
    for (int q = 0; q < 2; ++q) {
        const GAS f32x4* xr = (const GAS f32x4*)(X1 + (size_t)(t0 + q) * DM) + lane;
        const GAS unsigned long long* y1 = (const GAS unsigned long long*)(Y + (size_t)ss[2 * q] * DM) + lane; const GAS unsigned long long* y2 = (const GAS unsigned long long*)(Y + (size_t)ss[2 * q + 1] * DM) + lane;
#pragma unroll
        for (int j = 0; j < 8; ++j) { x[q][j] = xr[64 * j]; ya[q][j] = y1[64 * j]; yb[q][j] = y2[64 * j]; }
    }
    const GAS f32x4* wr = (const GAS f32x4*)fw + lane;
#pragma unroll
    for (int q = 0; q < 2; ++q) {
        const float g1 = gg[2 * q], g2 = gg[2 * q + 1]; float sq = 0.f;
#pragma unroll
        for (int j = 0; j < 8; ++j) {
            const unsigned alo = (unsigned)ya[q][j], ahi = (unsigned)(ya[q][j] >> 32), blo = (unsigned)yb[q][j], bhi = (unsigned)(yb[q][j] >> 32);
            f32x4 r = x[q][j];
            r.x += g1 * __builtin_bit_cast(float, alo << 16) + g2 * __builtin_bit_cast(float, blo << 16);
            r.y += g1 * __builtin_bit_cast(float, alo & 0xffff0000u) + g2 * __builtin_bit_cast(float, blo & 0xffff0000u);
            r.z += g1 * __builtin_bit_cast(float, ahi << 16) + g2 * __builtin_bit_cast(float, bhi << 16);
            r.w += g1 * __builtin_bit_cast(float, ahi & 0xffff0000u) + g2 * __builtin_bit_cast(float, bhi & 0xffff0000u);
            x[q][j] = r; sq += (r.x * r.x + r.y * r.y) + (r.z * r.z + r.w * r.w);
        }
        const float rr = rsqrtf(wave_sum(sq) * (1.f / DM) + EPS);
        GAS f32x4* o = (GAS f32x4*)(out + (size_t)(t0 + q) * DM) + lane;
#pragma unroll
        for (int j = 0; j < 8; ++j) { const f32x4 g = wr[64 * j]; o[64 * j] = x[q][j] * rr * g; }
    }
}


constexpr int MQ_A = 0, MQ_B = 65536, MQ_CTL = 98304;
__device__ __forceinline__ int perm32_inv(int c) { return 16 * ((c >> 2) & 1) + 4 * (c >> 3) + (c & 3); }
template <bool UP>
__device__ __forceinline__ void moe_gemm(LAS unsigned char* lds, unsigned char* ws, const float* w1, const float* w3  , unsigned* qctr, int nblk, int tid) {
    typedef pg8::bf16x8 bf16x8; typedef pg8::f32x4 f32x4;
    constexpr int K = UP ? DM : DE, NT = K / 64, UPB = UP ? 8 : 16;
    const int wid = __builtin_amdgcn_readfirstlane(tid >> 6), lane = tid & 63, wr = wid >> 2, wc = wid & 3, fr = lane & 15, fq = lane >> 4;
    const int* slot_tok = (const int*)(ws + WS_SMALL + SM_SLOTTOK); const int* blk_exp = (const int*)(ws + WS_SMALL + SM_BLKEXP);
    int Rr[2], Cc[2];
#pragma unroll
    for (int i = 0; i < 2; ++i) pg8::stage_rc(tid * 16 + i * 8192, Rr[i], Cc[i]);
    const unsigned ldsw = (unsigned)wid * 1024u;
    const int aoff = pg8::lds_byte(fr, fq * 8), boff = pg8::lds_byte(wc * 32 + fr, fq * 8);
    const int cidx = tid & 127, kq = wid >> 1, chalf = wid & 1;
    int slot;
    if (UP) { const int x = cidx & 63; slot = 32 * (x >> 4) + ((cidx >> 6) ? 16 : 0) + (x & 15); } else slot = (cidx & ~31) + perm32_inv(cidx & 31);
    const int bw0 = pg8::lds_byte(slot, 8 * kq), bw1 = pg8::lds_byte(slot, 32 + 8 * kq);
    LAS int* uword = (LAS int*)(lds + MQ_CTL);
    const int nunits = nblk * UPB;
    for (;;) {
        __syncthreads();
        if (tid == 0) uword[0] = (int)__hip_atomic_fetch_add(qctr, 1u, __ATOMIC_RELAXED, __HIP_MEMORY_SCOPE_AGENT);
        __syncthreads();
        const int u = __builtin_amdgcn_readfirstlane(uword[0]);
        if (u >= nunits) break;
        const int b = u / UPB, j = u % UPB;
        const int e = __builtin_amdgcn_readfirstlane(__hip_atomic_load(blk_exp + b, __ATOMIC_RELAXED, __HIP_MEMORY_SCOPE_AGENT));
        unsigned ao[2][2];
#pragma unroll
        for (int h = 0; h < 2; ++h)
#pragma unroll
            for (int i = 0; i < 2; ++i) { const int row = UP ? slot_tok[b * 256 + h * 128 + Rr[i]] : b * 256 + h * 128 + Rr[i]; ao[h][i] = (unsigned)row * (unsigned)(K * 2) + (unsigned)Cc[i] * 2u; }
        const char* Abase = (const char*)(ws + (UP ? WS_UB : WS_HH));
        const float* bcolu;
        if (UP) bcolu = (chalf ? w3 : w1) + (size_t)e * DM * DE + 64 * j; else bcolu = w1 + (size_t)e * DE * DM + 128 * j + 64 * chalf;
        constexpr int LDN = UP ? DE : DM;
        f32x4 acc[8][2];
#pragma unroll
        for (int m = 0; m < 8; ++m)
#pragma unroll
            for (int n = 0; n < 2; ++n) acc[m][n] = (f32x4){0.f, 0.f, 0.f, 0.f};
        float r0[16], r1[16], r2[16];
#define MQ_LOAD_A(t, ra) do { _Pragma("unroll") for (int h = 0; h < 2; ++h) _Pragma("unroll") for (int i = 0; i < 2; ++i) \
            ra[h * 2 + i] = *(const pg8::u32x4*)(Abase + ao[h][i] + (size_t)(t) * 128); } while (0)
#define MQ_WRITE_A(ra, buf) do { _Pragma("unroll") for (int h = 0; h < 2; ++h) _Pragma("unroll") for (int i = 0; i < 2; ++i) \
            *(LAS pg8::u32x4*)(lds + MQ_A + ((buf) * 2 + h) * 16384 + ldsw + i * 8192 + lane * 16) = ra[h * 2 + i]; } while (0)
#define MQ_LOAD_B(t, r) do { const float* p_ = bcolu + (size_t)((t) * 64 + 8 * kq) * LDN; \
            _Pragma("unroll") for (int e_ = 0; e_ < 8; ++e_) { r[e_] = (p_ + (size_t)e_ * LDN)[lane]; r[8 + e_] = (p_ + (size_t)(32 + e_) * LDN)[lane]; } } while (0)
#define MQ_WRITE_B(r, buf) do { pg8::u32x4 w0_, w1_; \
            w0_.x = pg8::cvt_pk_bf16(r[0], r[1]); w0_.y = pg8::cvt_pk_bf16(r[2], r[3]); w0_.z = pg8::cvt_pk_bf16(r[4], r[5]); w0_.w = pg8::cvt_pk_bf16(r[6], r[7]); \
            w1_.x = pg8::cvt_pk_bf16(r[8], r[9]); w1_.y = pg8::cvt_pk_bf16(r[10], r[11]); w1_.z = pg8::cvt_pk_bf16(r[12], r[13]); w1_.w = pg8::cvt_pk_bf16(r[14], r[15]); \
            *(LAS pg8::u32x4*)(lds + MQ_B + (buf) * 16384 + bw0) = w0_; *(LAS pg8::u32x4*)(lds + MQ_B + (buf) * 16384 + bw1) = w1_; } while (0)
#define MQ_COMPUTE(buf) do { const LAS unsigned char* A_ = lds + MQ_A + ((buf) * 2 + wr) * 16384 + aoff; const LAS unsigned char* B_ = lds + MQ_B + (buf) * 16384 + boff; \
            _Pragma("unroll") for (int k = 0; k < 2; ++k) { bf16x8 bf_[2]; \
                _Pragma("unroll") for (int n = 0; n < 2; ++n) bf_[n] = *(const LAS bf16x8*)(B_ + n * 2048 + k * 1024); \
                _Pragma("unroll") for (int mh = 0; mh < 2; ++mh) { bf16x8 af_[4]; \
                    _Pragma("unroll") for (int m = 0; m < 4; ++m) af_[m] = *(const LAS bf16x8*)(A_ + (4 * mh + m) * 2048 + k * 1024); \
                    _Pragma("unroll") for (int m = 0; m < 4; ++m) _Pragma("unroll") for (int n = 0; n < 2; ++n) acc[4 * mh + m][n] = __builtin_amdgcn_mfma_f32_16x16x32_bf16(bf_[n], af_[m], acc[4 * mh + m][n], 0, 0, 0); } } } while (0)
#define MQ_STEP(t, rcur, rnxt, acur, anxt, buf) do { \
            { const int tb_ = (t) + 3 < NT ? (t) + 3 : NT - 1, ta_ = (t) + 2 < NT ? (t) + 2 : NT - 1; MQ_LOAD_A(ta_, acur); MQ_LOAD_B(tb_, rcur); }     \
            MQ_COMPUTE(buf); \
            if ((t) + 1 < NT) { MQ_WRITE_A(anxt, (buf) ^ 1); MQ_WRITE_B(rnxt, (buf) ^ 1); } \
            asm volatile("s_waitcnt lgkmcnt(0)" ::: "memory"); __builtin_amdgcn_s_barrier(); asm volatile("" ::: "memory"); } while (0)
        pg8::u32x4 a0[4], a1[4];
        MQ_LOAD_A(0, a0); MQ_LOAD_B(0, r0); MQ_LOAD_A(1, a1); MQ_LOAD_B(1, r1); MQ_LOAD_B(2, r2);
        MQ_WRITE_A(a0, 0); MQ_WRITE_B(r0, 0);
        asm volatile("s_waitcnt lgkmcnt(0)" ::: "memory"); __builtin_amdgcn_s_barrier(); asm volatile("" ::: "memory");
        static_assert(NT % 6 == 2, "step loop: six steps per trip + two");
#pragma unroll 1
        for (int t = 0; t + 6 <= NT; t += 6) {
            MQ_STEP(t, r0, r1, a0, a1, 0); MQ_STEP(t + 1, r1, r2, a1, a0, 1); MQ_STEP(t + 2, r2, r0, a0, a1, 0);
            MQ_STEP(t + 3, r0, r1, a1, a0, 1); MQ_STEP(t + 4, r1, r2, a0, a1, 0); MQ_STEP(t + 5, r2, r0, a1, a0, 1); }
        { constexpr int t = NT - 2; MQ_STEP(t, r0, r1, a0, a1, 0); MQ_STEP(t + 1, r1, r2, a1, a0, 1); }
        const int row0 = b * 256 + wr * 128 + fr;
        if (UP) {
            bf16* HH = (bf16*)(ws + WS_HH);
#pragma unroll
            for (int m = 0; m < 8; ++m) { float v[4];
#pragma unroll
                for (int r = 0; r < 4; ++r) { const float a = acc[m][0][r], bb = acc[m][1][r]; v[r] = a / (1.f + __expf(-a)) * bb; }
                *(unsigned long long*)(HH + (size_t)(row0 + 16 * m) * DE + 64 * j + 16 * wc + 4 * fq) = (unsigned long long)pg8::cvt_pk_bf16(v[0], v[1]) | ((unsigned long long)pg8::cvt_pk_bf16(v[2], v[3]) << 32); }
        } else {
            bf16* Y = (bf16*)(ws + WS_Y);
#pragma unroll
            for (int m = 0; m < 8; ++m) { const f32x4 v0 = acc[m][0], v1 = acc[m][1];
                pg8::u32x4 w; w.x = pg8::cvt_pk_bf16(v0[0], v0[1]); w.y = pg8::cvt_pk_bf16(v0[2], v0[3]); w.z = pg8::cvt_pk_bf16(v1[0], v1[1]); w.w = pg8::cvt_pk_bf16(v1[2], v1[3]);
                *(pg8::u32x4*)(Y + (size_t)(row0 + 16 * m) * DM + 128 * j + 32 * wc + 8 * fq) = w; }
        }
#undef MQ_LOAD_A
#undef MQ_WRITE_A
#undef MQ_LOAD_B
#undef MQ_WRITE_B
#undef MQ_COMPUTE
#undef MQ_STEP
    }
    asm volatile("s_waitcnt vmcnt(0)" ::: "memory");
    __syncthreads();
}

constexpr int NWAVES = 8;
constexpr int LDS_BYTES = 147456, LDSCTL_OFF = LDS_BYTES - 256;

struct Args { const float* in[31]; float* out; unsigned char* ws; int ph_lo, ph_hi, li, pad; };

struct Epi1 {
    bf16* PG; float* PGATE; float* PT;
    __device__ __forceinline__ void operator()(const pg8::f32x4 (&acc)[2][2][4][2], const pg8::Unit& u, int wr, int wc, int fr, int fq) const {
        const int row0 = u.pm * 256 + wr * 64 + fr;
        if (u.kind == 0) {
            if (u.pn < 16) {
                const int col0 = u.pn * 256 + wc * 32 + 8 * fq;
#pragma unroll
                for (int ai = 0; ai < 2; ++ai)
#pragma unroll
                    for (int m = 0; m < 4; ++m) { bf16* rowp = PG + (size_t)(row0 + ai * 128 + m * 16) * 4096 + col0;
#pragma unroll
                        for (int bj = 0; bj < 2; ++bj) { const pg8::f32x4 v0 = acc[ai][bj][m][0], v1 = acc[ai][bj][m][1];
                            pg8::u32x4 w; w.x = pg8::cvt_pk_bf16(v0[0], v0[1]); w.y = pg8::cvt_pk_bf16(v0[2], v0[3]); w.z = pg8::cvt_pk_bf16(v1[0], v1[1]); w.w = pg8::cvt_pk_bf16(v1[2], v1[3]);
                            *(pg8::u32x4*)(rowp + bj * 128) = w; } }
            } else if (wc == 0) {
#pragma unroll
                for (int ai = 0; ai < 2; ++ai)
#pragma unroll
                    for (int m = 0; m < 4; ++m) { float* rowp = PGATE + (size_t)(row0 + ai * 128 + m * 16) * 32 + 8 * fq;
                        *(pg8::f32x4*)(rowp) = acc[ai][0][m][0]; *(pg8::f32x4*)(rowp + 4) = acc[ai][0][m][1]; }
            }
        } else {
            const int col0 = u.pn * 256 + wc * 32 + 8 * fq;
#pragma unroll
            for (int ai = 0; ai < 2; ++ai)
#pragma unroll
                for (int m = 0; m < 4; ++m) { float* rowp = PT + (size_t)(row0 + ai * 128 + m * 16) * T + col0;
#pragma unroll
                    for (int bj = 0; bj < 2; ++bj) { *(pg8::f32x4*)(rowp + bj * 128) = acc[ai][bj][m][0]; *(pg8::f32x4*)(rowp + bj * 128 + 4) = acc[ai][bj][m][1]; } }
        }
    }
};
struct Order1 {
    const char* Hb; const char* WinT; int G, c;
    __device__ __forceinline__ bool next(int i, pg8::Unit& u) const {
        const int L = i * G + c;
        if (L >= 928) return false;
        u.rows = nullptr;
        if (L < 544) { int pm, pn; pg8::tile_of(L, 32, 17, pm, pn); u.pm = pm; u.pn = pn; u.kind = 0;
            u.A = Hb + (size_t)pm * 256 * DM * 2; u.B = WinT + (size_t)(GOFF + pn * 256) * DM * 2; }
        else { int pm, pn; pg8::tile_of(L - 544, 12, 32, pm, pn); u.pm = pm; u.pn = pn; u.kind = 1;
            u.A = WinT + (size_t)pm * 256 * DM * 2; u.B = Hb + (size_t)pn * 256 * DM * 2; }
        return true;
    }
};

struct Epi2 {
    const float* x; float* X1;
    __device__ __forceinline__ void operator()(const pg8::f32x4 (&acc)[2][2][4][2], const pg8::Unit& u, int wr, int wc, int fr, int fq) const {
        const int row0 = u.pm * 256 + wr * 64 + fr, col0 = u.pn * 256 + wc * 32 + 8 * fq;
#pragma unroll
        for (int ai = 0; ai < 2; ++ai)
#pragma unroll
            for (int m = 0; m < 4; ++m) { const size_t off = (size_t)(row0 + ai * 128 + m * 16) * DM + col0;
#pragma unroll
                for (int bj = 0; bj < 2; ++bj) {
                    const pg8::f32x4 x0 = *(const pg8::f32x4*)(x + off + bj * 128), x1 = *(const pg8::f32x4*)(x + off + bj * 128 + 4);
                    *(pg8::f32x4*)(X1 + off + bj * 128) = x0 + acc[ai][bj][m][0]; *(pg8::f32x4*)(X1 + off + bj * 128 + 4) = x1 + acc[ai][bj][m][1]; }
                asm volatile("" ::: "memory"); }
    }
};
struct Order2 {
    const char* A2; const char* WoutT; int G, c;
    __device__ __forceinline__ bool next(int i, pg8::Unit& u) const {
        const int L = i * G + c; if (L >= 256) return false;
        int pm, pn; pg8::tile_of(L, 32, 8, pm, pn); u.pm = pm; u.pn = pn; u.kind = 0; u.rows = nullptr;
        u.A = A2 + (size_t)pm * 256 * DM * 2; u.B = WoutT + (size_t)pn * 256 * DM * 2; return true;
    }
};
struct Epi3 {
    bf16* HH;
    __device__ __forceinline__ void operator()(const pg8::f32x4 (&acc)[2][2][4][2], const pg8::Unit& u, int wr, int wc, int fr, int fq) const {
        const int row0 = u.pm * 256 + wr * 64 + fr, col0 = u.pn * 128 + wc * 32 + 8 * fq;
#pragma unroll
        for (int ai = 0; ai < 2; ++ai)
#pragma unroll
            for (int m = 0; m < 4; ++m) { bf16* rowp = HH + (size_t)(row0 + ai * 128 + m * 16) * DE + col0;
                float v[8];
#pragma unroll
                for (int n = 0; n < 2; ++n)
#pragma unroll
                    for (int j = 0; j < 4; ++j) { const float a = acc[ai][0][m][n][j], b = acc[ai][1][m][n][j]; v[n * 4 + j] = a / (1.f + __expf(-a)) * b; }
                pg8::u32x4 w; w.x = pg8::cvt_pk_bf16(v[0], v[1]); w.y = pg8::cvt_pk_bf16(v[2], v[3]); w.z = pg8::cvt_pk_bf16(v[4], v[5]); w.w = pg8::cvt_pk_bf16(v[6], v[7]);
                *(pg8::u32x4*)rowp = w; }
    }
};
struct Order3 {
    const char* Ub; const char* W13T; const int* slot_tok; const int* blk_exp; int nunits, G, c;
    __device__ __forceinline__ bool next(int i, pg8::Unit& u) const {
        const int L = i * G + c; if (L >= nunits) return false;
        const int b = L >> 2, j = L & 3; u.pm = b; u.pn = j; u.kind = 0; u.rows = slot_tok + b * 256; u.A = Ub;
        const int e = __hip_atomic_load(blk_exp + b, __ATOMIC_RELAXED, __HIP_MEMORY_SCOPE_AGENT);
        u.B = W13T + ((size_t)e * 1024 + j * 256) * DM * 2; return true;
    }
};
struct Epi4 {
    bf16* Y;
    __device__ __forceinline__ void operator()(const pg8::f32x4 (&acc)[2][2][4][2], const pg8::Unit& u, int wr, int wc, int fr, int fq) const {
        const int row0 = u.pm * 256 + wr * 64 + fr, col0 = u.pn * 256 + wc * 32 + 8 * fq;
#pragma unroll
        for (int ai = 0; ai < 2; ++ai)
#pragma unroll
            for (int m = 0; m < 4; ++m) { bf16* rowp = Y + (size_t)(row0 + ai * 128 + m * 16) * DM + col0;
#pragma unroll
                for (int bj = 0; bj < 2; ++bj) { const pg8::f32x4 v0 = acc[ai][bj][m][0], v1 = acc[ai][bj][m][1];
                    pg8::u32x4 w; w.x = pg8::cvt_pk_bf16(v0[0], v0[1]); w.y = pg8::cvt_pk_bf16(v0[2], v0[3]); w.z = pg8::cvt_pk_bf16(v1[0], v1[1]); w.w = pg8::cvt_pk_bf16(v1[2], v1[3]);
                    *(pg8::u32x4*)(rowp + bj * 128) = w; } }
    }
};
struct Order4 {
    const char* HH; const char* W2T; const int* blk_exp; int nunits, G, c;
    __device__ __forceinline__ bool next(int i, pg8::Unit& u) const {
        const int L = i * G + c; if (L >= nunits) return false;
        const int b = L >> 3, j = L & 7; u.pm = b; u.pn = j; u.kind = 0; u.rows = nullptr; u.A = HH + (size_t)b * 256 * DE * 2;
        const int e = __hip_atomic_load(blk_exp + b, __ATOMIC_RELAXED, __HIP_MEMORY_SCOPE_AGENT);
        u.B = W2T + ((size_t)e * DM + j * 256) * DE * 2; return true;
    }
};

struct TrItem { const float* W; int ldn, k0, n0; bf16* WT; size_t dst_row0; int ldk; };
__device__ __forceinline__ void tr_store(const TrItem& I, LAS float* scr, const float (&tv)[32], int lane) {
#pragma unroll
    for (int i = 0; i < 32; ++i) { const int kk = 2 * i + (lane >> 5); scr[kk * 33 + (lane & 31)] = tv[i]; }
    asm volatile("s_waitcnt lgkmcnt(0)" ::: "memory");
    const int c = lane & 7;
#pragma unroll
    for (int j = 0; j < 4; ++j) { const int n = (lane >> 3) + 8 * j; const LAS float* s = scr + (8 * c) * 33 + n;
        v4u o; o.x = pg8::cvt_pk_bf16(s[0 * 33], s[1 * 33]); o.y = pg8::cvt_pk_bf16(s[2 * 33], s[3 * 33]); o.z = pg8::cvt_pk_bf16(s[4 * 33], s[5 * 33]); o.w = pg8::cvt_pk_bf16(s[6 * 33], s[7 * 33]);
        *(GAS v4u*)(I.WT + (I.dst_row0 + n) * I.ldk + I.k0 + 8 * c) = o; }
    asm volatile("s_waitcnt lgkmcnt(0)" ::: "memory");
}
__device__ __forceinline__ void tr_pair(const TrItem& A, const TrItem& B, bool hasB, LAS float* scr, int lane) {
    float ta[32], tb[32];
    const float* pa = A.W + (size_t)(A.k0 + (lane >> 5)) * A.ldn + A.n0 + (lane & 31);
    const float* pb = (hasB ? B.W + (size_t)(B.k0 + (lane >> 5)) * B.ldn + B.n0 : A.W + (size_t)(A.k0 + (lane >> 5)) * A.ldn + A.n0) + (lane & 31);
    const size_t sa = (size_t)2 * A.ldn, sb = (size_t)2 * (hasB ? B.ldn : A.ldn);
#pragma unroll
    for (int i = 0; i < 32; ++i) { ta[i] = pa[i * sa]; tb[i] = pb[i * sb]; }
    tr_store(A, scr, ta, lane);
    if (hasB) tr_store(B, scr, tb, lane);
}
__device__ __forceinline__ void tr_item(const float* W, int ldn, int k0, int n0, bf16* WT, size_t dst_row0, int ldk, LAS float* scr, int lane) {
    const TrItem A{W, ldn, k0, n0, WT, dst_row0, ldk}; tr_pair(A, A, false, scr, lane);
}
__device__ __forceinline__ void rms_row_to_bf16(const float* xrow, const float* w, bf16* orow, int lane) {
    const GAS pg8::f32x4* xr = (const GAS pg8::f32x4*)xrow + lane; const GAS pg8::f32x4* wr = (const GAS pg8::f32x4*)w + lane;
    pg8::f32x4 v[8]; float s = 0.f;
#pragma unroll
    for (int j = 0; j < 8; ++j) { v[j] = xr[64 * j]; s += (v[j].x * v[j].x + v[j].y * v[j].y) + (v[j].z * v[j].z + v[j].w * v[j].w); }
    const float r = rsqrtf(wave_sum(s) * (1.f / DM) + EPS);
    GAS unsigned long long* o8 = (GAS unsigned long long*)orow + lane;
#pragma unroll
    for (int j = 0; j < 8; ++j) { const pg8::f32x4 g = wr[64 * j];
        o8[64 * j] = (unsigned long long)pk2(v[j].x * r * g.x, v[j].y * r * g.y) | ((unsigned long long)pk2(v[j].z * r * g.z, v[j].w * r * g.w) << 32); }
}

__global__ void __launch_bounds__(NWAVES * 64, 2) fwd(Args args) {
    extern __shared__ __attribute__((aligned(16))) unsigned char lds_raw[];
    LAS unsigned char* lds = (LAS unsigned char*)lds_raw;
    const int tid = threadIdx.x, lane = tid & 63, wave = __builtin_amdgcn_readfirstlane(tid >> 6);
    const int G = gridDim.x; const int bx = blockIdx.x; const int vcu = (G % 8 == 0) ? (bx % 8) * (G / 8) + bx / 8 : bx;
    unsigned char* ws = args.ws;
    unsigned* ctl = (unsigned*)(ws + WS_CTL);
    for (int u = tid; u < (LDS_BYTES - LDSCTL_OFF) / 4; u += NWAVES * 64) ((LAS unsigned*)(lds + LDSCTL_OFF))[u] = 0u;
    __syncthreads();
    XcdBarrier bar = xcd_barrier_post(ctl + CW_BAR + args.li * XCD_BAR_WORDS, (volatile LAS unsigned*)(lds + LDSCTL_OFF + 64));
    static_assert(2 * FFT_BUF_BYTES <= LDSCTL_OFF && 1024 * 33 * 4 <= LDSCTL_OFF, "LDS map");
    const int lo = args.ph_lo, hi = args.ph_hi;
#if 0
#define MK_DUP_MASK 0
#endif
#define IN(k) (lo <= (k) && (k) < hi)
#define BOTH(k) (IN(k) && IN((k) + 1))
    bf16* WinT = (bf16*)(ws + WS_WINT); bf16* Hb = (bf16*)(ws + WS_HB);

    if (IN(0)) { REP(0) {
        int tid_p = tid; asm volatile("" : "+v"(tid_p)); const int lane_p = tid_p & 63; (void)lane_p;
        LAS float* scr = (LAS float*)(lds + wave * 16384);
        const int gw = vcu * NWAVES + wave, NGW = G * NWAVES;
        const float* w_in = args.in[2];
        for (int it = gw; it < 32 * 225; it += NGW) { const int kb = it / 225, nb = it % 225; tr_item(w_in, NPROJ, 64 * kb, 32 * nb, WinT, (size_t)(32 * nb), DM, scr, lane); }
        for (int r = gw; r < NPROJ_PAD - NPROJ; r += NGW) { GAS v4u* o = (GAS v4u*)(WinT + (size_t)(NPROJ + r) * DM) + lane;
#pragma unroll
            for (int j = 0; j < 4; ++j) o[64 * j] = (v4u){0u, 0u, 0u, 0u}; }
        { bf16* WoutT = (bf16*)(ws + WS_WOUTT); const float* w_out = args.in[21];
          for (int it = gw; it < 32 * 64; it += NGW) { const int kb = it >> 6, nb = it & 63; tr_item(w_out, DM, 64 * kb, 32 * nb, WoutT, (size_t)(32 * nb), DM, scr, lane); } }
        for (int it = bx; it < 256; it += G)
            hyena_filter_item(lds, it, args.in[5], args.in[6], args.in[7], args.in[8], args.in[9], args.in[10], args.in[11], args.in[12], (float*)(ws + WS_KC), tid_p, lane_p, wave);
        { bf16* RWh = (bf16*)(ws + WS_SMALL + SM_RWT); bf16* RWl = RWh + 80 * 2048; const float* rgw = args.in[23]; const float* rew = args.in[25];
          for (int i = vcu * 512 + tid; i < 80 * 2048; i += G * 512) { const int n = i >> 11, k = i & 2047;
              const float w = n < 8 ? rgw[k * 8 + n] : (n < 72 ? rew[k * 64 + n - 8] : 0.f); const unsigned h = f2bf(w); const float hf = __builtin_bit_cast(float, h << 16);
              RWh[i] = (bf16)h; RWl[i] = (bf16)f2bf(w - hf); } }
        for (int m = gw; m < T; m += NGW) rms_row_to_bf16(args.in[0] + (size_t)m * DM, args.in[1], Hb + (size_t)m * DM, lane);
        }
        if (BOTH(0)) xcd_barrier(bar);
    }
    if (IN(1)) { REP(1) {
        int tid_p = tid; asm volatile("" : "+v"(tid_p)); const int lane_p = tid_p & 63; (void)lane_p;
        Order1 S{(const char*)Hb, (const char*)WinT, G, bx};
        Epi1 E{(bf16*)(ws + WS_PG), (float*)(ws + WS_PGATE), (float*)(ws + WS_PT)};
        pg8::gemm_phase<Epi1, Order1, false>(lds, DM, S, E, tid_p);
        }
        if (BOTH(1)) xcd_barrier(bar);
    }
    if (IN(2)) { REP(2) {
        int tid_p = tid; asm volatile("" : "+v"(tid_p)); const int lane_p = tid_p & 63; (void)lane_p;
        REP(11) hyena_phase(lds, (const float*)(ws + WS_PT), (const float*)(ws + WS_KC), args.in[3], args.in[4], args.in[13], (float*)(ws + WS_YHT), G, vcu);
        REP(12) for (int wg = bx; wg < 256; wg += G) {
            int tid_i = tid_p; asm volatile("" : "+v"(tid_i)); const int lane_i = tid_i & 63;
            gdn_pre(lds, wg, (const bf16*)(ws + WS_PG), (const float*)(ws + WS_PGATE), args.in[15], args.in[16], args.in[17], args.in[18], args.in[19], ws, tid_i, lane_i, wave);
            gdn_prep_wave(lds, wg, ws, lane_i, wave);
            __syncthreads();
        }
        }
        if (BOTH(2)) xcd_barrier(bar);
    }
    if (IN(3)) { REP(3) {
        int tid_p = tid; asm volatile("" : "+v"(tid_p)); const int lane_p = tid_p & 63; (void)lane_p;
        for (int v = vcu; v < 256; v += G) gdn_scan(lds, ws, (bf16*)(ws + WS_OF), (bf16*)(ws + WS_OB), v, tid_p, lane_p, wave);
        }
        if (BOTH(3)) xcd_barrier(bar);
    }
    if (IN(4)) { REP(4) {
        int tid_p = tid; asm volatile("" : "+v"(tid_p)); const int lane_p = tid_p & 63; (void)lane_p;
        for (int tile = bx; tile < T / 32; tile += G) hyena_post_tile(lds, tile, (const float*)(ws + WS_YHT), args.in[14], (bf16*)(ws + WS_A2), tid_p, lane_p, wave);
        for (int it = (vcu * NWAVES + wave) * 8; it < T * 8; it += G * NWAVES * 8) gdn_post_batch(it, (const bf16*)(ws + WS_OF), (const bf16*)(ws + WS_OB), (const bf16*)(ws + WS_PG), args.in[20], (bf16*)(ws + WS_A2), lane_p);
        }
        if (BOTH(4)) xcd_barrier(bar);
    }
    if (IN(5)) { REP(5) {
        int tid_p = tid; asm volatile("" : "+v"(tid_p)); const int lane_p = tid_p & 63; (void)lane_p;
        Order2 S{(const char*)(ws + WS_A2), (const char*)(ws + WS_WOUTT), G, bx};
        Epi2 E{args.in[0], (float*)(ws + WS_X1)};
        pg8::gemm_phase<Epi2, Order2, false>(lds, DM, S, E, tid_p);
        }
        if (BOTH(5)) xcd_barrier(bar);
    }
    if (IN(6)) {
        int tid_p = tid; asm volatile("" : "+v"(tid_p)); const int lane_p = tid_p & 63; (void)lane_p;
        for (int wg = bx; wg < 256; wg += G) { route_phase(lds, wg, (const float*)(ws + WS_X1), args.in[22], args.in[24], args.in[26], ws, ctl + CW_CNT, tid_p, lane_p, wave); __syncthreads(); }
        if (BOTH(6)) xcd_barrier(bar);
    }
    if (IN(7)) {
        int tid_p = tid; asm volatile("" : "+v"(tid_p)); const int lane_p = tid_p & 63; (void)lane_p;
        for (int wg = bx; wg < 256; wg += G) fill_phase(lds, wg, ws, ctl + CW_CNT, tid_p);
        if (BOTH(7)) xcd_barrier(bar);
    }
    const int* slot_tok = (const int*)(ws + WS_SMALL + SM_SLOTTOK); const int* blk_exp = (const int*)(ws + WS_SMALL + SM_BLKEXP); const int* nblk_p = (const int*)(ws + WS_SMALL + SM_NBLK);
    if (IN(8)) { REP(8) {
        int tid_p = tid; asm volatile("" : "+v"(tid_p)); const int lane_p = tid_p & 63; (void)lane_p;
        const int nblk = __hip_atomic_load(nblk_p, __ATOMIC_RELAXED, __HIP_MEMORY_SCOPE_AGENT);
        moe_gemm<true>(lds, ws, args.in[27], args.in[28], ctl + CW_Q8, nblk, tid_p);
        }
        if (BOTH(8)) xcd_barrier(bar);
    }
    if (IN(9)) { REP(9) {
        int tid_p = tid; asm volatile("" : "+v"(tid_p)); const int lane_p = tid_p & 63; (void)lane_p;
        const int nblk = __hip_atomic_load(nblk_p, __ATOMIC_RELAXED, __HIP_MEMORY_SCOPE_AGENT);
        moe_gemm<false>(lds, ws, args.in[29], nullptr, ctl + CW_Q9, nblk, tid_p);
        }
        if (BOTH(9)) xcd_barrier(bar);
    }
    if (IN(10)) { REP(10) {
        int tid_p = tid; asm volatile("" : "+v"(tid_p)); const int lane_p = tid_p & 63; (void)lane_p;
        for (int t = (vcu * NWAVES + wave) * 2; t < T; t += G * NWAVES * 2) final_rows(t, (const float*)(ws + WS_X1), (const bf16*)(ws + WS_Y), ws, args.in[30], args.out, lane_p);
    }
    }
#undef IN
#undef BOTH
}

#ifndef MK_PER_PHASE
#define MK_PER_PHASE 0
#endif
constexpr int N_PHASES = 11;
extern "C" void kernel_launch(void* const* d_in, const int* in_sizes, int n_in, void* d_out, int out_size, void* d_ws, size_t ws_size, hipStream_t stream) {
    static int grid = 0;
    if (grid == 0) {
        int dev = 0, cus = 0;
        (void)hipGetDevice(&dev); (void)hipDeviceGetAttribute(&cus, hipDeviceAttributeMultiprocessorCount, dev);
        (void)hipFuncSetAttribute((const void*)fwd, hipFuncAttributeMaxDynamicSharedMemorySize, LDS_BYTES);
        int per_cu = 0; (void)hipOccupancyMaxActiveBlocksPerMultiprocessor(&per_cu, (const void*)fwd, NWAVES * 64, LDS_BYTES);
        (void)hipGetLastError();
        grid = cus > 0 ? cus : 256;
    }
    (void)hipMemsetAsync((char*)d_ws + WS_CTL, 0, CTL_ZERO_BYTES, stream);
    Args a{};
    for (int i = 0; i < 31; ++i) a.in[i] = (const float*)d_in[i];
    a.out = (float*)d_out; a.ws = (unsigned char*)d_ws;
#if MK_PER_PHASE
    for (int p = 0; p < N_PHASES; ++p) { a.ph_lo = p; a.ph_hi = p + 1; a.li = 0; hipLaunchKernelGGL(fwd, dim3(grid), dim3(NWAVES * 64), LDS_BYTES, stream, a); }
#else
    a.ph_lo = 0; a.ph_hi = N_PHASES; a.li = 0;
    hipLaunchKernelGGL(fwd, dim3(grid), dim3(NWAVES * 64), LDS_BYTES, stream, a);
#endif
}
```

```cpp
#include <hip/hip_runtime.h>
#include <cstdio>
#include <cstdint>
#include <cmath>

constexpr int BATCH = 2, LSEQ = 4096, DM = 2048, T = BATCH * LSEQ;
constexpr int DHY = 1024, DGD = 1024, NH = 8, HD = 128;
constexpr int NPROJ = 3 * DHY + 4 * DGD + 4 * NH;
constexpr int GOFF = 3 * DHY;
constexpr int NPROJ_PAD = 7424;
constexpr int NG = 8, EPG = 8, NE = 64, DE = 512;
constexpr int RB = 256, PMAX = 32768, NBLK_MAX = 128;
constexpr float EPS = 1e-6f;

constexpr size_t MiB = 1u << 20;
constexpr size_t WS_CTL = 0;
constexpr size_t CTL_ZERO_BYTES = 1 * MiB;
constexpr size_t WS_SMALL = 2 * MiB;
constexpr size_t WS_WINT = 16 * MiB;
constexpr size_t WS_WOUTT = 608 * MiB;
constexpr size_t WS_HB = 56 * MiB;
constexpr size_t WS_PT = 88 * MiB;
constexpr size_t WS_PG = 184 * MiB;
constexpr size_t WS_PGATE = 248 * MiB;
constexpr size_t WS_A2 = 250 * MiB;
constexpr size_t WS_KC = 282 * MiB;
constexpr size_t WS_YHT = 314 * MiB;
constexpr size_t WS_X0 = 314 * MiB, WS_VG = 346 * MiB, WS_YH = 378 * MiB;
constexpr size_t WS_QN = 16 * MiB, WS_KN = 32 * MiB, WS_KT = 48 * MiB, WS_VT = 64 * MiB;
constexpr size_t WS_V = 346 * MiB, WS_OF = 378 * MiB, WS_OB = 410 * MiB;
constexpr size_t GW_B = 64 * 272, GKDT_B = 128 * 144, GQK_B = 64 * 144, GUT_B = 128 * 128;
constexpr size_t WS_GW = 442 * MiB;
constexpr size_t WS_GQD = WS_GW + 2048 * GW_B;
constexpr size_t WS_GKDT = WS_GQD + 2048 * GW_B;
constexpr size_t WS_GQK = WS_GKDT + 2048 * GKDT_B;
constexpr size_t WS_GUT = WS_GQK + 2048 * GQK_B;
constexpr size_t WS_GCD = WS_GUT + 2048 * GUT_B + 4096;
static_assert(WS_GCD + 2048 * 4 <= 640 * MiB, "ws map");
constexpr size_t WS_W13T = 640 * MiB;
constexpr size_t WS_W2T = 896 * MiB;
constexpr size_t WS_X1 = 282 * MiB;
constexpr size_t WS_U = 346 * MiB;
constexpr size_t WS_UB = 412 * MiB;
constexpr size_t WS_HH = 446 * MiB;
constexpr size_t WS_Y = 88 * MiB;
constexpr int CW_CNT = 0;
constexpr int CW_Q8 = 1024, CW_Q9 = 2048;
constexpr int CW_DONE = 3072;
constexpr int CW_BAR = 4096;
constexpr size_t SM_LOGITS = 0;
constexpr size_t SM_GB = SM_LOGITS + (size_t)T * 72 * 4;
constexpr size_t SM_EID = SM_GB + (size_t)4 * T * 8 * 4;
constexpr size_t SM_GATE = SM_EID + (size_t)T * 2 * 4;
constexpr size_t SM_POS = SM_GATE + (size_t)T * 2 * 4;
constexpr size_t SM_TSLOT = SM_POS + (size_t)T * 2 * 4;
constexpr size_t SM_SLOTTOK = SM_TSLOT + (size_t)T * 2 * 4;
constexpr size_t SM_BLKEXP = SM_SLOTTOK + (size_t)PMAX * 4;
constexpr size_t SM_PADSTART = SM_BLKEXP + NBLK_MAX * 4;
constexpr size_t SM_NBLK = SM_PADSTART + NE * 4;
constexpr size_t SM_RWT = (SM_NBLK + 256 + 255) / 256 * 256;
static_assert(SM_RWT + 2 * 80 * 2048 * 2 <= 14 * MiB, "small region");

#define LAS __attribute__((address_space(3)))
#define GAS __attribute__((address_space(1)))
typedef unsigned short bf16;
typedef unsigned v4u __attribute__((ext_vector_type(4)));

__device__ __forceinline__ float dpp_f(float v, const int ctrl_unused) { return v; }
#define WS_DPP(v, ctrl) __builtin_bit_cast(float, __builtin_amdgcn_update_dpp(0, __builtin_bit_cast(int, (v)), (ctrl), 0xF, 0xF, true))
__device__ __forceinline__ float wave_sum(float v) {
    v += WS_DPP(v, 0xB1);
    v += WS_DPP(v, 0x4E);
    v += WS_DPP(v, 0x141);
    v += WS_DPP(v, 0x140);
    v += __shfl_xor(v, 16); v += __shfl_xor(v, 32);
    return v;
}
__device__ __forceinline__ float silu_f(float x) { return x / (1.f + expf(-x)); }
__device__ __forceinline__ float sigmoid_f(float x) { return 1.f / (1.f + expf(-x)); }
__device__ __forceinline__ float softplus_f(float x) { return fmaxf(x, 0.f) + log1pf(expf(-fabsf(x))); }
__device__ __forceinline__ unsigned f2bf(float f) { unsigned u = __builtin_bit_cast(unsigned, f); return (u + 0x7fffu + ((u >> 16) & 1u)) >> 16; }
__device__ __forceinline__ unsigned pk2(float lo, float hi) { return f2bf(lo) | (f2bf(hi) << 16); }
__device__ __forceinline__ float bf2f(bf16 b) { return __builtin_bit_cast(float, ((unsigned)b) << 16); }

#ifndef MK_DUP_MASK
#define MK_DUP_MASK 0
#endif
#define REP(k) _Pragma("unroll 1") for (int rep_ = 0; rep_ < (((MK_DUP_MASK) >> (k)) & 1) + 1; ++rep_)
constexpr int LDSCTL_OFF_C = 147456 - 256;
namespace pg8 {
#define PG8_LAS __attribute__((address_space(3)))
typedef unsigned short bf16_t;
typedef short bf16x8 __attribute__((ext_vector_type(8)));
typedef float f32x4 __attribute__((ext_vector_type(4)));
typedef unsigned u32x4 __attribute__((ext_vector_type(4)));
constexpr int BM = 256, BK = 64, HALF = 128, HTB = HALF * BK * 2  , STAGE_BYTES = 8 * HTB, NXCD = 8, WGM = 8;

__host__ __device__ __forceinline__ int lds_byte(int r, int c) { const int st = (r >> 4) * 2 + (c >> 5), rr = r & 15, cc = c & 31, ob = rr * 64 + cc * 2; return st * 1024 + (ob ^ (((ob >> 9) & 1) << 5)); }
__host__ __device__ __forceinline__ void stage_rc(int b, int& R, int& C) { const int st = b / 1024, sb = b % 1024, swz = sb ^ (((sb >> 9) & 1) << 5); R = (st >> 1) * 16 + swz / 64; C = (st & 1) * 32 + (swz % 64) / 2; }
__host__ __device__ __forceinline__ int perm32(int rho) { const int n = rho >> 4, i = rho & 15; return 8 * (i >> 2) + 4 * n + (i & 3); }

struct Unit { const char* A; const char* B; const int* rows; int pm, pn, kind; };

__device__ __forceinline__ void tile_of(int L, int nM, int nN, int& pm, int& pn) {
    const int nwg = nM * nN;
    int wgid = L; { const int q = nwg / NXCD, r = nwg % NXCD, xcd = wgid % NXCD, off = wgid / NXCD; wgid = (xcd < r ? xcd * (q + 1) : r * (q + 1) + (xcd - r) * q) + off; }
    const int nig = WGM * nN, gid = wgid / nig, fm = gid * WGM, gsz = (nM - fm) < WGM ? (nM - fm) : WGM;
    pm = fm + ((wgid % nig) % gsz); pn = (wgid % nig) / gsz;
}

typedef float cvt_f2 __attribute__((ext_vector_type(2)));
typedef __bf16 cvt_b2 __attribute__((ext_vector_type(2)));
__device__ __forceinline__ unsigned cvt_pk_bf16(float lo, float hi) { const cvt_f2 f = {lo, hi}; const cvt_b2 v = __builtin_convertvector(f, cvt_b2); return __builtin_bit_cast(unsigned, v); }

template <class Epi, class Sched, bool GATHER>
__device__ __forceinline__ void gemm_phase(PG8_LAS unsigned char* lds, const int K, const Sched& S, const Epi& E, const int tid) {
    const int wid = __builtin_amdgcn_readfirstlane(tid >> 6), lane = tid & 63, wr = wid >> 2, wc = wid & 3, fr = lane & 15, fq = lane >> 4;
    const int nt = K / BK;
    int Rr[2], Cc[2];
    unsigned voffB[2];
#pragma unroll
    for (int i = 0; i < 2; ++i) { stage_rc(tid * 16 + i * 8192, Rr[i], Cc[i]); const int Rb = (Rr[i] & ~31) + perm32(Rr[i] & 31); voffB[i] = (unsigned)(Rb * K + Cc[i]) * 2u; }
    const size_t kstep = (size_t)(BK * 2);
    const size_t hstep = (size_t)HALF * K * 2;
    const unsigned ldsw = (unsigned)wid * 1024u;
    const int aoff = lds_byte(wr * 64 + fr, fq * 8), boff = lds_byte(wc * 32 + fr, fq * 8);
#define PG8_SA(b, h) (((b) * 2 + (h)) * HTB)
#define PG8_SB(b, h) ((4 + (b) * 2 + (h)) * HTB)
#define PG8_STAGE2(bufoff, gbase, v0, v1) do { \
        __builtin_amdgcn_global_load_lds((const unsigned*)((const char*)(gbase) + (v0)), (PG8_LAS unsigned*)(lds + (bufoff) + ldsw), 16, 0, 0); \
        __builtin_amdgcn_global_load_lds((const unsigned*)((const char*)(gbase) + (v1)), (PG8_LAS unsigned*)(lds + (bufoff) + ldsw + 8192), 16, 0, 0); } while (0)
#define PG8_STAGEB(bufoff, gbase) PG8_STAGE2(bufoff, gbase, voffB[0], voffB[1])
#define PG8_LDA(dst, b, h) do { _Pragma("unroll") for (int m = 0; m < 4; ++m) _Pragma("unroll") for (int k = 0; k < 2; ++k) dst[m][k] = *(const PG8_LAS bf16x8*)(lds + PG8_SA(b, h) + aoff + m * 2048 + k * 1024); } while (0)
#define PG8_LDB(dst, b, h) do { _Pragma("unroll") for (int n = 0; n < 2; ++n) _Pragma("unroll") for (int k = 0; k < 2; ++k) dst[n][k] = *(const PG8_LAS bf16x8*)(lds + PG8_SB(b, h) + boff + n * 2048 + k * 1024); } while (0)
#define PG8_MMA(ai, bj, At, Bt) do { __builtin_amdgcn_s_setprio(1); _Pragma("unroll") for (int m = 0; m < 4; ++m) _Pragma("unroll") for (int n = 0; n < 2; ++n) _Pragma("unroll") for (int k = 0; k < 2; ++k) \
        acc[ai][bj][m][n] = __builtin_amdgcn_mfma_f32_16x16x32_bf16(Bt[n][k], At[m][k], acc[ai][bj][m][n], 0, 0, 0); __builtin_amdgcn_s_setprio(0); } while (0)
#define PG8_WAIT_V(n) asm volatile("s_waitcnt vmcnt(" #n ")" ::: "memory")
#define PG8_WAIT_L(n) asm volatile("s_waitcnt lgkmcnt(" #n ")" ::: "memory")
#define PG8_BAR __builtin_amdgcn_s_barrier()
#define PG8_SCHED __builtin_amdgcn_sched_barrier(0)
    Unit cur, nxt; int ui = 0;
    if (!S.next(0, cur)) return;
    f32x4 acc[2][2][4][2];
#pragma unroll
    for (int a = 0; a < 2; ++a)
#pragma unroll
        for (int b = 0; b < 2; ++b)
#pragma unroll
            for (int m = 0; m < 4; ++m)
#pragma unroll
                for (int n = 0; n < 2; ++n) acc[a][b][m][n] = (f32x4){0.f, 0.f, 0.f, 0.f};
    bf16x8 At[4][2], B0[2][2], B1[2][2];
    unsigned c00, c01, c10, c11, n00, n01, n10, n11;
    if constexpr (GATHER) {
        c00 = (unsigned)cur.rows[Rr[0]] * (unsigned)(K * 2) + (unsigned)Cc[0] * 2u; c01 = (unsigned)cur.rows[Rr[1]] * (unsigned)(K * 2) + (unsigned)Cc[1] * 2u;
        c10 = (unsigned)cur.rows[128 + Rr[0]] * (unsigned)(K * 2) + (unsigned)Cc[0] * 2u; c11 = (unsigned)cur.rows[128 + Rr[1]] * (unsigned)(K * 2) + (unsigned)Cc[1] * 2u;
    } else {
        c00 = (unsigned)(Rr[0] * K + Cc[0]) * 2u; c01 = (unsigned)(Rr[1] * K + Cc[1]) * 2u;
        c10 = c00 + (unsigned)hstep; c11 = c01 + (unsigned)hstep;
    }
    n00 = c00; n01 = c01; n10 = c10; n11 = c11;
    const char* cA = cur.A; const char* cB = cur.B;
    PG8_STAGEB(PG8_SB(0, 0), cB); PG8_STAGEB(PG8_SB(0, 1), cB + hstep); PG8_STAGE2(PG8_SA(0, 0), cA, c00, c01); PG8_STAGE2(PG8_SA(0, 1), cA, c10, c11);
    if (wr == 1) PG8_BAR;
    PG8_WAIT_V(2); PG8_BAR;
    PG8_STAGEB(PG8_SB(1, 0), cB + kstep); PG8_STAGE2(PG8_SA(1, 0), cA + kstep, c00, c01); PG8_STAGEB(PG8_SB(1, 1), cB + hstep + kstep);
    PG8_WAIT_V(6); PG8_BAR;
    for (;;) {
        const bool has_next = S.next(ui + 1, nxt);
        const char* nA = has_next ? nxt.A : cA; const char* nB = has_next ? nxt.B : cB;
        if constexpr (GATHER) {
            if (has_next) {
                n00 = (unsigned)nxt.rows[Rr[0]] * (unsigned)(K * 2) + (unsigned)Cc[0] * 2u; n01 = (unsigned)nxt.rows[Rr[1]] * (unsigned)(K * 2) + (unsigned)Cc[1] * 2u;
                n10 = (unsigned)nxt.rows[128 + Rr[0]] * (unsigned)(K * 2) + (unsigned)Cc[0] * 2u; n11 = (unsigned)nxt.rows[128 + Rr[1]] * (unsigned)(K * 2) + (unsigned)Cc[1] * 2u;
            } else { n00 = c00; n01 = c01; n10 = c10; n11 = c11; }
        }
        for (int t = 0; t < nt; t += 2) {
            const bool last = (t == nt - 2);
            const char* a1 = cA + (size_t)(t + 1) * kstep;
            const char* a2 = last ? nA : cA + (size_t)(t + 2) * kstep; const char* b2 = last ? nB : cB + (size_t)(t + 2) * kstep;
            const char* a3 = a2 + kstep; const char* b3 = b2 + kstep;
            unsigned e00, e01, e10, e11;
            if constexpr (GATHER) { e00 = last ? n00 : c00; e01 = last ? n01 : c01; e10 = last ? n10 : c10; e11 = last ? n11 : c11; } else { e00 = c00; e01 = c01; e10 = c10; e11 = c11; }
            PG8_LDB(B0, 0, 0); PG8_LDB(B1, 0, 1); PG8_SCHED; PG8_LDA(At, 0, 0); PG8_STAGE2(PG8_SA(1, 1), a1, c10, c11);
            PG8_WAIT_V(8); PG8_WAIT_L(0); PG8_BAR; PG8_MMA(0, 0, At, B0); PG8_MMA(0, 1, At, B1); PG8_BAR; PG8_SCHED;
            PG8_LDA(At, 0, 1); PG8_STAGEB(PG8_SB(0, 0), b2); PG8_STAGEB(PG8_SB(0, 1), b2 + hstep); PG8_STAGE2(PG8_SA(0, 0), a2, e00, e01);
            PG8_WAIT_V(8); PG8_WAIT_L(0); PG8_BAR; PG8_MMA(1, 0, At, B0); PG8_MMA(1, 1, At, B1); PG8_BAR; PG8_SCHED;
            PG8_LDB(B0, 1, 0); PG8_LDB(B1, 1, 1); PG8_SCHED; PG8_LDA(At, 1, 0); PG8_STAGE2(PG8_SA(0, 1), a2, e10, e11);
            PG8_WAIT_V(8); PG8_WAIT_L(0); PG8_BAR; PG8_MMA(0, 0, At, B0); PG8_MMA(0, 1, At, B1); PG8_BAR; PG8_SCHED;
            PG8_LDA(At, 1, 1); PG8_STAGEB(PG8_SB(1, 0), b3); PG8_STAGEB(PG8_SB(1, 1), b3 + hstep); PG8_STAGE2(PG8_SA(1, 0), a3, e00, e01);
            PG8_WAIT_V(8); PG8_WAIT_L(0); PG8_BAR; PG8_MMA(1, 0, At, B0); PG8_MMA(1, 1, At, B1); PG8_BAR; PG8_SCHED;
        }
        if (wr == 0) PG8_BAR;
        E(acc, cur, wr, wc, fr, fq);
        if (!has_next) break;
#pragma unroll
        for (int a = 0; a < 2; ++a)
#pragma unroll
            for (int b = 0; b < 2; ++b)
#pragma unroll
                for (int m = 0; m < 4; ++m)
#pragma unroll
                    for (int n = 0; n < 2; ++n) acc[a][b][m][n] = (f32x4){0.f, 0.f, 0.f, 0.f};
        cur = nxt; cA = nA; cB = nB; ++ui;
        if constexpr (GATHER) { c00 = n00; c01 = n01; c10 = n10; c11 = n11; }
        if (wr == 1) PG8_BAR;
    }
    PG8_WAIT_V(0);
    PG8_BAR;
#undef PG8_SA
#undef PG8_SB
#undef PG8_STAGE2
#undef PG8_STAGEB
#undef PG8_LDA
#undef PG8_LDB
#undef PG8_MMA
#undef PG8_WAIT_V
#undef PG8_WAIT_L
#undef PG8_BAR
#undef PG8_SCHED
}
}

#define XB_TMO      128
#define XB_XCNT(j)  (256  + 64 * (j))
#define XB_XSUB(j)  (1280 + 64 * (j))
#define XB_XGEN(j)  (2304 + 64 * (j))
#define XB_TOP      3328
#define XB_TOPGEN   3392
#define XCD_BAR_WORDS 3456
#define XB_SPIN_CAP (1u << 18)
__device__ __forceinline__ unsigned xb_ld(unsigned* p)              { return __hip_atomic_load(p, __ATOMIC_RELAXED, __HIP_MEMORY_SCOPE_AGENT); }
__device__ __forceinline__ unsigned xb_add(unsigned* p, unsigned v) { return __hip_atomic_fetch_add(p, v, __ATOMIC_RELAXED, __HIP_MEMORY_SCOPE_AGENT); }
__device__ __forceinline__ unsigned xb_xcc_id() { return (unsigned)__builtin_amdgcn_s_getreg((3 << 11) | 20) & 0xFu; }
#define XB_SPIN(cond, bar) do { unsigned _sp = 0; while (cond) { __builtin_amdgcn_s_sleep(1); \
    if ((++_sp & 255u) == 0u) { if (xb_ld(&(bar)[XB_TMO])) break; if (_sp > XB_SPIN_CAP) { atomicAdd(&(bar)[XB_TMO], 1u); break; } } } } while (0)
struct XcdBarrier { unsigned* bar; unsigned x; volatile LAS unsigned* st; };
__device__ __forceinline__ XcdBarrier xcd_barrier_post(unsigned* bar, volatile LAS unsigned* st) {
    XcdBarrier b; b.bar = bar; b.x = xb_xcc_id(); b.st = st;
    if (threadIdx.x == 0) (void)xb_add(&bar[XB_XCNT(b.x)], 1u);
    return b;
}
__device__ __forceinline__ void xcd_barrier_complete(unsigned* bar, unsigned x, unsigned& nloc, unsigned& nx) {
    const unsigned G = gridDim.x * gridDim.y * gridDim.z;
    unsigned sum, cnt, mine, sp = 0u;
    for (;;) {
        sum = 0u; cnt = 0u; mine = 0u;
#pragma unroll
        for (unsigned j = 0; j < 16; ++j) { const unsigned c = xb_ld(&bar[XB_XCNT(j)]); sum += c; cnt += (c > 0u) ? 1u : 0u; mine = (j == x) ? c : mine; }
        if (sum == G) break;
        __builtin_amdgcn_s_sleep(1);
        if ((++sp & 255u) == 0u) { if (xb_ld(&bar[XB_TMO])) break; if (sp > XB_SPIN_CAP) { atomicAdd(&bar[XB_TMO], 1u); break; } }
    }
    nloc = mine > 0u ? mine : 1u; nx = cnt > 0u ? cnt : 1u;
}
__device__ __forceinline__ void xcd_barrier(const XcdBarrier& b) {
    asm volatile("s_waitcnt vmcnt(0)" ::: "memory");
    __syncthreads();
    if (threadIdx.x == 0) {
        unsigned* bar = b.bar;
        __builtin_amdgcn_s_waitcnt(0);
        unsigned nloc = b.st[0], nx = b.st[1];
        if (nloc == 0u) { xcd_barrier_complete(bar, b.x, nloc, nx); b.st[0] = nloc; b.st[1] = nx; }
        const unsigned old = xb_add(&bar[XB_XSUB(b.x)], 1u);
        const unsigned gen = old / nloc;
        if (old + 1u == (gen + 1u) * nloc) {
            __builtin_amdgcn_fence(__ATOMIC_RELEASE, "agent");
            asm volatile("s_waitcnt vmcnt(0)" ::: "memory");
            const unsigned og = xb_add(&bar[XB_TOP], 1u);
            const unsigned tg = og / nx;
            if (og + 1u == (tg + 1u) * nx) xb_add(&bar[XB_TOPGEN], 1u);
            else XB_SPIN(xb_ld(&bar[XB_TOPGEN]) == tg, bar);
            __builtin_amdgcn_fence(__ATOMIC_ACQUIRE, "agent");
            xb_add(&bar[XB_XGEN(b.x)], 1u);
            asm volatile("s_waitcnt vmcnt(0)" ::: "memory");
        } else {
            XB_SPIN(xb_ld(&bar[XB_XGEN(b.x)]) == gen, bar);
            __builtin_amdgcn_fence(__ATOMIC_ACQUIRE, "agent");
            asm volatile("s_waitcnt vmcnt(0)" ::: "memory");
        }
    }
    __syncthreads();
}


#define HD __device__ __forceinline__
struct cpx { float x, y; };
HD cpx cadd(cpx a, cpx b) { return cpx{a.x + b.x, a.y + b.y}; }
HD cpx csub(cpx a, cpx b) { return cpx{a.x - b.x, a.y - b.y}; }
HD cpx cmul(cpx a, cpx b) { return cpx{a.x * b.x - a.y * b.y, a.x * b.y + a.y * b.x}; }
HD cpx cconj(cpx a) { return cpx{a.x, -a.y}; }
HD int fft_pp(int p) { return p + 2 * (p >> 5); }
constexpr int FFT_N = 8192, FFT_BUF_BYTES = (FFT_N + 2 * (FFT_N >> 5)) * 8;

template <bool INV> HD cpx mul_w16(cpx d, int k) {
    const float C1 = 0.92387953251128674f, S1 = 0.38268343236508977f, R2 = 0.70710678118654752f;
    float c, s;
    switch (k & 15) {
        case 0: return d;
        case 4: return INV ? cpx{-d.y, d.x} : cpx{d.y, -d.x};
        case 8: return cpx{-d.x, -d.y};
        case 12: return INV ? cpx{d.y, -d.x} : cpx{-d.y, d.x};
        case 1: c = C1; s = S1; break;
        case 2: c = R2; s = R2; break;
        case 3: c = S1; s = C1; break;
        case 5: c = -S1; s = C1; break;
        case 6: c = -R2; s = R2; break;
        case 7: c = -C1; s = S1; break;
        case 9: c = -C1; s = -S1; break;
        case 10: c = -R2; s = -R2; break;
        case 11: c = -S1; s = -C1; break;
        case 13: c = S1; s = -C1; break;
        case 14: c = R2; s = -R2; break;
        default: c = C1; s = -S1; break;
    }
    if (INV) s = -s;
    return cpx{d.x * c + d.y * s, d.y * c - d.x * s};
}
template <bool INV, int HALF> HD void dft16_stage(cpx (&v)[16]) {
#pragma unroll
    for (int g = 0; g < 16; g += 2 * HALF) {
#pragma unroll
        for (int i = 0; i < HALF; ++i) {
            const cpx a = v[g + i], b = v[g + i + HALF];
            v[g + i] = cadd(a, b);
            v[g + i + HALF] = mul_w16<INV>(csub(a, b), i * (8 / HALF));
        }
    }
}
template <bool INV> HD void dft16(cpx (&v)[16]) {
    dft16_stage<INV, 8>(v); dft16_stage<INV, 4>(v); dft16_stage<INV, 2>(v); dft16_stage<INV, 1>(v);
    cpx t;
    t = v[1]; v[1] = v[8]; v[8] = t;   t = v[2]; v[2] = v[4]; v[4] = t;   t = v[3]; v[3] = v[12]; v[12] = t;
    t = v[5]; v[5] = v[10]; v[10] = t; t = v[7]; v[7] = v[14]; v[14] = t; t = v[11]; v[11] = v[13]; v[13] = t;
}
template <bool INV> HD void twiddle16(cpx (&v)[16], float frac) {
    float s, c;
    asm volatile("" : "+v"(frac));
#if defined(__HIP_DEVICE_COMPILE__)
    sincospif(2.0f * frac, &s, &c);
#else
    s = sinf(6.283185307179586f * frac); c = cosf(6.283185307179586f * frac);
#endif
    const cpx w1 = INV ? cpx{c, s} : cpx{c, -s};
    cpx w = w1;
#pragma unroll
    for (int q = 1; q < 16; ++q) { v[q] = cmul(v[q], w); if (q < 15) w = cmul(w, w1); }
}
HD int fft_k_of_p(int p) { return (p >> 9) + 16 * ((p >> 5) & 15) + 256 * (p & 31); }
HD int fft_p_of_k(int k) { return (k & 15) * 512 + ((k >> 4) & 15) * 32 + (k >> 8); }

typedef float f2v __attribute__((ext_vector_type(2)));
__device__ __forceinline__ cpx ldc(const LAS cpx* b, int i) { const f2v v = ((const LAS f2v*)b)[i]; return cpx{v.x, v.y}; }
__device__ __forceinline__ void stc(LAS cpx* b, int i, cpx v) { ((LAS f2v*)b)[i] = (f2v){v.x, v.y}; }
__device__ __forceinline__ float dpp_xor1(float v) { return __builtin_bit_cast(float, __builtin_amdgcn_update_dpp(0, __builtin_bit_cast(int, v), 0xB1, 0xF, 0xF, true)); }
__device__ __forceinline__ void fft_fwd_pass2(LAS cpx* buf, int t) {
    const int blk = t >> 5, r2 = t & 31; cpx v[16];
#pragma unroll
    for (int j = 0; j < 16; ++j) v[j] = ldc(buf, fft_pp(blk * 512 + j * 32 + r2));
    dft16<false>(v); twiddle16<false>(v, (float)r2 * (1.f / 512.f));
#pragma unroll
    for (int q = 0; q < 16; ++q) stc(buf, fft_pp(blk * 512 + q * 32 + r2), v[q]);
}
__device__ __forceinline__ void fft_fwd_pass3(const LAS cpx* buf, int t, cpx (&v)[16]) {
    const int b = t >> 1, r = t & 1;
#pragma unroll
    for (int j = 0; j < 16; ++j) v[j] = ldc(buf, fft_pp(b * 32 + 2 * j + r));
    dft16<false>(v); twiddle16<false>(v, (float)r * (1.f / 32.f));
#pragma unroll
    for (int q = 0; q < 16; ++q) { const float px = dpp_xor1(v[q].x), py = dpp_xor1(v[q].y);
        v[q] = r ? cpx{px - v[q].x, py - v[q].y} : cpx{v[q].x + px, v[q].y + py}; }
}
__device__ __forceinline__ float bload(__amdgpu_buffer_rsrc_t rs, int voff, int soff) { return __builtin_bit_cast(float, __builtin_amdgcn_raw_buffer_load_b32(rs, voff, soff, 0)); }
__device__ __forceinline__ float conv3_b(__amdgpu_buffer_rsrc_t rs, int voff, int e0, float w0, float w1, float w2, float bias, bool lo_ok, bool hi_ok) {
    const float xm = (e0 > 0) ? bload(rs, voff, e0 * 4 - 4) : bload(rs, voff - 4, 0);
    const float xc = bload(rs, voff, e0 * 4), xp = bload(rs, voff + 4, e0 * 4);
    return bias + w1 * xc + (lo_ok ? w0 * xm : 0.f) + (hi_ok ? w2 * xp : 0.f);
}
__device__ __forceinline__ void hyena_phase(LAS unsigned char* lds, const float* PT, const float* KC, const float* cw, const float* cb, const float* skip, float* YHT, int G, int vcu) {
    LAS cpx* Wb = (LAS cpx*)lds;
    LAS cpx* Lb = (LAS cpx*)(lds + FFT_BUF_BYTES);
    const int t0 = threadIdx.x;
#define HY_T() int t = t0; asm volatile("" : "+v"(t))
    for (int pair = vcu; pair < 512; pair += G) {
        const int c0 = 2 * pair;
        {
            HY_T();
            const __amdgpu_buffer_rsrc_t rsk = __builtin_amdgcn_make_buffer_rsrc((void*)(KC + (size_t)c0 * 8192), 0, 65536, 0x00020000);
            cpx v[16];
#pragma unroll
            for (int j = 0; j < 16; ++j) v[j] = cpx{bload(rsk, t * 4, j * 2048), bload(rsk, t * 4, 32768 + j * 2048)};
            dft16<false>(v); twiddle16<false>(v, (float)t * (1.f / 8192.f));
#pragma unroll
            for (int q = 0; q < 16; ++q) stc(Wb, fft_pp(q * 512 + t), v[q]);
        }
        __syncthreads();
        { HY_T(); fft_fwd_pass2(Wb, t); }
        __syncthreads();
        { HY_T(); cpx v[16]; fft_fwd_pass3(Wb, t, v); __syncthreads();
          const int b = t >> 1, r = t & 1;
#pragma unroll
          for (int q = 0; q < 16; ++q) stc(Wb, fft_pp(b * 32 + 16 * r + q), v[q]); }
        __syncthreads();
#pragma unroll 1
        for (int ch = 0; ch < 2; ++ch) {
            const int c = c0 + ch;
            float vg[2][8];
            {
                HY_T();
                const __amdgpu_buffer_rsrc_t rs1 = __builtin_amdgcn_make_buffer_rsrc((void*)(PT + (size_t)(1024 + c) * T), 0, T * 4, 0x00020000);
                const __amdgpu_buffer_rsrc_t rs2 = __builtin_amdgcn_make_buffer_rsrc((void*)(PT + (size_t)(2048 + c) * T), 0, T * 4, 0x00020000);
                const float a0 = cw[1024 + c], a1 = cw[3072 + 1024 + c], a2 = cw[6144 + 1024 + c], ab = cb[1024 + c];
                const float v0 = cw[2048 + c], v1 = cw[3072 + 2048 + c], v2 = cw[6144 + 2048 + c], vb = cb[2048 + c];
#pragma unroll
                for (int b = 0; b < 2; ++b)
#pragma unroll
                    for (int j = 0; j < 8; ++j) { const bool lo = (j > 0) || (t > 0), hi = (j < 7) || (t < 511);
                        int vo = t * 4;
                        if (j == 0) asm volatile("" : "+v"(vo));
                        vg[b][j] = conv3_b(rs2, vo, b * LSEQ + j * 512, v0, v1, v2, vb, lo, hi) * conv3_b(rs1, vo, b * LSEQ + j * 512, a0, a1, a2, ab, lo, hi);
                        if (j == 7) asm volatile("" : "+v"(vg[b][0]), "+v"(vg[b][1]), "+v"(vg[b][2]), "+v"(vg[b][3]), "+v"(vg[b][4]), "+v"(vg[b][5]), "+v"(vg[b][6]), "+v"(vg[b][7])); }
                cpx v[16];
#pragma unroll
                for (int j = 0; j < 8; ++j) { v[j] = cpx{vg[0][j], vg[1][j]}; v[8 + j] = cpx{0.f, 0.f}; }
                dft16<false>(v); twiddle16<false>(v, (float)t * (1.f / 8192.f));
#pragma unroll
                for (int q = 0; q < 16; ++q) stc(Lb, fft_pp(q * 512 + t), v[q]);
            }
            __syncthreads();
            { HY_T(); fft_fwd_pass2(Lb, t); }
            __syncthreads();
            {
                HY_T();
                cpx v[16]; fft_fwd_pass3(Lb, t, v);
                const int b = t >> 1, r = t & 1;
                const float sc = 0.5f / 8192.f;
#pragma unroll
                for (int q = 0; q < 16; ++q) {
                    const int p = b * 32 + 16 * r + q, k = fft_k_of_p(p), km = (8192 - k) & 8191, pm = fft_p_of_k(km);
                    const cpx Wk = ldc(Wb, fft_pp(p)), Wm = ldc(Wb, fft_pp(pm));
                    cpx H;
                    if (ch == 0) H = cpx{(Wk.x + Wm.x) * sc, (Wk.y - Wm.y) * sc};
                    else H = cpx{(Wk.y + Wm.y) * sc, (Wm.x - Wk.x) * sc};
                    v[q] = cmul(v[q], H);
                    if ((q & 3) == 3) asm volatile("" ::: "memory");
                }
#pragma unroll
                for (int q = 0; q < 16; ++q) { const float px = dpp_xor1(v[q].x), py = dpp_xor1(v[q].y);
                    v[q] = r ? cpx{px - v[q].x, py - v[q].y} : cpx{v[q].x + px, v[q].y + py}; }
                twiddle16<true>(v, (float)r * (1.f / 32.f)); dft16<true>(v);
                __syncthreads();
#pragma unroll
                for (int j = 0; j < 16; ++j) stc(Lb, fft_pp(b * 32 + 2 * j + r), v[j]);
            }
            __syncthreads();
            {
                HY_T();
                const int blk = t >> 5, r2 = t & 31; cpx v[16];
#pragma unroll
                for (int q = 0; q < 16; ++q) v[q] = ldc(Lb, fft_pp(blk * 512 + q * 32 + r2));
                twiddle16<true>(v, (float)r2 * (1.f / 512.f)); dft16<true>(v);
                __syncthreads();
#pragma unroll
                for (int j = 0; j < 16; ++j) stc(Lb, fft_pp(blk * 512 + j * 32 + r2), v[j]);
            }
            __syncthreads();
            {
                HY_T();
                cpx v[16];
#pragma unroll
                for (int q = 0; q < 16; ++q) v[q] = ldc(Lb, fft_pp(q * 512 + t));
                twiddle16<true>(v, (float)t * (1.f / 8192.f)); dft16<true>(v);
                const __amdgpu_buffer_rsrc_t rs0 = __builtin_amdgcn_make_buffer_rsrc((void*)(PT + (size_t)c * T), 0, T * 4, 0x00020000);
                const __amdgpu_buffer_rsrc_t rsy = __builtin_amdgcn_make_buffer_rsrc((void*)(YHT + (size_t)c * T), 0, T * 4, 0x00020000);
                const float x0 = cw[c], x1 = cw[3072 + c], x2 = cw[6144 + c], xb = cb[c], sk = skip[c];
#pragma unroll
                for (int j = 0; j < 8; ++j) { const bool lo = (j > 0) || (t > 0), hi = (j < 7) || (t < 511);
                    int vo = t * 4;
                    if ((j & 3) == 0) asm volatile("" : "+v"(vo));
                    float o0 = (v[j].x + vg[0][j] * sk) * conv3_b(rs0, vo, j * 512, x0, x1, x2, xb, lo, hi);
                    float o1 = (v[j].y + vg[1][j] * sk) * conv3_b(rs0, vo, LSEQ + j * 512, x0, x1, x2, xb, lo, hi);
                    if ((j & 3) == 3) asm volatile("" : "+v"(o0), "+v"(o1));
                    __builtin_amdgcn_raw_buffer_store_b32(__builtin_bit_cast(unsigned, o0), rsy, t * 4, j * 2048, 0);
                    __builtin_amdgcn_raw_buffer_store_b32(__builtin_bit_cast(unsigned, o1), rsy, t * 4, (LSEQ + j * 512) * 4, 0); }
            }
            __syncthreads();
        }
    }
}
#undef HY_T
__device__ __forceinline__ void hyena_filter_item(LAS unsigned char* lds, int item, const float* w1, const float* b1, const float* w2, const float* b2, const float* w3, const float* b3,
                                                  const float* w4, const float* freq, float* KC, int tid, int lane, int wave) {
    typedef pg8::f32x4 f32x4;
    LAS float* H3 = (LAS float*)lds;
    LAS float* sc0 = (LAS float*)(lds + 4096) + wave * 256;
    const int l0 = item * 16;
    int lane_w = lane; asm volatile("" : "+v"(lane_w));
    float w1r[33], w2r[64], w3r[64];
#pragma unroll
    for (int i = 0; i < 33; ++i) w1r[i] = w1[i * 64 + lane_w];
#pragma unroll
    for (int i = 0; i < 64; ++i) w2r[i] = w2[i * 64 + lane_w];
    const float fr = freq[lane], bb1 = b1[lane], bb2 = b2[lane], bb3 = b3[lane];
    __syncthreads();
#pragma unroll
    for (int pp = 0; pp < 2; ++pp) {
        const int l = l0 + wave * 2 + pp; LAS float* sc = sc0 + 128 * pp;
        if (lane == 0) sc[0] = (float)l / (float)(LSEQ - 1);
        if (lane < 16) { const float omega = (2.0f * 3.14159265358979323846f / (float)LSEQ) * (float)l; const float fb = 1e-4f + (float)lane * ((15.0f - 1e-4f) / 15.0f); const float ang = omega * fb;
            sc[1 + lane] = cosf(ang); sc[17 + lane] = -sinf(ang); }
    }
    asm volatile("s_waitcnt lgkmcnt(0)" ::: "memory");
    float s[2], h[2];
#pragma unroll
    for (int pp = 0; pp < 2; ++pp) { const LAS float* sc = sc0 + 128 * pp; s[pp] = bb1;
#pragma unroll
        for (int i4 = 0; i4 < 8; ++i4) { const f32x4 z = *(const LAS f32x4*)(sc + 4 * i4); s[pp] += z.x * w1r[4 * i4] + z.y * w1r[4 * i4 + 1] + z.z * w1r[4 * i4 + 2] + z.w * w1r[4 * i4 + 3]; }
        s[pp] += sc[32] * w1r[32]; h[pp] = sinf(fr * s[pp]); }
    asm volatile("s_waitcnt lgkmcnt(0)" ::: "memory");
#pragma unroll
    for (int i = 0; i < 64; ++i) w3r[i] = w3[i * 64 + lane_w];
#pragma unroll
    for (int pp = 0; pp < 2; ++pp) sc0[128 * pp + 64 + lane] = h[pp];
    asm volatile("s_waitcnt lgkmcnt(0)" ::: "memory");
#pragma unroll
    for (int pp = 0; pp < 2; ++pp) { const LAS float* sc = sc0 + 128 * pp + 64; s[pp] = bb2;
#pragma unroll
        for (int i4 = 0; i4 < 16; ++i4) { const f32x4 z = *(const LAS f32x4*)(sc + 4 * i4); s[pp] += z.x * w2r[4 * i4] + z.y * w2r[4 * i4 + 1] + z.z * w2r[4 * i4 + 2] + z.w * w2r[4 * i4 + 3]; }
        h[pp] = sinf(fr * s[pp]); }
    asm volatile("s_waitcnt lgkmcnt(0)" ::: "memory");
#pragma unroll
    for (int pp = 0; pp < 2; ++pp) sc0[128 * pp + lane] = h[pp];
    asm volatile("s_waitcnt lgkmcnt(0)" ::: "memory");
#pragma unroll
    for (int pp = 0; pp < 2; ++pp) { const LAS float* sc = sc0 + 128 * pp; s[pp] = bb3;
#pragma unroll
        for (int i4 = 0; i4 < 16; ++i4) { const f32x4 z = *(const LAS f32x4*)(sc + 4 * i4); s[pp] += z.x * w3r[4 * i4] + z.y * w3r[4 * i4 + 1] + z.z * w3r[4 * i4 + 2] + z.w * w3r[4 * i4 + 3]; }
        H3[lane * 16 + wave * 2 + pp] = sinf(fr * s[pp]); }
    asm volatile("s_waitcnt lgkmcnt(0)" ::: "memory");
    __syncthreads();
    const float max_decay = logf(1e-2f) / 0.3f, min_decay = logf(1e-2f) / 1.5f;
    float acc[4][16];
#pragma unroll
    for (int a = 0; a < 4; ++a)
#pragma unroll
        for (int l = 0; l < 16; ++l) acc[a][l] = 0.f;
    int tid_o = tid; asm volatile("" : "+v"(tid_o));
    const float* w4t = w4 + tid_o;
#define HF_LOAD(wr_, b_) do { _Pragma("unroll") for (int i = 0; i < 4; ++i) { const float* p_ = w4t + ((b_) * 4 + i) * 2048; \
        wr_[4 * i] = p_[0]; wr_[4 * i + 1] = p_[1024]; wr_[4 * i + 2] = p_[512]; wr_[4 * i + 3] = p_[1536]; } } while (0)
#define HF_COMP(wr_, b_) do { _Pragma("unroll") for (int i = 0; i < 4; ++i) { _Pragma("unroll") for (int l4 = 0; l4 < 4; ++l4) { \
        const pg8::f32x4 hv = *(const LAS pg8::f32x4*)(H3 + ((b_) * 4 + i) * 16 + 4 * l4); \
        _Pragma("unroll") for (int q = 0; q < 4; ++q) { _Pragma("unroll") for (int a = 0; a < 4; ++a) acc[a][4 * l4 + q] = fmaf(hv[q], wr_[4 * i + a], acc[a][4 * l4 + q]); } } } } while (0)
    float wa[16], wb[16];
    HF_LOAD(wa, 0);
#pragma unroll 1
    for (int b = 0; b < 16; b += 2) {
        HF_LOAD(wb, b + 1);
        HF_COMP(wa, b);
        { const int bn = b + 2 < 16 ? b + 2 : 15; HF_LOAD(wa, bn); }
        HF_COMP(wb, b + 1);
    }
#undef HF_LOAD
#undef HF_COMP
#pragma unroll
    for (int cc = 0; cc < 2; ++cc) {
        const int c = tid_o + 512 * cc;
        const float delta = fabsf(min_decay + (float)c * ((max_decay - min_decay) / (float)(DHY - 1)));
        float* kc = KC + (size_t)c * 8192;
#pragma unroll
        for (int l = 0; l < 16; ++l) {
            const int ll = l0 + l; const float win = expf(-((float)ll / (float)(LSEQ - 1)) * delta);
            const float f = acc[2 * cc][l] * win, bb = acc[2 * cc + 1][l] * win;
            if (ll == 0) { kc[0] = f + bb; kc[4096] = 0.f; } else { kc[ll] = f; kc[8192 - ll] = bb; }
        }
    }
    __syncthreads();
}
__device__ __forceinline__ void hyena_post_tile(LAS unsigned char* lds, int tile, const float* YHT, const float* nw, bf16* A2, int tid, int lane, int wave) {
    LAS float* tl = (LAS float*)lds;
    const int tok0 = tile * 32, tk = tid & 31, cg = tid >> 5;
    for (int i = 0; i < 64; ++i) { const int c = cg + 16 * i; tl[c * 33 + tk] = YHT[(size_t)c * T + tok0 + tk]; }
    __syncthreads();
    for (int q = 0; q < 4; ++q) {
        const int tq = wave * 4 + q; float v[16]; float ss = 0.f;
#pragma unroll
        for (int i = 0; i < 16; ++i) { v[i] = tl[(lane + 64 * i) * 33 + tq]; ss += v[i] * v[i]; }
        const float r = rsqrtf(wave_sum(ss) * (1.f / DHY) + EPS);
#pragma unroll
        for (int i = 0; i < 16; ++i) { const int c = lane + 64 * i; A2[(size_t)(tok0 + tq) * DM + c] = (bf16)f2bf(v[i] * r * nw[c]); }
    }
    __syncthreads();
}


constexpr int GP_TILE = 128 * 132;
constexpr int GP_GATES = 143104;
constexpr int GP_WREG2 = 8448 + 512;
constexpr int GP_TT = 64 * 68 * 4;
__device__ __forceinline__ int aoff_fn(int i) { const int q = i >> 2, r = i & 3; return 4 * (2 * q * q + q + (r >= 1 ? q : 0) + (r >= 2 ? q + 1 : 0) + (r >= 3 ? q + 1 : 0)); }
static_assert(8 * GP_TILE <= GP_GATES && 8 * GP_WREG2 + 4 * GP_TT <= GP_GATES && GP_GATES + 4096 <= LDSCTL_OFF_C, "gdn prep LDS");
__device__ __forceinline__ void gdn_pre(LAS unsigned char* lds, int wg, const bf16* PG, const float* PGATE, const float* cw, const float* alf, const float* alb, const float* dtf, const float* dtb,
                                        unsigned char* ws, int tid, int lane, int wave) {
    const int bh = wg >> 4, b = bh >> 3, h = bh & 7, l0 = 256 * (wg & 15), cid0 = bh * 64 + 4 * (wg & 15);
    LAS float* gates = (LAS float*)(lds + GP_GATES);
    float w[3][3][2];
#pragma unroll
    for (int x = 0; x < 3; ++x)
#pragma unroll
        for (int tp = 0; tp < 3; ++tp)
#pragma unroll
            for (int e = 0; e < 2; ++e) w[x][tp][e] = cw[tp * 3072 + x * 1024 + h * 128 + 2 * lane + e];
    const int lw = l0 + 32 * wave;
    const unsigned* pgw = (const unsigned*)PG;
    auto ldraw = [&](int l, int x) -> unsigned { return (l >= 0 && l < LSEQ) ? pgw[((size_t)(b * LSEQ + l) * 4096 + x * 1024 + h * 128) / 2 + lane] : 0u; };
    if (lane < 32) {
        const int l = lw + lane, li = 32 * wave + lane; const float* pr = PGATE + (size_t)(b * LSEQ + l) * 32;
        gates[0 * 256 + li] = -expf(alf[h]) * softplus_f(pr[16 + h] + dtf[h]);
        gates[1 * 256 + li] = -expf(alb[h]) * softplus_f(pr[24 + h] + dtb[h]);
        gates[2 * 256 + li] = sigmoid_f(pr[h]);
        gates[3 * 256 + li] = sigmoid_f(pr[8 + h]);
    }
#pragma unroll 1
    for (int bt8 = 0; bt8 < 4; ++bt8) {
        unsigned raw[3][10];
#pragma unroll
        for (int x = 0; x < 3; ++x)
#pragma unroll
            for (int k = 0; k < 10; ++k) raw[x][k] = ldraw(lw + 8 * bt8 - 1 + k, x);
#pragma unroll
        for (int k = 0; k < 8; ++k) {
            const int tt = 8 * bt8 + k, li = 32 * wave + tt, cl = li >> 6, i = li & 63;
            float r[3][2];
#pragma unroll
            for (int x = 0; x < 3; ++x) {
                const unsigned pv = raw[x][k], cv = raw[x][k + 1], nv = raw[x][k + 2];
                const float p0 = __builtin_bit_cast(float, pv << 16), p1 = __builtin_bit_cast(float, pv & 0xffff0000u);
                const float c0 = __builtin_bit_cast(float, cv << 16), c1 = __builtin_bit_cast(float, cv & 0xffff0000u);
                const float n0 = __builtin_bit_cast(float, nv << 16), n1 = __builtin_bit_cast(float, nv & 0xffff0000u);
                r[x][0] = silu_f(w[x][0][0] * p0 + w[x][1][0] * c0 + w[x][2][0] * n0);
                r[x][1] = silu_f(w[x][0][1] * p1 + w[x][1][1] * c1 + w[x][2][1] * n1);
            }
            const float qs = rsqrtf(wave_sum(r[0][0] * r[0][0] + r[0][1] * r[0][1]) + EPS);
            const float ks = rsqrtf(wave_sum(r[1][0] * r[1][0] + r[1][1] * r[1][1]) + EPS);
            const unsigned qp = pk2(r[0][0] * qs, r[0][1] * qs), kp = pk2(r[1][0] * ks, r[1][1] * ks), vp = pk2(r[2][0], r[2][1]);
            const size_t rowoff = ((size_t)(cid0 + cl) * 64 + i) * 64 + lane;
            ((unsigned*)(ws + WS_QN))[rowoff] = qp; ((unsigned*)(ws + WS_KN))[rowoff] = kp;
            LAS bf16* kt = (LAS bf16*)(lds + (cl * 2 + 0) * GP_TILE); LAS bf16* vt = (LAS bf16*)(lds + (cl * 2 + 1) * GP_TILE);
            kt[(2 * lane) * 66 + i] = (bf16)(kp & 0xffffu); kt[(2 * lane + 1) * 66 + i] = (bf16)(kp >> 16);
            vt[(2 * lane) * 66 + i] = (bf16)(vp & 0xffffu); vt[(2 * lane + 1) * 66 + i] = (bf16)(vp >> 16);
        }
    }
    __syncthreads();
    for (int it = wave; it < 8 * 64; it += 8) {
        const int tile = it >> 6, rp = it & 63, row = 2 * rp + (lane >> 5), cl = tile >> 1, which = tile & 1;
        const unsigned v = *(const LAS unsigned*)(lds + tile * GP_TILE + row * 132 + (lane & 31) * 4);
        ((unsigned*)(ws + (which ? WS_VT : WS_KT)))[((size_t)(cid0 + cl) * 128 + row) * 32 + (lane & 31)] = v;
    }
    asm volatile("s_waitcnt vmcnt(0)" ::: "memory");
    __syncthreads();
}
__device__ __forceinline__ void gdn_prep_wave(LAS unsigned char* lds, int wg, unsigned char* ws, int lane, int wave) {
    typedef pg8::bf16x8 bf16x8; typedef pg8::f32x4 f32x4;
    const int cl = wave >> 1, dir = wave & 1, bh = wg >> 4, cid = bh * 64 + 4 * (wg & 15) + cl; const size_t ci = (size_t)cid * 2 + dir;
    const int fr = lane & 15, fq = lane >> 4;
    LAS unsigned char* R = lds + wave * GP_WREG2;
    LAS float* Tt = (LAS float*)(lds + 8 * GP_WREG2 + (wave & 3) * GP_TT);
    LAS float* Ap = (LAS float*)R;
    LAS float* gcA = (LAS float*)(R + 8448); LAS float* btA = gcA + 64;
    const LAS float* gates = (const LAS float*)(lds + GP_GATES);
    const bf16* QN = (const bf16*)(ws + WS_QN) + (size_t)cid * 64 * 128; const bf16* KN = (const bf16*)(ws + WS_KN) + (size_t)cid * 64 * 128;
    const bf16* KT = (const bf16*)(ws + WS_KT) + (size_t)cid * 128 * 64; const bf16* VT = (const bf16*)(ws + WS_VT) + (size_t)cid * 128 * 64;
    unsigned char* GW = ws + WS_GW + ci * GW_B; unsigned char* GQD = ws + WS_GQD + ci * GW_B; unsigned char* GKDT = ws + WS_GKDT + ci * GKDT_B;
    unsigned char* GQK = ws + WS_GQK + ci * GQK_B; unsigned char* GUT = ws + WS_GUT + ci * GUT_B;
#define RIDX(i) (dir ? 63 - (i) : (i))
    const float bt = gates[(2 + dir) * 256 + 64 * cl + RIDX(lane)];
    float gc = gates[dir * 256 + 64 * cl + RIDX(lane)];
#pragma unroll
    for (int o = 1; o < 64; o <<= 1) { const float t = __shfl_up(gc, o); if (lane >= o) gc += t; }
    const float gl = __shfl(gc, 63);
    gcA[lane] = gc; btA[lane] = bt;
    asm volatile("s_waitcnt lgkmcnt(0)" ::: "memory");
    if (lane == 0) ((float*)(ws + WS_GCD))[ci] = expf(gl);
    {
    bf16x8 kfr[4][4];
#pragma unroll
    for (int t4 = 0; t4 < 4; ++t4)
#pragma unroll
        for (int ks = 0; ks < 4; ++ks) kfr[t4][ks] = *(const bf16x8*)(KN + (size_t)RIDX(16 * t4 + fr) * 128 + 32 * ks + 8 * fq);
    __builtin_amdgcn_sched_barrier(0);
#pragma unroll
    for (int mt = 0; mt < 4; ++mt) {
        const f32x4 gi = *(const LAS f32x4*)(gcA + 16 * mt + 4 * fq), bi = *(const LAS f32x4*)(btA + 16 * mt + 4 * fq);
#pragma unroll
        for (int nt = 0; nt <= mt; ++nt) {
            f32x4 c = (f32x4){0.f, 0.f, 0.f, 0.f};
#pragma unroll
            for (int ks = 0; ks < 4; ++ks) c = __builtin_amdgcn_mfma_f32_16x16x32_bf16(kfr[mt][ks], kfr[nt][ks], c, 0, 0, 0);
            const int j = 16 * nt + fr; const float gj = gcA[j];
#pragma unroll
            for (int r = 0; r < 4; ++r) { const int i = 16 * mt + 4 * fq + r; if (j < ((i + 3) & ~3)) Ap[aoff_fn(i) + j] = (j < i) ? bi[r] * c[r] * __expf(gi[r] - gj) : 0.f; }
        }
    }
#pragma unroll 1
    for (int ih = 0; ih < 2; ++ih) {
        bf16x8 qfr[2][4];
#pragma unroll
        for (int t2 = 0; t2 < 2; ++t2)
#pragma unroll
            for (int ks = 0; ks < 4; ++ks) qfr[t2][ks] = *(const bf16x8*)(QN + (size_t)RIDX(16 * (2 * ih + t2) + fr) * 128 + 32 * ks + 8 * fq);
        __builtin_amdgcn_sched_barrier(0);
#pragma unroll
        for (int i2 = 0; i2 < 2; ++i2) {
            const int it = 2 * ih + i2;
            const int i = 16 * it + fr; const float gi = gcA[i];
#pragma unroll
            for (int jt = 0; jt < 4; ++jt) {
                f32x4 c = (f32x4){0.f, 0.f, 0.f, 0.f};
                if (jt <= it) {
#pragma unroll
                    for (int ks = 0; ks < 4; ++ks) c = __builtin_amdgcn_mfma_f32_16x16x32_bf16(kfr[jt][ks], qfr[i2][ks], c, 0, 0, 0);
                }
                const f32x4 gj = *(const LAS f32x4*)(gcA + 16 * jt + 4 * fq);
                float v[4];
#pragma unroll
                for (int r = 0; r < 4; ++r) { const int j = 16 * jt + 4 * fq + r; v[r] = (j <= i) ? c[r] * __expf(gi - gj[r]) * 0.08838834764831845f : 0.f; }
                *(unsigned long long*)(GQK + i * 144 + (32 * (jt >> 1) + 8 * fq + 4 * (jt & 1)) * 2) = (unsigned long long)pg8::cvt_pk_bf16(v[0], v[1]) | ((unsigned long long)pg8::cvt_pk_bf16(v[2], v[3]) << 32);
            }
        }
    }
    }
    {
    {
        const int L2 = lane & 31, m = 4 * L2, src = (m & ~31) + ((m & 4) ? 16 + 4 * ((m & 31) >> 3) : 4 * ((m & 31) >> 3));
#pragma unroll 8
        for (int rp = 0; rp < 32; ++rp) {
            const int i = 2 * rp + (lane >> 5);
            const unsigned long long q = *(const unsigned long long*)(QN + (size_t)RIDX(i) * 128 + src);
            const float sc = __expf(gcA[i]) * 0.08838834764831845f;
            const unsigned lo = (unsigned)q, hi = (unsigned)(q >> 32);
            const float a0 = __builtin_bit_cast(float, lo << 16) * sc, a1 = __builtin_bit_cast(float, lo & 0xffff0000u) * sc, a2 = __builtin_bit_cast(float, hi << 16) * sc, a3 = __builtin_bit_cast(float, hi & 0xffff0000u) * sc;
            *(unsigned long long*)(GQD + i * 272 + m * 2) = (unsigned long long)pg8::cvt_pk_bf16(a0, a1) | ((unsigned long long)pg8::cvt_pk_bf16(a2, a3) << 32);
        }
        const int L4 = lane & 15, mm = 4 * L4, isrc = (mm & ~31) + ((mm & 4) ? 16 + 4 * ((mm & 31) >> 3) : 4 * ((mm & 31) >> 3));
        const f32x4 gi4 = *(const LAS f32x4*)(gcA + isrc);
        float sc4[4];
#pragma unroll
        for (int r = 0; r < 4; ++r) sc4[r] = __expf(gl - gi4[r]);
#pragma unroll 8
        for (int rq = 0; rq < 32; ++rq) {
            const int dk = 4 * rq + (lane >> 4);
            const unsigned long long k = *(const unsigned long long*)(KT + (size_t)dk * 64 + (dir ? 60 - isrc : isrc));
            const unsigned lo = (unsigned)k, hi = (unsigned)(k >> 32);
            float e0 = __builtin_bit_cast(float, lo << 16), e1 = __builtin_bit_cast(float, lo & 0xffff0000u), e2 = __builtin_bit_cast(float, hi << 16), e3 = __builtin_bit_cast(float, hi & 0xffff0000u);
            const float f0 = dir ? e3 : e0, f1 = dir ? e2 : e1, f2 = dir ? e1 : e2, f3 = dir ? e0 : e3;
            *(unsigned long long*)(GKDT + dk * 144 + mm * 2) = (unsigned long long)pg8::cvt_pk_bf16(f0 * sc4[0], f1 * sc4[1]) | ((unsigned long long)pg8::cvt_pk_bf16(f2 * sc4[2], f3 * sc4[3]) << 32);
        }
    }
    asm volatile("s_waitcnt lgkmcnt(0)" ::: "memory");
    }
    asm volatile("s_waitcnt lgkmcnt(0)" ::: "memory");
    __syncthreads();
    const float s_u = bt, s_w = bt * __expf(gc);
    const int cn = RIDX(lane);
#pragma unroll 1
    for (int round = 0; round < 2; ++round) {
        if ((wave >> 2) == round) {
            LAS float* trow = Tt + lane * 68;
#pragma unroll
            for (int q = 0; q < 16; ++q) *(LAS f32x4*)(trow + 4 * q) = (f32x4){(4 * q == lane) ? 1.f : 0.f, (4 * q + 1 == lane) ? 1.f : 0.f, (4 * q + 2 == lane) ? 1.f : 0.f, (4 * q + 3 == lane) ? 1.f : 0.f};
            asm volatile("s_waitcnt lgkmcnt(0)" ::: "memory");
            int ao = 0;
            for (int i = 1; i < 64; ++i) {
                const LAS float* ar = Ap + ao;
                f32x4 acc4 = (f32x4){0.f, 0.f, 0.f, 0.f};
                const int n4 = (i + 3) >> 2;
                for (int q = 0; q < n4; ++q) { const f32x4 a4 = *(const LAS f32x4*)(ar + 4 * q), t4 = *(const LAS f32x4*)(trow + 4 * q); acc4 += a4 * t4; }
                const float sv = (acc4[0] + acc4[1]) + (acc4[2] + acc4[3]);
                if (lane < i) trow[i] = -sv;
                asm volatile("s_waitcnt lgkmcnt(0)" ::: "memory");
                ao += 4 * n4;
            }
#define GP_WRITE_T(scale) do { LAS bf16* Tq = (LAS bf16*)R; \
                for (int j0 = 0; j0 < 64; j0 += 8) { const f32x4 ta = *(const LAS f32x4*)(trow + j0), tb = *(const LAS f32x4*)(trow + j0 + 4); \
                    _Pragma("unroll") for (int e = 0; e < 4; ++e) { Tq[(j0 + e) * 64 + cn] = (bf16)f2bf(ta[e] * (scale)); Tq[(j0 + 4 + e) * 64 + cn] = (bf16)f2bf(tb[e] * (scale)); } } \
                asm volatile("s_waitcnt lgkmcnt(0)" ::: "memory"); } while (0)
            GP_WRITE_T(s_w);
#pragma unroll 1
            for (int dh = 0; dh < 2; ++dh) {
                bf16x8 ktf[4][2];
#pragma unroll
                for (int d4 = 0; d4 < 4; ++d4)
#pragma unroll
                    for (int ks = 0; ks < 2; ++ks) ktf[d4][ks] = *(const bf16x8*)(KT + (size_t)(16 * (4 * dh + d4) + fr) * 64 + 32 * ks + 8 * fq);
                __builtin_amdgcn_sched_barrier(0);
#pragma unroll 1
                for (int it = 0; it < 4; ++it) {
                    bf16x8 tf[2];
#pragma unroll
                    for (int ks = 0; ks < 2; ++ks) tf[ks] = *(const LAS bf16x8*)(R + ((16 * it + fr) * 64 + 32 * ks + 8 * fq) * 2);
                    const int i = 16 * it + fr;
#pragma unroll
                    for (int d4 = 0; d4 < 4; ++d4) {
                        const int dt = 4 * dh + d4;
                        f32x4 c = (f32x4){0.f, 0.f, 0.f, 0.f};
#pragma unroll
                        for (int ks = 0; ks < 2; ++ks) c = __builtin_amdgcn_mfma_f32_16x16x32_bf16(ktf[d4][ks], tf[ks], c, 0, 0, 0);
                        *(unsigned long long*)(GW + i * 272 + (32 * (dt >> 1) + 8 * fq + 4 * (dt & 1)) * 2) = (unsigned long long)pg8::cvt_pk_bf16(c[0], c[1]) | ((unsigned long long)pg8::cvt_pk_bf16(c[2], c[3]) << 32);
                    }
                }
            }
            asm volatile("s_waitcnt lgkmcnt(0)" ::: "memory");
            GP_WRITE_T(s_u);
#pragma unroll 1
            for (int vh = 0; vh < 2; ++vh) {
                bf16x8 vtf[4][2];
#pragma unroll
                for (int v4 = 0; v4 < 4; ++v4)
#pragma unroll
                    for (int ks = 0; ks < 2; ++ks) vtf[v4][ks] = *(const bf16x8*)(VT + (size_t)(16 * (4 * vh + v4) + fr) * 64 + 32 * ks + 8 * fq);
                __builtin_amdgcn_sched_barrier(0);
#pragma unroll 1
                for (int it = 0; it < 4; ++it) {
                    bf16x8 tf[2];
#pragma unroll
                    for (int ks = 0; ks < 2; ++ks) tf[ks] = *(const LAS bf16x8*)(R + ((16 * it + fr) * 64 + 32 * ks + 8 * fq) * 2);
#pragma unroll
                    for (int v4 = 0; v4 < 4; ++v4) {
                        const int vt = 4 * vh + v4;
                        f32x4 c = (f32x4){0.f, 0.f, 0.f, 0.f};
#pragma unroll
                        for (int ks = 0; ks < 2; ++ks) c = __builtin_amdgcn_mfma_f32_16x16x32_bf16(tf[ks], vtf[v4][ks], c, 0, 0, 0);
                        *(unsigned long long*)(GUT + (16 * vt + fr) * 128 + (16 * it + 4 * fq) * 2) = (unsigned long long)pg8::cvt_pk_bf16(c[0], c[1]) | ((unsigned long long)pg8::cvt_pk_bf16(c[2], c[3]) << 32);
                    }
                }
            }
#undef GP_WRITE_T
        }
        __syncthreads();
    }
#undef RIDX
}

__host__ __device__ __forceinline__ int mperm32(int o) { return ((o & 15) >> 2) * 8 + (o >> 4) * 4 + (o & 3); }
__host__ __device__ __forceinline__ int mcol(int x) { return (x & ~31) + mperm32(x & 31); }
constexpr int SC_W = 0, SC_QD = 17408, SC_KDT = 34816, SC_QK = 53248, SC_UT = 62464, SC_STEP = 64512;
static_assert(2 * SC_STEP <= LDSCTL_OFF_C, "scan LDS");
__device__ __forceinline__ void gdn_scan(LAS unsigned char* lds, const unsigned char* ws, bf16* OF, bf16* OB, int vcu, int tid, int lane, int wave) {
    typedef pg8::bf16x8 bf16x8; typedef pg8::f32x4 f32x4;
    const int chain = vcu >> 3, slice = vcu & 7, dir = chain & 1, bh = chain >> 1, b = bh >> 3, h = bh & 7;
    const int fr = lane & 15, fq = lane >> 4;
    const int dv0 = slice * 16;
    bf16* O = dir ? OB : OF;
    auto issue = [&](int s, int buf) {
        const int n = dir ? 63 - s : s; const size_t ci = ((size_t)(bh * 64 + n) * 2 + dir);
#pragma unroll
        for (int k = 0; k < 8; ++k) {
            const int p = wave + 8 * k;
            if (p < 63) {
                const unsigned char* g; int l;
                if (p < 17) { g = ws + WS_GW + ci * GW_B + p * 1024; l = SC_W + p * 1024; }
                else if (p < 34) { g = ws + WS_GQD + ci * GW_B + (p - 17) * 1024; l = SC_QD + (p - 17) * 1024; }
                else if (p < 52) { g = ws + WS_GKDT + ci * GKDT_B + (p - 34) * 1024; l = SC_KDT + (p - 34) * 1024; }
                else if (p < 61) { g = ws + WS_GQK + ci * GQK_B + (p - 52) * 1024; l = SC_QK + (p - 52) * 1024; }
                else { g = ws + WS_GUT + ci * GUT_B + slice * 2048 + (p - 61) * 1024; l = SC_UT + (p - 61) * 1024; }
                __builtin_amdgcn_global_load_lds((const unsigned*)(g + lane * 16), (LAS unsigned*)(lds + buf * SC_STEP + l), 16, 0, 0);
            }
        }
    };
    f32x4 S[8];
#pragma unroll
    for (int i = 0; i < 8; ++i) S[i] = (f32x4){0.f, 0.f, 0.f, 0.f};
    LAS float* cdl = (LAS float*)(lds + 2 * SC_STEP);
    if (wave == 0) { const int n = dir ? 63 - lane : lane; cdl[lane] = __builtin_bit_cast(float, __hip_atomic_load((const unsigned*)(ws + WS_GCD) + ((size_t)(bh * 64 + n) * 2 + dir), __ATOMIC_RELAXED, __HIP_MEMORY_SCOPE_AGENT)); }
    issue(0, 0);
    asm volatile("s_waitcnt vmcnt(0)" ::: "memory"); __syncthreads();
    for (int s = 0; s < 64; ++s) {
        const int buf = s & 1;
        if (s + 1 < 64) issue(s + 1, buf ^ 1);
        if (wave == 0) {
            const LAS unsigned char* L = lds + buf * SC_STEP;
            const int n = dir ? 63 - s : s;
            const float cd = cdl[s];
#define SC_RD(dst, addr, off) asm volatile("ds_read_b128 %0, %1 offset:%2" : "=v"(dst) : "v"(addr), "i"(off))
#define SC_WAIT(n, f) do { asm volatile("s_waitcnt lgkmcnt(" #n ")" : "+v"(f[0]), "+v"(f[1]), "+v"(f[2]), "+v"(f[3]), "+v"(f[4]), "+v"(f[5]), "+v"(f[6]), "+v"(f[7])); __builtin_amdgcn_sched_barrier(0); } while (0)
#define SC_LD_WQ(dst, mt) do { SC_RD(dst[0], wb, SC_W + (mt) * 4352); SC_RD(dst[1], wb, SC_W + (mt) * 4352 + 64); SC_RD(dst[2], wb, SC_W + (mt) * 4352 + 128); SC_RD(dst[3], wb, SC_W + (mt) * 4352 + 192); \
                SC_RD(dst[4], wb, SC_QD + (mt) * 4352); SC_RD(dst[5], wb, SC_QD + (mt) * 4352 + 64); SC_RD(dst[6], wb, SC_QD + (mt) * 4352 + 128); SC_RD(dst[7], wb, SC_QD + (mt) * 4352 + 192); } while (0)
#define SC_LD_K(dst, base, t0) do { SC_RD(dst[0], kb, (base) + (t0) * 2304); SC_RD(dst[1], kb, (base) + (t0) * 2304 + 64); SC_RD(dst[2], kb, (base) + ((t0) + 1) * 2304); SC_RD(dst[3], kb, (base) + ((t0) + 1) * 2304 + 64); \
                SC_RD(dst[4], kb, (base) + ((t0) + 2) * 2304); SC_RD(dst[5], kb, (base) + ((t0) + 2) * 2304 + 64); SC_RD(dst[6], kb, (base) + ((t0) + 3) * 2304); SC_RD(dst[7], kb, (base) + ((t0) + 3) * 2304 + 64); } while (0)
            const unsigned wb = (unsigned)(size_t)(L + fr * 272 + fq * 16), kb = (unsigned)(size_t)(L + fr * 144 + fq * 16);
            bf16x8 Sb[4];
#pragma unroll
            for (int ks = 0; ks < 4; ++ks) { pg8::u32x4 w; w.x = pg8::cvt_pk_bf16(S[2 * ks][0], S[2 * ks][1]); w.y = pg8::cvt_pk_bf16(S[2 * ks][2], S[2 * ks][3]);
                w.z = pg8::cvt_pk_bf16(S[2 * ks + 1][0], S[2 * ks + 1][1]); w.w = pg8::cvt_pk_bf16(S[2 * ks + 1][2], S[2 * ks + 1][3]); Sb[ks] = __builtin_bit_cast(bf16x8, w); }
            unsigned long long uu[4];
#pragma unroll
            for (int mt = 0; mt < 4; ++mt) uu[mt] = *(const LAS unsigned long long*)(L + SC_UT + fr * 128 + (16 * mt + 4 * fq) * 2);
            asm volatile("s_waitcnt lgkmcnt(0)" : "+v"(uu[0]), "+v"(uu[1]), "+v"(uu[2]), "+v"(uu[3]));
            __builtin_amdgcn_sched_barrier(0);
            bf16x8 fa[8], fb[8];
            f32x4 vn[4], o[4];
#define SC_MMA_WQ(src, mt) do { f32x4 a_ = (f32x4){0.f, 0.f, 0.f, 0.f}, q_ = (f32x4){0.f, 0.f, 0.f, 0.f}; \
                _Pragma("unroll") for (int ks = 0; ks < 4; ++ks) { a_ = __builtin_amdgcn_mfma_f32_16x16x32_bf16(src[ks], Sb[ks], a_, 0, 0, 0); q_ = __builtin_amdgcn_mfma_f32_16x16x32_bf16(src[4 + ks], Sb[ks], q_, 0, 0, 0); } \
                const unsigned ulo = (unsigned)uu[mt], uhi = (unsigned)(uu[mt] >> 32); \
                vn[mt][0] = __builtin_bit_cast(float, ulo << 16) - a_[0]; vn[mt][1] = __builtin_bit_cast(float, ulo & 0xffff0000u) - a_[1]; \
                vn[mt][2] = __builtin_bit_cast(float, uhi << 16) - a_[2]; vn[mt][3] = __builtin_bit_cast(float, uhi & 0xffff0000u) - a_[3]; o[mt] = q_; } while (0)
            SC_LD_WQ(fa, 0); SC_LD_WQ(fb, 1);
            SC_WAIT(8, fa); SC_MMA_WQ(fa, 0); __builtin_amdgcn_sched_barrier(0);
            SC_LD_WQ(fa, 2); SC_WAIT(8, fb); SC_MMA_WQ(fb, 1); __builtin_amdgcn_sched_barrier(0);
            SC_LD_WQ(fb, 3); SC_WAIT(8, fa); SC_MMA_WQ(fa, 2); __builtin_amdgcn_sched_barrier(0);
            SC_LD_K(fa, SC_QK, 0); SC_WAIT(8, fb); SC_MMA_WQ(fb, 3); __builtin_amdgcn_sched_barrier(0);
            bf16x8 vb[2];
#pragma unroll
            for (int ks = 0; ks < 2; ++ks) { pg8::u32x4 w; w.x = pg8::cvt_pk_bf16(vn[2 * ks][0], vn[2 * ks][1]); w.y = pg8::cvt_pk_bf16(vn[2 * ks][2], vn[2 * ks][3]);
                w.z = pg8::cvt_pk_bf16(vn[2 * ks + 1][0], vn[2 * ks + 1][1]); w.w = pg8::cvt_pk_bf16(vn[2 * ks + 1][2], vn[2 * ks + 1][3]); vb[ks] = __builtin_bit_cast(bf16x8, w); }
            __builtin_amdgcn_sched_barrier(0);
            SC_LD_K(fb, SC_KDT, 0); SC_WAIT(8, fa);
#pragma unroll
            for (int mt = 0; mt < 4; ++mt) {
#pragma unroll
                for (int ks = 0; ks < 2; ++ks) o[mt] = __builtin_amdgcn_mfma_f32_16x16x32_bf16(fa[2 * mt + ks], vb[ks], o[mt], 0, 0, 0);
            }
            __builtin_amdgcn_sched_barrier(0);
            SC_LD_K(fa, SC_KDT, 4); SC_WAIT(8, fb);
#pragma unroll
            for (int dt = 0; dt < 4; ++dt) { f32x4 a_ = S[dt] * cd;
#pragma unroll
                for (int ks = 0; ks < 2; ++ks) a_ = __builtin_amdgcn_mfma_f32_16x16x32_bf16(fb[2 * dt + ks], vb[ks], a_, 0, 0, 0);
                S[dt] = a_; }
            __builtin_amdgcn_sched_barrier(0);
            SC_WAIT(0, fa);
#pragma unroll
            for (int dt = 0; dt < 4; ++dt) { f32x4 a_ = S[4 + dt] * cd;
#pragma unroll
                for (int ks = 0; ks < 2; ++ks) a_ = __builtin_amdgcn_mfma_f32_16x16x32_bf16(fa[2 * dt + ks], vb[ks], a_, 0, 0, 0);
                S[4 + dt] = a_; }
#pragma unroll
            for (int mt = 0; mt < 4; ++mt)
#pragma unroll
                for (int r = 0; r < 4; ++r) { const int i = 16 * mt + 4 * fq + r; const int l = 64 * n + (dir ? 63 - i : i);
                    O[((size_t)b * LSEQ + l) * DGD + h * 128 + dv0 + fr] = (bf16)f2bf(o[mt][r]); }
#undef SC_RD
#undef SC_WAIT
#undef SC_LD_WQ
#undef SC_LD_K
#undef SC_MMA_WQ
            asm volatile("s_waitcnt vmcnt(16)" ::: "memory");
        } else asm volatile("s_waitcnt vmcnt(0)" ::: "memory");
        asm volatile("s_waitcnt lgkmcnt(0)" ::: "memory"); __builtin_amdgcn_s_barrier(); asm volatile("" ::: "memory");
    }
    asm volatile("s_waitcnt vmcnt(0)" ::: "memory"); __syncthreads();
}

__device__ __forceinline__ void gdn_post_batch(int item0, const bf16* OF, const bf16* OB, const bf16* PG, const float* nw, bf16* A2, int lane) {
    unsigned a[8], b[8], zz[8];
#pragma unroll
    for (int k = 0; k < 8; ++k) { const int item = item0 + k, tok = item >> 3, h = item & 7; const size_t o = (size_t)tok * DGD + h * 128 + lane * 2;
        a[k] = *(const unsigned*)(OF + o); b[k] = *(const unsigned*)(OB + o); zz[k] = *(const unsigned*)(PG + (size_t)tok * 4096 + 3072 + h * 128 + lane * 2); }
    const float2 g = *(const float2*)(nw + lane * 2);
#pragma unroll
    for (int k = 0; k < 8; ++k) { const int item = item0 + k, tok = item >> 3, h = item & 7;
        const float o0 = __builtin_bit_cast(float, a[k] << 16) + __builtin_bit_cast(float, b[k] << 16), o1 = __builtin_bit_cast(float, a[k] & 0xffff0000u) + __builtin_bit_cast(float, b[k] & 0xffff0000u);
        const float r = rsqrtf(wave_sum(o0 * o0 + o1 * o1) * (1.f / 128.f) + EPS);
        const float z0 = __builtin_bit_cast(float, zz[k] << 16), z1 = __builtin_bit_cast(float, zz[k] & 0xffff0000u);
        *(unsigned*)(A2 + (size_t)tok * DM + 1024 + h * 128 + lane * 2) = pk2(o0 * r * g.x * silu_f(z0), o1 * r * g.y * silu_f(z1)); }
}
constexpr int RT_PART = 0, RT_LG = 81920, RT_RS = 81920 + 32 * 80 * 4;
__device__ __forceinline__ void route_phase(LAS unsigned char* lds, int wg, const float* X1, const float* nw, const float* gbias, const float* ebias, unsigned char* ws, unsigned* cnt, int tid, int lane, int wave) {
    typedef pg8::bf16x8 bf16x8; typedef pg8::f32x4 f32x4;
    asm volatile("" : "+v"(lane), "+v"(tid));
    const int tok0 = wg * 32, fr = lane & 15, fq = lane >> 4;
    LAS float* part = (LAS float*)(lds + RT_PART); LAS float* lg = (LAS float*)(lds + RT_LG); LAS float* rs = (LAS float*)(lds + RT_RS);
    LAS int* hist = (LAS int*)(lds + RT_RS + 128);
    if (tid < 64) hist[tid] = 0;
    bf16* Ub = (bf16*)(ws + WS_UB);
    {
        const GAS f32x4* wr = (const GAS f32x4*)nw + lane;
        f32x4 v[4][8], g[8];
#pragma unroll
        for (int q = 0; q < 4; ++q) { const GAS f32x4* xr = (const GAS f32x4*)(X1 + (size_t)(tok0 + 4 * wave + q) * DM) + lane;
#pragma unroll
            for (int j = 0; j < 8; ++j) v[q][j] = xr[64 * j]; }
#pragma unroll
        for (int j = 0; j < 8; ++j) g[j] = wr[64 * j];
#pragma unroll
        for (int q = 0; q < 4; ++q) { const int t = 4 * wave + q; float s = 0.f;
#pragma unroll
            for (int j = 0; j < 8; ++j) s += (v[q][j].x * v[q][j].x + v[q][j].y * v[q][j].y) + (v[q][j].z * v[q][j].z + v[q][j].w * v[q][j].w);
            const float r = rsqrtf(wave_sum(s) * (1.f / DM) + EPS);
            GAS unsigned long long* o8 = (GAS unsigned long long*)(Ub + (size_t)(tok0 + t) * DM) + lane;
#pragma unroll
            for (int j = 0; j < 8; ++j) o8[64 * j] = (unsigned long long)pk2(v[q][j].x * r * g[j].x, v[q][j].y * r * g[j].y) | ((unsigned long long)pk2(v[q][j].z * r * g[j].z, v[q][j].w * r * g[j].w) << 32);
            if (lane == 0) rs[t] = r; }
    }
    if (wg == 0) { GAS unsigned long long* z = (GAS unsigned long long*)(Ub + (size_t)T * DM); z[tid] = 0ull; }
    { int* slot_tok = (int*)(ws + WS_SMALL + SM_SLOTTOK); if (tid < PMAX / 256) slot_tok[wg * (PMAX / 256) + tid] = T; }
    __syncthreads();
    const bf16* RWh = (const bf16*)(ws + WS_SMALL + SM_RWT); const bf16* RWl = RWh + 80 * 2048;
    f32x4 acc[2][5];
#pragma unroll
    for (int mt = 0; mt < 2; ++mt)
#pragma unroll
        for (int nt = 0; nt < 5; ++nt) acc[mt][nt] = (f32x4){0.f, 0.f, 0.f, 0.f};
    struct RtSet { f32x4 g0, g1, x0[2], x1[2]; bf16x8 bh[5], bl[5]; };
    const float rr[2] = {rs[fr], rs[16 + fr]};
#define RT_LOAD(ks_, S) do { const int ka_ = 256 * wave + 32 * (ks_) + 4 * fq, kb_ = 256 * wave + 32 * (ks_) + 8 * fq; \
        S.g0 = *(const f32x4*)(nw + ka_); S.g1 = *(const f32x4*)(nw + ka_ + 16); \
        _Pragma("unroll") for (int mt = 0; mt < 2; ++mt) { const float* xp = X1 + (size_t)(tok0 + 16 * mt + fr) * DM + ka_; S.x0[mt] = *(const f32x4*)xp; S.x1[mt] = *(const f32x4*)(xp + 16); } \
        _Pragma("unroll") for (int nt = 0; nt < 5; ++nt) { S.bh[nt] = *(const bf16x8*)(RWh + (size_t)(16 * nt + fr) * 2048 + kb_); S.bl[nt] = *(const bf16x8*)(RWl + (size_t)(16 * nt + fr) * 2048 + kb_); } } while (0)
#define RT_COMP(S) do { bf16x8 ah[2], al[2]; \
        _Pragma("unroll") for (int mt = 0; mt < 2; ++mt) { const float r = rr[mt]; float u[8], hf[8]; \
            _Pragma("unroll") for (int j = 0; j < 4; ++j) { u[j] = S.x0[mt][j] * r * S.g0[j]; u[4 + j] = S.x1[mt][j] * r * S.g1[j]; } \
            pg8::u32x4 wh, wl; \
            wh.x = pg8::cvt_pk_bf16(u[0], u[1]); wh.y = pg8::cvt_pk_bf16(u[2], u[3]); wh.z = pg8::cvt_pk_bf16(u[4], u[5]); wh.w = pg8::cvt_pk_bf16(u[6], u[7]); \
            hf[0] = __builtin_bit_cast(float, wh.x << 16); hf[1] = __builtin_bit_cast(float, wh.x & 0xffff0000u); hf[2] = __builtin_bit_cast(float, wh.y << 16); hf[3] = __builtin_bit_cast(float, wh.y & 0xffff0000u); \
            hf[4] = __builtin_bit_cast(float, wh.z << 16); hf[5] = __builtin_bit_cast(float, wh.z & 0xffff0000u); hf[6] = __builtin_bit_cast(float, wh.w << 16); hf[7] = __builtin_bit_cast(float, wh.w & 0xffff0000u); \
            wl.x = pg8::cvt_pk_bf16(u[0] - hf[0], u[1] - hf[1]); wl.y = pg8::cvt_pk_bf16(u[2] - hf[2], u[3] - hf[3]); wl.z = pg8::cvt_pk_bf16(u[4] - hf[4], u[5] - hf[5]); wl.w = pg8::cvt_pk_bf16(u[6] - hf[6], u[7] - hf[7]); \
            ah[mt] = __builtin_bit_cast(bf16x8, wh); al[mt] = __builtin_bit_cast(bf16x8, wl); } \
        _Pragma("unroll") for (int nt = 0; nt < 5; ++nt) { _Pragma("unroll") for (int mt = 0; mt < 2; ++mt) { \
            acc[mt][nt] = __builtin_amdgcn_mfma_f32_16x16x32_bf16(ah[mt], S.bh[nt], acc[mt][nt], 0, 0, 0); \
            acc[mt][nt] = __builtin_amdgcn_mfma_f32_16x16x32_bf16(al[mt], S.bh[nt], acc[mt][nt], 0, 0, 0); \
            acc[mt][nt] = __builtin_amdgcn_mfma_f32_16x16x32_bf16(ah[mt], S.bl[nt], acc[mt][nt], 0, 0, 0); } } } while (0)
    {
        RtSet s0, s1;
#define RT_PIN() asm volatile("" ::: "memory")
        RT_LOAD(0, s0); RT_LOAD(1, s1); RT_PIN();
        RT_COMP(s0); RT_PIN(); RT_LOAD(2, s0); RT_PIN(); RT_COMP(s1); RT_PIN(); RT_LOAD(3, s1); RT_PIN();
        RT_COMP(s0); RT_PIN(); RT_LOAD(4, s0); RT_PIN(); RT_COMP(s1); RT_PIN(); RT_LOAD(5, s1); RT_PIN();
        RT_COMP(s0); RT_PIN(); RT_LOAD(6, s0); RT_PIN(); RT_COMP(s1); RT_PIN(); RT_LOAD(7, s1); RT_PIN();
        RT_COMP(s0); RT_COMP(s1);
#undef RT_PIN
    }
#undef RT_LOAD
#undef RT_COMP
#pragma unroll
    for (int mt = 0; mt < 2; ++mt)
#pragma unroll
        for (int nt = 0; nt < 5; ++nt) *(LAS f32x4*)(part + ((wave * 10 + mt * 5 + nt) * 64 + lane) * 4) = acc[mt][nt];
    __syncthreads();
    for (int o = tid; o < 32 * 80; o += 512) {
        const int t = o / 80, col = o % 80, mt = t >> 4, tr = t & 15, nt = col >> 4, ln = (tr >> 2) * 16 + (col & 15), rg = tr & 3;
        float s = 0.f;
#pragma unroll
        for (int w = 0; w < 8; ++w) s += part[((w * 10 + mt * 5 + nt) * 64 + ln) * 4 + rg];
        lg[t * 80 + col] = s;
    }
    __syncthreads();
    if (tid < 32) {
        const int t = tok0 + tid; const LAS float* l = lg + tid * 80;
        float g[8]; int gi = 0; float gm = -INFINITY;
#pragma unroll
        for (int i = 0; i < 8; ++i) { g[i] = l[i] + gbias[i]; if (g[i] > gm) { gm = g[i]; gi = i; } }
        float gs = 0.f;
#pragma unroll
        for (int i = 0; i < 8; ++i) gs += expf(g[i] - gm);
        const float ggate = 1.f / gs;
        float e[8]; float em = -INFINITY;
#pragma unroll
        for (int i = 0; i < 8; ++i) { e[i] = l[8 + gi * 8 + i] + ebias[gi * 8 + i]; em = fmaxf(em, e[i]); }
        float es = 0.f; float p[8];
#pragma unroll
        for (int i = 0; i < 8; ++i) { p[i] = expf(e[i] - em); es += p[i]; }
        int i1 = 0; float p1 = -1.f;
#pragma unroll
        for (int i = 0; i < 8; ++i) if (p[i] > p1) { p1 = p[i]; i1 = i; }
        int i2 = 0; float p2 = -1.f;
#pragma unroll
        for (int i = 0; i < 8; ++i) if (i != i1 && p[i] > p2) { p2 = p[i]; i2 = i; }
        const float q1 = p1 / es, q2 = p2 / es, qs = q1 + q2;
        const int e1 = gi * 8 + i1, e2 = gi * 8 + i2;
        int* eid = (int*)(ws + WS_SMALL + SM_EID); float* gate = (float*)(ws + WS_SMALL + SM_GATE); int* pos = (int*)(ws + WS_SMALL + SM_POS);
        eid[t * 2] = e1; eid[t * 2 + 1] = e2;
        gate[t * 2] = ggate * (q1 / qs); gate[t * 2 + 1] = ggate * (q2 / qs);
        pos[t * 2] = __hip_atomic_fetch_add(hist + e1, 1, __ATOMIC_RELAXED, __HIP_MEMORY_SCOPE_WORKGROUP);
        pos[t * 2 + 1] = __hip_atomic_fetch_add(hist + e2, 1, __ATOMIC_RELAXED, __HIP_MEMORY_SCOPE_WORKGROUP);
    }
    __syncthreads();
    if (tid < 64) ((int*)(ws + WS_SMALL + SM_LOGITS))[wg * 64 + tid] = hist[tid];
}
__device__ __forceinline__ void fill_phase(LAS unsigned char* lds, int wg, unsigned char* ws, unsigned* cnt, int tid) {
    LAS int* ps = (LAS int*)lds;
    char* sm = (char*)(ws + WS_SMALL);
    if (tid < 64) {
        const int* tab = (const int*)(sm + SM_LOGITS) + tid;
        int below = 0, total = 0;
#pragma unroll 1
        for (int w0 = 0; w0 < 256; w0 += 32) { int v[32];
#pragma unroll
            for (int i = 0; i < 32; ++i) v[i] = tab[(w0 + i) * 64];
#pragma unroll
            for (int i = 0; i < 32; ++i) { total += v[i]; below += (w0 + i < wg) ? v[i] : 0; } }
        const int padded = (total + RB - 1) / RB * RB;
        int inc = padded;
#pragma unroll
        for (int o = 1; o < 64; o <<= 1) { const int t = __shfl_up(inc, o); if (tid >= o) inc += t; }
        ps[tid] = inc - padded; if (tid == 63) ps[NE] = inc;
        ps[128 + tid] = inc - padded + below;
    }
    __syncthreads();
    if (wg == 0) {
        int* blk_exp = (int*)(sm + SM_BLKEXP); int* nblk = (int*)(sm + SM_NBLK);
        if (tid < NBLK_MAX) { int e = NE - 1; for (int i = 0; i < NE; ++i) if (tid * RB >= ps[i] && tid * RB < ps[i + 1]) { e = i; break; } blk_exp[tid] = e; }
        if (tid == 0) *nblk = ps[NE] / RB;
    }
    if (tid < 64) {
        const int i = wg * 64 + tid; const int* eid = (const int*)(sm + SM_EID); const int* pos = (const int*)(sm + SM_POS);
        const int s = ps[128 + eid[i]] + pos[i];
        ((int*)(sm + SM_SLOTTOK))[s] = i >> 1; ((int*)(sm + SM_TSLOT))[i] = s;
    }
    __syncthreads();
}
__device__ __forceinline__ void final_rows(int t0, const float* X1, const bf16* Y, unsigned char* ws, const float* fw, float* out, int lane) {
    typedef pg8::f32x4 f32x4;
    const char* sm = (const char*)(ws + WS_SMALL);
    const int4 sl = *(const int4*)((const int*)(sm + SM_TSLOT) + t0 * 2); const float4 gt = *(const float4*)((const float*)(sm + SM_GATE) + t0 * 2);
    const int ss[4] = {sl.x, sl.y, sl.z, sl.w}; const float gg[4] = {gt.x, gt.y, gt.z, gt.w};
    f32x4 x[2][8]; unsigned long long ya[2][8], yb[2][8];
#pragma unroll
    for (int q = 0; q < 2; ++q) {
        const GAS f32x4* xr = (const GAS f32x4*)(X1 + (size_t)(t0 + q) * DM) + lane;
        const GAS unsigned long long* y1 = (const GAS unsigned long long*)(Y + (size_t)ss[2 * q] * DM) + lane; const GAS unsigned long long* y2 = (const GAS unsigned long long*)(Y + (size_t)ss[2 * q + 1] * DM) + lane;
#pragma unroll
        for (int j = 0; j < 8; ++j) { x[q][j] = xr[64 * j]; ya[q][j] = y1[64 * j]; yb[q][j] = y2[64 * j]; }
    }
    const GAS f32x4* wr = (const GAS f32x4*)fw + lane;
#pragma unroll
    for (int q = 0; q < 2; ++q) {
        const float g1 = gg[2 * q], g2 = gg[2 * q + 1]; float sq = 0.f;
#pragma unroll
        for (int j = 0; j < 8; ++j) {
            const unsigned alo = (unsigned)ya[q][j], ahi = (unsigned)(ya[q][j] >> 32), blo = (unsigned)yb[q][j], bhi = (unsigned)(yb[q][j] >> 32);
            f32x4 r = x[q][j];
            r.x += g1 * __builtin_bit_cast(float, alo << 16) + g2 * __builtin_bit_cast(float, blo << 16);
            r.y += g1 * __builtin_bit_cast(float, alo & 0xffff0000u) + g2 * __builtin_bit_cast(float, blo & 0xffff0000u);
            r.z += g1 * __builtin_bit_cast(float, ahi << 16) + g2 * __builtin_bit_cast(float, bhi << 16);
            r.w += g1 * __builtin_bit_cast(float, ahi & 0xffff0000u) + g2 * __builtin_bit_cast(float, bhi & 0xffff0000u);
            x[q][j] = r; sq += (r.x * r.x + r.y * r.y) + (r.z * r.z + r.w * r.w);
        }
        const float rr = rsqrtf(wave_sum(sq) * (1.f / DM) + EPS);
        GAS f32x4* o = (GAS f32x4*)(out + (size_t)(t0 + q) * DM) + lane;
#pragma unroll
        for (int j = 0; j < 8; ++j) { const f32x4 g = wr[64 * j]; o[64 * j] = x[q][j] * rr * g; }
    }
}


constexpr int MQ_A = 0, MQ_B = 65536, MQ_CTL = 98304;
__device__ __forceinline__ int perm32_inv(int c) { return 16 * ((c >> 2) & 1) + 4 * (c >> 3) + (c & 3); }
template <bool UP>
__device__ __forceinline__ void moe_gemm(LAS unsigned char* lds, unsigned char* ws, const float* w1, const float* w3  , unsigned* qctr, unsigned* done, int nblk, int tid) {
    typedef pg8::bf16x8 bf16x8; typedef pg8::f32x4 f32x4;
    constexpr int K = UP ? DM : DE, NT = K / 64, UPB = UP ? 8 : 16;
    const int wid = __builtin_amdgcn_readfirstlane(tid >> 6), lane = tid & 63, wr = wid >> 2, wc = wid & 3, fr = lane & 15, fq = lane >> 4;
    const int* slot_tok = (const int*)(ws + WS_SMALL + SM_SLOTTOK); const int* blk_exp = (const int*)(ws + WS_SMALL + SM_BLKEXP);
    int Rr[2], Cc[2];
#pragma unroll
    for (int i = 0; i < 2; ++i) pg8::stage_rc(tid * 16 + i * 8192, Rr[i], Cc[i]);
    const unsigned ldsw = (unsigned)wid * 1024u;
    const int aoff = pg8::lds_byte(fr, fq * 8), boff = pg8::lds_byte(wc * 32 + fr, fq * 8);
    const int cidx = tid & 127, kq = wid >> 1, chalf = wid & 1;
    int slot;
    if (UP) { const int x = cidx & 63; slot = 32 * (x >> 4) + ((cidx >> 6) ? 16 : 0) + (x & 15); } else slot = (cidx & ~31) + perm32_inv(cidx & 31);
    const int bw0 = pg8::lds_byte(slot, 8 * kq), bw1 = pg8::lds_byte(slot, 32 + 8 * kq);
    LAS int* uword = (LAS int*)(lds + MQ_CTL);
    const int nunits = nblk * UPB;
    int bprev = -1;
    for (;;) {
        __syncthreads();
        if (tid == 0) {
            if (UP && bprev >= 0) { __builtin_amdgcn_fence(__ATOMIC_RELEASE, "agent"); asm volatile("s_waitcnt vmcnt(0)" ::: "memory"); (void)xb_add(done + bprev, 1u); }
            const unsigned un = __hip_atomic_fetch_add(qctr, 1u, __ATOMIC_RELAXED, __HIP_MEMORY_SCOPE_AGENT);
            if (!UP && (int)un < nunits) {
                unsigned sp = 0u; while (xb_ld(done + un / UPB) < 8u) { __builtin_amdgcn_s_sleep(2); if (++sp > (1u << 22)) break; }
                __builtin_amdgcn_fence(__ATOMIC_ACQUIRE, "agent"); asm volatile("s_waitcnt vmcnt(0)" ::: "memory");
            }
            uword[0] = (int)un;
        }
        __syncthreads();
        const int u = __builtin_amdgcn_readfirstlane(uword[0]);
        if (u >= nunits) break;
        const int b = u / UPB, j = u % UPB;
        bprev = b;
        const int e = __builtin_amdgcn_readfirstlane(__hip_atomic_load(blk_exp + b, __ATOMIC_RELAXED, __HIP_MEMORY_SCOPE_AGENT));
        unsigned ao[2][2];
#pragma unroll
        for (int h = 0; h < 2; ++h)
#pragma unroll
            for (int i = 0; i < 2; ++i) { const int row = UP ? slot_tok[b * 256 + h * 128 + Rr[i]] : b * 256 + h * 128 + Rr[i]; ao[h][i] = (unsigned)row * (unsigned)(K * 2) + (unsigned)Cc[i] * 2u; }
        const char* Abase = (const char*)(ws + (UP ? WS_UB : WS_HH));
        const float* bcolu;
        if (UP) bcolu = (chalf ? w3 : w1) + (size_t)e * DM * DE + 64 * j; else bcolu = w1 + (size_t)e * DE * DM + 128 * j + 64 * chalf;
        constexpr int LDN = UP ? DE : DM;
        f32x4 acc[8][2];
#pragma unroll
        for (int m = 0; m < 8; ++m)
#pragma unroll
            for (int n = 0; n < 2; ++n) acc[m][n] = (f32x4){0.f, 0.f, 0.f, 0.f};
        float r0[16], r1[16], r2[16];
#define MQ_LOAD_A(t, ra) do { _Pragma("unroll") for (int h = 0; h < 2; ++h) _Pragma("unroll") for (int i = 0; i < 2; ++i) \
            ra[h * 2 + i] = *(const pg8::u32x4*)(Abase + ao[h][i] + (size_t)(t) * 128); } while (0)
#define MQ_WRITE_A(ra, buf) do { _Pragma("unroll") for (int h = 0; h < 2; ++h) _Pragma("unroll") for (int i = 0; i < 2; ++i) \
            *(LAS pg8::u32x4*)(lds + MQ_A + ((buf) * 2 + h) * 16384 + ldsw + i * 8192 + lane * 16) = ra[h * 2 + i]; } while (0)
#define MQ_LOAD_B(t, r) do { const float* p_ = bcolu + (size_t)((t) * 64 + 8 * kq) * LDN; \
            _Pragma("unroll") for (int e_ = 0; e_ < 8; ++e_) { r[e_] = (p_ + (size_t)e_ * LDN)[lane]; r[8 + e_] = (p_ + (size_t)(32 + e_) * LDN)[lane]; } } while (0)
#define MQ_WRITE_B(r, buf) do { pg8::u32x4 w0_, w1_; \
            w0_.x = pg8::cvt_pk_bf16(r[0], r[1]); w0_.y = pg8::cvt_pk_bf16(r[2], r[3]); w0_.z = pg8::cvt_pk_bf16(r[4], r[5]); w0_.w = pg8::cvt_pk_bf16(r[6], r[7]); \
            w1_.x = pg8::cvt_pk_bf16(r[8], r[9]); w1_.y = pg8::cvt_pk_bf16(r[10], r[11]); w1_.z = pg8::cvt_pk_bf16(r[12], r[13]); w1_.w = pg8::cvt_pk_bf16(r[14], r[15]); \
            *(LAS pg8::u32x4*)(lds + MQ_B + (buf) * 16384 + bw0) = w0_; *(LAS pg8::u32x4*)(lds + MQ_B + (buf) * 16384 + bw1) = w1_; } while (0)
#define MQ_COMPUTE(buf) do { const LAS unsigned char* A_ = lds + MQ_A + ((buf) * 2 + wr) * 16384 + aoff; const LAS unsigned char* B_ = lds + MQ_B + (buf) * 16384 + boff; \
            _Pragma("unroll") for (int k = 0; k < 2; ++k) { bf16x8 bf_[2]; \
                _Pragma("unroll") for (int n = 0; n < 2; ++n) bf_[n] = *(const LAS bf16x8*)(B_ + n * 2048 + k * 1024); \
                _Pragma("unroll") for (int mh = 0; mh < 2; ++mh) { bf16x8 af_[4]; \
                    _Pragma("unroll") for (int m = 0; m < 4; ++m) af_[m] = *(const LAS bf16x8*)(A_ + (4 * mh + m) * 2048 + k * 1024); \
                    _Pragma("unroll") for (int m = 0; m < 4; ++m) _Pragma("unroll") for (int n = 0; n < 2; ++n) acc[4 * mh + m][n] = __builtin_amdgcn_mfma_f32_16x16x32_bf16(bf_[n], af_[m], acc[4 * mh + m][n], 0, 0, 0); } } } while (0)
#define MQ_STEP(t, rcur, rnxt, acur, anxt, buf) do { \
            { const int tb_ = (t) + 3 < NT ? (t) + 3 : NT - 1, ta_ = (t) + 2 < NT ? (t) + 2 : NT - 1; MQ_LOAD_A(ta_, acur); MQ_LOAD_B(tb_, rcur); }     \
            MQ_COMPUTE(buf); \
            if ((t) + 1 < NT) { MQ_WRITE_A(anxt, (buf) ^ 1); MQ_WRITE_B(rnxt, (buf) ^ 1); } \
            asm volatile("s_waitcnt lgkmcnt(0)" ::: "memory"); __builtin_amdgcn_s_barrier(); asm volatile("" ::: "memory"); } while (0)
        pg8::u32x4 a0[4], a1[4];
        MQ_LOAD_A(0, a0); MQ_LOAD_B(0, r0); MQ_LOAD_A(1, a1); MQ_LOAD_B(1, r1); MQ_LOAD_B(2, r2);
        MQ_WRITE_A(a0, 0); MQ_WRITE_B(r0, 0);
        asm volatile("s_waitcnt lgkmcnt(0)" ::: "memory"); __builtin_amdgcn_s_barrier(); asm volatile("" ::: "memory");
        static_assert(NT % 6 == 2, "step loop: six steps per trip + two");
#pragma unroll 1
        for (int t = 0; t + 6 <= NT; t += 6) {
            MQ_STEP(t, r0, r1, a0, a1, 0); MQ_STEP(t + 1, r1, r2, a1, a0, 1); MQ_STEP(t + 2, r2, r0, a0, a1, 0);
            MQ_STEP(t + 3, r0, r1, a1, a0, 1); MQ_STEP(t + 4, r1, r2, a0, a1, 0); MQ_STEP(t + 5, r2, r0, a1, a0, 1); }
        { constexpr int t = NT - 2; MQ_STEP(t, r0, r1, a0, a1, 0); MQ_STEP(t + 1, r1, r2, a1, a0, 1); }
        const int row0 = b * 256 + wr * 128 + fr;
        if (UP) {
            bf16* HH = (bf16*)(ws + WS_HH);
#pragma unroll
            for (int m = 0; m < 8; ++m) { float v[4];
#pragma unroll
                for (int r = 0; r < 4; ++r) { const float a = acc[m][0][r], bb = acc[m][1][r]; v[r] = a / (1.f + __expf(-a)) * bb; }
                *(unsigned long long*)(HH + (size_t)(row0 + 16 * m) * DE + 64 * j + 16 * wc + 4 * fq) = (unsigned long long)pg8::cvt_pk_bf16(v[0], v[1]) | ((unsigned long long)pg8::cvt_pk_bf16(v[2], v[3]) << 32); }
        } else {
            bf16* Y = (bf16*)(ws + WS_Y);
#pragma unroll
            for (int m = 0; m < 8; ++m) { const f32x4 v0 = acc[m][0], v1 = acc[m][1];
                pg8::u32x4 w; w.x = pg8::cvt_pk_bf16(v0[0], v0[1]); w.y = pg8::cvt_pk_bf16(v0[2], v0[3]); w.z = pg8::cvt_pk_bf16(v1[0], v1[1]); w.w = pg8::cvt_pk_bf16(v1[2], v1[3]);
                *(pg8::u32x4*)(Y + (size_t)(row0 + 16 * m) * DM + 128 * j + 32 * wc + 8 * fq) = w; }
        }
#undef MQ_LOAD_A
#undef MQ_WRITE_A
#undef MQ_LOAD_B
#undef MQ_WRITE_B
#undef MQ_COMPUTE
#undef MQ_STEP
        if (UP) asm volatile("s_waitcnt vmcnt(0)" ::: "memory");
    }
    asm volatile("s_waitcnt vmcnt(0)" ::: "memory");
    __syncthreads();
}

constexpr int NWAVES = 8;
constexpr int LDS_BYTES = 147456, LDSCTL_OFF = LDS_BYTES - 256;

struct Args { const float* in[31]; float* out; unsigned char* ws; int ph_lo, ph_hi, li, pad; };

struct Epi1 {
    bf16* PG; float* PGATE; float* PT;
    __device__ __forceinline__ void operator()(const pg8::f32x4 (&acc)[2][2][4][2], const pg8::Unit& u, int wr, int wc, int fr, int fq) const {
        const int row0 = u.pm * 256 + wr * 64 + fr;
        if (u.kind == 0) {
            if (u.pn < 16) {
                const int col0 = u.pn * 256 + wc * 32 + 8 * fq;
#pragma unroll
                for (int ai = 0; ai < 2; ++ai)
#pragma unroll
                    for (int m = 0; m < 4; ++m) { bf16* rowp = PG + (size_t)(row0 + ai * 128 + m * 16) * 4096 + col0;
#pragma unroll
                        for (int bj = 0; bj < 2; ++bj) { const pg8::f32x4 v0 = acc[ai][bj][m][0], v1 = acc[ai][bj][m][1];
                            pg8::u32x4 w; w.x = pg8::cvt_pk_bf16(v0[0], v0[1]); w.y = pg8::cvt_pk_bf16(v0[2], v0[3]); w.z = pg8::cvt_pk_bf16(v1[0], v1[1]); w.w = pg8::cvt_pk_bf16(v1[2], v1[3]);
                            *(pg8::u32x4*)(rowp + bj * 128) = w; } }
            } else if (wc == 0) {
#pragma unroll
                for (int ai = 0; ai < 2; ++ai)
#pragma unroll
                    for (int m = 0; m < 4; ++m) { float* rowp = PGATE + (size_t)(row0 + ai * 128 + m * 16) * 32 + 8 * fq;
                        *(pg8::f32x4*)(rowp) = acc[ai][0][m][0]; *(pg8::f32x4*)(rowp + 4) = acc[ai][0][m][1]; }
            }
        } else {
            const int col0 = u.pn * 256 + wc * 32 + 8 * fq;
#pragma unroll
            for (int ai = 0; ai < 2; ++ai)
#pragma unroll
                for (int m = 0; m < 4; ++m) { float* rowp = PT + (size_t)(row0 + ai * 128 + m * 16) * T + col0;
#pragma unroll
                    for (int bj = 0; bj < 2; ++bj) { *(pg8::f32x4*)(rowp + bj * 128) = acc[ai][bj][m][0]; *(pg8::f32x4*)(rowp + bj * 128 + 4) = acc[ai][bj][m][1]; } }
        }
    }
};
struct Order1 {
    const char* Hb; const char* WinT; int G, c;
    __device__ __forceinline__ bool next(int i, pg8::Unit& u) const {
        const int L = i * G + c;
        if (L >= 928) return false;
        u.rows = nullptr;
        if (L < 544) { int pm, pn; pg8::tile_of(L, 32, 17, pm, pn); u.pm = pm; u.pn = pn; u.kind = 0;
            u.A = Hb + (size_t)pm * 256 * DM * 2; u.B = WinT + (size_t)(GOFF + pn * 256) * DM * 2; }
        else { int pm, pn; pg8::tile_of(L - 544, 12, 32, pm, pn); u.pm = pm; u.pn = pn; u.kind = 1;
            u.A = WinT + (size_t)pm * 256 * DM * 2; u.B = Hb + (size_t)pn * 256 * DM * 2; }
        return true;
    }
};

struct Epi2 {
    const float* x; float* X1;
    __device__ __forceinline__ void operator()(const pg8::f32x4 (&acc)[2][2][4][2], const pg8::Unit& u, int wr, int wc, int fr, int fq) const {
        const int row0 = u.pm * 256 + wr * 64 + fr, col0 = u.pn * 256 + wc * 32 + 8 * fq;
#pragma unroll
        for (int ai = 0; ai < 2; ++ai)
#pragma unroll
            for (int m = 0; m < 4; ++m) { const size_t off = (size_t)(row0 + ai * 128 + m * 16) * DM + col0;
#pragma unroll
                for (int bj = 0; bj < 2; ++bj) {
                    const pg8::f32x4 x0 = *(const pg8::f32x4*)(x + off + bj * 128), x1 = *(const pg8::f32x4*)(x + off + bj * 128 + 4);
                    *(pg8::f32x4*)(X1 + off + bj * 128) = x0 + acc[ai][bj][m][0]; *(pg8::f32x4*)(X1 + off + bj * 128 + 4) = x1 + acc[ai][bj][m][1]; }
                asm volatile("" ::: "memory"); }
    }
};
struct Order2 {
    const char* A2; const char* WoutT; int G, c;
    __device__ __forceinline__ bool next(int i, pg8::Unit& u) const {
        const int L = i * G + c; if (L >= 256) return false;
        int pm, pn; pg8::tile_of(L, 32, 8, pm, pn); u.pm = pm; u.pn = pn; u.kind = 0; u.rows = nullptr;
        u.A = A2 + (size_t)pm * 256 * DM * 2; u.B = WoutT + (size_t)pn * 256 * DM * 2; return true;
    }
};
struct Epi3 {
    bf16* HH;
    __device__ __forceinline__ void operator()(const pg8::f32x4 (&acc)[2][2][4][2], const pg8::Unit& u, int wr, int wc, int fr, int fq) const {
        const int row0 = u.pm * 256 + wr * 64 + fr, col0 = u.pn * 128 + wc * 32 + 8 * fq;
#pragma unroll
        for (int ai = 0; ai < 2; ++ai)
#pragma unroll
            for (int m = 0; m < 4; ++m) { bf16* rowp = HH + (size_t)(row0 + ai * 128 + m * 16) * DE + col0;
                float v[8];
#pragma unroll
                for (int n = 0; n < 2; ++n)
#pragma unroll
                    for (int j = 0; j < 4; ++j) { const float a = acc[ai][0][m][n][j], b = acc[ai][1][m][n][j]; v[n * 4 + j] = a / (1.f + __expf(-a)) * b; }
                pg8::u32x4 w; w.x = pg8::cvt_pk_bf16(v[0], v[1]); w.y = pg8::cvt_pk_bf16(v[2], v[3]); w.z = pg8::cvt_pk_bf16(v[4], v[5]); w.w = pg8::cvt_pk_bf16(v[6], v[7]);
                *(pg8::u32x4*)rowp = w; }
    }
};
struct Order3 {
    const char* Ub; const char* W13T; const int* slot_tok; const int* blk_exp; int nunits, G, c;
    __device__ __forceinline__ bool next(int i, pg8::Unit& u) const {
        const int L = i * G + c; if (L >= nunits) return false;
        const int b = L >> 2, j = L & 3; u.pm = b; u.pn = j; u.kind = 0; u.rows = slot_tok + b * 256; u.A = Ub;
        const int e = __hip_atomic_load(blk_exp + b, __ATOMIC_RELAXED, __HIP_MEMORY_SCOPE_AGENT);
        u.B = W13T + ((size_t)e * 1024 + j * 256) * DM * 2; return true;
    }
};
struct Epi4 {
    bf16* Y;
    __device__ __forceinline__ void operator()(const pg8::f32x4 (&acc)[2][2][4][2], const pg8::Unit& u, int wr, int wc, int fr, int fq) const {
        const int row0 = u.pm * 256 + wr * 64 + fr, col0 = u.pn * 256 + wc * 32 + 8 * fq;
#pragma unroll
        for (int ai = 0; ai < 2; ++ai)
#pragma unroll
            for (int m = 0; m < 4; ++m) { bf16* rowp = Y + (size_t)(row0 + ai * 128 + m * 16) * DM + col0;
#pragma unroll
                for (int bj = 0; bj < 2; ++bj) { const pg8::f32x4 v0 = acc[ai][bj][m][0], v1 = acc[ai][bj][m][1];
                    pg8::u32x4 w; w.x = pg8::cvt_pk_bf16(v0[0], v0[1]); w.y = pg8::cvt_pk_bf16(v0[2], v0[3]); w.z = pg8::cvt_pk_bf16(v1[0], v1[1]); w.w = pg8::cvt_pk_bf16(v1[2], v1[3]);
                    *(pg8::u32x4*)(rowp + bj * 128) = w; } }
    }
};
struct Order4 {
    const char* HH; const char* W2T; const int* blk_exp; int nunits, G, c;
    __device__ __forceinline__ bool next(int i, pg8::Unit& u) const {
        const int L = i * G + c; if (L >= nunits) return false;
        const int b = L >> 3, j = L & 7; u.pm = b; u.pn = j; u.kind = 0; u.rows = nullptr; u.A = HH + (size_t)b * 256 * DE * 2;
        const int e = __hip_atomic_load(blk_exp + b, __ATOMIC_RELAXED, __HIP_MEMORY_SCOPE_AGENT);
        u.B = W2T + ((size_t)e * DM + j * 256) * DE * 2; return true;
    }
};

struct TrItem { const float* W; int ldn, k0, n0; bf16* WT; size_t dst_row0; int ldk; };
__device__ __forceinline__ void tr_store(const TrItem& I, LAS float* scr, const float (&tv)[32], int lane) {
#pragma unroll
    for (int i = 0; i < 32; ++i) { const int kk = 2 * i + (lane >> 5); scr[kk * 33 + (lane & 31)] = tv[i]; }
    asm volatile("s_waitcnt lgkmcnt(0)" ::: "memory");
    const int c = lane & 7;
#pragma unroll
    for (int j = 0; j < 4; ++j) { const int n = (lane >> 3) + 8 * j; const LAS float* s = scr + (8 * c) * 33 + n;
        v4u o; o.x = pg8::cvt_pk_bf16(s[0 * 33], s[1 * 33]); o.y = pg8::cvt_pk_bf16(s[2 * 33], s[3 * 33]); o.z = pg8::cvt_pk_bf16(s[4 * 33], s[5 * 33]); o.w = pg8::cvt_pk_bf16(s[6 * 33], s[7 * 33]);
        *(GAS v4u*)(I.WT + (I.dst_row0 + n) * I.ldk + I.k0 + 8 * c) = o; }
    asm volatile("s_waitcnt lgkmcnt(0)" ::: "memory");
}
__device__ __forceinline__ void tr_pair(const TrItem& A, const TrItem& B, bool hasB, LAS float* scr, int lane) {
    float ta[32], tb[32];
    const float* pa = A.W + (size_t)(A.k0 + (lane >> 5)) * A.ldn + A.n0 + (lane & 31);
    const float* pb = (hasB ? B.W + (size_t)(B.k0 + (lane >> 5)) * B.ldn + B.n0 : A.W + (size_t)(A.k0 + (lane >> 5)) * A.ldn + A.n0) + (lane & 31);
    const size_t sa = (size_t)2 * A.ldn, sb = (size_t)2 * (hasB ? B.ldn : A.ldn);
#pragma unroll
    for (int i = 0; i < 32; ++i) { ta[i] = pa[i * sa]; tb[i] = pb[i * sb]; }
    tr_store(A, scr, ta, lane);
    if (hasB) tr_store(B, scr, tb, lane);
}
__device__ __forceinline__ void tr_item(const float* W, int ldn, int k0, int n0, bf16* WT, size_t dst_row0, int ldk, LAS float* scr, int lane) {
    const TrItem A{W, ldn, k0, n0, WT, dst_row0, ldk}; tr_pair(A, A, false, scr, lane);
}
__device__ __forceinline__ void rms_row_to_bf16(const float* xrow, const float* w, bf16* orow, int lane) {
    const GAS pg8::f32x4* xr = (const GAS pg8::f32x4*)xrow + lane; const GAS pg8::f32x4* wr = (const GAS pg8::f32x4*)w + lane;
    pg8::f32x4 v[8]; float s = 0.f;
#pragma unroll
    for (int j = 0; j < 8; ++j) { v[j] = xr[64 * j]; s += (v[j].x * v[j].x + v[j].y * v[j].y) + (v[j].z * v[j].z + v[j].w * v[j].w); }
    const float r = rsqrtf(wave_sum(s) * (1.f / DM) + EPS);
    GAS unsigned long long* o8 = (GAS unsigned long long*)orow + lane;
#pragma unroll
    for (int j = 0; j < 8; ++j) { const pg8::f32x4 g = wr[64 * j];
        o8[64 * j] = (unsigned long long)pk2(v[j].x * r * g.x, v[j].y * r * g.y) | ((unsigned long long)pk2(v[j].z * r * g.z, v[j].w * r * g.w) << 32); }
}

__device__ __forceinline__ void rms_rows2_to_bf16(const float* xrow, const float* w, bf16* orow, int lane) {
    const GAS pg8::f32x4* xr = (const GAS pg8::f32x4*)xrow + lane; const GAS pg8::f32x4* wr = (const GAS pg8::f32x4*)w + lane;
    pg8::f32x4 v[2][8], g[8];
#pragma unroll
    for (int q = 0; q < 2; ++q)
#pragma unroll
        for (int j = 0; j < 8; ++j) v[q][j] = xr[q * (DM / 4) + 64 * j];
#pragma unroll
    for (int j = 0; j < 8; ++j) g[j] = wr[64 * j];
#pragma unroll
    for (int q = 0; q < 2; ++q) { float s = 0.f;
#pragma unroll
        for (int j = 0; j < 8; ++j) s += (v[q][j].x * v[q][j].x + v[q][j].y * v[q][j].y) + (v[q][j].z * v[q][j].z + v[q][j].w * v[q][j].w);
        const float r = rsqrtf(wave_sum(s) * (1.f / DM) + EPS);
        GAS unsigned long long* o8 = (GAS unsigned long long*)(orow + (size_t)q * DM) + lane;
#pragma unroll
        for (int j = 0; j < 8; ++j) o8[64 * j] = (unsigned long long)pk2(v[q][j].x * r * g[j].x, v[q][j].y * r * g[j].y) | ((unsigned long long)pk2(v[q][j].z * r * g[j].z, v[q][j].w * r * g[j].w) << 32); }
}

__global__ void __launch_bounds__(NWAVES * 64, 2) fwd(Args args) {
    extern __shared__ __attribute__((aligned(16))) unsigned char lds_raw[];
    LAS unsigned char* lds = (LAS unsigned char*)lds_raw;
    const int tid = threadIdx.x, lane = tid & 63, wave = __builtin_amdgcn_readfirstlane(tid >> 6);
    const int G = gridDim.x; const int bx = blockIdx.x; const int vcu = (G % 8 == 0) ? (bx % 8) * (G / 8) + bx / 8 : bx;
    unsigned char* ws = args.ws;
    unsigned* ctl = (unsigned*)(ws + WS_CTL);
    for (int u = tid; u < (LDS_BYTES - LDSCTL_OFF) / 4; u += NWAVES * 64) ((LAS unsigned*)(lds + LDSCTL_OFF))[u] = 0u;
    __syncthreads();
    XcdBarrier bar = xcd_barrier_post(ctl + CW_BAR + args.li * XCD_BAR_WORDS, (volatile LAS unsigned*)(lds + LDSCTL_OFF + 64));
    static_assert(2 * FFT_BUF_BYTES <= LDSCTL_OFF && 1024 * 33 * 4 <= LDSCTL_OFF, "LDS map");
    const int lo = args.ph_lo, hi = args.ph_hi;
#if 0
#define MK_DUP_MASK 0
#endif
#define IN(k) (lo <= (k) && (k) < hi)
#define BOTH(k) (IN(k) && IN((k) + 1))
    bf16* WinT = (bf16*)(ws + WS_WINT); bf16* Hb = (bf16*)(ws + WS_HB);

    if (IN(0)) { REP(0) {
        int tid_p = tid; asm volatile("" : "+v"(tid_p)); const int lane_p = tid_p & 63; (void)lane_p;
        LAS float* scr = (LAS float*)(lds + wave * 16384);
        const int gw = vcu * NWAVES + wave, NGW = G * NWAVES;
        for (int it = bx; it < 256; it += G)
            hyena_filter_item(lds, it, args.in[5], args.in[6], args.in[7], args.in[8], args.in[9], args.in[10], args.in[11], args.in[12], (float*)(ws + WS_KC), tid_p, lane_p, wave);
        const float* w_in = args.in[2];
        { bf16* WoutT = (bf16*)(ws + WS_WOUTT); const float* w_out = args.in[21];
          auto mk = [&](int it) -> TrItem { if (it < 32 * 225) { const int kb = it / 225, nb = it % 225; return TrItem{w_in, NPROJ, 64 * kb, 32 * nb, WinT, (size_t)(32 * nb), DM}; }
                                           const int j = it - 32 * 225, kb = j >> 6, nb = j & 63; return TrItem{w_out, DM, 64 * kb, 32 * nb, WoutT, (size_t)(32 * nb), DM}; };
          for (int p = gw; p < (32 * 225 + 32 * 64) / 2; p += NGW) tr_pair(mk(2 * p), mk(2 * p + 1), true, scr, lane); }
        for (int r = gw; r < NPROJ_PAD - NPROJ; r += NGW) { GAS v4u* o = (GAS v4u*)(WinT + (size_t)(NPROJ + r) * DM) + lane;
#pragma unroll
            for (int j = 0; j < 4; ++j) o[64 * j] = (v4u){0u, 0u, 0u, 0u}; }
        { bf16* RWh = (bf16*)(ws + WS_SMALL + SM_RWT); bf16* RWl = RWh + 80 * 2048; const float* rgw = args.in[23]; const float* rew = args.in[25];
          for (int i = vcu * 512 + tid; i < 80 * 2048; i += G * 512) { const int n = i >> 11, k = i & 2047;
              const float w = n < 8 ? rgw[k * 8 + n] : (n < 72 ? rew[k * 64 + n - 8] : 0.f); const unsigned h = f2bf(w); const float hf = __builtin_bit_cast(float, h << 16);
              const int kk = k & 31, o = (i & ~31) + 8 * ((kk & 15) >> 2) + (kk & 3) + ((kk >> 4) << 2);
              RWh[o] = (bf16)h; RWl[o] = (bf16)f2bf(w - hf); } }
        for (int m = 2 * gw; m < T; m += 2 * NGW) rms_rows2_to_bf16(args.in[0] + (size_t)m * DM, args.in[1], Hb + (size_t)m * DM, lane);
        }
        if (BOTH(0)) xcd_barrier(bar);
    }
    if (IN(1)) { REP(1) {
        int tid_p = tid; asm volatile("" : "+v"(tid_p)); const int lane_p = tid_p & 63; (void)lane_p;
        Order1 S{(const char*)Hb, (const char*)WinT, G, bx};
        Epi1 E{(bf16*)(ws + WS_PG), (float*)(ws + WS_PGATE), (float*)(ws + WS_PT)};
        pg8::gemm_phase<Epi1, Order1, false>(lds, DM, S, E, tid_p);
        }
        if (BOTH(1)) xcd_barrier(bar);
    }
    if (IN(2)) { REP(2) {
        int tid_p = tid; asm volatile("" : "+v"(tid_p)); const int lane_p = tid_p & 63; (void)lane_p;
        REP(11) hyena_phase(lds, (const float*)(ws + WS_PT), (const float*)(ws + WS_KC), args.in[3], args.in[4], args.in[13], (float*)(ws + WS_YHT), G, vcu);
        REP(12) for (int wg = bx; wg < 256; wg += G) {
            int tid_i = tid_p; asm volatile("" : "+v"(tid_i)); const int lane_i = tid_i & 63;
            gdn_pre(lds, wg, (const bf16*)(ws + WS_PG), (const float*)(ws + WS_PGATE), args.in[15], args.in[16], args.in[17], args.in[18], args.in[19], ws, tid_i, lane_i, wave);
            gdn_prep_wave(lds, wg, ws, lane_i, wave);
            __syncthreads();
        }
        }
        if (BOTH(2)) xcd_barrier(bar);
    }
    if (IN(3)) { REP(3) {
        int tid_p = tid; asm volatile("" : "+v"(tid_p)); const int lane_p = tid_p & 63; (void)lane_p;
        for (int v = vcu; v < 256; v += G) gdn_scan(lds, ws, (bf16*)(ws + WS_OF), (bf16*)(ws + WS_OB), v, tid_p, lane_p, wave);
        }
        if (BOTH(3)) xcd_barrier(bar);
    }
    if (IN(4)) { REP(4) {
        int tid_p = tid; asm volatile("" : "+v"(tid_p)); const int lane_p = tid_p & 63; (void)lane_p;
        for (int tile = bx; tile < T / 32; tile += G) hyena_post_tile(lds, tile, (const float*)(ws + WS_YHT), args.in[14], (bf16*)(ws + WS_A2), tid_p, lane_p, wave);
        for (int it = (vcu * NWAVES + wave) * 8; it < T * 8; it += G * NWAVES * 8) gdn_post_batch(it, (const bf16*)(ws + WS_OF), (const bf16*)(ws + WS_OB), (const bf16*)(ws + WS_PG), args.in[20], (bf16*)(ws + WS_A2), lane_p);
        }
        if (BOTH(4)) xcd_barrier(bar);
    }
    if (IN(5)) { REP(5) {
        int tid_p = tid; asm volatile("" : "+v"(tid_p)); const int lane_p = tid_p & 63; (void)lane_p;
        Order2 S{(const char*)(ws + WS_A2), (const char*)(ws + WS_WOUTT), G, bx};
        Epi2 E{args.in[0], (float*)(ws + WS_X1)};
        pg8::gemm_phase<Epi2, Order2, false>(lds, DM, S, E, tid_p);
        }
        if (BOTH(5)) xcd_barrier(bar);
    }
    if (IN(6)) {
        int tid_p = tid; asm volatile("" : "+v"(tid_p)); const int lane_p = tid_p & 63; (void)lane_p;
        REP(6) for (int wg = bx; wg < 256; wg += G) { route_phase(lds, wg, (const float*)(ws + WS_X1), args.in[22], args.in[24], args.in[26], ws, ctl + CW_CNT + rep_ * 128, tid_p, lane_p, wave); __syncthreads(); }
        if (BOTH(6)) xcd_barrier(bar);
    }
    if (IN(7)) {
        int tid_p = tid; asm volatile("" : "+v"(tid_p)); const int lane_p = tid_p & 63; (void)lane_p;
        REP(7) for (int wg = bx; wg < 256; wg += G) fill_phase(lds, wg, ws, ctl + CW_CNT, tid_p);
        if (BOTH(7)) xcd_barrier(bar);
    }
    const int* slot_tok = (const int*)(ws + WS_SMALL + SM_SLOTTOK); const int* blk_exp = (const int*)(ws + WS_SMALL + SM_BLKEXP); const int* nblk_p = (const int*)(ws + WS_SMALL + SM_NBLK);
    if (IN(8)) { REP(8) {
        int tid_p = tid; asm volatile("" : "+v"(tid_p)); const int lane_p = tid_p & 63; (void)lane_p;
        const int nblk = __hip_atomic_load(nblk_p, __ATOMIC_RELAXED, __HIP_MEMORY_SCOPE_AGENT);
        moe_gemm<true>(lds, ws, args.in[27], args.in[28], ctl + CW_Q8 + rep_ * 32, ctl + CW_DONE, nblk, tid_p);
        }
    }
    if (IN(9)) { REP(9) {
        int tid_p = tid; asm volatile("" : "+v"(tid_p)); const int lane_p = tid_p & 63; (void)lane_p;
        const int nblk = __hip_atomic_load(nblk_p, __ATOMIC_RELAXED, __HIP_MEMORY_SCOPE_AGENT);
        moe_gemm<false>(lds, ws, args.in[29], nullptr, ctl + CW_Q9 + rep_ * 32, ctl + CW_DONE, nblk, tid_p);
        }
        if (BOTH(9)) xcd_barrier(bar);
    }
    if (IN(10)) { REP(10) {
        int tid_p = tid; asm volatile("" : "+v"(tid_p)); const int lane_p = tid_p & 63; (void)lane_p;
        for (int t = (vcu * NWAVES + wave) * 2; t < T; t += G * NWAVES * 2) final_rows(t, (const float*)(ws + WS_X1), (const bf16*)(ws + WS_Y), ws, args.in[30], args.out, lane_p);
    }
    }
#undef IN
#undef BOTH
}

#ifndef MK_PER_PHASE
#define MK_PER_PHASE 0
#endif
constexpr int N_PHASES = 11;
extern "C" void kernel_launch(void* const* d_in, const int* in_sizes, int n_in, void* d_out, int out_size, void* d_ws, size_t ws_size, hipStream_t stream) {
    static int grid = 0;
    if (grid == 0) {
        int dev = 0, cus = 0;
        (void)hipGetDevice(&dev); (void)hipDeviceGetAttribute(&cus, hipDeviceAttributeMultiprocessorCount, dev);
        (void)hipFuncSetAttribute((const void*)fwd, hipFuncAttributeMaxDynamicSharedMemorySize, LDS_BYTES);
        int per_cu = 0; (void)hipOccupancyMaxActiveBlocksPerMultiprocessor(&per_cu, (const void*)fwd, NWAVES * 64, LDS_BYTES);
        (void)hipGetLastError();
        grid = cus > 0 ? cus : 256;
    }
    (void)hipMemsetAsync((char*)d_ws + WS_CTL, 0, CTL_ZERO_BYTES, stream);
    Args a{};
    for (int i = 0; i < 31; ++i) a.in[i] = (const float*)d_in[i];
    a.out = (float*)d_out; a.ws = (unsigned char*)d_ws;
#if MK_PER_PHASE
    for (int p = 0; p < N_PHASES; ++p) { a.ph_lo = p; a.ph_hi = p + 1; a.li = 0; hipLaunchKernelGGL(fwd, dim3(grid), dim3(NWAVES * 64), LDS_BYTES, stream, a); }
#else
    a.ph_lo = 0; a.ph_hi = N_PHASES; a.li = 0;
    hipLaunchKernelGGL(fwd, dim3(grid), dim3(NWAVES * 64), LDS_BYTES, stream, a);
#endif
}
```

```cpp
#include <hip/hip_runtime.h>
#include <cstdio>
#include <cstdint>
#include <cmath>

constexpr int BATCH = 2, LSEQ = 4096, DM = 2048, T = BATCH * LSEQ;
constexpr int DHY = 1024, DGD = 1024, NH = 8, HD = 128;
constexpr int NPROJ = 3 * DHY + 4 * DGD + 4 * NH;
constexpr int GOFF = 3 * DHY;
constexpr int NPROJ_PAD = 7424;
constexpr int NG = 8, EPG = 8, NE = 64, DE = 512;
constexpr int RB = 256, PMAX = 32768, NBLK_MAX = 128;
constexpr float EPS = 1e-6f;

constexpr size_t MiB = 1u << 20;
constexpr size_t WS_CTL = 0;
constexpr size_t CTL_ZERO_BYTES = 1 * MiB;
constexpr size_t WS_SMALL = 2 * MiB;
constexpr size_t WS_WINT = 16 * MiB;
constexpr size_t WS_WOUTT = 608 * MiB;
constexpr size_t WS_HB = 56 * MiB;
constexpr size_t WS_PT = 88 * MiB;
constexpr size_t WS_PG = 184 * MiB;
constexpr size_t WS_PGATE = 248 * MiB;
constexpr size_t WS_A2 = 250 * MiB;
constexpr size_t WS_KC = 282 * MiB;
constexpr size_t WS_YHT = 314 * MiB;
constexpr size_t WS_X0 = 314 * MiB, WS_VG = 346 * MiB, WS_YH = 378 * MiB;
constexpr size_t WS_QN = 16 * MiB, WS_KN = 32 * MiB, WS_KT = 48 * MiB, WS_VT = 64 * MiB;
constexpr size_t WS_V = 346 * MiB, WS_OF = 378 * MiB, WS_OB = 410 * MiB;
constexpr size_t GW_B = 64 * 272, GKDT_B = 128 * 144, GQK_B = 64 * 144, GUT_B = 128 * 128;
constexpr size_t WS_GW = 442 * MiB;
constexpr size_t WS_GQD = WS_GW + 2048 * GW_B;
constexpr size_t WS_GKDT = WS_GQD + 2048 * GW_B;
constexpr size_t WS_GQK = WS_GKDT + 2048 * GKDT_B;
constexpr size_t WS_GUT = WS_GQK + 2048 * GQK_B;
constexpr size_t WS_GCD = WS_GUT + 2048 * GUT_B + 4096;
static_assert(WS_GCD + 2048 * 4 <= 640 * MiB, "ws map");
constexpr size_t WS_W13T = 640 * MiB;
constexpr size_t WS_W2T = 896 * MiB;
constexpr size_t WS_X1 = 282 * MiB;
constexpr size_t WS_U = 346 * MiB;
constexpr size_t WS_UB = 412 * MiB;
constexpr size_t WS_HH = 446 * MiB;
constexpr size_t WS_Y = 88 * MiB;
constexpr int CW_CNT = 0;
constexpr int CW_Q8 = 1024, CW_Q9 = 2048;
constexpr int CW_DONE = 3072;
constexpr int CW_BAR = 4096;
constexpr size_t SM_LOGITS = 0;
constexpr size_t SM_GB = SM_LOGITS + (size_t)T * 72 * 4;
constexpr size_t SM_EID = SM_GB + (size_t)4 * T * 8 * 4;
constexpr size_t SM_GATE = SM_EID + (size_t)T * 2 * 4;
constexpr size_t SM_POS = SM_GATE + (size_t)T * 2 * 4;
constexpr size_t SM_TSLOT = SM_POS + (size_t)T * 2 * 4;
constexpr size_t SM_SLOTTOK = SM_TSLOT + (size_t)T * 2 * 4;
constexpr size_t SM_BLKEXP = SM_SLOTTOK + (size_t)PMAX * 4;
constexpr size_t SM_PADSTART = SM_BLKEXP + NBLK_MAX * 4;
constexpr size_t SM_NBLK = SM_PADSTART + NE * 4;
constexpr size_t SM_RWT = (SM_NBLK + 256 + 255) / 256 * 256;
static_assert(SM_RWT + 2 * 80 * 2048 * 2 <= 14 * MiB, "small region");

#define LAS __attribute__((address_space(3)))
#define GAS __attribute__((address_space(1)))
typedef unsigned short bf16;
typedef unsigned v4u __attribute__((ext_vector_type(4)));

__device__ __forceinline__ float dpp_f(float v, const int ctrl_unused) { return v; }
#define WS_DPP(v, ctrl) __builtin_bit_cast(float, __builtin_amdgcn_update_dpp(0, __builtin_bit_cast(int, (v)), (ctrl), 0xF, 0xF, true))
__device__ __forceinline__ float wave_sum(float v) {
    v += WS_DPP(v, 0xB1);
    v += WS_DPP(v, 0x4E);
    v += WS_DPP(v, 0x141);
    v += WS_DPP(v, 0x140);
    v += __shfl_xor(v, 16); v += __shfl_xor(v, 32);
    return v;
}
__device__ __forceinline__ float silu_f(float x) { return x * __builtin_amdgcn_rcpf(1.f + __expf(-x)); }
__device__ __forceinline__ float sigmoid_f(float x) { return __builtin_amdgcn_rcpf(1.f + __expf(-x)); }
__device__ __forceinline__ float softplus_f(float x) { return fmaxf(x, 0.f) + log1pf(expf(-fabsf(x))); }
__device__ __forceinline__ unsigned f2bf(float f) { unsigned u = __builtin_bit_cast(unsigned, f); return (u + 0x7fffu + ((u >> 16) & 1u)) >> 16; }
typedef float pk2_f2 __attribute__((ext_vector_type(2)));
typedef __bf16 pk2_b2 __attribute__((ext_vector_type(2)));
__device__ __forceinline__ unsigned pk2(float lo, float hi) { const pk2_f2 f = {lo, hi}; return __builtin_bit_cast(unsigned, __builtin_convertvector(f, pk2_b2)); }
__device__ __forceinline__ float bf2f(bf16 b) { return __builtin_bit_cast(float, ((unsigned)b) << 16); }

#ifndef MK_DUP_MASK
#define MK_DUP_MASK 0
#endif
#define REP(k) _Pragma("unroll 1") for (int rep_ = 0; rep_ < (((MK_DUP_MASK) >> (k)) & 1) + 1; ++rep_)
constexpr int LDSCTL_OFF_C = 147456 - 256;
namespace pg8 {
#define PG8_LAS __attribute__((address_space(3)))
typedef unsigned short bf16_t;
typedef short bf16x8 __attribute__((ext_vector_type(8)));
typedef float f32x4 __attribute__((ext_vector_type(4)));
typedef unsigned u32x4 __attribute__((ext_vector_type(4)));
constexpr int BM = 256, BK = 64, HALF = 128, HTB = HALF * BK * 2  , STAGE_BYTES = 8 * HTB, NXCD = 8, WGM = 8;

__host__ __device__ __forceinline__ int lds_byte(int r, int c) { const int st = (r >> 4) * 2 + (c >> 5), rr = r & 15, cc = c & 31, ob = rr * 64 + cc * 2; return st * 1024 + (ob ^ (((ob >> 9) & 1) << 5)); }
__host__ __device__ __forceinline__ void stage_rc(int b, int& R, int& C) { const int st = b / 1024, sb = b % 1024, swz = sb ^ (((sb >> 9) & 1) << 5); R = (st >> 1) * 16 + swz / 64; C = (st & 1) * 32 + (swz % 64) / 2; }
__host__ __device__ __forceinline__ int perm32(int rho) { const int n = rho >> 4, i = rho & 15; return 8 * (i >> 2) + 4 * n + (i & 3); }

struct Unit { const char* A; const char* B; const int* rows; int pm, pn, kind; };

__device__ __forceinline__ void tile_of(int L, int nM, int nN, int& pm, int& pn) {
    const int nwg = nM * nN;
    int wgid = L; { const int q = nwg / NXCD, r = nwg % NXCD, xcd = wgid % NXCD, off = wgid / NXCD; wgid = (xcd < r ? xcd * (q + 1) : r * (q + 1) + (xcd - r) * q) + off; }
    const int nig = WGM * nN, gid = wgid / nig, fm = gid * WGM, gsz = (nM - fm) < WGM ? (nM - fm) : WGM;
    pm = fm + ((wgid % nig) % gsz); pn = (wgid % nig) / gsz;
}

typedef float cvt_f2 __attribute__((ext_vector_type(2)));
typedef __bf16 cvt_b2 __attribute__((ext_vector_type(2)));
__device__ __forceinline__ unsigned cvt_pk_bf16(float lo, float hi) { const cvt_f2 f = {lo, hi}; const cvt_b2 v = __builtin_convertvector(f, cvt_b2); return __builtin_bit_cast(unsigned, v); }

template <class Epi, class Sched, bool GATHER>
__device__ __forceinline__ void gemm_phase(PG8_LAS unsigned char* lds, const int K, const Sched& S, const Epi& E, const int tid) {
    const int wid = __builtin_amdgcn_readfirstlane(tid >> 6), lane = tid & 63, wr = wid >> 2, wc = wid & 3, fr = lane & 15, fq = lane >> 4;
    const int nt = K / BK;
    int Rr[2], Cc[2];
    unsigned voffB[2];
#pragma unroll
    for (int i = 0; i < 2; ++i) { stage_rc(tid * 16 + i * 8192, Rr[i], Cc[i]); const int Rb = (Rr[i] & ~31) + perm32(Rr[i] & 31); voffB[i] = (unsigned)(Rb * K + Cc[i]) * 2u; }
    const size_t kstep = (size_t)(BK * 2);
    const size_t hstep = (size_t)HALF * K * 2;
    const unsigned ldsw = (unsigned)wid * 1024u;
    const int aoff = lds_byte(wr * 64 + fr, fq * 8), boff = lds_byte(wc * 32 + fr, fq * 8);
#define PG8_SA(b, h) (((b) * 2 + (h)) * HTB)
#define PG8_SB(b, h) ((4 + (b) * 2 + (h)) * HTB)
#define PG8_STAGE2(bufoff, gbase, v0, v1) do { \
        __builtin_amdgcn_global_load_lds((const unsigned*)((const char*)(gbase) + (v0)), (PG8_LAS unsigned*)(lds + (bufoff) + ldsw), 16, 0, 0); \
        __builtin_amdgcn_global_load_lds((const unsigned*)((const char*)(gbase) + (v1)), (PG8_LAS unsigned*)(lds + (bufoff) + ldsw + 8192), 16, 0, 0); } while (0)
#define PG8_STAGEB(bufoff, gbase) PG8_STAGE2(bufoff, gbase, voffB[0], voffB[1])
#define PG8_LDA(dst, b, h) do { _Pragma("unroll") for (int m = 0; m < 4; ++m) _Pragma("unroll") for (int k = 0; k < 2; ++k) dst[m][k] = *(const PG8_LAS bf16x8*)(lds + PG8_SA(b, h) + aoff + m * 2048 + k * 1024); } while (0)
#define PG8_LDB(dst, b, h) do { _Pragma("unroll") for (int n = 0; n < 2; ++n) _Pragma("unroll") for (int k = 0; k < 2; ++k) dst[n][k] = *(const PG8_LAS bf16x8*)(lds + PG8_SB(b, h) + boff + n * 2048 + k * 1024); } while (0)
#define PG8_MMA(ai, bj, At, Bt) do { __builtin_amdgcn_s_setprio(1); _Pragma("unroll") for (int m = 0; m < 4; ++m) _Pragma("unroll") for (int n = 0; n < 2; ++n) _Pragma("unroll") for (int k = 0; k < 2; ++k) \
        acc[ai][bj][m][n] = __builtin_amdgcn_mfma_f32_16x16x32_bf16(Bt[n][k], At[m][k], acc[ai][bj][m][n], 0, 0, 0); __builtin_amdgcn_s_setprio(0); } while (0)
#define PG8_WAIT_V(n) asm volatile("s_waitcnt vmcnt(" #n ")" ::: "memory")
#define PG8_WAIT_L(n) asm volatile("s_waitcnt lgkmcnt(" #n ")" ::: "memory")
#define PG8_BAR __builtin_amdgcn_s_barrier()
#define PG8_SCHED __builtin_amdgcn_sched_barrier(0)
    Unit cur, nxt; int ui = 0;
    if (!S.next(0, cur)) return;
    f32x4 acc[2][2][4][2];
#pragma unroll
    for (int a = 0; a < 2; ++a)
#pragma unroll
        for (int b = 0; b < 2; ++b)
#pragma unroll
            for (int m = 0; m < 4; ++m)
#pragma unroll
                for (int n = 0; n < 2; ++n) acc[a][b][m][n] = (f32x4){0.f, 0.f, 0.f, 0.f};
    bf16x8 At[4][2], B0[2][2], B1[2][2];
    unsigned c00, c01, c10, c11, n00, n01, n10, n11;
    if constexpr (GATHER) {
        c00 = (unsigned)cur.rows[Rr[0]] * (unsigned)(K * 2) + (unsigned)Cc[0] * 2u; c01 = (unsigned)cur.rows[Rr[1]] * (unsigned)(K * 2) + (unsigned)Cc[1] * 2u;
        c10 = (unsigned)cur.rows[128 + Rr[0]] * (unsigned)(K * 2) + (unsigned)Cc[0] * 2u; c11 = (unsigned)cur.rows[128 + Rr[1]] * (unsigned)(K * 2) + (unsigned)Cc[1] * 2u;
    } else {
        c00 = (unsigned)(Rr[0] * K + Cc[0]) * 2u; c01 = (unsigned)(Rr[1] * K + Cc[1]) * 2u;
        c10 = c00 + (unsigned)hstep; c11 = c01 + (unsigned)hstep;
    }
    n00 = c00; n01 = c01; n10 = c10; n11 = c11;
    const char* cA = cur.A; const char* cB = cur.B;
    PG8_STAGEB(PG8_SB(0, 0), cB); PG8_STAGEB(PG8_SB(0, 1), cB + hstep); PG8_STAGE2(PG8_SA(0, 0), cA, c00, c01); PG8_STAGE2(PG8_SA(0, 1), cA, c10, c11);
    if (wr == 1) PG8_BAR;
    PG8_WAIT_V(2); PG8_BAR;
    PG8_STAGEB(PG8_SB(1, 0), cB + kstep); PG8_STAGE2(PG8_SA(1, 0), cA + kstep, c00, c01); PG8_STAGEB(PG8_SB(1, 1), cB + hstep + kstep);
    PG8_WAIT_V(6); PG8_BAR;
    for (;;) {
        const bool has_next = S.next(ui + 1, nxt);
        const char* nA = has_next ? nxt.A : cA; const char* nB = has_next ? nxt.B : cB;
        if constexpr (GATHER) {
            if (has_next) {
                n00 = (unsigned)nxt.rows[Rr[0]] * (unsigned)(K * 2) + (unsigned)Cc[0] * 2u; n01 = (unsigned)nxt.rows[Rr[1]] * (unsigned)(K * 2) + (unsigned)Cc[1] * 2u;
                n10 = (unsigned)nxt.rows[128 + Rr[0]] * (unsigned)(K * 2) + (unsigned)Cc[0] * 2u; n11 = (unsigned)nxt.rows[128 + Rr[1]] * (unsigned)(K * 2) + (unsigned)Cc[1] * 2u;
            } else { n00 = c00; n01 = c01; n10 = c10; n11 = c11; }
        }
        for (int t = 0; t < nt; t += 2) {
            const bool last = (t == nt - 2);
            const char* a1 = cA + (size_t)(t + 1) * kstep;
            const char* a2 = last ? nA : cA + (size_t)(t + 2) * kstep; const char* b2 = last ? nB : cB + (size_t)(t + 2) * kstep;
            const char* a3 = a2 + kstep; const char* b3 = b2 + kstep;
            unsigned e00, e01, e10, e11;
            if constexpr (GATHER) { e00 = last ? n00 : c00; e01 = last ? n01 : c01; e10 = last ? n10 : c10; e11 = last ? n11 : c11; } else { e00 = c00; e01 = c01; e10 = c10; e11 = c11; }
            PG8_LDB(B0, 0, 0); PG8_LDB(B1, 0, 1); PG8_SCHED; PG8_LDA(At, 0, 0); PG8_STAGE2(PG8_SA(1, 1), a1, c10, c11);
            PG8_WAIT_V(8); PG8_WAIT_L(0); PG8_BAR; PG8_MMA(0, 0, At, B0); PG8_MMA(0, 1, At, B1); PG8_BAR; PG8_SCHED;
            PG8_LDA(At, 0, 1); PG8_STAGEB(PG8_SB(0, 0), b2); PG8_STAGEB(PG8_SB(0, 1), b2 + hstep); PG8_STAGE2(PG8_SA(0, 0), a2, e00, e01);
            PG8_WAIT_V(8); PG8_WAIT_L(0); PG8_BAR; PG8_MMA(1, 0, At, B0); PG8_MMA(1, 1, At, B1); PG8_BAR; PG8_SCHED;
            PG8_LDB(B0, 1, 0); PG8_LDB(B1, 1, 1); PG8_SCHED; PG8_LDA(At, 1, 0); PG8_STAGE2(PG8_SA(0, 1), a2, e10, e11);
            PG8_WAIT_V(8); PG8_WAIT_L(0); PG8_BAR; PG8_MMA(0, 0, At, B0); PG8_MMA(0, 1, At, B1); PG8_BAR; PG8_SCHED;
            PG8_LDA(At, 1, 1); PG8_STAGEB(PG8_SB(1, 0), b3); PG8_STAGEB(PG8_SB(1, 1), b3 + hstep); PG8_STAGE2(PG8_SA(1, 0), a3, e00, e01);
            PG8_WAIT_V(8); PG8_WAIT_L(0); PG8_BAR; PG8_MMA(1, 0, At, B0); PG8_MMA(1, 1, At, B1); PG8_BAR; PG8_SCHED;
        }
        if (wr == 0) PG8_BAR;
        E(acc, cur, wr, wc, fr, fq);
        if (!has_next) break;
#pragma unroll
        for (int a = 0; a < 2; ++a)
#pragma unroll
            for (int b = 0; b < 2; ++b)
#pragma unroll
                for (int m = 0; m < 4; ++m)
#pragma unroll
                    for (int n = 0; n < 2; ++n) acc[a][b][m][n] = (f32x4){0.f, 0.f, 0.f, 0.f};
        cur = nxt; cA = nA; cB = nB; ++ui;
        if constexpr (GATHER) { c00 = n00; c01 = n01; c10 = n10; c11 = n11; }
        if (wr == 1) PG8_BAR;
    }
    PG8_WAIT_V(0);
    PG8_BAR;
#undef PG8_SA
#undef PG8_SB
#undef PG8_STAGE2
#undef PG8_STAGEB
#undef PG8_LDA
#undef PG8_LDB
#undef PG8_MMA
#undef PG8_WAIT_V
#undef PG8_WAIT_L
#undef PG8_BAR
#undef PG8_SCHED
}
}

#define XB_TMO      128
#define XB_XCNT(j)  (256  + 64 * (j))
#define XB_XSUB(j)  (1280 + 64 * (j))
#define XB_XGEN(j)  (2304 + 64 * (j))
#define XB_TOP      3328
#define XB_TOPGEN   3392
#define XCD_BAR_WORDS 3456
#define XB_SPIN_CAP (1u << 18)
__device__ __forceinline__ unsigned xb_ld(unsigned* p)              { return __hip_atomic_load(p, __ATOMIC_RELAXED, __HIP_MEMORY_SCOPE_AGENT); }
__device__ __forceinline__ unsigned xb_add(unsigned* p, unsigned v) { return __hip_atomic_fetch_add(p, v, __ATOMIC_RELAXED, __HIP_MEMORY_SCOPE_AGENT); }
__device__ __forceinline__ unsigned xb_xcc_id() { return (unsigned)__builtin_amdgcn_s_getreg((3 << 11) | 20) & 0xFu; }
#define XB_SPIN(cond, bar) do { unsigned _sp = 0; while (cond) { __builtin_amdgcn_s_sleep(1); \
    if ((++_sp & 255u) == 0u) { if (xb_ld(&(bar)[XB_TMO])) break; if (_sp > XB_SPIN_CAP) { atomicAdd(&(bar)[XB_TMO], 1u); break; } } } } while (0)
struct XcdBarrier { unsigned* bar; unsigned x; volatile LAS unsigned* st; };
__device__ __forceinline__ XcdBarrier xcd_barrier_post(unsigned* bar, volatile LAS unsigned* st) {
    XcdBarrier b; b.bar = bar; b.x = xb_xcc_id(); b.st = st;
    if (threadIdx.x == 0) (void)xb_add(&bar[XB_XCNT(b.x)], 1u);
    return b;
}
__device__ __forceinline__ void xcd_barrier_complete(unsigned* bar, unsigned x, unsigned& nloc, unsigned& nx) {
    const unsigned G = gridDim.x * gridDim.y * gridDim.z;
    unsigned sum, cnt, mine, sp = 0u;
    for (;;) {
        sum = 0u; cnt = 0u; mine = 0u;
#pragma unroll
        for (unsigned j = 0; j < 16; ++j) { const unsigned c = xb_ld(&bar[XB_XCNT(j)]); sum += c; cnt += (c > 0u) ? 1u : 0u; mine = (j == x) ? c : mine; }
        if (sum == G) break;
        __builtin_amdgcn_s_sleep(1);
        if ((++sp & 255u) == 0u) { if (xb_ld(&bar[XB_TMO])) break; if (sp > XB_SPIN_CAP) { atomicAdd(&bar[XB_TMO], 1u); break; } }
    }
    nloc = mine > 0u ? mine : 1u; nx = cnt > 0u ? cnt : 1u;
}
__device__ __forceinline__ void xcd_barrier(const XcdBarrier& b) {
    asm volatile("s_waitcnt vmcnt(0)" ::: "memory");
    __syncthreads();
    if (threadIdx.x == 0) {
        unsigned* bar = b.bar;
        __builtin_amdgcn_s_waitcnt(0);
        unsigned nloc = b.st[0], nx = b.st[1];
        if (nloc == 0u) { xcd_barrier_complete(bar, b.x, nloc, nx); b.st[0] = nloc; b.st[1] = nx; }
        const unsigned old = xb_add(&bar[XB_XSUB(b.x)], 1u);
        const unsigned gen = old / nloc;
        if (old + 1u == (gen + 1u) * nloc) {
            __builtin_amdgcn_fence(__ATOMIC_RELEASE, "agent");
            asm volatile("s_waitcnt vmcnt(0)" ::: "memory");
            const unsigned og = xb_add(&bar[XB_TOP], 1u);
            const unsigned tg = og / nx;
            if (og + 1u == (tg + 1u) * nx) xb_add(&bar[XB_TOPGEN], 1u);
            else XB_SPIN(xb_ld(&bar[XB_TOPGEN]) == tg, bar);
            __builtin_amdgcn_fence(__ATOMIC_ACQUIRE, "agent");
            xb_add(&bar[XB_XGEN(b.x)], 1u);
            asm volatile("s_waitcnt vmcnt(0)" ::: "memory");
        } else {
            XB_SPIN(xb_ld(&bar[XB_XGEN(b.x)]) == gen, bar);
            __builtin_amdgcn_fence(__ATOMIC_ACQUIRE, "agent");
            asm volatile("s_waitcnt vmcnt(0)" ::: "memory");
        }
    }
    __syncthreads();
}


#define HD __device__ __forceinline__
struct cpx { float x, y; };
HD cpx cadd(cpx a, cpx b) { return cpx{a.x + b.x, a.y + b.y}; }
HD cpx csub(cpx a, cpx b) { return cpx{a.x - b.x, a.y - b.y}; }
HD cpx cmul(cpx a, cpx b) { return cpx{a.x * b.x - a.y * b.y, a.x * b.y + a.y * b.x}; }
HD cpx cconj(cpx a) { return cpx{a.x, -a.y}; }
HD int fft_pp(int p) { return p + 2 * (p >> 5); }
constexpr int FFT_N = 8192, FFT_BUF_BYTES = (FFT_N + 2 * (FFT_N >> 5)) * 8;

template <bool INV> HD cpx mul_w16(cpx d, int k) {
    const float C1 = 0.92387953251128674f, S1 = 0.38268343236508977f, R2 = 0.70710678118654752f;
    float c, s;
    switch (k & 15) {
        case 0: return d;
        case 4: return INV ? cpx{-d.y, d.x} : cpx{d.y, -d.x};
        case 8: return cpx{-d.x, -d.y};
        case 12: return INV ? cpx{d.y, -d.x} : cpx{-d.y, d.x};
        case 1: c = C1; s = S1; break;
        case 2: c = R2; s = R2; break;
        case 3: c = S1; s = C1; break;
        case 5: c = -S1; s = C1; break;
        case 6: c = -R2; s = R2; break;
        case 7: c = -C1; s = S1; break;
        case 9: c = -C1; s = -S1; break;
        case 10: c = -R2; s = -R2; break;
        case 11: c = -S1; s = -C1; break;
        case 13: c = S1; s = -C1; break;
        case 14: c = R2; s = -R2; break;
        default: c = C1; s = -S1; break;
    }
    if (INV) s = -s;
    return cpx{d.x * c + d.y * s, d.y * c - d.x * s};
}
template <bool INV, int HALF> HD void dft16_stage(cpx (&v)[16]) {
#pragma unroll
    for (int g = 0; g < 16; g += 2 * HALF) {
#pragma unroll
        for (int i = 0; i < HALF; ++i) {
            const cpx a = v[g + i], b = v[g + i + HALF];
            v[g + i] = cadd(a, b);
            v[g + i + HALF] = mul_w16<INV>(csub(a, b), i * (8 / HALF));
        }
    }
}
template <bool INV> HD void dft16(cpx (&v)[16]) {
    dft16_stage<INV, 8>(v); dft16_stage<INV, 4>(v); dft16_stage<INV, 2>(v); dft16_stage<INV, 1>(v);
    cpx t;
    t = v[1]; v[1] = v[8]; v[8] = t;   t = v[2]; v[2] = v[4]; v[4] = t;   t = v[3]; v[3] = v[12]; v[12] = t;
    t = v[5]; v[5] = v[10]; v[10] = t; t = v[7]; v[7] = v[14]; v[14] = t; t = v[11]; v[11] = v[13]; v[13] = t;
}
template <bool INV> HD void twiddle16(cpx (&v)[16], float frac) {
    float s, c;
    asm volatile("" : "+v"(frac));
#if defined(__HIP_DEVICE_COMPILE__)
    sincospif(2.0f * frac, &s, &c);
#else
    s = sinf(6.283185307179586f * frac); c = cosf(6.283185307179586f * frac);
#endif
    const cpx w1 = INV ? cpx{c, s} : cpx{c, -s};
    cpx w = w1;
#pragma unroll
    for (int q = 1; q < 16; ++q) { v[q] = cmul(v[q], w); if (q < 15) w = cmul(w, w1); }
}
HD int fft_k_of_p(int p) { return (p >> 9) + 16 * ((p >> 5) & 15) + 256 * (p & 31); }
HD int fft_p_of_k(int k) { return (k & 15) * 512 + ((k >> 4) & 15) * 32 + (k >> 8); }

typedef float f2v __attribute__((ext_vector_type(2)));
__device__ __forceinline__ cpx ldc(const LAS cpx* b, int i) { const f2v v = ((const LAS f2v*)b)[i]; return cpx{v.x, v.y}; }
__device__ __forceinline__ void stc(LAS cpx* b, int i, cpx v) { ((LAS f2v*)b)[i] = (f2v){v.x, v.y}; }
__device__ __forceinline__ float dpp_xor1(float v) { return __builtin_bit_cast(float, __builtin_amdgcn_update_dpp(0, __builtin_bit_cast(int, v), 0xB1, 0xF, 0xF, true)); }
__device__ __forceinline__ void fft_fwd_pass2(LAS cpx* buf, int t) {
    const int blk = t >> 5, r2 = t & 31; cpx v[16];
#pragma unroll
    for (int j = 0; j < 16; ++j) v[j] = ldc(buf, fft_pp(blk * 512 + j * 32 + r2));
    dft16<false>(v); twiddle16<false>(v, (float)r2 * (1.f / 512.f));
#pragma unroll
    for (int q = 0; q < 16; ++q) stc(buf, fft_pp(blk * 512 + q * 32 + r2), v[q]);
}
__device__ __forceinline__ void fft_fwd_pass3(const LAS cpx* buf, int t, cpx (&v)[16]) {
    const int b = t >> 1, r = t & 1;
#pragma unroll
    for (int j = 0; j < 16; ++j) v[j] = ldc(buf, fft_pp(b * 32 + 2 * j + r));
    dft16<false>(v); twiddle16<false>(v, (float)r * (1.f / 32.f));
#pragma unroll
    for (int q = 0; q < 16; ++q) { const float px = dpp_xor1(v[q].x), py = dpp_xor1(v[q].y);
        v[q] = r ? cpx{px - v[q].x, py - v[q].y} : cpx{v[q].x + px, v[q].y + py}; }
}
__device__ __forceinline__ float bload(__amdgpu_buffer_rsrc_t rs, int voff, int soff) { return __builtin_bit_cast(float, __builtin_amdgcn_raw_buffer_load_b32(rs, voff, soff, 0)); }
__device__ __forceinline__ float conv3_b(__amdgpu_buffer_rsrc_t rs, int voff, int e0, float w0, float w1, float w2, float bias, bool lo_ok, bool hi_ok) {
    const float xm = (e0 > 0) ? bload(rs, voff, e0 * 4 - 4) : bload(rs, voff - 4, 0);
    const float xc = bload(rs, voff, e0 * 4), xp = bload(rs, voff + 4, e0 * 4);
    return bias + w1 * xc + (lo_ok ? w0 * xm : 0.f) + (hi_ok ? w2 * xp : 0.f);
}
__device__ __forceinline__ void hyena_phase(LAS unsigned char* lds, const float* PT, const float* KC, const float* cw, const float* cb, const float* skip, float* YHT, int G, int vcu) {
    LAS cpx* Wb = (LAS cpx*)lds;
    LAS cpx* Lb = (LAS cpx*)(lds + FFT_BUF_BYTES);
    const int t0 = threadIdx.x;
#define HY_T() int t = t0; asm volatile("" : "+v"(t))
    for (int pair = vcu; pair < 512; pair += G) {
        const int c0 = 2 * pair;
        {
            HY_T();
            const __amdgpu_buffer_rsrc_t rsk = __builtin_amdgcn_make_buffer_rsrc((void*)(KC + (size_t)c0 * 8192), 0, 65536, 0x00020000);
            cpx v[16];
#pragma unroll
            for (int j = 0; j < 16; ++j) v[j] = cpx{bload(rsk, t * 4, j * 2048), bload(rsk, t * 4, 32768 + j * 2048)};
            dft16<false>(v); twiddle16<false>(v, (float)t * (1.f / 8192.f));
#pragma unroll
            for (int q = 0; q < 16; ++q) stc(Wb, fft_pp(q * 512 + t), v[q]);
        }
        __syncthreads();
        { HY_T(); fft_fwd_pass2(Wb, t); }
        __syncthreads();
        { HY_T(); cpx v[16]; fft_fwd_pass3(Wb, t, v); __syncthreads();
          const int b = t >> 1, r = t & 1;
#pragma unroll
          for (int q = 0; q < 16; ++q) stc(Wb, fft_pp(b * 32 + 16 * r + q), v[q]); }
        __syncthreads();
#pragma unroll 1
        for (int ch = 0; ch < 2; ++ch) {
            const int c = c0 + ch;
            float vg[2][8];
            {
                HY_T();
                const __amdgpu_buffer_rsrc_t rs1 = __builtin_amdgcn_make_buffer_rsrc((void*)(PT + (size_t)(1024 + c) * T), 0, T * 4, 0x00020000);
                const __amdgpu_buffer_rsrc_t rs2 = __builtin_amdgcn_make_buffer_rsrc((void*)(PT + (size_t)(2048 + c) * T), 0, T * 4, 0x00020000);
                const float a0 = cw[1024 + c], a1 = cw[3072 + 1024 + c], a2 = cw[6144 + 1024 + c], ab = cb[1024 + c];
                const float v0 = cw[2048 + c], v1 = cw[3072 + 2048 + c], v2 = cw[6144 + 2048 + c], vb = cb[2048 + c];
#pragma unroll
                for (int b = 0; b < 2; ++b)
#pragma unroll
                    for (int j = 0; j < 8; ++j) { const bool lo = (j > 0) || (t > 0), hi = (j < 7) || (t < 511);
                        int vo = t * 4;
                        if (j == 0) asm volatile("" : "+v"(vo));
                        vg[b][j] = conv3_b(rs2, vo, b * LSEQ + j * 512, v0, v1, v2, vb, lo, hi) * conv3_b(rs1, vo, b * LSEQ + j * 512, a0, a1, a2, ab, lo, hi);
                        if (j == 7) asm volatile("" : "+v"(vg[b][0]), "+v"(vg[b][1]), "+v"(vg[b][2]), "+v"(vg[b][3]), "+v"(vg[b][4]), "+v"(vg[b][5]), "+v"(vg[b][6]), "+v"(vg[b][7])); }
                cpx v[16];
#pragma unroll
                for (int j = 0; j < 8; ++j) { v[j] = cpx{vg[0][j], vg[1][j]}; v[8 + j] = cpx{0.f, 0.f}; }
                dft16<false>(v); twiddle16<false>(v, (float)t * (1.f / 8192.f));
#pragma unroll
                for (int q = 0; q < 16; ++q) stc(Lb, fft_pp(q * 512 + t), v[q]);
            }
            __syncthreads();
            { HY_T(); fft_fwd_pass2(Lb, t); }
            __syncthreads();
            {
                HY_T();
                cpx v[16]; fft_fwd_pass3(Lb, t, v);
                const int b = t >> 1, r = t & 1;
                const float sc = 0.5f / 8192.f;
#pragma unroll
                for (int q = 0; q < 16; ++q) {
                    const int p = b * 32 + 16 * r + q, k = fft_k_of_p(p), km = (8192 - k) & 8191, pm = fft_p_of_k(km);
                    const cpx Wk = ldc(Wb, fft_pp(p)), Wm = ldc(Wb, fft_pp(pm));
                    cpx H;
                    if (ch == 0) H = cpx{(Wk.x + Wm.x) * sc, (Wk.y - Wm.y) * sc};
                    else H = cpx{(Wk.y + Wm.y) * sc, (Wm.x - Wk.x) * sc};
                    v[q] = cmul(v[q], H);
                    if ((q & 3) == 3) asm volatile("" ::: "memory");
                }
#pragma unroll
                for (int q = 0; q < 16; ++q) { const float px = dpp_xor1(v[q].x), py = dpp_xor1(v[q].y);
                    v[q] = r ? cpx{px - v[q].x, py - v[q].y} : cpx{v[q].x + px, v[q].y + py}; }
                twiddle16<true>(v, (float)r * (1.f / 32.f)); dft16<true>(v);
                __syncthreads();
#pragma unroll
                for (int j = 0; j < 16; ++j) stc(Lb, fft_pp(b * 32 + 2 * j + r), v[j]);
            }
            __syncthreads();
            {
                HY_T();
                const int blk = t >> 5, r2 = t & 31; cpx v[16];
#pragma unroll
                for (int q = 0; q < 16; ++q) v[q] = ldc(Lb, fft_pp(blk * 512 + q * 32 + r2));
                twiddle16<true>(v, (float)r2 * (1.f / 512.f)); dft16<true>(v);
                __syncthreads();
#pragma unroll
                for (int j = 0; j < 16; ++j) stc(Lb, fft_pp(blk * 512 + j * 32 + r2), v[j]);
            }
            __syncthreads();
            {
                HY_T();
                cpx v[16];
#pragma unroll
                for (int q = 0; q < 16; ++q) v[q] = ldc(Lb, fft_pp(q * 512 + t));
                twiddle16<true>(v, (float)t * (1.f / 8192.f)); dft16<true>(v);
                const __amdgpu_buffer_rsrc_t rs0 = __builtin_amdgcn_make_buffer_rsrc((void*)(PT + (size_t)c * T), 0, T * 4, 0x00020000);
                const __amdgpu_buffer_rsrc_t rsy = __builtin_amdgcn_make_buffer_rsrc((void*)(YHT + (size_t)c * T), 0, T * 4, 0x00020000);
                const float x0 = cw[c], x1 = cw[3072 + c], x2 = cw[6144 + c], xb = cb[c], sk = skip[c];
                float o0[8], o1[8];
#pragma unroll
                for (int j = 0; j < 8; ++j) { const bool lo = (j > 0) || (t > 0), hi = (j < 7) || (t < 511);
                    int vo = t * 4;
                    if ((j & 3) == 0) asm volatile("" : "+v"(vo));
                    o0[j] = (v[j].x + vg[0][j] * sk) * conv3_b(rs0, vo, j * 512, x0, x1, x2, xb, lo, hi);
                    o1[j] = (v[j].y + vg[1][j] * sk) * conv3_b(rs0, vo, LSEQ + j * 512, x0, x1, x2, xb, lo, hi); }
                asm volatile("" ::: "memory");
#pragma unroll
                for (int j = 0; j < 8; ++j) {
                    __builtin_amdgcn_raw_buffer_store_b32(__builtin_bit_cast(unsigned, o0[j]), rsy, t * 4, j * 2048, 0);
                    __builtin_amdgcn_raw_buffer_store_b32(__builtin_bit_cast(unsigned, o1[j]), rsy, t * 4, (LSEQ + j * 512) * 4, 0); }
            }
            __syncthreads();
        }
    }
}
#undef HY_T
__device__ __forceinline__ void hyena_filter_item(LAS unsigned char* lds, int item, const float* w1, const float* b1, const float* w2, const float* b2, const float* w3, const float* b3,
                                                  const float* w4, const float* freq, float* KC, int tid, int lane, int wave) {
    typedef pg8::f32x4 f32x4;
    LAS float* H3 = (LAS float*)lds;
    LAS float* sc0 = (LAS float*)(lds + 4096) + wave * 256;
    const int l0 = item * 16;
    int lane_w = lane; asm volatile("" : "+v"(lane_w));
    float w1r[33], w2r[64], w3r[64];
#pragma unroll
    for (int i = 0; i < 33; ++i) w1r[i] = w1[i * 64 + lane_w];
#pragma unroll
    for (int i = 0; i < 64; ++i) w2r[i] = w2[i * 64 + lane_w];
    const float fr = freq[lane], bb1 = b1[lane], bb2 = b2[lane], bb3 = b3[lane];
    __syncthreads();
#pragma unroll
    for (int pp = 0; pp < 2; ++pp) {
        const int l = l0 + wave * 2 + pp; LAS float* sc = sc0 + 128 * pp;
        if (lane == 0) sc[0] = (float)l / (float)(LSEQ - 1);
        if (lane < 16) { const float omega = (2.0f * 3.14159265358979323846f / (float)LSEQ) * (float)l; const float fb = 1e-4f + (float)lane * ((15.0f - 1e-4f) / 15.0f); const float ang = omega * fb;
            sc[1 + lane] = cosf(ang); sc[17 + lane] = -sinf(ang); }
    }
    asm volatile("s_waitcnt lgkmcnt(0)" ::: "memory");
    float s[2], h[2];
#pragma unroll
    for (int pp = 0; pp < 2; ++pp) { const LAS float* sc = sc0 + 128 * pp; s[pp] = bb1;
#pragma unroll
        for (int i4 = 0; i4 < 8; ++i4) { const f32x4 z = *(const LAS f32x4*)(sc + 4 * i4); s[pp] += z.x * w1r[4 * i4] + z.y * w1r[4 * i4 + 1] + z.z * w1r[4 * i4 + 2] + z.w * w1r[4 * i4 + 3]; }
        s[pp] += sc[32] * w1r[32]; h[pp] = sinf(fr * s[pp]); }
    asm volatile("s_waitcnt lgkmcnt(0)" ::: "memory");
#pragma unroll
    for (int i = 0; i < 64; ++i) w3r[i] = w3[i * 64 + lane_w];
#pragma unroll
    for (int pp = 0; pp < 2; ++pp) sc0[128 * pp + 64 + lane] = h[pp];
    asm volatile("s_waitcnt lgkmcnt(0)" ::: "memory");
#pragma unroll
    for (int pp = 0; pp < 2; ++pp) { const LAS float* sc = sc0 + 128 * pp + 64; s[pp] = bb2;
#pragma unroll
        for (int i4 = 0; i4 < 16; ++i4) { const f32x4 z = *(const LAS f32x4*)(sc + 4 * i4); s[pp] += z.x * w2r[4 * i4] + z.y * w2r[4 * i4 + 1] + z.z * w2r[4 * i4 + 2] + z.w * w2r[4 * i4 + 3]; }
        h[pp] = sinf(fr * s[pp]); }
    asm volatile("s_waitcnt lgkmcnt(0)" ::: "memory");
#pragma unroll
    for (int pp = 0; pp < 2; ++pp) sc0[128 * pp + lane] = h[pp];
    asm volatile("s_waitcnt lgkmcnt(0)" ::: "memory");
#pragma unroll
    for (int pp = 0; pp < 2; ++pp) { const LAS float* sc = sc0 + 128 * pp; s[pp] = bb3;
#pragma unroll
        for (int i4 = 0; i4 < 16; ++i4) { const f32x4 z = *(const LAS f32x4*)(sc + 4 * i4); s[pp] += z.x * w3r[4 * i4] + z.y * w3r[4 * i4 + 1] + z.z * w3r[4 * i4 + 2] + z.w * w3r[4 * i4 + 3]; }
        H3[lane * 16 + wave * 2 + pp] = sinf(fr * s[pp]); }
    asm volatile("s_waitcnt lgkmcnt(0)" ::: "memory");
    __syncthreads();
    const float max_decay = logf(1e-2f) / 0.3f, min_decay = logf(1e-2f) / 1.5f;
    float acc[4][16];
#pragma unroll
    for (int a = 0; a < 4; ++a)
#pragma unroll
        for (int l = 0; l < 16; ++l) acc[a][l] = 0.f;
    int tid_o = tid; asm volatile("" : "+v"(tid_o));
    const float* w4t = w4 + tid_o;
#define HF_LOAD(wr_, b_) do { _Pragma("unroll") for (int i = 0; i < 4; ++i) { const float* p_ = w4t + ((b_) * 4 + i) * 2048; \
        wr_[4 * i] = p_[0]; wr_[4 * i + 1] = p_[1024]; wr_[4 * i + 2] = p_[512]; wr_[4 * i + 3] = p_[1536]; } } while (0)
#define HF_COMP(wr_, b_) do { _Pragma("unroll") for (int i = 0; i < 4; ++i) { _Pragma("unroll") for (int l4 = 0; l4 < 4; ++l4) { \
        const pg8::f32x4 hv = *(const LAS pg8::f32x4*)(H3 + ((b_) * 4 + i) * 16 + 4 * l4); \
        _Pragma("unroll") for (int q = 0; q < 4; ++q) { _Pragma("unroll") for (int a = 0; a < 4; ++a) acc[a][4 * l4 + q] = fmaf(hv[q], wr_[4 * i + a], acc[a][4 * l4 + q]); } } } } while (0)
    float wa[16], wb[16];
    HF_LOAD(wa, 0);
#pragma unroll 1
    for (int b = 0; b < 16; b += 2) {
        HF_LOAD(wb, b + 1);
        HF_COMP(wa, b);
        { const int bn = b + 2 < 16 ? b + 2 : 15; HF_LOAD(wa, bn); }
        HF_COMP(wb, b + 1);
    }
#undef HF_LOAD
#undef HF_COMP
#pragma unroll
    for (int cc = 0; cc < 2; ++cc) {
        const int c = tid_o + 512 * cc;
        const float delta = fabsf(min_decay + (float)c * ((max_decay - min_decay) / (float)(DHY - 1)));
        float* kc = KC + (size_t)c * 8192;
#pragma unroll
        for (int l = 0; l < 16; ++l) {
            const int ll = l0 + l; const float win = expf(-((float)ll / (float)(LSEQ - 1)) * delta);
            const float f = acc[2 * cc][l] * win, bb = acc[2 * cc + 1][l] * win;
            if (ll == 0) { kc[0] = f + bb; kc[4096] = 0.f; } else { kc[ll] = f; kc[8192 - ll] = bb; }
        }
    }
    __syncthreads();
}
__device__ __forceinline__ void hyena_post_tile(LAS unsigned char* lds, int tile, const float* YHT, const float* nw, bf16* A2, int tid, int lane, int wave) {
    LAS float* tl = (LAS float*)lds;
    const int tok0 = tile * 32, tk = tid & 31, cg = tid >> 5;
    for (int i = 0; i < 64; ++i) { const int c = cg + 16 * i; tl[c * 33 + tk] = YHT[(size_t)c * T + tok0 + tk]; }
    __syncthreads();
    for (int q = 0; q < 4; ++q) {
        const int tq = wave * 4 + q; float v[16]; float ss = 0.f;
#pragma unroll
        for (int i = 0; i < 16; ++i) { v[i] = tl[(lane + 64 * i) * 33 + tq]; ss += v[i] * v[i]; }
        const float r = rsqrtf(wave_sum(ss) * (1.f / DHY) + EPS);
#pragma unroll
        for (int i = 0; i < 16; ++i) { const int c = lane + 64 * i; A2[(size_t)(tok0 + tq) * DM + c] = (bf16)f2bf(v[i] * r * nw[c]); }
    }
    __syncthreads();
}


constexpr int GP_TILE = 128 * 132;
constexpr int GP_GATES = 143104;
constexpr int GP_WREG2 = 8448 + 512;
constexpr int GP_TT = 64 * 68 * 4;
__device__ __forceinline__ int aoff_fn(int i) { const int q = i >> 2, r = i & 3; return 4 * (2 * q * q + q + (r >= 1 ? q : 0) + (r >= 2 ? q + 1 : 0) + (r >= 3 ? q + 1 : 0)); }
static_assert(8 * GP_TILE <= GP_GATES && 8 * GP_WREG2 + 4 * GP_TT <= GP_GATES && GP_GATES + 4096 <= LDSCTL_OFF_C, "gdn prep LDS");
__device__ __forceinline__ void gdn_pre(LAS unsigned char* lds, int wg, const bf16* PG, const float* PGATE, const float* cw, const float* alf, const float* alb, const float* dtf, const float* dtb,
                                        unsigned char* ws, int tid, int lane, int wave) {
    const int bh = wg >> 4, b = bh >> 3, h = bh & 7, l0 = 256 * (wg & 15), cid0 = bh * 64 + 4 * (wg & 15);
    LAS float* gates = (LAS float*)(lds + GP_GATES);
    float w[3][3][2];
#pragma unroll
    for (int x = 0; x < 3; ++x)
#pragma unroll
        for (int tp = 0; tp < 3; ++tp)
#pragma unroll
            for (int e = 0; e < 2; ++e) w[x][tp][e] = cw[tp * 3072 + x * 1024 + h * 128 + 2 * lane + e];
    const int lw = l0 + 32 * wave;
    const unsigned* pgw = (const unsigned*)PG;
    auto ldraw = [&](int l, int x) -> unsigned { const int lc = l < 0 ? 0 : (l >= LSEQ ? LSEQ - 1 : l);
        return pgw[((size_t)(b * LSEQ + lc) * 4096 + x * 1024 + h * 128) / 2 + lane]; };
    if (lane < 32) {
        const int l = lw + lane, li = 32 * wave + lane; const float* pr = PGATE + (size_t)(b * LSEQ + l) * 32;
        gates[0 * 256 + li] = -expf(alf[h]) * softplus_f(pr[16 + h] + dtf[h]);
        gates[1 * 256 + li] = -expf(alb[h]) * softplus_f(pr[24 + h] + dtb[h]);
        gates[2 * 256 + li] = sigmoid_f(pr[h]);
        gates[3 * 256 + li] = sigmoid_f(pr[8 + h]);
    }
#pragma unroll 1
    for (int bt8 = 0; bt8 < 4; ++bt8) {
        unsigned raw[3][10];
#pragma unroll
        for (int x = 0; x < 3; ++x)
#pragma unroll
            for (int k = 0; k < 10; ++k) raw[x][k] = ldraw(lw + 8 * bt8 - 1 + k, x);
#define GP_PIN5(a, i) "+v"(a[i]), "+v"(a[i + 1]), "+v"(a[i + 2]), "+v"(a[i + 3]), "+v"(a[i + 4])
        asm volatile("" : GP_PIN5(raw[0], 0), GP_PIN5(raw[0], 5), GP_PIN5(raw[1], 0));
        asm volatile("" : GP_PIN5(raw[1], 5), GP_PIN5(raw[2], 0), GP_PIN5(raw[2], 5));
#undef GP_PIN5
#pragma unroll
        for (int x = 0; x < 3; ++x)
#pragma unroll
            for (int k = 0; k < 10; ++k) { const int l = lw + 8 * bt8 - 1 + k; raw[x][k] = (l >= 0 && l < LSEQ) ? raw[x][k] : 0u; }
#pragma unroll
        for (int k = 0; k < 8; ++k) {
            const int tt = 8 * bt8 + k, li = 32 * wave + tt, cl = li >> 6, i = li & 63;
            float r[3][2];
#pragma unroll
            for (int x = 0; x < 3; ++x) {
                const unsigned pv = raw[x][k], cv = raw[x][k + 1], nv = raw[x][k + 2];
                const float p0 = __builtin_bit_cast(float, pv << 16), p1 = __builtin_bit_cast(float, pv & 0xffff0000u);
                const float c0 = __builtin_bit_cast(float, cv << 16), c1 = __builtin_bit_cast(float, cv & 0xffff0000u);
                const float n0 = __builtin_bit_cast(float, nv << 16), n1 = __builtin_bit_cast(float, nv & 0xffff0000u);
                r[x][0] = silu_f(w[x][0][0] * p0 + w[x][1][0] * c0 + w[x][2][0] * n0);
                r[x][1] = silu_f(w[x][0][1] * p1 + w[x][1][1] * c1 + w[x][2][1] * n1);
            }
            const float qs = rsqrtf(wave_sum(r[0][0] * r[0][0] + r[0][1] * r[0][1]) + EPS);
            const float ks = rsqrtf(wave_sum(r[1][0] * r[1][0] + r[1][1] * r[1][1]) + EPS);
            const unsigned qp = pk2(r[0][0] * qs, r[0][1] * qs), kp = pk2(r[1][0] * ks, r[1][1] * ks), vp = pk2(r[2][0], r[2][1]);
            const size_t rowoff = ((size_t)(cid0 + cl) * 64 + i) * 64 + lane;
            ((unsigned*)(ws + WS_QN))[rowoff] = qp; ((unsigned*)(ws + WS_KN))[rowoff] = kp;
            LAS bf16* kt = (LAS bf16*)(lds + (cl * 2 + 0) * GP_TILE); LAS bf16* vt = (LAS bf16*)(lds + (cl * 2 + 1) * GP_TILE);
            kt[(2 * lane) * 66 + i] = (bf16)(kp & 0xffffu); kt[(2 * lane + 1) * 66 + i] = (bf16)(kp >> 16);
            vt[(2 * lane) * 66 + i] = (bf16)(vp & 0xffffu); vt[(2 * lane + 1) * 66 + i] = (bf16)(vp >> 16);
        }
    }
    __syncthreads();
    for (int it = wave; it < 8 * 64; it += 8) {
        const int tile = it >> 6, rp = it & 63, row = 2 * rp + (lane >> 5), cl = tile >> 1, which = tile & 1;
        const unsigned v = *(const LAS unsigned*)(lds + tile * GP_TILE + row * 132 + (lane & 31) * 4);
        ((unsigned*)(ws + (which ? WS_VT : WS_KT)))[((size_t)(cid0 + cl) * 128 + row) * 32 + (lane & 31)] = v;
    }
    asm volatile("s_waitcnt vmcnt(0)" ::: "memory");
    __syncthreads();
}
__device__ __forceinline__ void gdn_prep_wave(LAS unsigned char* lds, int wg, unsigned char* ws, int lane, int wave) {
    typedef pg8::bf16x8 bf16x8; typedef pg8::f32x4 f32x4;
    const int cl = wave >> 1, dir = wave & 1, bh = wg >> 4, cid = bh * 64 + 4 * (wg & 15) + cl; const size_t ci = (size_t)cid * 2 + dir;
    const int fr = lane & 15, fq = lane >> 4;
    LAS unsigned char* R = lds + wave * GP_WREG2;
    LAS float* Tt = (LAS float*)(lds + 8 * GP_WREG2 + (wave & 3) * GP_TT);
    LAS float* Ap = (LAS float*)R;
    LAS float* gcA = (LAS float*)(R + 8448); LAS float* btA = gcA + 64;
    const LAS float* gates = (const LAS float*)(lds + GP_GATES);
    const bf16* QN = (const bf16*)(ws + WS_QN) + (size_t)cid * 64 * 128; const bf16* KN = (const bf16*)(ws + WS_KN) + (size_t)cid * 64 * 128;
    const bf16* KT = (const bf16*)(ws + WS_KT) + (size_t)cid * 128 * 64; const bf16* VT = (const bf16*)(ws + WS_VT) + (size_t)cid * 128 * 64;
    unsigned char* GW = ws + WS_GW + ci * GW_B; unsigned char* GQD = ws + WS_GQD + ci * GW_B; unsigned char* GKDT = ws + WS_GKDT + ci * GKDT_B;
    unsigned char* GQK = ws + WS_GQK + ci * GQK_B; unsigned char* GUT = ws + WS_GUT + ci * GUT_B;
#define RIDX(i) (dir ? 63 - (i) : (i))
    const float bt = gates[(2 + dir) * 256 + 64 * cl + RIDX(lane)];
    float gc = gates[dir * 256 + 64 * cl + RIDX(lane)];
#pragma unroll
    for (int o = 1; o < 64; o <<= 1) { const float t = __shfl_up(gc, o); if (lane >= o) gc += t; }
    const float gl = __shfl(gc, 63);
    gcA[lane] = gc; btA[lane] = bt;
    asm volatile("s_waitcnt lgkmcnt(0)" ::: "memory");
    if (lane == 0) ((float*)(ws + WS_GCD))[ci] = expf(gl);
    {
    bf16x8 kfr[4][4];
#pragma unroll
    for (int t4 = 0; t4 < 4; ++t4)
#pragma unroll
        for (int ks = 0; ks < 4; ++ks) kfr[t4][ks] = *(const bf16x8*)(KN + (size_t)RIDX(16 * t4 + fr) * 128 + 32 * ks + 8 * fq);
    __builtin_amdgcn_sched_barrier(0);
#pragma unroll
    for (int mt = 0; mt < 4; ++mt) {
        const f32x4 gi = *(const LAS f32x4*)(gcA + 16 * mt + 4 * fq), bi = *(const LAS f32x4*)(btA + 16 * mt + 4 * fq);
#pragma unroll
        for (int nt = 0; nt <= mt; ++nt) {
            f32x4 c = (f32x4){0.f, 0.f, 0.f, 0.f};
#pragma unroll
            for (int ks = 0; ks < 4; ++ks) c = __builtin_amdgcn_mfma_f32_16x16x32_bf16(kfr[mt][ks], kfr[nt][ks], c, 0, 0, 0);
            const int j = 16 * nt + fr; const float gj = gcA[j];
#pragma unroll
            for (int r = 0; r < 4; ++r) { const int i = 16 * mt + 4 * fq + r; if (j < ((i + 3) & ~3)) Ap[aoff_fn(i) + j] = (j < i) ? bi[r] * c[r] * __expf(gi[r] - gj) : 0.f; }
        }
    }
#pragma unroll 1
    for (int ih = 0; ih < 2; ++ih) {
        bf16x8 qfr[2][4];
#pragma unroll
        for (int t2 = 0; t2 < 2; ++t2)
#pragma unroll
            for (int ks = 0; ks < 4; ++ks) qfr[t2][ks] = *(const bf16x8*)(QN + (size_t)RIDX(16 * (2 * ih + t2) + fr) * 128 + 32 * ks + 8 * fq);
        __builtin_amdgcn_sched_barrier(0);
#pragma unroll
        for (int i2 = 0; i2 < 2; ++i2) {
            const int it = 2 * ih + i2;
            const int i = 16 * it + fr; const float gi = gcA[i];
#pragma unroll
            for (int jt = 0; jt < 4; ++jt) {
                f32x4 c = (f32x4){0.f, 0.f, 0.f, 0.f};
                if (jt <= it) {
#pragma unroll
                    for (int ks = 0; ks < 4; ++ks) c = __builtin_amdgcn_mfma_f32_16x16x32_bf16(kfr[jt][ks], qfr[i2][ks], c, 0, 0, 0);
                }
                const f32x4 gj = *(const LAS f32x4*)(gcA + 16 * jt + 4 * fq);
                float v[4];
#pragma unroll
                for (int r = 0; r < 4; ++r) { const int j = 16 * jt + 4 * fq + r; v[r] = (j <= i) ? c[r] * __expf(gi - gj[r]) * 0.08838834764831845f : 0.f; }
                *(unsigned long long*)(GQK + i * 144 + (32 * (jt >> 1) + 8 * fq + 4 * (jt & 1)) * 2) = (unsigned long long)pg8::cvt_pk_bf16(v[0], v[1]) | ((unsigned long long)pg8::cvt_pk_bf16(v[2], v[3]) << 32);
            }
        }
    }
    }
    {
    {
        const int L2 = lane & 31, m = 4 * L2, src = (m & ~31) + ((m & 4) ? 16 + 4 * ((m & 31) >> 3) : 4 * ((m & 31) >> 3));
#pragma unroll 1
        for (int rp0 = 0; rp0 < 32; rp0 += 16) {
            unsigned long long qv[16];
#pragma unroll
            for (int u = 0; u < 16; ++u) { const int i = 2 * (rp0 + u) + (lane >> 5); qv[u] = *(const unsigned long long*)(QN + (size_t)RIDX(i) * 128 + src); }
#pragma unroll
            for (int u = 0; u < 16; ++u) {
                const int i = 2 * (rp0 + u) + (lane >> 5); const unsigned long long q = qv[u];
                const float sc = __expf(gcA[i]) * 0.08838834764831845f;
                const unsigned lo = (unsigned)q, hi = (unsigned)(q >> 32);
                const float a0 = __builtin_bit_cast(float, lo << 16) * sc, a1 = __builtin_bit_cast(float, lo & 0xffff0000u) * sc, a2 = __builtin_bit_cast(float, hi << 16) * sc, a3 = __builtin_bit_cast(float, hi & 0xffff0000u) * sc;
                *(unsigned long long*)(GQD + i * 272 + m * 2) = (unsigned long long)pg8::cvt_pk_bf16(a0, a1) | ((unsigned long long)pg8::cvt_pk_bf16(a2, a3) << 32);
            }
        }
        const int L4 = lane & 15, mm = 4 * L4, isrc = (mm & ~31) + ((mm & 4) ? 16 + 4 * ((mm & 31) >> 3) : 4 * ((mm & 31) >> 3));
        const f32x4 gi4 = *(const LAS f32x4*)(gcA + isrc);
        float sc4[4];
#pragma unroll
        for (int r = 0; r < 4; ++r) sc4[r] = __expf(gl - gi4[r]);
#pragma unroll 1
        for (int rq0 = 0; rq0 < 32; rq0 += 16) {
            unsigned long long kv[16];
#pragma unroll
            for (int u = 0; u < 16; ++u) { const int dk = 4 * (rq0 + u) + (lane >> 4); kv[u] = *(const unsigned long long*)(KT + (size_t)dk * 64 + (dir ? 60 - isrc : isrc)); }
#pragma unroll
            for (int u = 0; u < 16; ++u) {
            const int dk = 4 * (rq0 + u) + (lane >> 4);
            const unsigned long long k = kv[u];
            const unsigned lo = (unsigned)k, hi = (unsigned)(k >> 32);
            float e0 = __builtin_bit_cast(float, lo << 16), e1 = __builtin_bit_cast(float, lo & 0xffff0000u), e2 = __builtin_bit_cast(float, hi << 16), e3 = __builtin_bit_cast(float, hi & 0xffff0000u);
            const float f0 = dir ? e3 : e0, f1 = dir ? e2 : e1, f2 = dir ? e1 : e2, f3 = dir ? e0 : e3;
            *(unsigned long long*)(GKDT + dk * 144 + mm * 2) = (unsigned long long)pg8::cvt_pk_bf16(f0 * sc4[0], f1 * sc4[1]) | ((unsigned long long)pg8::cvt_pk_bf16(f2 * sc4[2], f3 * sc4[3]) << 32);
            }
        }
    }
    asm volatile("s_waitcnt lgkmcnt(0)" ::: "memory");
    }
    asm volatile("s_waitcnt lgkmcnt(0)" ::: "memory");
    __syncthreads();
    const float s_u = bt, s_w = bt * __expf(gc);
    const int cn = RIDX(lane);
#pragma unroll 1
    for (int round = 0; round < 2; ++round) {
        if ((wave >> 2) == round) {
            LAS float* trow = Tt + lane * 68;
#pragma unroll
            for (int q = 0; q < 16; ++q) *(LAS f32x4*)(trow + 4 * q) = (f32x4){(4 * q == lane) ? 1.f : 0.f, (4 * q + 1 == lane) ? 1.f : 0.f, (4 * q + 2 == lane) ? 1.f : 0.f, (4 * q + 3 == lane) ? 1.f : 0.f};
            asm volatile("s_waitcnt lgkmcnt(0)" ::: "memory");
            int ao = 0;
            for (int i = 1; i < 64; ++i) {
                const LAS float* ar = Ap + ao;
                f32x4 acc4 = (f32x4){0.f, 0.f, 0.f, 0.f};
                const int n4 = (i + 3) >> 2;
                for (int q = 0; q < n4; ++q) { const f32x4 a4 = *(const LAS f32x4*)(ar + 4 * q), t4 = *(const LAS f32x4*)(trow + 4 * q); acc4 += a4 * t4; }
                const float sv = (acc4[0] + acc4[1]) + (acc4[2] + acc4[3]);
                if (lane < i) trow[i] = -sv;
                asm volatile("s_waitcnt lgkmcnt(0)" ::: "memory");
                ao += 4 * n4;
            }
#define GP_WRITE_T(scale) do { LAS bf16* Tq = (LAS bf16*)R; \
                for (int j0 = 0; j0 < 64; j0 += 8) { const f32x4 ta = *(const LAS f32x4*)(trow + j0), tb = *(const LAS f32x4*)(trow + j0 + 4); \
                    _Pragma("unroll") for (int e = 0; e < 4; ++e) { Tq[(j0 + e) * 64 + cn] = (bf16)f2bf(ta[e] * (scale)); Tq[(j0 + 4 + e) * 64 + cn] = (bf16)f2bf(tb[e] * (scale)); } } \
                asm volatile("s_waitcnt lgkmcnt(0)" ::: "memory"); } while (0)
            GP_WRITE_T(s_w);
#pragma unroll 1
            for (int dh = 0; dh < 2; ++dh) {
                bf16x8 ktf[4][2];
#pragma unroll
                for (int d4 = 0; d4 < 4; ++d4)
#pragma unroll
                    for (int ks = 0; ks < 2; ++ks) ktf[d4][ks] = *(const bf16x8*)(KT + (size_t)(16 * (4 * dh + d4) + fr) * 64 + 32 * ks + 8 * fq);
                __builtin_amdgcn_sched_barrier(0);
#pragma unroll 1
                for (int it = 0; it < 4; ++it) {
                    bf16x8 tf[2];
#pragma unroll
                    for (int ks = 0; ks < 2; ++ks) tf[ks] = *(const LAS bf16x8*)(R + ((16 * it + fr) * 64 + 32 * ks + 8 * fq) * 2);
                    const int i = 16 * it + fr;
#pragma unroll
                    for (int d4 = 0; d4 < 4; ++d4) {
                        const int dt = 4 * dh + d4;
                        f32x4 c = (f32x4){0.f, 0.f, 0.f, 0.f};
#pragma unroll
                        for (int ks = 0; ks < 2; ++ks) c = __builtin_amdgcn_mfma_f32_16x16x32_bf16(ktf[d4][ks], tf[ks], c, 0, 0, 0);
                        *(unsigned long long*)(GW + i * 272 + (32 * (dt >> 1) + 8 * fq + 4 * (dt & 1)) * 2) = (unsigned long long)pg8::cvt_pk_bf16(c[0], c[1]) | ((unsigned long long)pg8::cvt_pk_bf16(c[2], c[3]) << 32);
                    }
                }
            }
            asm volatile("s_waitcnt lgkmcnt(0)" ::: "memory");
            GP_WRITE_T(s_u);
#pragma unroll 1
            for (int vh = 0; vh < 2; ++vh) {
                bf16x8 vtf[4][2];
#pragma unroll
                for (int v4 = 0; v4 < 4; ++v4)
#pragma unroll
                    for (int ks = 0; ks < 2; ++ks) vtf[v4][ks] = *(const bf16x8*)(VT + (size_t)(16 * (4 * vh + v4) + fr) * 64 + 32 * ks + 8 * fq);
                __builtin_amdgcn_sched_barrier(0);
#pragma unroll 1
                for (int it = 0; it < 4; ++it) {
                    bf16x8 tf[2];
#pragma unroll
                    for (int ks = 0; ks < 2; ++ks) tf[ks] = *(const LAS bf16x8*)(R + ((16 * it + fr) * 64 + 32 * ks + 8 * fq) * 2);
#pragma unroll
                    for (int v4 = 0; v4 < 4; ++v4) {
                        const int vt = 4 * vh + v4;
                        f32x4 c = (f32x4){0.f, 0.f, 0.f, 0.f};
#pragma unroll
                        for (int ks = 0; ks < 2; ++ks) c = __builtin_amdgcn_mfma_f32_16x16x32_bf16(tf[ks], vtf[v4][ks], c, 0, 0, 0);
                        *(unsigned long long*)(GUT + (16 * vt + fr) * 128 + (16 * it + 4 * fq) * 2) = (unsigned long long)pg8::cvt_pk_bf16(c[0], c[1]) | ((unsigned long long)pg8::cvt_pk_bf16(c[2], c[3]) << 32);
                    }
                }
            }
#undef GP_WRITE_T
        }
        __syncthreads();
    }
#undef RIDX
}

__host__ __device__ __forceinline__ int mperm32(int o) { return ((o & 15) >> 2) * 8 + (o >> 4) * 4 + (o & 3); }
__host__ __device__ __forceinline__ int mcol(int x) { return (x & ~31) + mperm32(x & 31); }
constexpr int SC_W = 0, SC_QD = 17408, SC_KDT = 34816, SC_QK = 53248, SC_UT = 62464, SC_STEP = 64512;
static_assert(2 * SC_STEP <= LDSCTL_OFF_C, "scan LDS");
__device__ __forceinline__ void gdn_scan(LAS unsigned char* lds, const unsigned char* ws, bf16* OF, bf16* OB, int vcu, int tid, int lane, int wave) {
    typedef pg8::bf16x8 bf16x8; typedef pg8::f32x4 f32x4;
    const int chain = vcu >> 3, slice = vcu & 7, dir = chain & 1, bh = chain >> 1, b = bh >> 3, h = bh & 7;
    const int fr = lane & 15, fq = lane >> 4;
    const int dv0 = slice * 16;
    bf16* O = dir ? OB : OF;
    auto issue = [&](int s, int buf) {
        const int n = dir ? 63 - s : s; const size_t ci = ((size_t)(bh * 64 + n) * 2 + dir);
#pragma unroll
        for (int k = 0; k < 8; ++k) {
            const int p = wave + 8 * k;
            if (p < 63) {
                const unsigned char* g; int l;
                if (p < 17) { g = ws + WS_GW + ci * GW_B + p * 1024; l = SC_W + p * 1024; }
                else if (p < 34) { g = ws + WS_GQD + ci * GW_B + (p - 17) * 1024; l = SC_QD + (p - 17) * 1024; }
                else if (p < 52) { g = ws + WS_GKDT + ci * GKDT_B + (p - 34) * 1024; l = SC_KDT + (p - 34) * 1024; }
                else if (p < 61) { g = ws + WS_GQK + ci * GQK_B + (p - 52) * 1024; l = SC_QK + (p - 52) * 1024; }
                else { g = ws + WS_GUT + ci * GUT_B + slice * 2048 + (p - 61) * 1024; l = SC_UT + (p - 61) * 1024; }
                __builtin_amdgcn_global_load_lds((const unsigned*)(g + lane * 16), (LAS unsigned*)(lds + buf * SC_STEP + l), 16, 0, 0);
            }
        }
    };
    f32x4 S[8];
#pragma unroll
    for (int i = 0; i < 8; ++i) S[i] = (f32x4){0.f, 0.f, 0.f, 0.f};
    LAS float* cdl = (LAS float*)(lds + 2 * SC_STEP);
    if (wave == 0) { const int n = dir ? 63 - lane : lane; cdl[lane] = __builtin_bit_cast(float, __hip_atomic_load((const unsigned*)(ws + WS_GCD) + ((size_t)(bh * 64 + n) * 2 + dir), __ATOMIC_RELAXED, __HIP_MEMORY_SCOPE_AGENT)); }
    issue(0, 0);
    asm volatile("s_waitcnt vmcnt(0)" ::: "memory"); __syncthreads();
    for (int s = 0; s < 64; ++s) {
        const int buf = s & 1;
        if (s + 1 < 64) issue(s + 1, buf ^ 1);
        if (wave == 0) {
            const LAS unsigned char* L = lds + buf * SC_STEP;
            const int n = dir ? 63 - s : s;
            const float cd = cdl[s];
#define SC_RD(dst, addr, off) asm volatile("ds_read_b128 %0, %1 offset:%2" : "=v"(dst) : "v"(addr), "i"(off))
#define SC_WAIT(n, f) do { asm volatile("s_waitcnt lgkmcnt(" #n ")" : "+v"(f[0]), "+v"(f[1]), "+v"(f[2]), "+v"(f[3]), "+v"(f[4]), "+v"(f[5]), "+v"(f[6]), "+v"(f[7])); __builtin_amdgcn_sched_barrier(0); } while (0)
#define SC_LD_WQ(dst, mt) do { SC_RD(dst[0], wb, SC_W + (mt) * 4352); SC_RD(dst[1], wb, SC_W + (mt) * 4352 + 64); SC_RD(dst[2], wb, SC_W + (mt) * 4352 + 128); SC_RD(dst[3], wb, SC_W + (mt) * 4352 + 192); \
                SC_RD(dst[4], wb, SC_QD + (mt) * 4352); SC_RD(dst[5], wb, SC_QD + (mt) * 4352 + 64); SC_RD(dst[6], wb, SC_QD + (mt) * 4352 + 128); SC_RD(dst[7], wb, SC_QD + (mt) * 4352 + 192); } while (0)
#define SC_LD_K(dst, base, t0) do { SC_RD(dst[0], kb, (base) + (t0) * 2304); SC_RD(dst[1], kb, (base) + (t0) * 2304 + 64); SC_RD(dst[2], kb, (base) + ((t0) + 1) * 2304); SC_RD(dst[3], kb, (base) + ((t0) + 1) * 2304 + 64); \
                SC_RD(dst[4], kb, (base) + ((t0) + 2) * 2304); SC_RD(dst[5], kb, (base) + ((t0) + 2) * 2304 + 64); SC_RD(dst[6], kb, (base) + ((t0) + 3) * 2304); SC_RD(dst[7], kb, (base) + ((t0) + 3) * 2304 + 64); } while (0)
            const unsigned wb = (unsigned)(size_t)(L + fr * 272 + fq * 16), kb = (unsigned)(size_t)(L + fr * 144 + fq * 16);
            bf16x8 Sb[4];
#pragma unroll
            for (int ks = 0; ks < 4; ++ks) { pg8::u32x4 w; w.x = pg8::cvt_pk_bf16(S[2 * ks][0], S[2 * ks][1]); w.y = pg8::cvt_pk_bf16(S[2 * ks][2], S[2 * ks][3]);
                w.z = pg8::cvt_pk_bf16(S[2 * ks + 1][0], S[2 * ks + 1][1]); w.w = pg8::cvt_pk_bf16(S[2 * ks + 1][2], S[2 * ks + 1][3]); Sb[ks] = __builtin_bit_cast(bf16x8, w); }
            unsigned long long uu[4];
#pragma unroll
            for (int mt = 0; mt < 4; ++mt) uu[mt] = *(const LAS unsigned long long*)(L + SC_UT + fr * 128 + (16 * mt + 4 * fq) * 2);
            asm volatile("s_waitcnt lgkmcnt(0)" : "+v"(uu[0]), "+v"(uu[1]), "+v"(uu[2]), "+v"(uu[3]));
            __builtin_amdgcn_sched_barrier(0);
            bf16x8 fa[8], fb[8];
            f32x4 vn[4], o[4];
#define SC_MMA_WQ(src, mt) do { f32x4 a_ = (f32x4){0.f, 0.f, 0.f, 0.f}, q_ = (f32x4){0.f, 0.f, 0.f, 0.f}; \
                _Pragma("unroll") for (int ks = 0; ks < 4; ++ks) { a_ = __builtin_amdgcn_mfma_f32_16x16x32_bf16(src[ks], Sb[ks], a_, 0, 0, 0); q_ = __builtin_amdgcn_mfma_f32_16x16x32_bf16(Sb[ks], src[4 + ks], q_, 0, 0, 0); }   \
                const unsigned ulo = (unsigned)uu[mt], uhi = (unsigned)(uu[mt] >> 32); \
                vn[mt][0] = __builtin_bit_cast(float, ulo << 16) - a_[0]; vn[mt][1] = __builtin_bit_cast(float, ulo & 0xffff0000u) - a_[1]; \
                vn[mt][2] = __builtin_bit_cast(float, uhi << 16) - a_[2]; vn[mt][3] = __builtin_bit_cast(float, uhi & 0xffff0000u) - a_[3]; o[mt] = q_; } while (0)
            SC_LD_WQ(fa, 0); SC_LD_WQ(fb, 1);
            SC_WAIT(8, fa); SC_MMA_WQ(fa, 0); __builtin_amdgcn_sched_barrier(0);
            SC_LD_WQ(fa, 2); SC_WAIT(8, fb); SC_MMA_WQ(fb, 1); __builtin_amdgcn_sched_barrier(0);
            SC_LD_WQ(fb, 3); SC_WAIT(8, fa); SC_MMA_WQ(fa, 2); __builtin_amdgcn_sched_barrier(0);
            SC_LD_K(fa, SC_QK, 0); SC_WAIT(8, fb); SC_MMA_WQ(fb, 3); __builtin_amdgcn_sched_barrier(0);
            bf16x8 vb[2];
#pragma unroll
            for (int ks = 0; ks < 2; ++ks) { pg8::u32x4 w; w.x = pg8::cvt_pk_bf16(vn[2 * ks][0], vn[2 * ks][1]); w.y = pg8::cvt_pk_bf16(vn[2 * ks][2], vn[2 * ks][3]);
                w.z = pg8::cvt_pk_bf16(vn[2 * ks + 1][0], vn[2 * ks + 1][1]); w.w = pg8::cvt_pk_bf16(vn[2 * ks + 1][2], vn[2 * ks + 1][3]); vb[ks] = __builtin_bit_cast(bf16x8, w); }
            __builtin_amdgcn_sched_barrier(0);
            SC_LD_K(fb, SC_KDT, 0); SC_WAIT(8, fa);
#pragma unroll
            for (int mt = 0; mt < 4; ++mt) {
#pragma unroll
                for (int ks = 0; ks < 2; ++ks) o[mt] = __builtin_amdgcn_mfma_f32_16x16x32_bf16(vb[ks], fa[2 * mt + ks], o[mt], 0, 0, 0);
            }
            __builtin_amdgcn_sched_barrier(0);
            SC_LD_K(fa, SC_KDT, 4); SC_WAIT(8, fb);
#pragma unroll
            for (int dt = 0; dt < 4; ++dt) { f32x4 a_ = S[dt] * cd;
#pragma unroll
                for (int ks = 0; ks < 2; ++ks) a_ = __builtin_amdgcn_mfma_f32_16x16x32_bf16(fb[2 * dt + ks], vb[ks], a_, 0, 0, 0);
                S[dt] = a_; }
            __builtin_amdgcn_sched_barrier(0);
            SC_WAIT(0, fa);
#pragma unroll
            for (int dt = 0; dt < 4; ++dt) { f32x4 a_ = S[4 + dt] * cd;
#pragma unroll
                for (int ks = 0; ks < 2; ++ks) a_ = __builtin_amdgcn_mfma_f32_16x16x32_bf16(fa[2 * dt + ks], vb[ks], a_, 0, 0, 0);
                S[4 + dt] = a_; }
#pragma unroll
            for (int mt = 0; mt < 4; ++mt) { const int i = 16 * mt + fr; const int l = 64 * n + (dir ? 63 - i : i);
                *(unsigned long long*)(O + ((size_t)b * LSEQ + l) * DGD + h * 128 + dv0 + 4 * fq) = (unsigned long long)pg8::cvt_pk_bf16(o[mt][0], o[mt][1]) | ((unsigned long long)pg8::cvt_pk_bf16(o[mt][2], o[mt][3]) << 32); }
#undef SC_RD
#undef SC_WAIT
#undef SC_LD_WQ
#undef SC_LD_K
#undef SC_MMA_WQ
            asm volatile("s_waitcnt vmcnt(16)" ::: "memory");
        } else asm volatile("s_waitcnt vmcnt(0)" ::: "memory");
        asm volatile("s_waitcnt lgkmcnt(0)" ::: "memory"); __builtin_amdgcn_s_barrier(); asm volatile("" ::: "memory");
    }
    asm volatile("s_waitcnt vmcnt(0)" ::: "memory"); __syncthreads();
}

__device__ __forceinline__ void gdn_post_batch(int item0, const bf16* OF, const bf16* OB, const bf16* PG, const float* nw, bf16* A2, int lane) {
    unsigned a[8], b[8], zz[8];
#pragma unroll
    for (int k = 0; k < 8; ++k) { const int item = item0 + k, tok = item >> 3, h = item & 7; const size_t o = (size_t)tok * DGD + h * 128 + lane * 2;
        a[k] = *(const unsigned*)(OF + o); b[k] = *(const unsigned*)(OB + o); zz[k] = *(const unsigned*)(PG + (size_t)tok * 4096 + 3072 + h * 128 + lane * 2); }
    const float2 g = *(const float2*)(nw + lane * 2);
#pragma unroll
    for (int k = 0; k < 8; ++k) { const int item = item0 + k, tok = item >> 3, h = item & 7;
        const float o0 = __builtin_bit_cast(float, a[k] << 16) + __builtin_bit_cast(float, b[k] << 16), o1 = __builtin_bit_cast(float, a[k] & 0xffff0000u) + __builtin_bit_cast(float, b[k] & 0xffff0000u);
        const float r = rsqrtf(wave_sum(o0 * o0 + o1 * o1) * (1.f / 128.f) + EPS);
        const float z0 = __builtin_bit_cast(float, zz[k] << 16), z1 = __builtin_bit_cast(float, zz[k] & 0xffff0000u);
        *(unsigned*)(A2 + (size_t)tok * DM + 1024 + h * 128 + lane * 2) = pk2(o0 * r * g.x * silu_f(z0), o1 * r * g.y * silu_f(z1)); }
}
constexpr int RT_PART = 0, RT_LG = 81920, RT_RS = 81920 + 32 * 80 * 4;
__device__ __forceinline__ void route_phase(LAS unsigned char* lds, int wg, const float* X1, const float* nw, const float* gbias, const float* ebias, unsigned char* ws, unsigned* cnt, int tid, int lane, int wave) {
    typedef pg8::bf16x8 bf16x8; typedef pg8::f32x4 f32x4;
    asm volatile("" : "+v"(lane), "+v"(tid));
    const int tok0 = wg * 32, fr = lane & 15, fq = lane >> 4;
    LAS float* part = (LAS float*)(lds + RT_PART); LAS float* lg = (LAS float*)(lds + RT_LG); LAS float* rs = (LAS float*)(lds + RT_RS);
    LAS int* hist = (LAS int*)(lds + RT_RS + 128);
    if (tid < 64) hist[tid] = 0;
    bf16* Ub = (bf16*)(ws + WS_UB);
    {
        const GAS f32x4* wr = (const GAS f32x4*)nw + lane;
        f32x4 v[4][8], g[8];
#pragma unroll
        for (int q = 0; q < 4; ++q) { const GAS f32x4* xr = (const GAS f32x4*)(X1 + (size_t)(tok0 + 4 * wave + q) * DM) + lane;
#pragma unroll
            for (int j = 0; j < 8; ++j) v[q][j] = xr[64 * j]; }
#pragma unroll
        for (int j = 0; j < 8; ++j) g[j] = wr[64 * j];
#pragma unroll
        for (int q = 0; q < 4; ++q) { const int t = 4 * wave + q; float s = 0.f;
#pragma unroll
            for (int j = 0; j < 8; ++j) s += (v[q][j].x * v[q][j].x + v[q][j].y * v[q][j].y) + (v[q][j].z * v[q][j].z + v[q][j].w * v[q][j].w);
            const float r = rsqrtf(wave_sum(s) * (1.f / DM) + EPS);
            GAS unsigned long long* o8 = (GAS unsigned long long*)(Ub + (size_t)(tok0 + t) * DM) + lane;
#pragma unroll
            for (int j = 0; j < 8; ++j) o8[64 * j] = (unsigned long long)pk2(v[q][j].x * r * g[j].x, v[q][j].y * r * g[j].y) | ((unsigned long long)pk2(v[q][j].z * r * g[j].z, v[q][j].w * r * g[j].w) << 32);
            if (lane == 0) rs[t] = r; }
    }
    if (wg == 0) { GAS unsigned long long* z = (GAS unsigned long long*)(Ub + (size_t)T * DM); z[tid] = 0ull; }
    { int* slot_tok = (int*)(ws + WS_SMALL + SM_SLOTTOK); if (tid < PMAX / 256) slot_tok[wg * (PMAX / 256) + tid] = T; }
    __syncthreads();
    const bf16* RWh = (const bf16*)(ws + WS_SMALL + SM_RWT); const bf16* RWl = RWh + 80 * 2048;
    f32x4 acc[2][5];
#pragma unroll
    for (int mt = 0; mt < 2; ++mt)
#pragma unroll
        for (int nt = 0; nt < 5; ++nt) acc[mt][nt] = (f32x4){0.f, 0.f, 0.f, 0.f};
    struct RtSet { f32x4 g0, g1, x0[2], x1[2]; bf16x8 bh[5], bl[5]; };
    const float rr[2] = {rs[fr], rs[16 + fr]};
#define RT_LOAD(ks_, S) do { const int ka_ = 256 * wave + 32 * (ks_) + 4 * fq, kb_ = 256 * wave + 32 * (ks_) + 8 * fq; \
        S.g0 = *(const f32x4*)(nw + ka_); S.g1 = *(const f32x4*)(nw + ka_ + 16); \
        _Pragma("unroll") for (int mt = 0; mt < 2; ++mt) { const float* xp = X1 + (size_t)(tok0 + 16 * mt + fr) * DM + ka_; S.x0[mt] = *(const f32x4*)xp; S.x1[mt] = *(const f32x4*)(xp + 16); } \
        _Pragma("unroll") for (int nt = 0; nt < 5; ++nt) { S.bh[nt] = *(const bf16x8*)(RWh + (size_t)(16 * nt + fr) * 2048 + kb_); S.bl[nt] = *(const bf16x8*)(RWl + (size_t)(16 * nt + fr) * 2048 + kb_); } } while (0)
#define RT_COMP(S) do { bf16x8 ah[2], al[2]; \
        _Pragma("unroll") for (int mt = 0; mt < 2; ++mt) { const float r = rr[mt]; float u[8], hf[8]; \
            _Pragma("unroll") for (int j = 0; j < 4; ++j) { u[j] = S.x0[mt][j] * r * S.g0[j]; u[4 + j] = S.x1[mt][j] * r * S.g1[j]; } \
            pg8::u32x4 wh, wl; \
            wh.x = pg8::cvt_pk_bf16(u[0], u[1]); wh.y = pg8::cvt_pk_bf16(u[2], u[3]); wh.z = pg8::cvt_pk_bf16(u[4], u[5]); wh.w = pg8::cvt_pk_bf16(u[6], u[7]); \
            hf[0] = __builtin_bit_cast(float, wh.x << 16); hf[1] = __builtin_bit_cast(float, wh.x & 0xffff0000u); hf[2] = __builtin_bit_cast(float, wh.y << 16); hf[3] = __builtin_bit_cast(float, wh.y & 0xffff0000u); \
            hf[4] = __builtin_bit_cast(float, wh.z << 16); hf[5] = __builtin_bit_cast(float, wh.z & 0xffff0000u); hf[6] = __builtin_bit_cast(float, wh.w << 16); hf[7] = __builtin_bit_cast(float, wh.w & 0xffff0000u); \
            wl.x = pg8::cvt_pk_bf16(u[0] - hf[0], u[1] - hf[1]); wl.y = pg8::cvt_pk_bf16(u[2] - hf[2], u[3] - hf[3]); wl.z = pg8::cvt_pk_bf16(u[4] - hf[4], u[5] - hf[5]); wl.w = pg8::cvt_pk_bf16(u[6] - hf[6], u[7] - hf[7]); \
            ah[mt] = __builtin_bit_cast(bf16x8, wh); al[mt] = __builtin_bit_cast(bf16x8, wl); } \
        _Pragma("unroll") for (int nt = 0; nt < 5; ++nt) { _Pragma("unroll") for (int mt = 0; mt < 2; ++mt) { \
            acc[mt][nt] = __builtin_amdgcn_mfma_f32_16x16x32_bf16(ah[mt], S.bh[nt], acc[mt][nt], 0, 0, 0); \
            acc[mt][nt] = __builtin_amdgcn_mfma_f32_16x16x32_bf16(al[mt], S.bh[nt], acc[mt][nt], 0, 0, 0); \
            acc[mt][nt] = __builtin_amdgcn_mfma_f32_16x16x32_bf16(ah[mt], S.bl[nt], acc[mt][nt], 0, 0, 0); } } } while (0)
    {
        RtSet s0, s1;
#define RT_PIN() asm volatile("" ::: "memory")
        RT_LOAD(0, s0); RT_LOAD(1, s1); RT_PIN();
        RT_COMP(s0); RT_PIN(); RT_LOAD(2, s0); RT_PIN(); RT_COMP(s1); RT_PIN(); RT_LOAD(3, s1); RT_PIN();
        RT_COMP(s0); RT_PIN(); RT_LOAD(4, s0); RT_PIN(); RT_COMP(s1); RT_PIN(); RT_LOAD(5, s1); RT_PIN();
        RT_COMP(s0); RT_PIN(); RT_LOAD(6, s0); RT_PIN(); RT_COMP(s1); RT_PIN(); RT_LOAD(7, s1); RT_PIN();
        RT_COMP(s0); RT_COMP(s1);
#undef RT_PIN
    }
#undef RT_LOAD
#undef RT_COMP
#pragma unroll
    for (int mt = 0; mt < 2; ++mt)
#pragma unroll
        for (int nt = 0; nt < 5; ++nt) *(LAS f32x4*)(part + ((wave * 10 + mt * 5 + nt) * 64 + lane) * 4) = acc[mt][nt];
    __syncthreads();
    for (int o = tid; o < 32 * 80; o += 512) {
        const int t = o / 80, col = o % 80, mt = t >> 4, tr = t & 15, nt = col >> 4, ln = (tr >> 2) * 16 + (col & 15), rg = tr & 3;
        float s = 0.f;
#pragma unroll
        for (int w = 0; w < 8; ++w) s += part[((w * 10 + mt * 5 + nt) * 64 + ln) * 4 + rg];
        lg[t * 80 + col] = s;
    }
    __syncthreads();
    if (tid < 32) {
        const int t = tok0 + tid; const LAS float* l = lg + tid * 80;
        float g[8]; int gi = 0; float gm = -INFINITY;
#pragma unroll
        for (int i = 0; i < 8; ++i) { g[i] = l[i] + gbias[i]; if (g[i] > gm) { gm = g[i]; gi = i; } }
        float gs = 0.f;
#pragma unroll
        for (int i = 0; i < 8; ++i) gs += expf(g[i] - gm);
        const float ggate = 1.f / gs;
        float e[8]; float em = -INFINITY;
#pragma unroll
        for (int i = 0; i < 8; ++i) { e[i] = l[8 + gi * 8 + i] + ebias[gi * 8 + i]; em = fmaxf(em, e[i]); }
        float es = 0.f; float p[8];
#pragma unroll
        for (int i = 0; i < 8; ++i) { p[i] = expf(e[i] - em); es += p[i]; }
        int i1 = 0; float p1 = -1.f;
#pragma unroll
        for (int i = 0; i < 8; ++i) if (p[i] > p1) { p1 = p[i]; i1 = i; }
        int i2 = 0; float p2 = -1.f;
#pragma unroll
        for (int i = 0; i < 8; ++i) if (i != i1 && p[i] > p2) { p2 = p[i]; i2 = i; }
        const float q1 = p1 / es, q2 = p2 / es, qs = q1 + q2;
        const int e1 = gi * 8 + i1, e2 = gi * 8 + i2;
        int* eid = (int*)(ws + WS_SMALL + SM_EID); float* gate = (float*)(ws + WS_SMALL + SM_GATE); int* pos = (int*)(ws + WS_SMALL + SM_POS);
        eid[t * 2] = e1; eid[t * 2 + 1] = e2;
        gate[t * 2] = ggate * (q1 / qs); gate[t * 2 + 1] = ggate * (q2 / qs);
        pos[t * 2] = __hip_atomic_fetch_add(hist + e1, 1, __ATOMIC_RELAXED, __HIP_MEMORY_SCOPE_WORKGROUP);
        pos[t * 2 + 1] = __hip_atomic_fetch_add(hist + e2, 1, __ATOMIC_RELAXED, __HIP_MEMORY_SCOPE_WORKGROUP);
    }
    __syncthreads();
    if (tid < 64) ((int*)(ws + WS_SMALL + SM_LOGITS))[wg * 64 + tid] = hist[tid];
}
__device__ __forceinline__ void fill_phase(LAS unsigned char* lds, int wg, unsigned char* ws, unsigned* cnt, int tid) {
    LAS int* ps = (LAS int*)lds;
    char* sm = (char*)(ws + WS_SMALL);
    if (tid < 64) {
        const int* tab = (const int*)(sm + SM_LOGITS) + tid;
        int below = 0, total = 0;
#pragma unroll 1
        for (int w0 = 0; w0 < 256; w0 += 32) { int v[32];
#pragma unroll
            for (int i = 0; i < 32; ++i) v[i] = tab[(w0 + i) * 64];
#pragma unroll
            for (int i = 0; i < 32; ++i) { total += v[i]; below += (w0 + i < wg) ? v[i] : 0; } }
        const int padded = (total + RB - 1) / RB * RB;
        int inc = padded;
#pragma unroll
        for (int o = 1; o < 64; o <<= 1) { const int t = __shfl_up(inc, o); if (tid >= o) inc += t; }
        ps[tid] = inc - padded; if (tid == 63) ps[NE] = inc;
        ps[128 + tid] = inc - padded + below;
    }
    __syncthreads();
    if (wg == 0) {
        int* blk_exp = (int*)(sm + SM_BLKEXP); int* nblk = (int*)(sm + SM_NBLK);
        if (tid < NBLK_MAX) { int e = NE - 1; for (int i = 0; i < NE; ++i) if (tid * RB >= ps[i] && tid * RB < ps[i + 1]) { e = i; break; } blk_exp[tid] = e; }
        if (tid == 0) *nblk = ps[NE] / RB;
    }
    if (tid < 64) {
        const int i = wg * 64 + tid; const int* eid = (const int*)(sm + SM_EID); const int* pos = (const int*)(sm + SM_POS);
        const int s = ps[128 + eid[i]] + pos[i];
        ((int*)(sm + SM_SLOTTOK))[s] = i >> 1; ((int*)(sm + SM_TSLOT))[i] = s;
    }
    __syncthreads();
}
__device__ __forceinline__ void final_rows(int t0, const float* X1, const bf16* Y, unsigned char* ws, const float* fw, float* out, int lane) {
    typedef pg8::f32x4 f32x4;
    const char* sm = (const char*)(ws + WS_SMALL);
    const int4 sl = *(const int4*)((const int*)(sm + SM_TSLOT) + t0 * 2); const float4 gt = *(const float4*)((const float*)(sm + SM_GATE) + t0 * 2);
    const int ss[4] = {sl.x, sl.y, sl.z, sl.w}; const float gg[4] = {gt.x, gt.y, gt.z, gt.w};
    f32x4 x[2][8]; unsigned long long ya[2][8], yb[2][8];
#pragma unroll
    for (int q = 0; q < 2; ++q) {
        const GAS f32x4* xr = (const GAS f32x4*)(X1 + (size_t)(t0 + q) * DM) + lane;
        const GAS unsigned long long* y1 = (const GAS unsigned long long*)(Y + (size_t)ss[2 * q] * DM) + lane; const GAS unsigned long long* y2 = (const GAS unsigned long long*)(Y + (size_t)ss[2 * q + 1] * DM) + lane;
#pragma unroll
        for (int j = 0; j < 8; ++j) { x[q][j] = xr[64 * j]; ya[q][j] = y1[64 * j]; yb[q][j] = y2[64 * j]; }
    }
    int lane_g = lane; asm volatile("" : "+v"(lane_g));
    const GAS f32x4* wr = (const GAS f32x4*)fw + lane_g;
    f32x4 gw[8];
#pragma unroll
    for (int q = 0; q < 2; ++q) {
        const float g1 = gg[2 * q], g2 = gg[2 * q + 1]; float sq = 0.f;
#pragma unroll
        for (int j = 0; j < 8; ++j) {
            const unsigned alo = (unsigned)ya[q][j], ahi = (unsigned)(ya[q][j] >> 32), blo = (unsigned)yb[q][j], bhi = (unsigned)(yb[q][j] >> 32);
            f32x4 r = x[q][j];
            r.x += g1 * __builtin_bit_cast(float, alo << 16) + g2 * __builtin_bit_cast(float, blo << 16);
            r.y += g1 * __builtin_bit_cast(float, alo & 0xffff0000u) + g2 * __builtin_bit_cast(float, blo & 0xffff0000u);
            r.z += g1 * __builtin_bit_cast(float, ahi << 16) + g2 * __builtin_bit_cast(float, bhi << 16);
            r.w += g1 * __builtin_bit_cast(float, ahi & 0xffff0000u) + g2 * __builtin_bit_cast(float, bhi & 0xffff0000u);
            x[q][j] = r; sq += (r.x * r.x + r.y * r.y) + (r.z * r.z + r.w * r.w);
        }
        if (q == 0) {
#pragma unroll
            for (int j = 0; j < 8; ++j) gw[j] = wr[64 * j]; }
        const float rr = rsqrtf(wave_sum(sq) * (1.f / DM) + EPS);
        GAS f32x4* o = (GAS f32x4*)(out + (size_t)(t0 + q) * DM) + lane;
#pragma unroll
        for (int j = 0; j < 8; ++j) o[64 * j] = x[q][j] * rr * gw[j];
    }
}


constexpr int MQ_A = 0, MQ_B = 65536, MQ_CTL = 98304;
__device__ __forceinline__ int perm32_inv(int c) { return 16 * ((c >> 2) & 1) + 4 * (c >> 3) + (c & 3); }
template <bool UP>
__device__ __forceinline__ void moe_gemm(LAS unsigned char* lds, unsigned char* ws, const float* w1, const float* w3  , unsigned* qctr, unsigned* done, int nblk, int tid) {
    typedef pg8::bf16x8 bf16x8; typedef pg8::f32x4 f32x4;
    constexpr int K = UP ? DM : DE, NT = K / 64, UPB = UP ? 8 : 16;
    const int wid = __builtin_amdgcn_readfirstlane(tid >> 6), lane = tid & 63, wr = wid >> 2, wc = wid & 3, fr = lane & 15, fq = lane >> 4;
    const int* slot_tok = (const int*)(ws + WS_SMALL + SM_SLOTTOK); const int* blk_exp = (const int*)(ws + WS_SMALL + SM_BLKEXP);
    int Rr[2], Cc[2];
#pragma unroll
    for (int i = 0; i < 2; ++i) pg8::stage_rc(tid * 16 + i * 8192, Rr[i], Cc[i]);
    const unsigned ldsw = (unsigned)wid * 1024u;
    const int aoff = pg8::lds_byte(fr, fq * 8), boff = pg8::lds_byte(wc * 32 + fr, fq * 8);
    const int cidx = tid & 127, kq = wid >> 1, chalf = wid & 1;
    int slot;
    if (UP) { const int x = cidx & 63; slot = 32 * (x >> 4) + ((cidx >> 6) ? 16 : 0) + (x & 15); } else slot = (cidx & ~31) + perm32_inv(cidx & 31);
    const int bw0 = pg8::lds_byte(slot, 8 * kq), bw1 = pg8::lds_byte(slot, 32 + 8 * kq);
    LAS int* uword = (LAS int*)(lds + MQ_CTL);
    const int nunits = nblk * UPB;
    int bprev = -1;
    for (;;) {
        __syncthreads();
        if (tid == 0) {
            if (UP && bprev >= 0) { __builtin_amdgcn_fence(__ATOMIC_RELEASE, "agent"); asm volatile("s_waitcnt vmcnt(0)" ::: "memory"); (void)xb_add(done + bprev, 1u); }
            const unsigned un = __hip_atomic_fetch_add(qctr, 1u, __ATOMIC_RELAXED, __HIP_MEMORY_SCOPE_AGENT);
            if (!UP && (int)un < nunits) {
                unsigned sp = 0u; while (xb_ld(done + un / UPB) < 8u) { __builtin_amdgcn_s_sleep(2); if (++sp > (1u << 22)) break; }
                __builtin_amdgcn_fence(__ATOMIC_ACQUIRE, "agent"); asm volatile("s_waitcnt vmcnt(0)" ::: "memory");
            }
            uword[0] = (int)un;
        }
        __syncthreads();
        const int u = __builtin_amdgcn_readfirstlane(uword[0]);
        if (u >= nunits) break;
        const int b = u / UPB, j = u % UPB;
        bprev = b;
        const int e = __builtin_amdgcn_readfirstlane(__hip_atomic_load(blk_exp + b, __ATOMIC_RELAXED, __HIP_MEMORY_SCOPE_AGENT));
        unsigned ao[2][2];
#pragma unroll
        for (int h = 0; h < 2; ++h)
#pragma unroll
            for (int i = 0; i < 2; ++i) { const int row = UP ? slot_tok[b * 256 + h * 128 + Rr[i]] : b * 256 + h * 128 + Rr[i]; ao[h][i] = (unsigned)row * (unsigned)(K * 2) + (unsigned)Cc[i] * 2u; }
        const char* Abase = (const char*)(ws + (UP ? WS_UB : WS_HH));
        const float* bcolu;
        if (UP) bcolu = (chalf ? w3 : w1) + (size_t)e * DM * DE + 64 * j; else bcolu = w1 + (size_t)e * DE * DM + 128 * j + 64 * chalf;
        constexpr int LDN = UP ? DE : DM;
        f32x4 acc[8][2];
#pragma unroll
        for (int m = 0; m < 8; ++m)
#pragma unroll
            for (int n = 0; n < 2; ++n) acc[m][n] = (f32x4){0.f, 0.f, 0.f, 0.f};
        float r0[16], r1[16], r2[16];
#define MQ_LOAD_A(t, ra) do { _Pragma("unroll") for (int h = 0; h < 2; ++h) _Pragma("unroll") for (int i = 0; i < 2; ++i) \
            ra[h * 2 + i] = *(const pg8::u32x4*)(Abase + ao[h][i] + (size_t)(t) * 128); } while (0)
#define MQ_WRITE_A(ra, buf) do { _Pragma("unroll") for (int h = 0; h < 2; ++h) _Pragma("unroll") for (int i = 0; i < 2; ++i) \
            *(LAS pg8::u32x4*)(lds + MQ_A + ((buf) * 2 + h) * 16384 + ldsw + i * 8192 + lane * 16) = ra[h * 2 + i]; } while (0)
#define MQ_LOAD_B(t, r) do { const float* p_ = bcolu + (size_t)((t) * 64 + 8 * kq) * LDN; \
            _Pragma("unroll") for (int e_ = 0; e_ < 8; ++e_) { r[e_] = (p_ + (size_t)e_ * LDN)[lane]; r[8 + e_] = (p_ + (size_t)(32 + e_) * LDN)[lane]; } } while (0)
#define MQ_WRITE_B(r, buf) do { pg8::u32x4 w0_, w1_; \
            w0_.x = pg8::cvt_pk_bf16(r[0], r[1]); w0_.y = pg8::cvt_pk_bf16(r[2], r[3]); w0_.z = pg8::cvt_pk_bf16(r[4], r[5]); w0_.w = pg8::cvt_pk_bf16(r[6], r[7]); \
            w1_.x = pg8::cvt_pk_bf16(r[8], r[9]); w1_.y = pg8::cvt_pk_bf16(r[10], r[11]); w1_.z = pg8::cvt_pk_bf16(r[12], r[13]); w1_.w = pg8::cvt_pk_bf16(r[14], r[15]); \
            *(LAS pg8::u32x4*)(lds + MQ_B + (buf) * 16384 + bw0) = w0_; *(LAS pg8::u32x4*)(lds + MQ_B + (buf) * 16384 + bw1) = w1_; } while (0)
#define MQ_COMPUTE(buf) do { const LAS unsigned char* A_ = lds + MQ_A + ((buf) * 2 + wr) * 16384 + aoff; const LAS unsigned char* B_ = lds + MQ_B + (buf) * 16384 + boff; \
            _Pragma("unroll") for (int k = 0; k < 2; ++k) { bf16x8 bf_[2]; \
                _Pragma("unroll") for (int n = 0; n < 2; ++n) bf_[n] = *(const LAS bf16x8*)(B_ + n * 2048 + k * 1024); \
                _Pragma("unroll") for (int mh = 0; mh < 2; ++mh) { bf16x8 af_[4]; \
                    _Pragma("unroll") for (int m = 0; m < 4; ++m) af_[m] = *(const LAS bf16x8*)(A_ + (4 * mh + m) * 2048 + k * 1024); \
                    _Pragma("unroll") for (int m = 0; m < 4; ++m) _Pragma("unroll") for (int n = 0; n < 2; ++n) acc[4 * mh + m][n] = __builtin_amdgcn_mfma_f32_16x16x32_bf16(bf_[n], af_[m], acc[4 * mh + m][n], 0, 0, 0); } } } while (0)
#define MQ_STEP(t, rcur, rnxt, acur, anxt, buf) do { \
            { const int tb_ = (t) + 3 < NT ? (t) + 3 : NT - 1, ta_ = (t) + 2 < NT ? (t) + 2 : NT - 1; MQ_LOAD_A(ta_, acur); MQ_LOAD_B(tb_, rcur); }     \
            MQ_COMPUTE(buf); \
            if ((t) + 1 < NT) { MQ_WRITE_A(anxt, (buf) ^ 1); MQ_WRITE_B(rnxt, (buf) ^ 1); } \
            asm volatile("s_waitcnt lgkmcnt(0)" ::: "memory"); __builtin_amdgcn_s_barrier(); asm volatile("" ::: "memory"); } while (0)
        pg8::u32x4 a0[4], a1[4];
        MQ_LOAD_A(0, a0); MQ_LOAD_B(0, r0); MQ_LOAD_A(1, a1); MQ_LOAD_B(1, r1); MQ_LOAD_B(2, r2);
        MQ_WRITE_A(a0, 0); MQ_WRITE_B(r0, 0);
        asm volatile("s_waitcnt lgkmcnt(0)" ::: "memory"); __builtin_amdgcn_s_barrier(); asm volatile("" ::: "memory");
        static_assert(NT % 6 == 2, "step loop: six steps per trip + two");
#pragma unroll 1
        for (int t = 0; t + 6 <= NT; t += 6) {
            MQ_STEP(t, r0, r1, a0, a1, 0); MQ_STEP(t + 1, r1, r2, a1, a0, 1); MQ_STEP(t + 2, r2, r0, a0, a1, 0);
            MQ_STEP(t + 3, r0, r1, a1, a0, 1); MQ_STEP(t + 4, r1, r2, a0, a1, 0); MQ_STEP(t + 5, r2, r0, a1, a0, 1); }
        { constexpr int t = NT - 2; MQ_STEP(t, r0, r1, a0, a1, 0); MQ_STEP(t + 1, r1, r2, a1, a0, 1); }
        const int row0 = b * 256 + wr * 128 + fr;
        if (UP) {
            bf16* HH = (bf16*)(ws + WS_HH);
#pragma unroll
            for (int m = 0; m < 8; ++m) { float v[4];
#pragma unroll
                for (int r = 0; r < 4; ++r) { const float a = acc[m][0][r], bb = acc[m][1][r]; v[r] = a / (1.f + __expf(-a)) * bb; }
                *(unsigned long long*)(HH + (size_t)(row0 + 16 * m) * DE + 64 * j + 16 * wc + 4 * fq) = (unsigned long long)pg8::cvt_pk_bf16(v[0], v[1]) | ((unsigned long long)pg8::cvt_pk_bf16(v[2], v[3]) << 32); }
        } else {
            bf16* Y = (bf16*)(ws + WS_Y);
#pragma unroll
            for (int m = 0; m < 8; ++m) { const f32x4 v0 = acc[m][0], v1 = acc[m][1];
                pg8::u32x4 w; w.x = pg8::cvt_pk_bf16(v0[0], v0[1]); w.y = pg8::cvt_pk_bf16(v0[2], v0[3]); w.z = pg8::cvt_pk_bf16(v1[0], v1[1]); w.w = pg8::cvt_pk_bf16(v1[2], v1[3]);
                *(pg8::u32x4*)(Y + (size_t)(row0 + 16 * m) * DM + 128 * j + 32 * wc + 8 * fq) = w; }
        }
#undef MQ_LOAD_A
#undef MQ_WRITE_A
#undef MQ_LOAD_B
#undef MQ_WRITE_B
#undef MQ_COMPUTE
#undef MQ_STEP
        if (UP) asm volatile("s_waitcnt vmcnt(0)" ::: "memory");
    }
    asm volatile("s_waitcnt vmcnt(0)" ::: "memory");
    __syncthreads();
}

constexpr int NWAVES = 8;
constexpr int LDS_BYTES = 147456, LDSCTL_OFF = LDS_BYTES - 256;

struct Args { const float* in[31]; float* out; unsigned char* ws; int ph_lo, ph_hi, li, pad; };

struct Epi1 {
    bf16* PG; float* PGATE; float* PT;
    __device__ __forceinline__ void operator()(const pg8::f32x4 (&acc)[2][2][4][2], const pg8::Unit& u, int wr, int wc, int fr, int fq) const {
        const int row0 = u.pm * 256 + wr * 64 + fr;
        if (u.kind == 0) {
            if (u.pn < 16) {
                const int col0 = u.pn * 256 + wc * 32 + 8 * fq;
#pragma unroll
                for (int ai = 0; ai < 2; ++ai)
#pragma unroll
                    for (int m = 0; m < 4; ++m) { bf16* rowp = PG + (size_t)(row0 + ai * 128 + m * 16) * 4096 + col0;
#pragma unroll
                        for (int bj = 0; bj < 2; ++bj) { const pg8::f32x4 v0 = acc[ai][bj][m][0], v1 = acc[ai][bj][m][1];
                            pg8::u32x4 w; w.x = pg8::cvt_pk_bf16(v0[0], v0[1]); w.y = pg8::cvt_pk_bf16(v0[2], v0[3]); w.z = pg8::cvt_pk_bf16(v1[0], v1[1]); w.w = pg8::cvt_pk_bf16(v1[2], v1[3]);
                            *(pg8::u32x4*)(rowp + bj * 128) = w; } }
            } else if (wc == 0) {
#pragma unroll
                for (int ai = 0; ai < 2; ++ai)
#pragma unroll
                    for (int m = 0; m < 4; ++m) { float* rowp = PGATE + (size_t)(row0 + ai * 128 + m * 16) * 32 + 8 * fq;
                        *(pg8::f32x4*)(rowp) = acc[ai][0][m][0]; *(pg8::f32x4*)(rowp + 4) = acc[ai][0][m][1]; }
            }
        } else {
            const int col0 = u.pn * 256 + wc * 32 + 8 * fq;
#pragma unroll
            for (int ai = 0; ai < 2; ++ai)
#pragma unroll
                for (int m = 0; m < 4; ++m) { float* rowp = PT + (size_t)(row0 + ai * 128 + m * 16) * T + col0;
#pragma unroll
                    for (int bj = 0; bj < 2; ++bj) { *(pg8::f32x4*)(rowp + bj * 128) = acc[ai][bj][m][0]; *(pg8::f32x4*)(rowp + bj * 128 + 4) = acc[ai][bj][m][1]; } }
        }
    }
};
struct Order1 {
    const char* Hb; const char* WinT; int G, c;
    __device__ __forceinline__ bool next(int i, pg8::Unit& u) const {
        const int L = i * G + c;
        if (L >= 928) return false;
        u.rows = nullptr;
        if (L < 544) { int pm, pn; pg8::tile_of(L, 32, 17, pm, pn); u.pm = pm; u.pn = pn; u.kind = 0;
            u.A = Hb + (size_t)pm * 256 * DM * 2; u.B = WinT + (size_t)(GOFF + pn * 256) * DM * 2; }
        else { int pm, pn; pg8::tile_of(L - 544, 12, 32, pm, pn); u.pm = pm; u.pn = pn; u.kind = 1;
            u.A = WinT + (size_t)pm * 256 * DM * 2; u.B = Hb + (size_t)pn * 256 * DM * 2; }
        return true;
    }
};

struct Epi2 {
    const float* x; float* X1;
    __device__ __forceinline__ void operator()(const pg8::f32x4 (&acc)[2][2][4][2], const pg8::Unit& u, int wr, int wc, int fr, int fq) const {
        const int row0 = u.pm * 256 + wr * 64 + fr, col0 = u.pn * 256 + wc * 32 + 8 * fq;
#pragma unroll
        for (int ai = 0; ai < 2; ++ai) {
            pg8::f32x4 xv[4][2][2];
#pragma unroll
            for (int m = 0; m < 4; ++m) { const size_t off = (size_t)(row0 + ai * 128 + m * 16) * DM + col0;
#pragma unroll
                for (int bj = 0; bj < 2; ++bj) { xv[m][bj][0] = *(const pg8::f32x4*)(x + off + bj * 128); xv[m][bj][1] = *(const pg8::f32x4*)(x + off + bj * 128 + 4); } }
            asm volatile("" ::: "memory");
#pragma unroll
            for (int m = 0; m < 4; ++m) { const size_t off = (size_t)(row0 + ai * 128 + m * 16) * DM + col0;
#pragma unroll
                for (int bj = 0; bj < 2; ++bj) { *(pg8::f32x4*)(X1 + off + bj * 128) = xv[m][bj][0] + acc[ai][bj][m][0]; *(pg8::f32x4*)(X1 + off + bj * 128 + 4) = xv[m][bj][1] + acc[ai][bj][m][1]; } }
            asm volatile("" ::: "memory"); }
    }
};
struct Order2 {
    const char* A2; const char* WoutT; int G, c;
    __device__ __forceinline__ bool next(int i, pg8::Unit& u) const {
        const int L = i * G + c; if (L >= 256) return false;
        int pm, pn; pg8::tile_of(L, 32, 8, pm, pn); u.pm = pm; u.pn = pn; u.kind = 0; u.rows = nullptr;
        u.A = A2 + (size_t)pm * 256 * DM * 2; u.B = WoutT + (size_t)pn * 256 * DM * 2; return true;
    }
};
struct Epi3 {
    bf16* HH;
    __device__ __forceinline__ void operator()(const pg8::f32x4 (&acc)[2][2][4][2], const pg8::Unit& u, int wr, int wc, int fr, int fq) const {
        const int row0 = u.pm * 256 + wr * 64 + fr, col0 = u.pn * 128 + wc * 32 + 8 * fq;
#pragma unroll
        for (int ai = 0; ai < 2; ++ai)
#pragma unroll
            for (int m = 0; m < 4; ++m) { bf16* rowp = HH + (size_t)(row0 + ai * 128 + m * 16) * DE + col0;
                float v[8];
#pragma unroll
                for (int n = 0; n < 2; ++n)
#pragma unroll
                    for (int j = 0; j < 4; ++j) { const float a = acc[ai][0][m][n][j], b = acc[ai][1][m][n][j]; v[n * 4 + j] = a / (1.f + __expf(-a)) * b; }
                pg8::u32x4 w; w.x = pg8::cvt_pk_bf16(v[0], v[1]); w.y = pg8::cvt_pk_bf16(v[2], v[3]); w.z = pg8::cvt_pk_bf16(v[4], v[5]); w.w = pg8::cvt_pk_bf16(v[6], v[7]);
                *(pg8::u32x4*)rowp = w; }
    }
};
struct Order3 {
    const char* Ub; const char* W13T; const int* slot_tok; const int* blk_exp; int nunits, G, c;
    __device__ __forceinline__ bool next(int i, pg8::Unit& u) const {
        const int L = i * G + c; if (L >= nunits) return false;
        const int b = L >> 2, j = L & 3; u.pm = b; u.pn = j; u.kind = 0; u.rows = slot_tok + b * 256; u.A = Ub;
        const int e = __hip_atomic_load(blk_exp + b, __ATOMIC_RELAXED, __HIP_MEMORY_SCOPE_AGENT);
        u.B = W13T + ((size_t)e * 1024 + j * 256) * DM * 2; return true;
    }
};
struct Epi4 {
    bf16* Y;
    __device__ __forceinline__ void operator()(const pg8::f32x4 (&acc)[2][2][4][2], const pg8::Unit& u, int wr, int wc, int fr, int fq) const {
        const int row0 = u.pm * 256 + wr * 64 + fr, col0 = u.pn * 256 + wc * 32 + 8 * fq;
#pragma unroll
        for (int ai = 0; ai < 2; ++ai)
#pragma unroll
            for (int m = 0; m < 4; ++m) { bf16* rowp = Y + (size_t)(row0 + ai * 128 + m * 16) * DM + col0;
#pragma unroll
                for (int bj = 0; bj < 2; ++bj) { const pg8::f32x4 v0 = acc[ai][bj][m][0], v1 = acc[ai][bj][m][1];
                    pg8::u32x4 w; w.x = pg8::cvt_pk_bf16(v0[0], v0[1]); w.y = pg8::cvt_pk_bf16(v0[2], v0[3]); w.z = pg8::cvt_pk_bf16(v1[0], v1[1]); w.w = pg8::cvt_pk_bf16(v1[2], v1[3]);
                    *(pg8::u32x4*)(rowp + bj * 128) = w; } }
    }
};
struct Order4 {
    const char* HH; const char* W2T; const int* blk_exp; int nunits, G, c;
    __device__ __forceinline__ bool next(int i, pg8::Unit& u) const {
        const int L = i * G + c; if (L >= nunits) return false;
        const int b = L >> 3, j = L & 7; u.pm = b; u.pn = j; u.kind = 0; u.rows = nullptr; u.A = HH + (size_t)b * 256 * DE * 2;
        const int e = __hip_atomic_load(blk_exp + b, __ATOMIC_RELAXED, __HIP_MEMORY_SCOPE_AGENT);
        u.B = W2T + ((size_t)e * DM + j * 256) * DE * 2; return true;
    }
};

struct TrItem { const float* W; int ldn, k0, n0; bf16* WT; size_t dst_row0; int ldk; };
__device__ __forceinline__ void tr_store(const TrItem& I, LAS float* scr, const float (&tv)[32], int lane) {
#pragma unroll
    for (int i = 0; i < 32; ++i) { const int kk = 2 * i + (lane >> 5); scr[kk * 33 + (lane & 31)] = tv[i]; }
    asm volatile("s_waitcnt lgkmcnt(0)" ::: "memory");
    const int c = lane & 7;
#pragma unroll
    for (int j = 0; j < 4; ++j) { const int n = (lane >> 3) + 8 * j; const LAS float* s = scr + (8 * c) * 33 + n;
        v4u o; o.x = pg8::cvt_pk_bf16(s[0 * 33], s[1 * 33]); o.y = pg8::cvt_pk_bf16(s[2 * 33], s[3 * 33]); o.z = pg8::cvt_pk_bf16(s[4 * 33], s[5 * 33]); o.w = pg8::cvt_pk_bf16(s[6 * 33], s[7 * 33]);
        *(GAS v4u*)(I.WT + (I.dst_row0 + n) * I.ldk + I.k0 + 8 * c) = o; }
    asm volatile("s_waitcnt lgkmcnt(0)" ::: "memory");
}
__device__ __forceinline__ void tr_pair(const TrItem& A, const TrItem& B, bool hasB, LAS float* scr, int lane) {
    float ta[32], tb[32];
    const float* pa = A.W + (size_t)(A.k0 + (lane >> 5)) * A.ldn + A.n0 + (lane & 31);
    const float* pb = (hasB ? B.W + (size_t)(B.k0 + (lane >> 5)) * B.ldn + B.n0 : A.W + (size_t)(A.k0 + (lane >> 5)) * A.ldn + A.n0) + (lane & 31);
    const size_t sa = (size_t)2 * A.ldn, sb = (size_t)2 * (hasB ? B.ldn : A.ldn);
#pragma unroll
    for (int i = 0; i < 32; ++i) { ta[i] = pa[i * sa]; tb[i] = pb[i * sb]; }
    tr_store(A, scr, ta, lane);
    if (hasB) tr_store(B, scr, tb, lane);
}
__device__ __forceinline__ void tr_item(const float* W, int ldn, int k0, int n0, bf16* WT, size_t dst_row0, int ldk, LAS float* scr, int lane) {
    const TrItem A{W, ldn, k0, n0, WT, dst_row0, ldk}; tr_pair(A, A, false, scr, lane);
}
__device__ __forceinline__ void rms_row_to_bf16(const float* xrow, const float* w, bf16* orow, int lane) {
    const GAS pg8::f32x4* xr = (const GAS pg8::f32x4*)xrow + lane; const GAS pg8::f32x4* wr = (const GAS pg8::f32x4*)w + lane;
    pg8::f32x4 v[8]; float s = 0.f;
#pragma unroll
    for (int j = 0; j < 8; ++j) { v[j] = xr[64 * j]; s += (v[j].x * v[j].x + v[j].y * v[j].y) + (v[j].z * v[j].z + v[j].w * v[j].w); }
    const float r = rsqrtf(wave_sum(s) * (1.f / DM) + EPS);
    GAS unsigned long long* o8 = (GAS unsigned long long*)orow + lane;
#pragma unroll
    for (int j = 0; j < 8; ++j) { const pg8::f32x4 g = wr[64 * j];
        o8[64 * j] = (unsigned long long)pk2(v[j].x * r * g.x, v[j].y * r * g.y) | ((unsigned long long)pk2(v[j].z * r * g.z, v[j].w * r * g.w) << 32); }
}

__device__ __forceinline__ void rms_rows2_to_bf16(const float* xrow, const float* w, bf16* orow, int lane) {
    const GAS pg8::f32x4* xr = (const GAS pg8::f32x4*)xrow + lane; const GAS pg8::f32x4* wr = (const GAS pg8::f32x4*)w + lane;
    pg8::f32x4 v[2][8], g[8];
#pragma unroll
    for (int q = 0; q < 2; ++q)
#pragma unroll
        for (int j = 0; j < 8; ++j) v[q][j] = xr[q * (DM / 4) + 64 * j];
#pragma unroll
    for (int j = 0; j < 8; ++j) g[j] = wr[64 * j];
#pragma unroll
    for (int q = 0; q < 2; ++q) { float s = 0.f;
#pragma unroll
        for (int j = 0; j < 8; ++j) s += (v[q][j].x * v[q][j].x + v[q][j].y * v[q][j].y) + (v[q][j].z * v[q][j].z + v[q][j].w * v[q][j].w);
        const float r = rsqrtf(wave_sum(s) * (1.f / DM) + EPS);
        GAS unsigned long long* o8 = (GAS unsigned long long*)(orow + (size_t)q * DM) + lane;
#pragma unroll
        for (int j = 0; j < 8; ++j) o8[64 * j] = (unsigned long long)pk2(v[q][j].x * r * g[j].x, v[q][j].y * r * g[j].y) | ((unsigned long long)pk2(v[q][j].z * r * g[j].z, v[q][j].w * r * g[j].w) << 32); }
}

__global__ void __launch_bounds__(NWAVES * 64, 2) fwd(Args args) {
    extern __shared__ __attribute__((aligned(16))) unsigned char lds_raw[];
    LAS unsigned char* lds = (LAS unsigned char*)lds_raw;
    const int tid = threadIdx.x, lane = tid & 63, wave = __builtin_amdgcn_readfirstlane(tid >> 6);
    const int G = gridDim.x; const int bx = blockIdx.x; const int vcu = (G % 8 == 0) ? (bx % 8) * (G / 8) + bx / 8 : bx;
    unsigned char* ws = args.ws;
    unsigned* ctl = (unsigned*)(ws + WS_CTL);
    for (int u = tid; u < (LDS_BYTES - LDSCTL_OFF) / 4; u += NWAVES * 64) ((LAS unsigned*)(lds + LDSCTL_OFF))[u] = 0u;
    __syncthreads();
    XcdBarrier bar = xcd_barrier_post(ctl + CW_BAR + args.li * XCD_BAR_WORDS, (volatile LAS unsigned*)(lds + LDSCTL_OFF + 64));
    static_assert(2 * FFT_BUF_BYTES <= LDSCTL_OFF && 1024 * 33 * 4 <= LDSCTL_OFF, "LDS map");
    const int lo = args.ph_lo, hi = args.ph_hi;
#if 0
#define MK_DUP_MASK 0
#endif
#define IN(k) (lo <= (k) && (k) < hi)
#define BOTH(k) (IN(k) && IN((k) + 1))
    bf16* WinT = (bf16*)(ws + WS_WINT); bf16* Hb = (bf16*)(ws + WS_HB);

    if (IN(0)) { REP(0) {
        int tid_p = tid; asm volatile("" : "+v"(tid_p)); const int lane_p = tid_p & 63; (void)lane_p;
        LAS float* scr = (LAS float*)(lds + wave * 16384);
        const int gw = vcu * NWAVES + wave, NGW = G * NWAVES;
        for (int it = bx; it < 256; it += G)
            hyena_filter_item(lds, it, args.in[5], args.in[6], args.in[7], args.in[8], args.in[9], args.in[10], args.in[11], args.in[12], (float*)(ws + WS_KC), tid_p, lane_p, wave);
        const float* w_in = args.in[2];
        { bf16* WoutT = (bf16*)(ws + WS_WOUTT); const float* w_out = args.in[21];
          auto mk = [&](int it) -> TrItem { if (it < 32 * 225) { const int kb = it / 225, nb = it % 225; return TrItem{w_in, NPROJ, 64 * kb, 32 * nb, WinT, (size_t)(32 * nb), DM}; }
                                           const int j = it - 32 * 225, kb = j >> 6, nb = j & 63; return TrItem{w_out, DM, 64 * kb, 32 * nb, WoutT, (size_t)(32 * nb), DM}; };
          for (int p = gw; p < (32 * 225 + 32 * 64) / 2; p += NGW) tr_pair(mk(2 * p), mk(2 * p + 1), true, scr, lane); }
        for (int r = gw; r < NPROJ_PAD - NPROJ; r += NGW) { GAS v4u* o = (GAS v4u*)(WinT + (size_t)(NPROJ + r) * DM) + lane;
#pragma unroll
            for (int j = 0; j < 4; ++j) o[64 * j] = (v4u){0u, 0u, 0u, 0u}; }
        { bf16* RWh = (bf16*)(ws + WS_SMALL + SM_RWT); bf16* RWl = RWh + 80 * 2048; const float* rgw = args.in[23]; const float* rew = args.in[25];
          for (int i = vcu * 512 + tid; i < 80 * 2048; i += G * 512) { const int n = i >> 11, k = i & 2047;
              const float w = n < 8 ? rgw[k * 8 + n] : (n < 72 ? rew[k * 64 + n - 8] : 0.f); const unsigned h = f2bf(w); const float hf = __builtin_bit_cast(float, h << 16);
              const int kk = k & 31, o = (i & ~31) + 8 * ((kk & 15) >> 2) + (kk & 3) + ((kk >> 4) << 2);
              RWh[o] = (bf16)h; RWl[o] = (bf16)f2bf(w - hf); } }
        for (int m = 2 * gw; m < T; m += 2 * NGW) rms_rows2_to_bf16(args.in[0] + (size_t)m * DM, args.in[1], Hb + (size_t)m * DM, lane);
        }
        if (BOTH(0)) xcd_barrier(bar);
    }
    if (IN(1)) { REP(1) {
        int tid_p = tid; asm volatile("" : "+v"(tid_p)); const int lane_p = tid_p & 63; (void)lane_p;
        Order1 S{(const char*)Hb, (const char*)WinT, G, bx};
        Epi1 E{(bf16*)(ws + WS_PG), (float*)(ws + WS_PGATE), (float*)(ws + WS_PT)};
        pg8::gemm_phase<Epi1, Order1, false>(lds, DM, S, E, tid_p);
        }
        if (BOTH(1)) xcd_barrier(bar);
    }
    if (IN(2)) { REP(2) {
        int tid_p = tid; asm volatile("" : "+v"(tid_p)); const int lane_p = tid_p & 63; (void)lane_p;
        REP(11) hyena_phase(lds, (const float*)(ws + WS_PT), (const float*)(ws + WS_KC), args.in[3], args.in[4], args.in[13], (float*)(ws + WS_YHT), G, vcu);
        REP(12) for (int wg = bx; wg < 256; wg += G) {
            int tid_i = tid_p; asm volatile("" : "+v"(tid_i)); const int lane_i = tid_i & 63;
            gdn_pre(lds, wg, (const bf16*)(ws + WS_PG), (const float*)(ws + WS_PGATE), args.in[15], args.in[16], args.in[17], args.in[18], args.in[19], ws, tid_i, lane_i, wave);
            gdn_prep_wave(lds, wg, ws, lane_i, wave);
            __syncthreads();
        }
        }
        if (BOTH(2)) xcd_barrier(bar);
    }
    if (IN(3)) { REP(3) {
        int tid_p = tid; asm volatile("" : "+v"(tid_p)); const int lane_p = tid_p & 63; (void)lane_p;
        for (int v = vcu; v < 256; v += G) gdn_scan(lds, ws, (bf16*)(ws + WS_OF), (bf16*)(ws + WS_OB), v, tid_p, lane_p, wave);
        }
        if (BOTH(3)) xcd_barrier(bar);
    }
    if (IN(4)) { REP(4) {
        int tid_p = tid; asm volatile("" : "+v"(tid_p)); const int lane_p = tid_p & 63; (void)lane_p;
        for (int tile = bx; tile < T / 32; tile += G) hyena_post_tile(lds, tile, (const float*)(ws + WS_YHT), args.in[14], (bf16*)(ws + WS_A2), tid_p, lane_p, wave);
        for (int it = (vcu * NWAVES + wave) * 8; it < T * 8; it += G * NWAVES * 8) gdn_post_batch(it, (const bf16*)(ws + WS_OF), (const bf16*)(ws + WS_OB), (const bf16*)(ws + WS_PG), args.in[20], (bf16*)(ws + WS_A2), lane_p);
        }
        if (BOTH(4)) xcd_barrier(bar);
    }
    if (IN(5)) { REP(5) {
        int tid_p = tid; asm volatile("" : "+v"(tid_p)); const int lane_p = tid_p & 63; (void)lane_p;
        Order2 S{(const char*)(ws + WS_A2), (const char*)(ws + WS_WOUTT), G, bx};
        Epi2 E{args.in[0], (float*)(ws + WS_X1)};
        pg8::gemm_phase<Epi2, Order2, false>(lds, DM, S, E, tid_p);
        }
        if (BOTH(5)) xcd_barrier(bar);
    }
    if (IN(6)) {
        int tid_p = tid; asm volatile("" : "+v"(tid_p)); const int lane_p = tid_p & 63; (void)lane_p;
        REP(6) for (int wg = bx; wg < 256; wg += G) { route_phase(lds, wg, (const float*)(ws + WS_X1), args.in[22], args.in[24], args.in[26], ws, ctl + CW_CNT + rep_ * 128, tid_p, lane_p, wave); __syncthreads(); }
        if (BOTH(6)) xcd_barrier(bar);
    }
    if (IN(7)) {
        int tid_p = tid; asm volatile("" : "+v"(tid_p)); const int lane_p = tid_p & 63; (void)lane_p;
        REP(7) for (int wg = bx; wg < 256; wg += G) fill_phase(lds, wg, ws, ctl + CW_CNT, tid_p);
        if (BOTH(7)) xcd_barrier(bar);
    }
    const int* slot_tok = (const int*)(ws + WS_SMALL + SM_SLOTTOK); const int* blk_exp = (const int*)(ws + WS_SMALL + SM_BLKEXP); const int* nblk_p = (const int*)(ws + WS_SMALL + SM_NBLK);
    if (IN(8)) { REP(8) {
        int tid_p = tid; asm volatile("" : "+v"(tid_p)); const int lane_p = tid_p & 63; (void)lane_p;
        const int nblk = __hip_atomic_load(nblk_p, __ATOMIC_RELAXED, __HIP_MEMORY_SCOPE_AGENT);
        moe_gemm<true>(lds, ws, args.in[27], args.in[28], ctl + CW_Q8 + rep_ * 32, ctl + CW_DONE, nblk, tid_p);
        }
    }
    if (IN(9)) { REP(9) {
        int tid_p = tid; asm volatile("" : "+v"(tid_p)); const int lane_p = tid_p & 63; (void)lane_p;
        const int nblk = __hip_atomic_load(nblk_p, __ATOMIC_RELAXED, __HIP_MEMORY_SCOPE_AGENT);
        moe_gemm<false>(lds, ws, args.in[29], nullptr, ctl + CW_Q9 + rep_ * 32, ctl + CW_DONE, nblk, tid_p);
        }
        if (BOTH(9)) xcd_barrier(bar);
    }
    if (IN(10)) { REP(10) {
        int tid_p = tid; asm volatile("" : "+v"(tid_p)); const int lane_p = tid_p & 63; (void)lane_p;
        for (int t = (vcu * NWAVES + wave) * 2; t < T; t += G * NWAVES * 2) final_rows(t, (const float*)(ws + WS_X1), (const bf16*)(ws + WS_Y), ws, args.in[30], args.out, lane_p);
    }
    }
#undef IN
#undef BOTH
}

#ifndef MK_PER_PHASE
#define MK_PER_PHASE 0
#endif
constexpr int N_PHASES = 11;
extern "C" void kernel_launch(void* const* d_in, const int* in_sizes, int n_in, void* d_out, int out_size, void* d_ws, size_t ws_size, hipStream_t stream) {
    static int grid = 0;
    if (grid == 0) {
        int dev = 0, cus = 0;
        (void)hipGetDevice(&dev); (void)hipDeviceGetAttribute(&cus, hipDeviceAttributeMultiprocessorCount, dev);
        (void)hipFuncSetAttribute((const void*)fwd, hipFuncAttributeMaxDynamicSharedMemorySize, LDS_BYTES);
        int per_cu = 0; (void)hipOccupancyMaxActiveBlocksPerMultiprocessor(&per_cu, (const void*)fwd, NWAVES * 64, LDS_BYTES);
        (void)hipGetLastError();
        grid = cus > 0 ? cus : 256;
    }
    (void)hipMemsetAsync((char*)d_ws + WS_CTL, 0, CTL_ZERO_BYTES, stream);
    Args a{};
    for (int i = 0; i < 31; ++i) a.in[i] = (const float*)d_in[i];
    a.out = (float*)d_out; a.ws = (unsigned char*)d_ws;
#if MK_PER_PHASE
    for (int p = 0; p < N_PHASES; ++p) { a.ph_lo = p; a.ph_hi = p + 1; a.li = 0; hipLaunchKernelGGL(fwd, dim3(grid), dim3(NWAVES * 64), LDS_BYTES, stream, a); }
#else
    a.ph_lo = 0; a.ph_hi = N_PHASES; a.li = 0;
    hipLaunchKernelGGL(fwd, dim3(grid), dim3(NWAVES * 64), LDS_BYTES, stream, a);
#endif
}
```

```cpp
#include <hip/hip_runtime.h>
#include <type_traits>
#include <cstdio>
#include <cstdint>
#include <cmath>

constexpr int BATCH = 2, LSEQ = 4096, DM = 2048, T = BATCH * LSEQ;
constexpr int DHY = 1024, DGD = 1024, NH = 8, HD = 128;
constexpr int NPROJ = 3 * DHY + 4 * DGD + 4 * NH;
constexpr int GOFF = 3 * DHY;
constexpr int NPROJ_PAD = 7424;
constexpr int NG = 8, EPG = 8, NE = 64, DE = 512;
constexpr int RB = 256, PMAX = 32768, NBLK_MAX = 128;
constexpr float EPS = 1e-6f;

constexpr size_t MiB = 1u << 20;
constexpr size_t WS_CTL = 0;
constexpr size_t CTL_ZERO_BYTES = 1 * MiB;
constexpr size_t WS_SMALL = 2 * MiB;
constexpr size_t WS_WINT = 16 * MiB;
constexpr size_t WS_WOUTT = 608 * MiB;
constexpr size_t WS_HB = 56 * MiB;
constexpr size_t WS_PT = 88 * MiB;
constexpr size_t WS_PG = 184 * MiB;
constexpr size_t WS_PGATE = 248 * MiB;
constexpr size_t WS_A2 = 250 * MiB;
constexpr size_t WS_KC = 282 * MiB;
constexpr size_t WS_YHT = 314 * MiB;
constexpr size_t WS_X0 = 314 * MiB, WS_VG = 346 * MiB, WS_YH = 378 * MiB;
constexpr size_t WS_QN = 16 * MiB, WS_KN = 32 * MiB, WS_KT = 48 * MiB, WS_VT = 64 * MiB;
constexpr size_t WS_V = 346 * MiB, WS_OF = 378 * MiB, WS_OB = 410 * MiB;
constexpr size_t GW_B = 64 * 272, GKDT_B = 128 * 144, GQK_B = 64 * 144, GUT_B = 128 * 128;
constexpr size_t WS_GW = 442 * MiB;
constexpr size_t WS_GQD = WS_GW + 2048 * GW_B;
constexpr size_t WS_GKDT = WS_GQD + 2048 * GW_B;
constexpr size_t WS_GQK = WS_GKDT + 2048 * GKDT_B;
constexpr size_t WS_GUT = WS_GQK + 2048 * GQK_B;
constexpr size_t WS_GCD = WS_GUT + 2048 * GUT_B + 4096;
static_assert(WS_GCD + 2048 * 4 <= 640 * MiB, "ws map");
constexpr size_t WS_W13T = 640 * MiB;
constexpr size_t WS_W2T = 896 * MiB;
constexpr size_t WS_X1 = 282 * MiB;
constexpr size_t WS_U = 346 * MiB;
constexpr size_t WS_UB = 412 * MiB;
constexpr size_t WS_HH = 446 * MiB;
constexpr size_t WS_Y = 88 * MiB;
constexpr int CW_CNT = 0;
constexpr int CW_Q8 = 1024, CW_Q9 = 2048;
constexpr int CW_DONE = 3072;
constexpr int CW_BAR = 4096;
constexpr size_t SM_LOGITS = 0;
constexpr size_t SM_GB = SM_LOGITS + (size_t)T * 72 * 4;
constexpr size_t SM_EID = SM_GB + (size_t)4 * T * 8 * 4;
constexpr size_t SM_GATE = SM_EID + (size_t)T * 2 * 4;
constexpr size_t SM_POS = SM_GATE + (size_t)T * 2 * 4;
constexpr size_t SM_TSLOT = SM_POS + (size_t)T * 2 * 4;
constexpr size_t SM_SLOTTOK = SM_TSLOT + (size_t)T * 2 * 4;
constexpr size_t SM_BLKEXP = SM_SLOTTOK + (size_t)PMAX * 4;
constexpr size_t SM_PADSTART = SM_BLKEXP + NBLK_MAX * 4;
constexpr size_t SM_NBLK = SM_PADSTART + NE * 4;
constexpr size_t SM_RWT = (SM_NBLK + 256 + 255) / 256 * 256;
static_assert(SM_RWT + 2 * 80 * 2048 * 2 <= 14 * MiB, "small region");

#define LAS __attribute__((address_space(3)))
#define GAS __attribute__((address_space(1)))
typedef unsigned short bf16;
typedef unsigned v4u __attribute__((ext_vector_type(4)));

__device__ __forceinline__ float dpp_f(float v, const int ctrl_unused) { return v; }
#define WS_DPP(v, ctrl) __builtin_bit_cast(float, __builtin_amdgcn_update_dpp(0, __builtin_bit_cast(int, (v)), (ctrl), 0xF, 0xF, true))
__device__ __forceinline__ float wave_sum(float v) {
    v += WS_DPP(v, 0xB1);
    v += WS_DPP(v, 0x4E);
    v += WS_DPP(v, 0x141);
    v += WS_DPP(v, 0x140);
    v += __shfl_xor(v, 16); v += __shfl_xor(v, 32);
    return v;
}
__device__ __forceinline__ float silu_f(float x) { return x * __builtin_amdgcn_rcpf(1.f + __expf(-x)); }
__device__ __forceinline__ float sigmoid_f(float x) { return __builtin_amdgcn_rcpf(1.f + __expf(-x)); }
__device__ __forceinline__ float softplus_f(float x) { return fmaxf(x, 0.f) + log1pf(expf(-fabsf(x))); }
typedef float pk2_f2 __attribute__((ext_vector_type(2)));
typedef __bf16 pk2_b2 __attribute__((ext_vector_type(2)));
__device__ __forceinline__ unsigned pk2(float lo, float hi) { const pk2_f2 f = {lo, hi}; return __builtin_bit_cast(unsigned, __builtin_convertvector(f, pk2_b2)); }
__device__ __forceinline__ unsigned f2bf(float f) { return pk2(f, 0.f) & 0xffffu; }
typedef float up4_f32x4 __attribute__((ext_vector_type(4)));
__device__ __forceinline__ up4_f32x4 unpack4(unsigned long long v) { const unsigned lo = (unsigned)v, hi = (unsigned)(v >> 32);
    return (up4_f32x4){__builtin_bit_cast(float, lo << 16), __builtin_bit_cast(float, lo & 0xffff0000u), __builtin_bit_cast(float, hi << 16), __builtin_bit_cast(float, hi & 0xffff0000u)}; }
__device__ __forceinline__ float bf2f(bf16 b) { return __builtin_bit_cast(float, ((unsigned)b) << 16); }

#ifndef MK_DUP_MASK
#define MK_DUP_MASK 0
#endif
#ifndef MK_TPROBE
#define MK_TPROBE (-1)
#endif
#ifndef MK_TSCALE
#define MK_TSCALE 4e-6f
#endif
#define REP(k) _Pragma("unroll 1") for (int rep_ = 0; rep_ < (((MK_DUP_MASK) >> (k)) & 1) + 1; ++rep_)
constexpr int LDSCTL_OFF_C = 147456 - 256;
namespace pg8 {
#define PG8_LAS __attribute__((address_space(3)))
typedef unsigned short bf16_t;
typedef short bf16x8 __attribute__((ext_vector_type(8)));
typedef float f32x4 __attribute__((ext_vector_type(4)));
typedef unsigned u32x4 __attribute__((ext_vector_type(4)));
constexpr int BM = 256, BK = 64, HALF = 128, HTB = HALF * BK * 2  , STAGE_BYTES = 8 * HTB, NXCD = 8, WGM = 8;

__host__ __device__ __forceinline__ int lds_byte(int r, int c) { const int st = (r >> 4) * 2 + (c >> 5), rr = r & 15, cc = c & 31, ob = rr * 64 + cc * 2; return st * 1024 + (ob ^ (((ob >> 9) & 1) << 5)); }
__host__ __device__ __forceinline__ void stage_rc(int b, int& R, int& C) { const int st = b / 1024, sb = b % 1024, swz = sb ^ (((sb >> 9) & 1) << 5); R = (st >> 1) * 16 + swz / 64; C = (st & 1) * 32 + (swz % 64) / 2; }
__host__ __device__ __forceinline__ int perm32(int rho) { const int n = rho >> 4, i = rho & 15; return 8 * (i >> 2) + 4 * n + (i & 3); }

struct Unit { const char* A; const char* B; const int* rows; int pm, pn, kind; };

__device__ __forceinline__ void tile_of(int L, int nM, int nN, int& pm, int& pn) {
    const int nwg = nM * nN;
    int wgid = L; { const int q = nwg / NXCD, r = nwg % NXCD, xcd = wgid % NXCD, off = wgid / NXCD; wgid = (xcd < r ? xcd * (q + 1) : r * (q + 1) + (xcd - r) * q) + off; }
    const int nig = WGM * nN, gid = wgid / nig, fm = gid * WGM, gsz = (nM - fm) < WGM ? (nM - fm) : WGM;
    pm = fm + ((wgid % nig) % gsz); pn = (wgid % nig) / gsz;
}

typedef float cvt_f2 __attribute__((ext_vector_type(2)));
typedef __bf16 cvt_b2 __attribute__((ext_vector_type(2)));
__device__ __forceinline__ unsigned cvt_pk_bf16(float lo, float hi) { const cvt_f2 f = {lo, hi}; const cvt_b2 v = __builtin_convertvector(f, cvt_b2); return __builtin_bit_cast(unsigned, v); }

template <class Epi, class Sched, bool GATHER>
__device__ __forceinline__ void gemm_phase(PG8_LAS unsigned char* lds, const int K, const Sched& S, const Epi& E, const int tid) {
    const int wid = __builtin_amdgcn_readfirstlane(tid >> 6), lane = tid & 63, wr = wid >> 2, wc = wid & 3, fr = lane & 15, fq = lane >> 4;
    const int nt = K / BK;
    int Rr[2], Cc[2];
    unsigned voffB[2];
#pragma unroll
    for (int i = 0; i < 2; ++i) { stage_rc(tid * 16 + i * 8192, Rr[i], Cc[i]); const int Rb = (Rr[i] & ~31) + perm32(Rr[i] & 31); voffB[i] = (unsigned)(Rb * K + Cc[i]) * 2u; }
    const size_t kstep = (size_t)(BK * 2);
    const size_t hstep = (size_t)HALF * K * 2;
    const unsigned ldsw = (unsigned)wid * 1024u;
    const int aoff = lds_byte(wr * 64 + fr, fq * 8), boff = lds_byte(wc * 32 + fr, fq * 8);
#define PG8_SA(b, h) (((b) * 2 + (h)) * HTB)
#define PG8_SB(b, h) ((4 + (b) * 2 + (h)) * HTB)
#define PG8_STAGE2(bufoff, gbase, v0, v1) do { \
        __builtin_amdgcn_global_load_lds((const unsigned*)((const char*)(gbase) + (v0)), (PG8_LAS unsigned*)(lds + (bufoff) + ldsw), 16, 0, 0); \
        __builtin_amdgcn_global_load_lds((const unsigned*)((const char*)(gbase) + (v1)), (PG8_LAS unsigned*)(lds + (bufoff) + ldsw + 8192), 16, 0, 0); } while (0)
#define PG8_STAGEB(bufoff, gbase) PG8_STAGE2(bufoff, gbase, voffB[0], voffB[1])
#define PG8_LDA(dst, b, h) do { _Pragma("unroll") for (int m = 0; m < 4; ++m) _Pragma("unroll") for (int k = 0; k < 2; ++k) dst[m][k] = *(const PG8_LAS bf16x8*)(lds + PG8_SA(b, h) + aoff + m * 2048 + k * 1024); } while (0)
#define PG8_LDB(dst, b, h) do { _Pragma("unroll") for (int n = 0; n < 2; ++n) _Pragma("unroll") for (int k = 0; k < 2; ++k) dst[n][k] = *(const PG8_LAS bf16x8*)(lds + PG8_SB(b, h) + boff + n * 2048 + k * 1024); } while (0)
#define PG8_MMA(ai, bj, At, Bt) do { __builtin_amdgcn_s_setprio(1); _Pragma("unroll") for (int m = 0; m < 4; ++m) _Pragma("unroll") for (int n = 0; n < 2; ++n) _Pragma("unroll") for (int k = 0; k < 2; ++k) \
        acc[ai][bj][m][n] = __builtin_amdgcn_mfma_f32_16x16x32_bf16(Bt[n][k], At[m][k], acc[ai][bj][m][n], 0, 0, 0); __builtin_amdgcn_s_setprio(0); } while (0)
#define PG8_WAIT_V(n) asm volatile("s_waitcnt vmcnt(" #n ")" ::: "memory")
#define PG8_WAIT_L(n) asm volatile("s_waitcnt lgkmcnt(" #n ")" ::: "memory")
#define PG8_BAR __builtin_amdgcn_s_barrier()
#define PG8_SCHED __builtin_amdgcn_sched_barrier(0)
    Unit cur, nxt; int ui = 0;
    if (!S.next(0, cur)) return;
    f32x4 acc[2][2][4][2];
#pragma unroll
    for (int a = 0; a < 2; ++a)
#pragma unroll
        for (int b = 0; b < 2; ++b)
#pragma unroll
            for (int m = 0; m < 4; ++m)
#pragma unroll
                for (int n = 0; n < 2; ++n) acc[a][b][m][n] = (f32x4){0.f, 0.f, 0.f, 0.f};
    bf16x8 At[4][2], B0[2][2], B1[2][2];
    unsigned c00, c01, c10, c11, n00, n01, n10, n11;
    if constexpr (GATHER) {
        c00 = (unsigned)cur.rows[Rr[0]] * (unsigned)(K * 2) + (unsigned)Cc[0] * 2u; c01 = (unsigned)cur.rows[Rr[1]] * (unsigned)(K * 2) + (unsigned)Cc[1] * 2u;
        c10 = (unsigned)cur.rows[128 + Rr[0]] * (unsigned)(K * 2) + (unsigned)Cc[0] * 2u; c11 = (unsigned)cur.rows[128 + Rr[1]] * (unsigned)(K * 2) + (unsigned)Cc[1] * 2u;
    } else {
        c00 = (unsigned)(Rr[0] * K + Cc[0]) * 2u; c01 = (unsigned)(Rr[1] * K + Cc[1]) * 2u;
        c10 = c00 + (unsigned)hstep; c11 = c01 + (unsigned)hstep;
    }
    n00 = c00; n01 = c01; n10 = c10; n11 = c11;
    const char* cA = cur.A; const char* cB = cur.B;
    PG8_STAGEB(PG8_SB(0, 0), cB); PG8_STAGEB(PG8_SB(0, 1), cB + hstep); PG8_STAGE2(PG8_SA(0, 0), cA, c00, c01); PG8_STAGE2(PG8_SA(0, 1), cA, c10, c11);
    if (wr == 1) PG8_BAR;
    PG8_WAIT_V(2); PG8_BAR;
    PG8_STAGEB(PG8_SB(1, 0), cB + kstep); PG8_STAGE2(PG8_SA(1, 0), cA + kstep, c00, c01); PG8_STAGEB(PG8_SB(1, 1), cB + hstep + kstep);
    PG8_WAIT_V(6); PG8_BAR;
    for (;;) {
        const bool has_next = S.next(ui + 1, nxt);
        const char* nA = has_next ? nxt.A : cA; const char* nB = has_next ? nxt.B : cB;
        if constexpr (GATHER) {
            if (has_next) {
                n00 = (unsigned)nxt.rows[Rr[0]] * (unsigned)(K * 2) + (unsigned)Cc[0] * 2u; n01 = (unsigned)nxt.rows[Rr[1]] * (unsigned)(K * 2) + (unsigned)Cc[1] * 2u;
                n10 = (unsigned)nxt.rows[128 + Rr[0]] * (unsigned)(K * 2) + (unsigned)Cc[0] * 2u; n11 = (unsigned)nxt.rows[128 + Rr[1]] * (unsigned)(K * 2) + (unsigned)Cc[1] * 2u;
            } else { n00 = c00; n01 = c01; n10 = c10; n11 = c11; }
        }
        for (int t = 0; t < nt; t += 2) {
            const bool last = (t == nt - 2);
            const char* a1 = cA + (size_t)(t + 1) * kstep;
            const char* a2 = last ? nA : cA + (size_t)(t + 2) * kstep; const char* b2 = last ? nB : cB + (size_t)(t + 2) * kstep;
            const char* a3 = a2 + kstep; const char* b3 = b2 + kstep;
            unsigned e00, e01, e10, e11;
            if constexpr (GATHER) { e00 = last ? n00 : c00; e01 = last ? n01 : c01; e10 = last ? n10 : c10; e11 = last ? n11 : c11; } else { e00 = c00; e01 = c01; e10 = c10; e11 = c11; }
            PG8_LDB(B0, 0, 0); PG8_LDB(B1, 0, 1); PG8_SCHED; PG8_LDA(At, 0, 0); PG8_STAGE2(PG8_SA(1, 1), a1, c10, c11);
            PG8_WAIT_V(8); PG8_WAIT_L(0); PG8_BAR; PG8_MMA(0, 0, At, B0); PG8_MMA(0, 1, At, B1); PG8_BAR; PG8_SCHED;
            PG8_LDA(At, 0, 1); PG8_STAGEB(PG8_SB(0, 0), b2); PG8_STAGEB(PG8_SB(0, 1), b2 + hstep); PG8_STAGE2(PG8_SA(0, 0), a2, e00, e01);
            PG8_WAIT_V(8); PG8_WAIT_L(0); PG8_BAR; PG8_MMA(1, 0, At, B0); PG8_MMA(1, 1, At, B1); PG8_BAR; PG8_SCHED;
            PG8_LDB(B0, 1, 0); PG8_LDB(B1, 1, 1); PG8_SCHED; PG8_LDA(At, 1, 0); PG8_STAGE2(PG8_SA(0, 1), a2, e10, e11);
            PG8_WAIT_V(8); PG8_WAIT_L(0); PG8_BAR; PG8_MMA(0, 0, At, B0); PG8_MMA(0, 1, At, B1); PG8_BAR; PG8_SCHED;
            PG8_LDA(At, 1, 1); PG8_STAGEB(PG8_SB(1, 0), b3); PG8_STAGEB(PG8_SB(1, 1), b3 + hstep); PG8_STAGE2(PG8_SA(1, 0), a3, e00, e01);
            PG8_WAIT_V(8); PG8_WAIT_L(0); PG8_BAR; PG8_MMA(1, 0, At, B0); PG8_MMA(1, 1, At, B1); PG8_BAR; PG8_SCHED;
        }
        if (wr == 0) PG8_BAR;
        E(acc, cur, wr, wc, fr, fq);
        if (!has_next) break;
#pragma unroll
        for (int a = 0; a < 2; ++a)
#pragma unroll
            for (int b = 0; b < 2; ++b)
#pragma unroll
                for (int m = 0; m < 4; ++m)
#pragma unroll
                    for (int n = 0; n < 2; ++n) acc[a][b][m][n] = (f32x4){0.f, 0.f, 0.f, 0.f};
        cur = nxt; cA = nA; cB = nB; ++ui;
        if constexpr (GATHER) { c00 = n00; c01 = n01; c10 = n10; c11 = n11; }
        if (wr == 1) PG8_BAR;
    }
    PG8_WAIT_V(0);
    PG8_BAR;
#undef PG8_SA
#undef PG8_SB
#undef PG8_STAGE2
#undef PG8_STAGEB
#undef PG8_LDA
#undef PG8_LDB
#undef PG8_MMA
#undef PG8_WAIT_V
#undef PG8_WAIT_L
#undef PG8_BAR
#undef PG8_SCHED
}
}

#define XB_TMO      128
#define XB_XCNT(j)  (256  + 64 * (j))
#define XB_XSUB(j)  (1280 + 64 * (j))
#define XB_XGEN(j)  (2304 + 64 * (j))
#define XB_TOP      3328
#define XB_TOPGEN   3392
#define XCD_BAR_WORDS 3456
#define XB_SPIN_CAP (1u << 18)
__device__ __forceinline__ unsigned xb_ld(unsigned* p)              { return __hip_atomic_load(p, __ATOMIC_RELAXED, __HIP_MEMORY_SCOPE_AGENT); }
__device__ __forceinline__ unsigned xb_add(unsigned* p, unsigned v) { return __hip_atomic_fetch_add(p, v, __ATOMIC_RELAXED, __HIP_MEMORY_SCOPE_AGENT); }
__device__ __forceinline__ unsigned xb_xcc_id() { return (unsigned)__builtin_amdgcn_s_getreg((3 << 11) | 20) & 0xFu; }
#define XB_SPIN(cond, bar) do { unsigned _sp = 0; while (cond) { __builtin_amdgcn_s_sleep(1); \
    if ((++_sp & 255u) == 0u) { if (xb_ld(&(bar)[XB_TMO])) break; if (_sp > XB_SPIN_CAP) { atomicAdd(&(bar)[XB_TMO], 1u); break; } } } } while (0)
struct XcdBarrier { unsigned* bar; unsigned x; volatile LAS unsigned* st; };
__device__ __forceinline__ XcdBarrier xcd_barrier_post(unsigned* bar, volatile LAS unsigned* st) {
    XcdBarrier b; b.bar = bar; b.x = xb_xcc_id(); b.st = st;
    if (threadIdx.x == 0) (void)xb_add(&bar[XB_XCNT(b.x)], 1u);
    return b;
}
__device__ __forceinline__ void xcd_barrier_complete(unsigned* bar, unsigned x, unsigned& nloc, unsigned& nx) {
    const unsigned G = gridDim.x * gridDim.y * gridDim.z;
    unsigned sum, cnt, mine, sp = 0u;
    for (;;) {
        sum = 0u; cnt = 0u; mine = 0u;
#pragma unroll
        for (unsigned j = 0; j < 16; ++j) { const unsigned c = xb_ld(&bar[XB_XCNT(j)]); sum += c; cnt += (c > 0u) ? 1u : 0u; mine = (j == x) ? c : mine; }
        if (sum == G) break;
        __builtin_amdgcn_s_sleep(1);
        if ((++sp & 255u) == 0u) { if (xb_ld(&bar[XB_TMO])) break; if (sp > XB_SPIN_CAP) { atomicAdd(&bar[XB_TMO], 1u); break; } }
    }
    nloc = mine > 0u ? mine : 1u; nx = cnt > 0u ? cnt : 1u;
}
template <int BYTES>
__device__ __forceinline__ void code_prefetch(int idx, int nthr) {
    const char* pc = (const char*)((unsigned long long)__builtin_amdgcn_s_getpc() & ~63ull);
    constexpr int NL = (BYTES + 448 * 16 - 1) / (448 * 16);
    pg8::u32x4 v[NL];
#pragma unroll
    for (int k = 0; k < NL; ++k) { int o = (idx + k * nthr) * 16; o = o < BYTES - 16 ? o : BYTES - 16; v[k] = *(const pg8::u32x4*)(pc + o); }
#pragma unroll
    for (int k = 0; k < NL; ++k) asm volatile("" :: "v"(v[k]));
}
template <int PF = 0>
__device__ __forceinline__ void xcd_barrier(const XcdBarrier& b) {
    asm volatile("s_waitcnt vmcnt(0)" ::: "memory");
    __syncthreads();
    if (PF > 0 && threadIdx.x >= 64) code_prefetch<(PF > 0 ? PF : 16)>((int)threadIdx.x - 64, 448);
    if (threadIdx.x == 0) {
        unsigned* bar = b.bar;
        __builtin_amdgcn_s_waitcnt(0);
        unsigned nloc = b.st[0], nx = b.st[1];
        if (nloc == 0u) { xcd_barrier_complete(bar, b.x, nloc, nx); b.st[0] = nloc; b.st[1] = nx; }
        const unsigned old = xb_add(&bar[XB_XSUB(b.x)], 1u);
        const unsigned gen = old / nloc;
        if (old + 1u == (gen + 1u) * nloc) {
            __builtin_amdgcn_fence(__ATOMIC_RELEASE, "agent");
            asm volatile("s_waitcnt vmcnt(0)" ::: "memory");
            const unsigned og = xb_add(&bar[XB_TOP], 1u);
            const unsigned tg = og / nx;
            if (og + 1u == (tg + 1u) * nx) xb_add(&bar[XB_TOPGEN], 1u);
            else XB_SPIN(xb_ld(&bar[XB_TOPGEN]) == tg, bar);
            __builtin_amdgcn_fence(__ATOMIC_ACQUIRE, "agent");
            xb_add(&bar[XB_XGEN(b.x)], 1u);
            asm volatile("s_waitcnt vmcnt(0)" ::: "memory");
        } else {
            XB_SPIN(xb_ld(&bar[XB_XGEN(b.x)]) == gen, bar);
            __builtin_amdgcn_fence(__ATOMIC_ACQUIRE, "agent");
            asm volatile("s_waitcnt vmcnt(0)" ::: "memory");
        }
    }
    __syncthreads();
}


#define HD __device__ __forceinline__
struct cpx { float x, y; };
HD cpx cadd(cpx a, cpx b) { return cpx{a.x + b.x, a.y + b.y}; }
HD cpx csub(cpx a, cpx b) { return cpx{a.x - b.x, a.y - b.y}; }
HD cpx cmul(cpx a, cpx b) { return cpx{a.x * b.x - a.y * b.y, a.x * b.y + a.y * b.x}; }
HD cpx cconj(cpx a) { return cpx{a.x, -a.y}; }
HD int fft_pp(int p) { return p + 2 * (p >> 5); }
constexpr int FFT_N = 8192, FFT_BUF_BYTES = (FFT_N + 2 * (FFT_N >> 5)) * 8;

template <bool INV> HD cpx mul_w16(cpx d, int k) {
    const float C1 = 0.92387953251128674f, S1 = 0.38268343236508977f, R2 = 0.70710678118654752f;
    float c, s;
    switch (k & 15) {
        case 0: return d;
        case 4: return INV ? cpx{-d.y, d.x} : cpx{d.y, -d.x};
        case 8: return cpx{-d.x, -d.y};
        case 12: return INV ? cpx{d.y, -d.x} : cpx{-d.y, d.x};
        case 1: c = C1; s = S1; break;
        case 2: c = R2; s = R2; break;
        case 3: c = S1; s = C1; break;
        case 5: c = -S1; s = C1; break;
        case 6: c = -R2; s = R2; break;
        case 7: c = -C1; s = S1; break;
        case 9: c = -C1; s = -S1; break;
        case 10: c = -R2; s = -R2; break;
        case 11: c = -S1; s = -C1; break;
        case 13: c = S1; s = -C1; break;
        case 14: c = R2; s = -R2; break;
        default: c = C1; s = -S1; break;
    }
    if (INV) s = -s;
    return cpx{d.x * c + d.y * s, d.y * c - d.x * s};
}
template <bool INV, int HALF> HD void dft16_stage(cpx (&v)[16]) {
#pragma unroll
    for (int g = 0; g < 16; g += 2 * HALF) {
#pragma unroll
        for (int i = 0; i < HALF; ++i) {
            const cpx a = v[g + i], b = v[g + i + HALF];
            v[g + i] = cadd(a, b);
            v[g + i + HALF] = mul_w16<INV>(csub(a, b), i * (8 / HALF));
        }
    }
}
template <bool INV> HD void dft16(cpx (&v)[16]) {
    dft16_stage<INV, 8>(v); dft16_stage<INV, 4>(v); dft16_stage<INV, 2>(v); dft16_stage<INV, 1>(v);
    cpx t;
    t = v[1]; v[1] = v[8]; v[8] = t;   t = v[2]; v[2] = v[4]; v[4] = t;   t = v[3]; v[3] = v[12]; v[12] = t;
    t = v[5]; v[5] = v[10]; v[10] = t; t = v[7]; v[7] = v[14]; v[14] = t; t = v[11]; v[11] = v[13]; v[13] = t;
}
template <bool INV> HD void twiddle16(cpx (&v)[16], float frac) {
    float s, c;
    asm volatile("" : "+v"(frac));
#if defined(__HIP_DEVICE_COMPILE__)
    sincospif(2.0f * frac, &s, &c);
#else
    s = sinf(6.283185307179586f * frac); c = cosf(6.283185307179586f * frac);
#endif
    const cpx w1 = INV ? cpx{c, s} : cpx{c, -s};
    cpx w = w1;
#pragma unroll
    for (int q = 1; q < 16; ++q) { v[q] = cmul(v[q], w); if (q < 15) w = cmul(w, w1); }
}
HD int fft_k_of_p(int p) { return (p >> 9) + 16 * ((p >> 5) & 15) + 256 * (p & 31); }
HD int fft_p_of_k(int k) { return (k & 15) * 512 + ((k >> 4) & 15) * 32 + (k >> 8); }

typedef float f2v __attribute__((ext_vector_type(2)));
__device__ __forceinline__ cpx ldc(const LAS cpx* b, int i) { const f2v v = ((const LAS f2v*)b)[i]; return cpx{v.x, v.y}; }
__device__ __forceinline__ void stc(LAS cpx* b, int i, cpx v) { ((LAS f2v*)b)[i] = (f2v){v.x, v.y}; }
__device__ __forceinline__ float dpp_xor1(float v) { return __builtin_bit_cast(float, __builtin_amdgcn_update_dpp(0, __builtin_bit_cast(int, v), 0xB1, 0xF, 0xF, true)); }
__device__ __forceinline__ void fft_fwd_pass2(LAS cpx* buf, int t) {
    const int blk = t >> 5, r2 = t & 31; cpx v[16];
#pragma unroll
    for (int j = 0; j < 16; ++j) v[j] = ldc(buf, fft_pp(blk * 512 + j * 32 + r2));
    dft16<false>(v); twiddle16<false>(v, (float)r2 * (1.f / 512.f));
#pragma unroll
    for (int q = 0; q < 16; ++q) stc(buf, fft_pp(blk * 512 + q * 32 + r2), v[q]);
}
__device__ __forceinline__ void fft_fwd_pass3(const LAS cpx* buf, int t, cpx (&v)[16]) {
    const int b = t >> 1, r = t & 1;
#pragma unroll
    for (int j = 0; j < 16; ++j) v[j] = ldc(buf, fft_pp(b * 32 + 2 * j + r));
    dft16<false>(v); twiddle16<false>(v, (float)r * (1.f / 32.f));
#pragma unroll
    for (int q = 0; q < 16; ++q) { const float px = dpp_xor1(v[q].x), py = dpp_xor1(v[q].y);
        v[q] = r ? cpx{px - v[q].x, py - v[q].y} : cpx{v[q].x + px, v[q].y + py}; }
}
__device__ __forceinline__ float bload(__amdgpu_buffer_rsrc_t rs, int voff, int soff) { return __builtin_bit_cast(float, __builtin_amdgcn_raw_buffer_load_b32(rs, voff, soff, 0)); }
__device__ __forceinline__ float conv3_b(__amdgpu_buffer_rsrc_t rs, int vo, int e0, float w0, float w1, float w2, float bias, bool lo_ok, bool hi_ok) {
    const bool odd = (vo & 4) != 0; const int h4 = (vo >> 3) << 2;
    const unsigned d0 = (unsigned)__builtin_amdgcn_raw_buffer_load_b32(rs, h4, e0 * 2, 0);
    const unsigned d1 = (e0 > 0) ? (unsigned)__builtin_amdgcn_raw_buffer_load_b32(rs, h4 + (odd ? 8 : 0), e0 * 2 - 4, 0)
                                 : (unsigned)__builtin_amdgcn_raw_buffer_load_b32(rs, h4 + (odd ? 4 : -4), 0, 0);
    const float lo0 = __builtin_bit_cast(float, d0 << 16), hi0 = __builtin_bit_cast(float, d0 & 0xffff0000u);
    const float xm = odd ? lo0 : __builtin_bit_cast(float, d1 & 0xffff0000u), xc = odd ? hi0 : lo0, xp = odd ? __builtin_bit_cast(float, d1 << 16) : hi0;
    return bias + w1 * xc + (lo_ok ? w0 * xm : 0.f) + (hi_ok ? w2 * xp : 0.f);
}
__device__ __forceinline__ void hyena_phase(LAS unsigned char* lds, const bf16* PT, const float* KC, const float* cw, const float* cb, const float* skip, float* YHT, int G, int vcu) {
    LAS cpx* Wb = (LAS cpx*)lds;
    LAS cpx* Lb = (LAS cpx*)(lds + FFT_BUF_BYTES);
    const int t0 = threadIdx.x;
#define HY_T() int t = t0; asm volatile("" : "+v"(t))
    for (int pair = vcu; pair < 512; pair += G) {
        const int c0 = 2 * pair;
        {
            HY_T();
            const __amdgpu_buffer_rsrc_t rsk = __builtin_amdgcn_make_buffer_rsrc((void*)(KC + (size_t)c0 * 8192), 0, 65536, 0x00020000);
            cpx v[16];
#pragma unroll
            for (int j = 0; j < 16; ++j) v[j] = cpx{bload(rsk, t * 4, j * 2048), bload(rsk, t * 4, 32768 + j * 2048)};
            dft16<false>(v); twiddle16<false>(v, (float)t * (1.f / 8192.f));
#pragma unroll
            for (int q = 0; q < 16; ++q) stc(Wb, fft_pp(q * 512 + t), v[q]);
        }
        __syncthreads();
        { HY_T(); fft_fwd_pass2(Wb, t); }
        __syncthreads();
        { HY_T(); cpx v[16]; fft_fwd_pass3(Wb, t, v); __syncthreads();
          const int b = t >> 1, r = t & 1;
#pragma unroll
          for (int q = 0; q < 16; ++q) stc(Wb, fft_pp(b * 32 + 16 * r + q), v[q]); }
        __syncthreads();
#pragma unroll 1
        for (int ch = 0; ch < 2; ++ch) {
            const int c = c0 + ch;
            float vg[2][8];
            {
                HY_T();
                const __amdgpu_buffer_rsrc_t rs1 = __builtin_amdgcn_make_buffer_rsrc((void*)(PT + (size_t)(1024 + c) * T), 0, T * 2, 0x00020000);
                const __amdgpu_buffer_rsrc_t rs2 = __builtin_amdgcn_make_buffer_rsrc((void*)(PT + (size_t)(2048 + c) * T), 0, T * 2, 0x00020000);
                const float a0 = cw[1024 + c], a1 = cw[3072 + 1024 + c], a2 = cw[6144 + 1024 + c], ab = cb[1024 + c];
                const float v0 = cw[2048 + c], v1 = cw[3072 + 2048 + c], v2 = cw[6144 + 2048 + c], vb = cb[2048 + c];
#pragma unroll
                for (int b = 0; b < 2; ++b)
#pragma unroll
                    for (int j = 0; j < 8; ++j) { const bool lo = (j > 0) || (t > 0), hi = (j < 7) || (t < 511);
                        int vo = t * 4;
                        if (j == 0) asm volatile("" : "+v"(vo));
                        vg[b][j] = conv3_b(rs2, vo, b * LSEQ + j * 512, v0, v1, v2, vb, lo, hi) * conv3_b(rs1, vo, b * LSEQ + j * 512, a0, a1, a2, ab, lo, hi);
                        if (j == 7) asm volatile("" : "+v"(vg[b][0]), "+v"(vg[b][1]), "+v"(vg[b][2]), "+v"(vg[b][3]), "+v"(vg[b][4]), "+v"(vg[b][5]), "+v"(vg[b][6]), "+v"(vg[b][7])); }
                cpx v[16];
#pragma unroll
                for (int j = 0; j < 8; ++j) { v[j] = cpx{vg[0][j], vg[1][j]}; v[8 + j] = cpx{0.f, 0.f}; }
                dft16<false>(v); twiddle16<false>(v, (float)t * (1.f / 8192.f));
#pragma unroll
                for (int q = 0; q < 16; ++q) stc(Lb, fft_pp(q * 512 + t), v[q]);
            }
            __syncthreads();
            { HY_T(); fft_fwd_pass2(Lb, t); }
            __syncthreads();
            {
                HY_T();
                cpx v[16]; fft_fwd_pass3(Lb, t, v);
                const int b = t >> 1, r = t & 1;
                const float sc = 0.5f / 8192.f;
#pragma unroll
                for (int q = 0; q < 16; ++q) {
                    const int p = b * 32 + 16 * r + q, k = fft_k_of_p(p), km = (8192 - k) & 8191, pm = fft_p_of_k(km);
                    const cpx Wk = ldc(Wb, fft_pp(p)), Wm = ldc(Wb, fft_pp(pm));
                    cpx H;
                    if (ch == 0) H = cpx{(Wk.x + Wm.x) * sc, (Wk.y - Wm.y) * sc};
                    else H = cpx{(Wk.y + Wm.y) * sc, (Wm.x - Wk.x) * sc};
                    v[q] = cmul(v[q], H);
                    if ((q & 3) == 3) asm volatile("" ::: "memory");
                }
#pragma unroll
                for (int q = 0; q < 16; ++q) { const float px = dpp_xor1(v[q].x), py = dpp_xor1(v[q].y);
                    v[q] = r ? cpx{px - v[q].x, py - v[q].y} : cpx{v[q].x + px, v[q].y + py}; }
                twiddle16<true>(v, (float)r * (1.f / 32.f)); dft16<true>(v);
                __syncthreads();
#pragma unroll
                for (int j = 0; j < 16; ++j) stc(Lb, fft_pp(b * 32 + 2 * j + r), v[j]);
            }
            __syncthreads();
            {
                HY_T();
                const int blk = t >> 5, r2 = t & 31; cpx v[16];
#pragma unroll
                for (int q = 0; q < 16; ++q) v[q] = ldc(Lb, fft_pp(blk * 512 + q * 32 + r2));
                twiddle16<true>(v, (float)r2 * (1.f / 512.f)); dft16<true>(v);
                __syncthreads();
#pragma unroll
                for (int j = 0; j < 16; ++j) stc(Lb, fft_pp(blk * 512 + j * 32 + r2), v[j]);
            }
            __syncthreads();
            {
                HY_T();
                cpx v[16];
#pragma unroll
                for (int q = 0; q < 16; ++q) v[q] = ldc(Lb, fft_pp(q * 512 + t));
                twiddle16<true>(v, (float)t * (1.f / 8192.f)); dft16<true>(v);
                const __amdgpu_buffer_rsrc_t rs0 = __builtin_amdgcn_make_buffer_rsrc((void*)(PT + (size_t)c * T), 0, T * 2, 0x00020000);
                const __amdgpu_buffer_rsrc_t rsy = __builtin_amdgcn_make_buffer_rsrc((void*)(YHT + (size_t)c * T), 0, T * 4, 0x00020000);
                const float x0 = cw[c], x1 = cw[3072 + c], x2 = cw[6144 + c], xb = cb[c], sk = skip[c];
                float o0[8], o1[8];
#pragma unroll
                for (int j = 0; j < 8; ++j) { const bool lo = (j > 0) || (t > 0), hi = (j < 7) || (t < 511);
                    int vo = t * 4;
                    if ((j & 3) == 0) asm volatile("" : "+v"(vo));
                    o0[j] = (v[j].x + vg[0][j] * sk) * conv3_b(rs0, vo, j * 512, x0, x1, x2, xb, lo, hi);
                    o1[j] = (v[j].y + vg[1][j] * sk) * conv3_b(rs0, vo, LSEQ + j * 512, x0, x1, x2, xb, lo, hi); }
                asm volatile("" ::: "memory");
#pragma unroll
                for (int j = 0; j < 8; ++j) {
                    __builtin_amdgcn_raw_buffer_store_b32(__builtin_bit_cast(unsigned, o0[j]), rsy, t * 4, j * 2048, 0);
                    __builtin_amdgcn_raw_buffer_store_b32(__builtin_bit_cast(unsigned, o1[j]), rsy, t * 4, (LSEQ + j * 512) * 4, 0); }
            }
            __syncthreads();
        }
    }
}
#undef HY_T
__device__ __forceinline__ void hyena_filter_item(LAS unsigned char* lds, int item, const float* w1, const float* b1, const float* w2, const float* b2, const float* w3, const float* b3,
                                                  const float* w4, const float* freq, float* KC, int tid, int lane, int wave) {
    typedef pg8::f32x4 f32x4;
    LAS float* H3 = (LAS float*)lds;
    LAS float* sc0 = (LAS float*)(lds + 4096) + wave * 256;
    const int l0 = item * 16;
    int lane_w = lane; asm volatile("" : "+v"(lane_w));
    float w1r[33], w2r[64], w3r[64];
#pragma unroll
    for (int i = 0; i < 33; ++i) w1r[i] = w1[i * 64 + lane_w];
#pragma unroll
    for (int i = 0; i < 64; ++i) w2r[i] = w2[i * 64 + lane_w];
    const float fr = freq[lane], bb1 = b1[lane], bb2 = b2[lane], bb3 = b3[lane];
    __syncthreads();
#pragma unroll
    for (int pp = 0; pp < 2; ++pp) {
        const int l = l0 + wave * 2 + pp; LAS float* sc = sc0 + 128 * pp;
        if (lane == 0) sc[0] = (float)l / (float)(LSEQ - 1);
        if (lane < 16) { const float omega = (2.0f * 3.14159265358979323846f / (float)LSEQ) * (float)l; const float fb = 1e-4f + (float)lane * ((15.0f - 1e-4f) / 15.0f); const float ang = omega * fb;
            sc[1 + lane] = cosf(ang); sc[17 + lane] = -sinf(ang); }
    }
    asm volatile("s_waitcnt lgkmcnt(0)" ::: "memory");
    float s[2], h[2];
#pragma unroll
    for (int pp = 0; pp < 2; ++pp) { const LAS float* sc = sc0 + 128 * pp; s[pp] = bb1;
#pragma unroll
        for (int i4 = 0; i4 < 8; ++i4) { const f32x4 z = *(const LAS f32x4*)(sc + 4 * i4); s[pp] += z.x * w1r[4 * i4] + z.y * w1r[4 * i4 + 1] + z.z * w1r[4 * i4 + 2] + z.w * w1r[4 * i4 + 3]; }
        s[pp] += sc[32] * w1r[32]; h[pp] = sinf(fr * s[pp]); }
    asm volatile("s_waitcnt lgkmcnt(0)" ::: "memory");
#pragma unroll
    for (int i = 0; i < 64; ++i) w3r[i] = w3[i * 64 + lane_w];
#pragma unroll
    for (int pp = 0; pp < 2; ++pp) sc0[128 * pp + 64 + lane] = h[pp];
    asm volatile("s_waitcnt lgkmcnt(0)" ::: "memory");
#pragma unroll
    for (int pp = 0; pp < 2; ++pp) { const LAS float* sc = sc0 + 128 * pp + 64; s[pp] = bb2;
#pragma unroll
        for (int i4 = 0; i4 < 16; ++i4) { const f32x4 z = *(const LAS f32x4*)(sc + 4 * i4); s[pp] += z.x * w2r[4 * i4] + z.y * w2r[4 * i4 + 1] + z.z * w2r[4 * i4 + 2] + z.w * w2r[4 * i4 + 3]; }
        h[pp] = sinf(fr * s[pp]); }
    asm volatile("s_waitcnt lgkmcnt(0)" ::: "memory");
#pragma unroll
    for (int pp = 0; pp < 2; ++pp) sc0[128 * pp + lane] = h[pp];
    asm volatile("s_waitcnt lgkmcnt(0)" ::: "memory");
#pragma unroll
    for (int pp = 0; pp < 2; ++pp) { const LAS float* sc = sc0 + 128 * pp; s[pp] = bb3;
#pragma unroll
        for (int i4 = 0; i4 < 16; ++i4) { const f32x4 z = *(const LAS f32x4*)(sc + 4 * i4); s[pp] += z.x * w3r[4 * i4] + z.y * w3r[4 * i4 + 1] + z.z * w3r[4 * i4 + 2] + z.w * w3r[4 * i4 + 3]; }
        H3[lane * 16 + wave * 2 + pp] = sinf(fr * s[pp]); }
    asm volatile("s_waitcnt lgkmcnt(0)" ::: "memory");
    __syncthreads();
    const float max_decay = logf(1e-2f) / 0.3f, min_decay = logf(1e-2f) / 1.5f;
    float acc[4][16];
#pragma unroll
    for (int a = 0; a < 4; ++a)
#pragma unroll
        for (int l = 0; l < 16; ++l) acc[a][l] = 0.f;
    int tid_o = tid; asm volatile("" : "+v"(tid_o));
    const float* w4t = w4 + tid_o;
#define HF_LOAD(wr_, b_) do { _Pragma("unroll") for (int i = 0; i < 4; ++i) { const float* p_ = w4t + ((b_) * 4 + i) * 2048; \
        wr_[4 * i] = p_[0]; wr_[4 * i + 1] = p_[1024]; wr_[4 * i + 2] = p_[512]; wr_[4 * i + 3] = p_[1536]; } } while (0)
#define HF_COMP(wr_, b_) do { _Pragma("unroll") for (int i = 0; i < 4; ++i) { _Pragma("unroll") for (int l4 = 0; l4 < 4; ++l4) { \
        const pg8::f32x4 hv = *(const LAS pg8::f32x4*)(H3 + ((b_) * 4 + i) * 16 + 4 * l4); \
        _Pragma("unroll") for (int q = 0; q < 4; ++q) { _Pragma("unroll") for (int a = 0; a < 4; ++a) acc[a][4 * l4 + q] = fmaf(hv[q], wr_[4 * i + a], acc[a][4 * l4 + q]); } } } } while (0)
    float wa[16], wb[16];
    HF_LOAD(wa, 0);
#pragma unroll 1
    for (int b = 0; b < 16; b += 2) {
        HF_LOAD(wb, b + 1);
        HF_COMP(wa, b);
        { const int bn = b + 2 < 16 ? b + 2 : 15; HF_LOAD(wa, bn); }
        HF_COMP(wb, b + 1);
    }
#undef HF_LOAD
#undef HF_COMP
#pragma unroll
    for (int cc = 0; cc < 2; ++cc) {
        const int c = tid_o + 512 * cc;
        const float delta = fabsf(min_decay + (float)c * ((max_decay - min_decay) / (float)(DHY - 1)));
        float* kc = KC + (size_t)c * 8192;
#pragma unroll
        for (int l = 0; l < 16; ++l) {
            const int ll = l0 + l; const float win = expf(-((float)ll / (float)(LSEQ - 1)) * delta);
            const float f = acc[2 * cc][l] * win, bb = acc[2 * cc + 1][l] * win;
            if (ll == 0) { kc[0] = f + bb; kc[4096] = 0.f; } else { kc[ll] = f; kc[8192 - ll] = bb; }
        }
    }
    __syncthreads();
}
__device__ __forceinline__ void hyena_post_tile(LAS unsigned char* lds, int tile, const float* YHT, const float* nw, bf16* A2, int tid, int lane, int wave) {
    LAS float* tl = (LAS float*)lds;
    const int tok0 = tile * 32, tk = tid & 31, cg = tid >> 5;
#pragma unroll 1
    for (int i0 = 0; i0 < 64; i0 += 16) { float yv[16];
#pragma unroll
        for (int i = 0; i < 16; ++i) yv[i] = YHT[(size_t)(cg + 16 * (i0 + i)) * T + tok0 + tk];
#pragma unroll
        for (int i = 0; i < 16; ++i) tl[(cg + 16 * (i0 + i)) * 33 + tk] = yv[i]; }
    float gn[16];
#pragma unroll
    for (int i = 0; i < 16; ++i) gn[i] = nw[lane + 64 * i];
    __syncthreads();
    for (int q = 0; q < 4; ++q) {
        const int tq = wave * 4 + q; float v[16]; float ss = 0.f;
#pragma unroll
        for (int i = 0; i < 16; ++i) { v[i] = tl[(lane + 64 * i) * 33 + tq]; ss += v[i] * v[i]; }
        const float r = rsqrtf(wave_sum(ss) * (1.f / DHY) + EPS);
#pragma unroll
        for (int i = 0; i < 16; ++i) { const int c = lane + 64 * i; A2[(size_t)(tok0 + tq) * DM + c] = (bf16)f2bf(v[i] * r * gn[i]); }
    }
    __syncthreads();
}


constexpr int GP_TILE = 128 * 132;
constexpr int GP_GATES = 143104;
constexpr int GP_WREG2 = 8448 + 512;
constexpr int GP_TT = 64 * 68 * 4;
__device__ __forceinline__ int aoff_fn(int i) { const int q = i >> 2, r = i & 3; return 4 * (2 * q * q + q + (r >= 1 ? q : 0) + (r >= 2 ? q + 1 : 0) + (r >= 3 ? q + 1 : 0)); }
static_assert(8 * GP_TILE <= GP_GATES && 8 * GP_WREG2 + 4 * GP_TT <= GP_GATES && GP_GATES + 4096 <= LDSCTL_OFF_C, "gdn prep LDS");
__device__ __forceinline__ void gdn_pre(LAS unsigned char* lds, int wg, const bf16* PG, const float* PGATE, const float* cw, const float* alf, const float* alb, const float* dtf, const float* dtb,
                                        unsigned char* ws, int tid, int lane, int wave) {
    const int bh = wg >> 4, b = bh >> 3, h = bh & 7, l0 = 256 * (wg & 15), cid0 = bh * 64 + 4 * (wg & 15);
    LAS float* gates = (LAS float*)(lds + GP_GATES);
    float w[3][3][2];
#pragma unroll
    for (int x = 0; x < 3; ++x)
#pragma unroll
        for (int tp = 0; tp < 3; ++tp)
#pragma unroll
            for (int e = 0; e < 2; ++e) w[x][tp][e] = cw[tp * 3072 + x * 1024 + h * 128 + 2 * lane + e];
    const int lw = l0 + 32 * wave;
    const unsigned* pgw = (const unsigned*)PG;
    auto ldraw = [&](int l, int x) -> unsigned { const int lc = l < 0 ? 0 : (l >= LSEQ ? LSEQ - 1 : l);
        return pgw[((size_t)(b * LSEQ + lc) * 4096 + x * 1024 + h * 128) / 2 + lane]; };
    if (lane < 32) {
        const int l = lw + lane, li = 32 * wave + lane; const float* pr = PGATE + (size_t)(b * LSEQ + l) * 32;
        gates[0 * 256 + li] = -expf(alf[h]) * softplus_f(pr[16 + h] + dtf[h]);
        gates[1 * 256 + li] = -expf(alb[h]) * softplus_f(pr[24 + h] + dtb[h]);
        gates[2 * 256 + li] = sigmoid_f(pr[h]);
        gates[3 * 256 + li] = sigmoid_f(pr[8 + h]);
    }
#pragma unroll 1
    for (int bt8 = 0; bt8 < 4; ++bt8) {
        unsigned raw[3][10];
#pragma unroll
        for (int x = 0; x < 3; ++x)
#pragma unroll
            for (int k = 0; k < 10; ++k) raw[x][k] = ldraw(lw + 8 * bt8 - 1 + k, x);
#define GP_PIN5(a, i) "+v"(a[i]), "+v"(a[i + 1]), "+v"(a[i + 2]), "+v"(a[i + 3]), "+v"(a[i + 4])
        asm volatile("" : GP_PIN5(raw[0], 0), GP_PIN5(raw[0], 5), GP_PIN5(raw[1], 0));
        asm volatile("" : GP_PIN5(raw[1], 5), GP_PIN5(raw[2], 0), GP_PIN5(raw[2], 5));
#undef GP_PIN5
#pragma unroll
        for (int x = 0; x < 3; ++x)
#pragma unroll
            for (int k = 0; k < 10; ++k) { const int l = lw + 8 * bt8 - 1 + k; raw[x][k] = (l >= 0 && l < LSEQ) ? raw[x][k] : 0u; }
#pragma unroll
        for (int k = 0; k < 8; ++k) {
            const int tt = 8 * bt8 + k, li = 32 * wave + tt, cl = li >> 6, i = li & 63;
            float r[3][2];
#pragma unroll
            for (int x = 0; x < 3; ++x) {
                const unsigned pv = raw[x][k], cv = raw[x][k + 1], nv = raw[x][k + 2];
                const float p0 = __builtin_bit_cast(float, pv << 16), p1 = __builtin_bit_cast(float, pv & 0xffff0000u);
                const float c0 = __builtin_bit_cast(float, cv << 16), c1 = __builtin_bit_cast(float, cv & 0xffff0000u);
                const float n0 = __builtin_bit_cast(float, nv << 16), n1 = __builtin_bit_cast(float, nv & 0xffff0000u);
                r[x][0] = silu_f(w[x][0][0] * p0 + w[x][1][0] * c0 + w[x][2][0] * n0);
                r[x][1] = silu_f(w[x][0][1] * p1 + w[x][1][1] * c1 + w[x][2][1] * n1);
            }
            const float qs = rsqrtf(wave_sum(r[0][0] * r[0][0] + r[0][1] * r[0][1]) + EPS);
            const float ks = rsqrtf(wave_sum(r[1][0] * r[1][0] + r[1][1] * r[1][1]) + EPS);
            const unsigned qp = pk2(r[0][0] * qs, r[0][1] * qs), kp = pk2(r[1][0] * ks, r[1][1] * ks), vp = pk2(r[2][0], r[2][1]);
            const size_t rowoff = ((size_t)(cid0 + cl) * 64 + i) * 64 + lane;
            ((unsigned*)(ws + WS_QN))[rowoff] = qp; ((unsigned*)(ws + WS_KN))[rowoff] = kp;
            LAS bf16* kt = (LAS bf16*)(lds + (cl * 2 + 0) * GP_TILE); LAS bf16* vt = (LAS bf16*)(lds + (cl * 2 + 1) * GP_TILE);
            kt[(2 * lane) * 66 + i] = (bf16)(kp & 0xffffu); kt[(2 * lane + 1) * 66 + i] = (bf16)(kp >> 16);
            vt[(2 * lane) * 66 + i] = (bf16)(vp & 0xffffu); vt[(2 * lane + 1) * 66 + i] = (bf16)(vp >> 16);
        }
    }
    __syncthreads();
    for (int it = wave; it < 8 * 64; it += 8) {
        const int tile = it >> 6, rp = it & 63, row = 2 * rp + (lane >> 5), cl = tile >> 1, which = tile & 1;
        const unsigned v = *(const LAS unsigned*)(lds + tile * GP_TILE + row * 132 + (lane & 31) * 4);
        ((unsigned*)(ws + (which ? WS_VT : WS_KT)))[((size_t)(cid0 + cl) * 128 + row) * 32 + (lane & 31)] = v;
    }
    asm volatile("s_waitcnt vmcnt(0)" ::: "memory");
    __syncthreads();
}
__device__ __forceinline__ void gdn_prep_wave(LAS unsigned char* lds, int wg, unsigned char* ws, int lane, int wave) {
    typedef pg8::bf16x8 bf16x8; typedef pg8::f32x4 f32x4;
    const int cl = wave >> 1, dir = wave & 1, bh = wg >> 4, cid = bh * 64 + 4 * (wg & 15) + cl; const size_t ci = (size_t)cid * 2 + dir;
    const int fr = lane & 15, fq = lane >> 4;
    LAS unsigned char* R = lds + wave * GP_WREG2;
    LAS float* Tt = (LAS float*)(lds + 8 * GP_WREG2 + (wave & 3) * GP_TT);
    LAS float* Ap = (LAS float*)R;
    LAS float* gcA = (LAS float*)(R + 8448); LAS float* btA = gcA + 64;
    const LAS float* gates = (const LAS float*)(lds + GP_GATES);
    const bf16* QN = (const bf16*)(ws + WS_QN) + (size_t)cid * 64 * 128; const bf16* KN = (const bf16*)(ws + WS_KN) + (size_t)cid * 64 * 128;
    const bf16* KT = (const bf16*)(ws + WS_KT) + (size_t)cid * 128 * 64; const bf16* VT = (const bf16*)(ws + WS_VT) + (size_t)cid * 128 * 64;
    unsigned char* GW = ws + WS_GW + ci * GW_B; unsigned char* GQD = ws + WS_GQD + ci * GW_B; unsigned char* GKDT = ws + WS_GKDT + ci * GKDT_B;
    unsigned char* GQK = ws + WS_GQK + ci * GQK_B; unsigned char* GUT = ws + WS_GUT + ci * GUT_B;
#define RIDX(i) (dir ? 63 - (i) : (i))
    const float bt = gates[(2 + dir) * 256 + 64 * cl + RIDX(lane)];
    float gc = gates[dir * 256 + 64 * cl + RIDX(lane)];
#pragma unroll
    for (int o = 1; o < 64; o <<= 1) { const float t = __shfl_up(gc, o); if (lane >= o) gc += t; }
    const float gl = __shfl(gc, 63);
    gcA[lane] = gc; btA[lane] = bt;
    asm volatile("s_waitcnt lgkmcnt(0)" ::: "memory");
    if (lane == 0) ((float*)(ws + WS_GCD))[ci] = expf(gl);
    {
    bf16x8 kfr[4][4];
#pragma unroll
    for (int t4 = 0; t4 < 4; ++t4)
#pragma unroll
        for (int ks = 0; ks < 4; ++ks) kfr[t4][ks] = *(const bf16x8*)(KN + (size_t)RIDX(16 * t4 + fr) * 128 + 32 * ks + 8 * fq);
    __builtin_amdgcn_sched_barrier(0);
#pragma unroll
    for (int mt = 0; mt < 4; ++mt) {
        const f32x4 gi = *(const LAS f32x4*)(gcA + 16 * mt + 4 * fq), bi = *(const LAS f32x4*)(btA + 16 * mt + 4 * fq);
#pragma unroll
        for (int nt = 0; nt <= mt; ++nt) {
            f32x4 c = (f32x4){0.f, 0.f, 0.f, 0.f};
#pragma unroll
            for (int ks = 0; ks < 4; ++ks) c = __builtin_amdgcn_mfma_f32_16x16x32_bf16(kfr[mt][ks], kfr[nt][ks], c, 0, 0, 0);
            const int j = 16 * nt + fr; const float gj = gcA[j];
#pragma unroll
            for (int r = 0; r < 4; ++r) { const int i = 16 * mt + 4 * fq + r; if (j < ((i + 3) & ~3)) Ap[aoff_fn(i) + j] = (j < i) ? bi[r] * c[r] * __expf(gi[r] - gj) : 0.f; }
        }
    }
#pragma unroll 1
    for (int ih = 0; ih < 2; ++ih) {
        bf16x8 qfr[2][4];
#pragma unroll
        for (int t2 = 0; t2 < 2; ++t2)
#pragma unroll
            for (int ks = 0; ks < 4; ++ks) qfr[t2][ks] = *(const bf16x8*)(QN + (size_t)RIDX(16 * (2 * ih + t2) + fr) * 128 + 32 * ks + 8 * fq);
        __builtin_amdgcn_sched_barrier(0);
#pragma unroll
        for (int i2 = 0; i2 < 2; ++i2) {
            const int it = 2 * ih + i2;
            const int i = 16 * it + fr; const float gi = gcA[i];
#pragma unroll
            for (int jt = 0; jt < 4; ++jt) {
                f32x4 c = (f32x4){0.f, 0.f, 0.f, 0.f};
                if (jt <= it) {
#pragma unroll
                    for (int ks = 0; ks < 4; ++ks) c = __builtin_amdgcn_mfma_f32_16x16x32_bf16(kfr[jt][ks], qfr[i2][ks], c, 0, 0, 0);
                }
                const f32x4 gj = *(const LAS f32x4*)(gcA + 16 * jt + 4 * fq);
                float v[4];
#pragma unroll
                for (int r = 0; r < 4; ++r) { const int j = 16 * jt + 4 * fq + r; v[r] = (j <= i) ? c[r] * __expf(gi - gj[r]) * 0.08838834764831845f : 0.f; }
                *(unsigned long long*)(GQK + i * 144 + (32 * (jt >> 1) + 8 * fq + 4 * (jt & 1)) * 2) = (unsigned long long)pg8::cvt_pk_bf16(v[0], v[1]) | ((unsigned long long)pg8::cvt_pk_bf16(v[2], v[3]) << 32);
            }
        }
    }
    }
    auto step4 = [&]() {
    {
        const int L2 = lane & 31, m = 4 * L2, src = (m & ~31) + ((m & 4) ? 16 + 4 * ((m & 31) >> 3) : 4 * ((m & 31) >> 3));
#pragma unroll 1
        for (int rp0 = 0; rp0 < 32; rp0 += 16) {
            unsigned long long qv[16];
#pragma unroll
            for (int u = 0; u < 16; ++u) { const int i = 2 * (rp0 + u) + (lane >> 5); qv[u] = *(const unsigned long long*)(QN + (size_t)RIDX(i) * 128 + src); }
#pragma unroll
            for (int u = 0; u < 16; ++u) {
                const int i = 2 * (rp0 + u) + (lane >> 5); const unsigned long long q = qv[u];
                const float sc = __expf(gcA[i]) * 0.08838834764831845f;
                const unsigned lo = (unsigned)q, hi = (unsigned)(q >> 32);
                const float a0 = __builtin_bit_cast(float, lo << 16) * sc, a1 = __builtin_bit_cast(float, lo & 0xffff0000u) * sc, a2 = __builtin_bit_cast(float, hi << 16) * sc, a3 = __builtin_bit_cast(float, hi & 0xffff0000u) * sc;
                *(unsigned long long*)(GQD + i * 272 + m * 2) = (unsigned long long)pg8::cvt_pk_bf16(a0, a1) | ((unsigned long long)pg8::cvt_pk_bf16(a2, a3) << 32);
            }
        }
        const int L4 = lane & 15, mm = 4 * L4, isrc = (mm & ~31) + ((mm & 4) ? 16 + 4 * ((mm & 31) >> 3) : 4 * ((mm & 31) >> 3));
        const f32x4 gi4 = *(const LAS f32x4*)(gcA + isrc);
        float sc4[4];
#pragma unroll
        for (int r = 0; r < 4; ++r) sc4[r] = __expf(gl - gi4[r]);
#pragma unroll 1
        for (int rq0 = 0; rq0 < 32; rq0 += 16) {
            unsigned long long kv[16];
#pragma unroll
            for (int u = 0; u < 16; ++u) { const int dk = 4 * (rq0 + u) + (lane >> 4); kv[u] = *(const unsigned long long*)(KT + (size_t)dk * 64 + (dir ? 60 - isrc : isrc)); }
#pragma unroll
            for (int u = 0; u < 16; ++u) {
            const int dk = 4 * (rq0 + u) + (lane >> 4);
            const unsigned long long k = kv[u];
            const unsigned lo = (unsigned)k, hi = (unsigned)(k >> 32);
            float e0 = __builtin_bit_cast(float, lo << 16), e1 = __builtin_bit_cast(float, lo & 0xffff0000u), e2 = __builtin_bit_cast(float, hi << 16), e3 = __builtin_bit_cast(float, hi & 0xffff0000u);
            const float f0 = dir ? e3 : e0, f1 = dir ? e2 : e1, f2 = dir ? e1 : e2, f3 = dir ? e0 : e3;
            *(unsigned long long*)(GKDT + dk * 144 + mm * 2) = (unsigned long long)pg8::cvt_pk_bf16(f0 * sc4[0], f1 * sc4[1]) | ((unsigned long long)pg8::cvt_pk_bf16(f2 * sc4[2], f3 * sc4[3]) << 32);
            }
        }
    }
    asm volatile("s_waitcnt lgkmcnt(0)" ::: "memory");
        };
    asm volatile("s_waitcnt lgkmcnt(0)" ::: "memory");
    __syncthreads();
    const float s_u = bt, s_w = bt * __expf(gc);
    const int cn = RIDX(lane);
#pragma unroll 1
    for (int round = 0; round < 2; ++round) {
        if ((wave >> 2) != round) step4();
        else {
            LAS float* trow = Tt + lane * 68;
#pragma unroll
            for (int q = 0; q < 16; ++q) *(LAS f32x4*)(trow + 4 * q) = (f32x4){(4 * q == lane) ? 1.f : 0.f, (4 * q + 1 == lane) ? 1.f : 0.f, (4 * q + 2 == lane) ? 1.f : 0.f, (4 * q + 3 == lane) ? 1.f : 0.f};
            asm volatile("s_waitcnt lgkmcnt(0)" ::: "memory");
            int ao = 0;
#pragma unroll 1
            for (int b = 0; b < 16; ++b) {
                const LAS float* a0 = Ap + ao; const LAS float* a1 = a0 + 4 * b; const LAS float* a2 = a1 + 4 * (b + 1); const LAS float* a3 = a2 + 4 * (b + 1);
                f32x4 s0 = (f32x4){0.f, 0.f, 0.f, 0.f}, s1 = s0, s2 = s0, s3 = s0;
#pragma unroll 1
                for (int q = 0; q < b; q += 2) {
                    const bool two = (q + 1 < b); const int q1 = two ? q + 1 : q;
                    const f32x4 ta = *(const LAS f32x4*)(trow + 4 * q); f32x4 tb = *(const LAS f32x4*)(trow + 4 * q1);
                    const f32x4 x0a = *(const LAS f32x4*)(a0 + 4 * q), x1a = *(const LAS f32x4*)(a1 + 4 * q), x2a = *(const LAS f32x4*)(a2 + 4 * q), x3a = *(const LAS f32x4*)(a3 + 4 * q);
                    const f32x4 x0b = *(const LAS f32x4*)(a0 + 4 * q1), x1b = *(const LAS f32x4*)(a1 + 4 * q1), x2b = *(const LAS f32x4*)(a2 + 4 * q1), x3b = *(const LAS f32x4*)(a3 + 4 * q1);
                    tb = two ? tb : (f32x4){0.f, 0.f, 0.f, 0.f};
                    s0 += x0a * ta + x0b * tb; s1 += x1a * ta + x1b * tb; s2 += x2a * ta + x2b * tb; s3 += x3a * ta + x3b * tb;
                }
                const f32x4 d1 = *(const LAS f32x4*)(a1 + 4 * b), d2 = *(const LAS f32x4*)(a2 + 4 * b), d3 = *(const LAS f32x4*)(a3 + 4 * b);
                const int i0 = 4 * b;
                const float v0 = (s0[0] + s0[1]) + (s0[2] + s0[3]);
                const float t0 = (lane < i0) ? -v0 : (lane == i0 ? 1.f : 0.f);
                const float v1 = (s1[0] + s1[1]) + (s1[2] + s1[3]) + d1[0] * t0;
                const float t1 = (lane < i0 + 1) ? -v1 : (lane == i0 + 1 ? 1.f : 0.f);
                const float v2 = (s2[0] + s2[1]) + (s2[2] + s2[3]) + d2[0] * t0 + d2[1] * t1;
                const float t2 = (lane < i0 + 2) ? -v2 : (lane == i0 + 2 ? 1.f : 0.f);
                const float v3 = (s3[0] + s3[1]) + (s3[2] + s3[3]) + d3[0] * t0 + d3[1] * t1 + d3[2] * t2;
                const float t3 = (lane < i0 + 3) ? -v3 : (lane == i0 + 3 ? 1.f : 0.f);
                *(LAS f32x4*)(trow + i0) = (f32x4){t0, t1, t2, t3};
                asm volatile("s_waitcnt lgkmcnt(0)" ::: "memory");
                ao += 16 * b + 12;
            }
#define GP_WRITE_T(scale) do { LAS bf16* Tq = (LAS bf16*)R; \
                for (int j0 = 0; j0 < 64; j0 += 8) { const f32x4 ta = *(const LAS f32x4*)(trow + j0), tb = *(const LAS f32x4*)(trow + j0 + 4); \
                    _Pragma("unroll") for (int e = 0; e < 4; ++e) { Tq[(j0 + e) * 64 + cn] = (bf16)f2bf(ta[e] * (scale)); Tq[(j0 + 4 + e) * 64 + cn] = (bf16)f2bf(tb[e] * (scale)); } } \
                asm volatile("s_waitcnt lgkmcnt(0)" ::: "memory"); } while (0)
            GP_WRITE_T(s_w);
#pragma unroll 1
            for (int dh = 0; dh < 2; ++dh) {
                bf16x8 ktf[4][2];
#pragma unroll
                for (int d4 = 0; d4 < 4; ++d4)
#pragma unroll
                    for (int ks = 0; ks < 2; ++ks) ktf[d4][ks] = *(const bf16x8*)(KT + (size_t)(16 * (4 * dh + d4) + fr) * 64 + 32 * ks + 8 * fq);
                __builtin_amdgcn_sched_barrier(0);
#pragma unroll 1
                for (int it = 0; it < 4; ++it) {
                    bf16x8 tf[2];
#pragma unroll
                    for (int ks = 0; ks < 2; ++ks) tf[ks] = *(const LAS bf16x8*)(R + ((16 * it + fr) * 64 + 32 * ks + 8 * fq) * 2);
                    const int i = 16 * it + fr;
#pragma unroll
                    for (int d4 = 0; d4 < 4; ++d4) {
                        const int dt = 4 * dh + d4;
                        f32x4 c = (f32x4){0.f, 0.f, 0.f, 0.f};
#pragma unroll
                        for (int ks = 0; ks < 2; ++ks) c = __builtin_amdgcn_mfma_f32_16x16x32_bf16(ktf[d4][ks], tf[ks], c, 0, 0, 0);
                        *(unsigned long long*)(GW + i * 272 + (32 * (dt >> 1) + 8 * fq + 4 * (dt & 1)) * 2) = (unsigned long long)pg8::cvt_pk_bf16(c[0], c[1]) | ((unsigned long long)pg8::cvt_pk_bf16(c[2], c[3]) << 32);
                    }
                }
            }
            asm volatile("s_waitcnt lgkmcnt(0)" ::: "memory");
            GP_WRITE_T(s_u);
#pragma unroll 1
            for (int vh = 0; vh < 2; ++vh) {
                bf16x8 vtf[4][2];
#pragma unroll
                for (int v4 = 0; v4 < 4; ++v4)
#pragma unroll
                    for (int ks = 0; ks < 2; ++ks) vtf[v4][ks] = *(const bf16x8*)(VT + (size_t)(16 * (4 * vh + v4) + fr) * 64 + 32 * ks + 8 * fq);
                __builtin_amdgcn_sched_barrier(0);
#pragma unroll 1
                for (int it = 0; it < 4; ++it) {
                    bf16x8 tf[2];
#pragma unroll
                    for (int ks = 0; ks < 2; ++ks) tf[ks] = *(const LAS bf16x8*)(R + ((16 * it + fr) * 64 + 32 * ks + 8 * fq) * 2);
#pragma unroll
                    for (int v4 = 0; v4 < 4; ++v4) {
                        const int vt = 4 * vh + v4;
                        f32x4 c = (f32x4){0.f, 0.f, 0.f, 0.f};
#pragma unroll
                        for (int ks = 0; ks < 2; ++ks) c = __builtin_amdgcn_mfma_f32_16x16x32_bf16(tf[ks], vtf[v4][ks], c, 0, 0, 0);
                        *(unsigned long long*)(GUT + (16 * vt + fr) * 128 + (16 * it + 4 * fq) * 2) = (unsigned long long)pg8::cvt_pk_bf16(c[0], c[1]) | ((unsigned long long)pg8::cvt_pk_bf16(c[2], c[3]) << 32);
                    }
                }
            }
#undef GP_WRITE_T
        }
        __syncthreads();
    }
#undef RIDX
}

__host__ __device__ __forceinline__ int mperm32(int o) { return ((o & 15) >> 2) * 8 + (o >> 4) * 4 + (o & 3); }
__host__ __device__ __forceinline__ int mcol(int x) { return (x & ~31) + mperm32(x & 31); }
constexpr int SC_W = 0, SC_QD = 17408, SC_KDT = 34816, SC_QK = 53248, SC_UT = 62464, SC_STEP = 64512;
static_assert(2 * SC_STEP <= LDSCTL_OFF_C, "scan LDS");
constexpr int SC_XS = 2 * SC_STEP + 256, SC_XV = SC_XS + 4096, SC_DUMP = SC_XV + 2048;
static_assert(SC_DUMP + 1024 <= LDSCTL_OFF_C, "scan exchange LDS");
__device__ __forceinline__ void gdn_scan4(LAS unsigned char* lds, const unsigned char* ws, bf16* OF, bf16* OB, int vcu, int tid, int lane, int wave) {
    typedef pg8::bf16x8 bf16x8; typedef pg8::f32x4 f32x4;
    const int chain = vcu >> 3, slice = vcu & 7, dir = chain & 1, bh = chain >> 1, b = bh >> 3, h = bh & 7;
    const int fr = lane & 15, fq = lane >> 4;
    const int dv0 = slice * 16;
    bf16* O = dir ? OB : OF;
    auto issue_w = [&](auto wtag, int s, int buf) {
        constexpr int W4 = decltype(wtag)::value;
        const int n = dir ? 63 - s : s; const size_t ci = ((size_t)(bh * 64 + n) * 2 + dir);
        const unsigned char* gW = ws + WS_GW + ci * GW_B + lane * 16; const unsigned char* gQD = ws + WS_GQD + ci * GW_B + lane * 16; const unsigned char* gK = ws + WS_GKDT + ci * GKDT_B + lane * 16;
        const unsigned char* gQK = ws + WS_GQK + ci * GQK_B + lane * 16; const unsigned char* gU = ws + WS_GUT + ci * GUT_B + slice * 2048 + lane * 16;
        LAS unsigned char* lb = lds + buf * SC_STEP;
#pragma unroll
        for (int k = 0; k < 16; ++k) {
            constexpr int dummy = 0; (void)dummy;
            const int p = W4 + 4 * k;
            if (p < 17) __builtin_amdgcn_global_load_lds((const unsigned*)(gW + p * 1024), (LAS unsigned*)(lb + SC_W + p * 1024), 16, 0, 0);
            else if (p < 34) __builtin_amdgcn_global_load_lds((const unsigned*)(gQD + (p - 17) * 1024), (LAS unsigned*)(lb + SC_QD + (p - 17) * 1024), 16, 0, 0);
            else if (p < 52) __builtin_amdgcn_global_load_lds((const unsigned*)(gK + (p - 34) * 1024), (LAS unsigned*)(lb + SC_KDT + (p - 34) * 1024), 16, 0, 0);
            else if (p < 61) __builtin_amdgcn_global_load_lds((const unsigned*)(gQK + (p - 52) * 1024), (LAS unsigned*)(lb + SC_QK + (p - 52) * 1024), 16, 0, 0);
            else if (p < 63) __builtin_amdgcn_global_load_lds((const unsigned*)(gU + (p - 61) * 1024), (LAS unsigned*)(lb + SC_UT + (p - 61) * 1024), 16, 0, 0);
        }
    };
    auto issue = [&](int s, int buf) {
        if (wave == 4) issue_w(std::integral_constant<int, 0>{}, s, buf); else if (wave == 5) issue_w(std::integral_constant<int, 1>{}, s, buf);
        else if (wave == 6) issue_w(std::integral_constant<int, 2>{}, s, buf); else issue_w(std::integral_constant<int, 3>{}, s, buf);
    };
    auto touch = [&](int s2) {
        const int sc_ = s2 < 64 ? s2 : 63; const int n = dir ? 63 - sc_ : sc_; const size_t ci = ((size_t)(bh * 64 + n) * 2 + dir);
        const int d = wave - 4;
#pragma unroll
        for (int j = 0; j < 3; ++j) {
            const unsigned char* g;
            if (j == 2 && d < 2) g = ws + WS_GUT + ci * GUT_B + slice * 2048 + d * 1024;
            else { int p = slice + 8 * (j == 0 ? d : (j == 1 ? d + 4 : 0)); if (p > 60) p -= 8;
                if (p < 17) g = ws + WS_GW + ci * GW_B + p * 1024;
                else if (p < 34) g = ws + WS_GQD + ci * GW_B + (p - 17) * 1024;
                else if (p < 52) g = ws + WS_GKDT + ci * GKDT_B + (p - 34) * 1024;
                else g = ws + WS_GQK + ci * GQK_B + (p - 52) * 1024; }
            __builtin_amdgcn_global_load_lds((const unsigned*)(g + lane * 16), (LAS unsigned*)(lds + SC_DUMP), 16, 0, 0);
        }
    };
    LAS float* cdl = (LAS float*)(lds + 2 * SC_STEP);
    LAS unsigned char* XS = lds + SC_XS; LAS unsigned char* XV = lds + SC_XV;
    f32x4 S0 = (f32x4){0.f, 0.f, 0.f, 0.f}, S1 = S0;
    if (wave == 0) { const int n = dir ? 63 - lane : lane; cdl[lane] = __builtin_bit_cast(float, __hip_atomic_load((const unsigned*)(ws + WS_GCD) + ((size_t)(bh * 64 + n) * 2 + dir), __ATOMIC_RELAXED, __HIP_MEMORY_SCOPE_AGENT)); }
    if (wave < 4) *(LAS pg8::u32x4*)(XS + wave * 1024 + lane * 16) = (pg8::u32x4){0u, 0u, 0u, 0u};
    else { issue(0, 0); touch(1); }
    asm volatile("s_waitcnt vmcnt(0) lgkmcnt(0)" ::: "memory"); __syncthreads();
#pragma unroll 1
    for (int s = 0; s < 64; ++s) {
        const int buf = s & 1;
        if (wave >= 4) {
            issue(s + 1 < 64 ? s + 1 : 63, buf ^ 1);
            touch(s + 2);
            __builtin_amdgcn_s_barrier();
            asm volatile("s_waitcnt vmcnt(3)" ::: "memory");
        } else {
            const LAS unsigned char* L = lds + buf * SC_STEP;
            const int n = dir ? 63 - s : s;
            const float cd = cdl[s];
            const LAS unsigned char* wp = L + (16 * wave + fr) * 272 + fq * 16;
            const LAS unsigned char* kp = L + fr * 144 + fq * 16;
            bf16x8 Sb[4], Wf[4], Qf[4], QKf[2], Kf[2][2];
#pragma unroll
            for (int ks = 0; ks < 4; ++ks) Sb[ks] = *(const LAS bf16x8*)(XS + ks * 1024 + lane * 16);
#pragma unroll
            for (int ks = 0; ks < 4; ++ks) { Wf[ks] = *(const LAS bf16x8*)(wp + SC_W + ks * 64); Qf[ks] = *(const LAS bf16x8*)(wp + SC_QD + ks * 64); }
            const unsigned long long uu = *(const LAS unsigned long long*)(L + SC_UT + fr * 128 + (16 * wave + 4 * fq) * 2);
#pragma unroll
            for (int ks = 0; ks < 2; ++ks) { QKf[ks] = *(const LAS bf16x8*)(kp + SC_QK + wave * 2304 + ks * 64);
                Kf[0][ks] = *(const LAS bf16x8*)(kp + SC_KDT + (2 * wave) * 2304 + ks * 64); Kf[1][ks] = *(const LAS bf16x8*)(kp + SC_KDT + (2 * wave + 1) * 2304 + ks * 64); }
            f32x4 a_ = (f32x4){0.f, 0.f, 0.f, 0.f}, o = (f32x4){0.f, 0.f, 0.f, 0.f};
#pragma unroll
            for (int ks = 0; ks < 4; ++ks) { a_ = __builtin_amdgcn_mfma_f32_16x16x32_bf16(Wf[ks], Sb[ks], a_, 0, 0, 0); o = __builtin_amdgcn_mfma_f32_16x16x32_bf16(Sb[ks], Qf[ks], o, 0, 0, 0); }
            const unsigned ulo = (unsigned)uu, uhi = (unsigned)(uu >> 32);
            const float v0 = __builtin_bit_cast(float, ulo << 16) - a_[0], v1 = __builtin_bit_cast(float, ulo & 0xffff0000u) - a_[1];
            const float v2 = __builtin_bit_cast(float, uhi << 16) - a_[2], v3 = __builtin_bit_cast(float, uhi & 0xffff0000u) - a_[3];
            *(LAS unsigned long long*)(XV + (wave >> 1) * 1024 + lane * 16 + (wave & 1) * 8) = (unsigned long long)pg8::cvt_pk_bf16(v0, v1) | ((unsigned long long)pg8::cvt_pk_bf16(v2, v3) << 32);
            asm volatile("s_waitcnt lgkmcnt(0)" ::: "memory"); __builtin_amdgcn_s_barrier(); asm volatile("" ::: "memory");
            bf16x8 vb[2];
#pragma unroll
            for (int ks = 0; ks < 2; ++ks) vb[ks] = *(const LAS bf16x8*)(XV + ks * 1024 + lane * 16);
#pragma unroll
            for (int ks = 0; ks < 2; ++ks) o = __builtin_amdgcn_mfma_f32_16x16x32_bf16(vb[ks], QKf[ks], o, 0, 0, 0);
            f32x4 n0 = S0 * cd, n1 = S1 * cd;
#pragma unroll
            for (int ks = 0; ks < 2; ++ks) { n0 = __builtin_amdgcn_mfma_f32_16x16x32_bf16(Kf[0][ks], vb[ks], n0, 0, 0, 0); n1 = __builtin_amdgcn_mfma_f32_16x16x32_bf16(Kf[1][ks], vb[ks], n1, 0, 0, 0); }
            S0 = n0; S1 = n1;
            { pg8::u32x4 w; w.x = pg8::cvt_pk_bf16(S0[0], S0[1]); w.y = pg8::cvt_pk_bf16(S0[2], S0[3]); w.z = pg8::cvt_pk_bf16(S1[0], S1[1]); w.w = pg8::cvt_pk_bf16(S1[2], S1[3]);
              *(LAS pg8::u32x4*)(XS + wave * 1024 + lane * 16) = w; }
            { const int i = 16 * wave + fr; const int l = 64 * n + (dir ? 63 - i : i);
              *(unsigned long long*)(O + ((size_t)b * LSEQ + l) * DGD + h * 128 + dv0 + 4 * fq) = (unsigned long long)pg8::cvt_pk_bf16(o[0], o[1]) | ((unsigned long long)pg8::cvt_pk_bf16(o[2], o[3]) << 32); }
        }
        asm volatile("s_waitcnt lgkmcnt(0)" ::: "memory"); __builtin_amdgcn_s_barrier(); asm volatile("" ::: "memory");
    }
    asm volatile("s_waitcnt vmcnt(0)" ::: "memory"); __syncthreads();
}

__device__ __forceinline__ void gdn_post_batch(int item0, const bf16* OF, const bf16* OB, const bf16* PG, const float* nw, bf16* A2, int lane) {
    unsigned a[8], b[8], zz[8];
#pragma unroll
    for (int k = 0; k < 8; ++k) { const int item = item0 + k, tok = item >> 3, h = item & 7; const size_t o = (size_t)tok * DGD + h * 128 + lane * 2;
        a[k] = *(const unsigned*)(OF + o); b[k] = *(const unsigned*)(OB + o); zz[k] = *(const unsigned*)(PG + (size_t)tok * 4096 + 3072 + h * 128 + lane * 2); }
    const float2 g = *(const float2*)(nw + lane * 2);
#pragma unroll
    for (int k = 0; k < 8; ++k) { const int item = item0 + k, tok = item >> 3, h = item & 7;
        const float o0 = __builtin_bit_cast(float, a[k] << 16) + __builtin_bit_cast(float, b[k] << 16), o1 = __builtin_bit_cast(float, a[k] & 0xffff0000u) + __builtin_bit_cast(float, b[k] & 0xffff0000u);
        const float r = rsqrtf(wave_sum(o0 * o0 + o1 * o1) * (1.f / 128.f) + EPS);
        const float z0 = __builtin_bit_cast(float, zz[k] << 16), z1 = __builtin_bit_cast(float, zz[k] & 0xffff0000u);
        *(unsigned*)(A2 + (size_t)tok * DM + 1024 + h * 128 + lane * 2) = pk2(o0 * r * g.x * silu_f(z0), o1 * r * g.y * silu_f(z1)); }
}
constexpr int RT_PART = 0, RT_LG = 81920, RT_RS = 81920 + 32 * 80 * 4;
__device__ __forceinline__ void route_phase(LAS unsigned char* lds, int wg, const bf16* X1, const float* nw, const float* gbias, const float* ebias, unsigned char* ws, unsigned* cnt, int tid, int lane, int wave) {
    typedef pg8::bf16x8 bf16x8; typedef pg8::f32x4 f32x4;
    asm volatile("" : "+v"(lane), "+v"(tid));
    const int tok0 = wg * 32, fr = lane & 15, fq = lane >> 4;
    LAS float* part = (LAS float*)(lds + RT_PART); LAS float* lg = (LAS float*)(lds + RT_LG); LAS float* rs = (LAS float*)(lds + RT_RS);
    LAS int* hist = (LAS int*)(lds + RT_RS + 128);
    if (tid < 64) hist[tid] = 0;
    bf16* Ub = (bf16*)(ws + WS_UB);
    pg8::u32x4 warm[3];
    { const char* rwb = (const char*)(ws + WS_SMALL + SM_RWT) + (size_t)(wg & 31) * 20480;
#pragma unroll
      for (int k = 0; k < 3; ++k) { int o = (tid + 512 * k) * 16; o = o < 20480 - 16 ? o : 20480 - 16; warm[k] = *(const pg8::u32x4*)(rwb + o); } }
    {
        const GAS f32x4* wr = (const GAS f32x4*)nw + lane;
        f32x4 v[4][8], g[8];
        unsigned long long vr[4][8];
#pragma unroll
        for (int q = 0; q < 4; ++q) { const GAS unsigned long long* xr = (const GAS unsigned long long*)(X1 + (size_t)(tok0 + 4 * wave + q) * DM) + lane;
#pragma unroll
            for (int j = 0; j < 8; ++j) vr[q][j] = xr[64 * j]; }
#pragma unroll
        for (int j = 0; j < 8; ++j) g[j] = wr[64 * j];
#pragma unroll
        for (int q = 0; q < 4; ++q)
#pragma unroll
            for (int j = 0; j < 8; ++j) v[q][j] = unpack4(vr[q][j]);
#pragma unroll
        for (int q = 0; q < 4; ++q) { const int t = 4 * wave + q; float s = 0.f;
#pragma unroll
            for (int j = 0; j < 8; ++j) s += (v[q][j].x * v[q][j].x + v[q][j].y * v[q][j].y) + (v[q][j].z * v[q][j].z + v[q][j].w * v[q][j].w);
            const float r = rsqrtf(wave_sum(s) * (1.f / DM) + EPS);
            GAS unsigned long long* o8 = (GAS unsigned long long*)(Ub + (size_t)(tok0 + t) * DM) + lane;
#pragma unroll
            for (int j = 0; j < 8; ++j) o8[64 * j] = (unsigned long long)pk2(v[q][j].x * r * g[j].x, v[q][j].y * r * g[j].y) | ((unsigned long long)pk2(v[q][j].z * r * g[j].z, v[q][j].w * r * g[j].w) << 32);
            if (lane == 0) rs[t] = r; }
    }
    asm volatile("" :: "v"(warm[0]), "v"(warm[1]), "v"(warm[2]));
    if (wg == 0) { GAS unsigned long long* z = (GAS unsigned long long*)(Ub + (size_t)T * DM); z[tid] = 0ull; }
    { int* slot_tok = (int*)(ws + WS_SMALL + SM_SLOTTOK); if (tid < PMAX / 256) slot_tok[wg * (PMAX / 256) + tid] = T; }
    __syncthreads();
    const bf16* RWh = (const bf16*)(ws + WS_SMALL + SM_RWT); const bf16* RWl = RWh + 80 * 2048;
    f32x4 acc[2][5];
#pragma unroll
    for (int mt = 0; mt < 2; ++mt)
#pragma unroll
        for (int nt = 0; nt < 5; ++nt) acc[mt][nt] = (f32x4){0.f, 0.f, 0.f, 0.f};
    struct RtSet { f32x4 g0, g1; unsigned long long x0[2], x1[2]; bf16x8 bh[5], bl[5]; };
    const float rr[2] = {rs[fr], rs[16 + fr]};
#define RT_LOAD(ks_, S) do { const int ka_ = 256 * wave + 32 * (ks_) + 4 * fq, kb_ = 256 * wave + 32 * (ks_) + 8 * fq; \
        S.g0 = *(const f32x4*)(nw + ka_); S.g1 = *(const f32x4*)(nw + ka_ + 16); \
        _Pragma("unroll") for (int mt = 0; mt < 2; ++mt) { const bf16* xp = X1 + (size_t)(tok0 + 16 * mt + fr) * DM + ka_; S.x0[mt] = *(const unsigned long long*)xp; S.x1[mt] = *(const unsigned long long*)(xp + 16); } \
        _Pragma("unroll") for (int nt = 0; nt < 5; ++nt) { S.bh[nt] = *(const bf16x8*)(RWh + (size_t)(16 * nt + fr) * 2048 + kb_); S.bl[nt] = *(const bf16x8*)(RWl + (size_t)(16 * nt + fr) * 2048 + kb_); } } while (0)
#define RT_COMP(S) do { bf16x8 ah[2], al[2]; \
        _Pragma("unroll") for (int mt = 0; mt < 2; ++mt) { const float r = rr[mt]; float u[8], hf[8]; \
            const f32x4 xa_ = unpack4(S.x0[mt]), xb_ = unpack4(S.x1[mt]); \
            _Pragma("unroll") for (int j = 0; j < 4; ++j) { u[j] = xa_[j] * r * S.g0[j]; u[4 + j] = xb_[j] * r * S.g1[j]; } \
            pg8::u32x4 wh, wl; \
            wh.x = pg8::cvt_pk_bf16(u[0], u[1]); wh.y = pg8::cvt_pk_bf16(u[2], u[3]); wh.z = pg8::cvt_pk_bf16(u[4], u[5]); wh.w = pg8::cvt_pk_bf16(u[6], u[7]); \
            hf[0] = __builtin_bit_cast(float, wh.x << 16); hf[1] = __builtin_bit_cast(float, wh.x & 0xffff0000u); hf[2] = __builtin_bit_cast(float, wh.y << 16); hf[3] = __builtin_bit_cast(float, wh.y & 0xffff0000u); \
            hf[4] = __builtin_bit_cast(float, wh.z << 16); hf[5] = __builtin_bit_cast(float, wh.z & 0xffff0000u); hf[6] = __builtin_bit_cast(float, wh.w << 16); hf[7] = __builtin_bit_cast(float, wh.w & 0xffff0000u); \
            wl.x = pg8::cvt_pk_bf16(u[0] - hf[0], u[1] - hf[1]); wl.y = pg8::cvt_pk_bf16(u[2] - hf[2], u[3] - hf[3]); wl.z = pg8::cvt_pk_bf16(u[4] - hf[4], u[5] - hf[5]); wl.w = pg8::cvt_pk_bf16(u[6] - hf[6], u[7] - hf[7]); \
            ah[mt] = __builtin_bit_cast(bf16x8, wh); al[mt] = __builtin_bit_cast(bf16x8, wl); } \
        _Pragma("unroll") for (int nt = 0; nt < 5; ++nt) { _Pragma("unroll") for (int mt = 0; mt < 2; ++mt) { \
            acc[mt][nt] = __builtin_amdgcn_mfma_f32_16x16x32_bf16(ah[mt], S.bh[nt], acc[mt][nt], 0, 0, 0); \
            acc[mt][nt] = __builtin_amdgcn_mfma_f32_16x16x32_bf16(al[mt], S.bh[nt], acc[mt][nt], 0, 0, 0); \
            acc[mt][nt] = __builtin_amdgcn_mfma_f32_16x16x32_bf16(ah[mt], S.bl[nt], acc[mt][nt], 0, 0, 0); } } } while (0)
    {
        RtSet s0, s1;
#define RT_PIN() asm volatile("" ::: "memory")
        RT_LOAD(0, s0); RT_LOAD(1, s1); RT_PIN();
        RT_COMP(s0); RT_PIN(); RT_LOAD(2, s0); RT_PIN(); RT_COMP(s1); RT_PIN(); RT_LOAD(3, s1); RT_PIN();
        RT_COMP(s0); RT_PIN(); RT_LOAD(4, s0); RT_PIN(); RT_COMP(s1); RT_PIN(); RT_LOAD(5, s1); RT_PIN();
        RT_COMP(s0); RT_PIN(); RT_LOAD(6, s0); RT_PIN(); RT_COMP(s1); RT_PIN(); RT_LOAD(7, s1); RT_PIN();
        RT_COMP(s0); RT_COMP(s1);
#undef RT_PIN
    }
#undef RT_LOAD
#undef RT_COMP
#pragma unroll
    for (int mt = 0; mt < 2; ++mt)
#pragma unroll
        for (int nt = 0; nt < 5; ++nt) *(LAS f32x4*)(part + ((wave * 10 + mt * 5 + nt) * 64 + lane) * 4) = acc[mt][nt];
    __syncthreads();
    for (int o = tid; o < 32 * 80; o += 512) {
        const int t = o / 80, col = o % 80, mt = t >> 4, tr = t & 15, nt = col >> 4, ln = (tr >> 2) * 16 + (col & 15), rg = tr & 3;
        float s = 0.f;
#pragma unroll
        for (int w = 0; w < 8; ++w) s += part[((w * 10 + mt * 5 + nt) * 64 + ln) * 4 + rg];
        lg[t * 80 + col] = s;
    }
    __syncthreads();
    if (tid < 32) {
        const int t = tok0 + tid; const LAS float* l = lg + tid * 80;
        float g[8]; int gi = 0; float gm = -INFINITY;
#pragma unroll
        for (int i = 0; i < 8; ++i) { g[i] = l[i] + gbias[i]; if (g[i] > gm) { gm = g[i]; gi = i; } }
        float gs = 0.f;
#pragma unroll
        for (int i = 0; i < 8; ++i) gs += expf(g[i] - gm);
        const float ggate = 1.f / gs;
        float e[8]; float em = -INFINITY;
#pragma unroll
        for (int i = 0; i < 8; ++i) { e[i] = l[8 + gi * 8 + i] + ebias[gi * 8 + i]; em = fmaxf(em, e[i]); }
        float es = 0.f; float p[8];
#pragma unroll
        for (int i = 0; i < 8; ++i) { p[i] = expf(e[i] - em); es += p[i]; }
        int i1 = 0; float p1 = -1.f;
#pragma unroll
        for (int i = 0; i < 8; ++i) if (p[i] > p1) { p1 = p[i]; i1 = i; }
        int i2 = 0; float p2 = -1.f;
#pragma unroll
        for (int i = 0; i < 8; ++i) if (i != i1 && p[i] > p2) { p2 = p[i]; i2 = i; }
        const float q1 = p1 / es, q2 = p2 / es, qs = q1 + q2;
        const int e1 = gi * 8 + i1, e2 = gi * 8 + i2;
        int* eid = (int*)(ws + WS_SMALL + SM_EID); float* gate = (float*)(ws + WS_SMALL + SM_GATE); int* pos = (int*)(ws + WS_SMALL + SM_POS);
        eid[t * 2] = e1; eid[t * 2 + 1] = e2;
        gate[t * 2] = ggate * (q1 / qs); gate[t * 2 + 1] = ggate * (q2 / qs);
        pos[t * 2] = __hip_atomic_fetch_add(hist + e1, 1, __ATOMIC_RELAXED, __HIP_MEMORY_SCOPE_WORKGROUP);
        pos[t * 2 + 1] = __hip_atomic_fetch_add(hist + e2, 1, __ATOMIC_RELAXED, __HIP_MEMORY_SCOPE_WORKGROUP);
    }
    __syncthreads();
    if (tid < 64) ((int*)(ws + WS_SMALL + SM_LOGITS))[wg * 64 + tid] = hist[tid];
}
__device__ __forceinline__ void fill_phase(LAS unsigned char* lds, int wg, unsigned char* ws, unsigned* cnt, int tid) {
    LAS int* ps = (LAS int*)lds;
    char* sm = (char*)(ws + WS_SMALL);
    if (tid < 64) {
        const int* tab = (const int*)(sm + SM_LOGITS) + tid;
        int below = 0, total = 0;
#pragma unroll 1
        for (int w0 = 0; w0 < 256; w0 += 32) { int v[32];
#pragma unroll
            for (int i = 0; i < 32; ++i) v[i] = tab[(w0 + i) * 64];
#pragma unroll
            for (int i = 0; i < 32; ++i) { total += v[i]; below += (w0 + i < wg) ? v[i] : 0; } }
        const int padded = (total + RB - 1) / RB * RB;
        int inc = padded;
#pragma unroll
        for (int o = 1; o < 64; o <<= 1) { const int t = __shfl_up(inc, o); if (tid >= o) inc += t; }
        ps[tid] = inc - padded; if (tid == 63) ps[NE] = inc;
        ps[128 + tid] = inc - padded + below;
    }
    __syncthreads();
    if (wg == 0) {
        int* blk_exp = (int*)(sm + SM_BLKEXP); int* nblk = (int*)(sm + SM_NBLK);
        if (tid < NBLK_MAX) { int e = NE - 1; for (int i = 0; i < NE; ++i) if (tid * RB >= ps[i] && tid * RB < ps[i + 1]) { e = i; break; } blk_exp[tid] = e; }
        if (tid == 0) *nblk = ps[NE] / RB;
    }
    if (tid < 64) {
        const int i = wg * 64 + tid; const int* eid = (const int*)(sm + SM_EID); const int* pos = (const int*)(sm + SM_POS);
        const int s = ps[128 + eid[i]] + pos[i];
        ((int*)(sm + SM_SLOTTOK))[s] = i >> 1; ((int*)(sm + SM_TSLOT))[i] = s;
    }
    __syncthreads();
}
__device__ __forceinline__ void final_rows(int t0, const bf16* X1, const bf16* Y, unsigned char* ws, const float* fw, float* out, int lane, float probe_scale) {
    typedef pg8::f32x4 f32x4;
    const char* sm = (const char*)(ws + WS_SMALL);
    const int4 sl = *(const int4*)((const int*)(sm + SM_TSLOT) + t0 * 2); const float4 gt = *(const float4*)((const float*)(sm + SM_GATE) + t0 * 2);
    const int ss[4] = {sl.x, sl.y, sl.z, sl.w}; const float gg[4] = {gt.x, gt.y, gt.z, gt.w};
    f32x4 x[2][8]; unsigned long long xq[2][8], ya[2][8], yb[2][8];
#pragma unroll
    for (int q = 0; q < 2; ++q) {
        const GAS unsigned long long* xr = (const GAS unsigned long long*)(X1 + (size_t)(t0 + q) * DM) + lane;
        const GAS unsigned long long* y1 = (const GAS unsigned long long*)(Y + (size_t)ss[2 * q] * DM) + lane; const GAS unsigned long long* y2 = (const GAS unsigned long long*)(Y + (size_t)ss[2 * q + 1] * DM) + lane;
#pragma unroll
        for (int j = 0; j < 8; ++j) { xq[q][j] = xr[64 * j]; ya[q][j] = y1[64 * j]; yb[q][j] = y2[64 * j]; }
    }
    int lane_g = lane; asm volatile("" : "+v"(lane_g));
    const GAS f32x4* wr = (const GAS f32x4*)fw + lane_g;
    f32x4 gw[8];
#pragma unroll
    for (int q = 0; q < 2; ++q) {
        const float g1 = gg[2 * q], g2 = gg[2 * q + 1]; float sq = 0.f;
#pragma unroll
        for (int j = 0; j < 8; ++j) {
            const unsigned alo = (unsigned)ya[q][j], ahi = (unsigned)(ya[q][j] >> 32), blo = (unsigned)yb[q][j], bhi = (unsigned)(yb[q][j] >> 32);
            f32x4 r = unpack4(xq[q][j]);
            r.x += g1 * __builtin_bit_cast(float, alo << 16) + g2 * __builtin_bit_cast(float, blo << 16);
            r.y += g1 * __builtin_bit_cast(float, alo & 0xffff0000u) + g2 * __builtin_bit_cast(float, blo & 0xffff0000u);
            r.z += g1 * __builtin_bit_cast(float, ahi << 16) + g2 * __builtin_bit_cast(float, bhi << 16);
            r.w += g1 * __builtin_bit_cast(float, ahi & 0xffff0000u) + g2 * __builtin_bit_cast(float, bhi & 0xffff0000u);
            x[q][j] = r; sq += (r.x * r.x + r.y * r.y) + (r.z * r.z + r.w * r.w);
        }
        if (q == 0) {
#pragma unroll
            for (int j = 0; j < 8; ++j) gw[j] = wr[64 * j]; }
        const float rr = rsqrtf(wave_sum(sq) * (1.f / DM) + EPS);
        GAS f32x4* o = (GAS f32x4*)(out + (size_t)(t0 + q) * DM) + lane;
#pragma unroll
        for (int j = 0; j < 8; ++j) o[64 * j] = x[q][j] * (MK_TPROBE >= 0 ? rr * probe_scale : rr) * gw[j];
    }
}


constexpr int MQ_A = 0, MQ_B = 65536, MQ_CTL = 98304;
__device__ __forceinline__ int perm32_inv(int c) { return 16 * ((c >> 2) & 1) + 4 * (c >> 3) + (c & 3); }
template <bool UP>
__device__ __forceinline__ void moe_gemm(LAS unsigned char* lds, unsigned char* ws, const float* w1, const float* w3  , unsigned* qctr, unsigned* done, int nblk, int tid) {
    typedef pg8::bf16x8 bf16x8; typedef pg8::f32x4 f32x4;
    constexpr int K = UP ? DM : DE, NT = K / 64, UPB = UP ? 8 : 16;
    const int wid = __builtin_amdgcn_readfirstlane(tid >> 6), lane = tid & 63, wr = wid >> 2, wc = wid & 3, fr = lane & 15, fq = lane >> 4;
    const int* slot_tok = (const int*)(ws + WS_SMALL + SM_SLOTTOK); const int* blk_exp = (const int*)(ws + WS_SMALL + SM_BLKEXP);
    int Rr[2], Cc[2];
#pragma unroll
    for (int i = 0; i < 2; ++i) pg8::stage_rc(tid * 16 + i * 8192, Rr[i], Cc[i]);
    const unsigned ldsw = (unsigned)wid * 1024u;
    const int aoff = pg8::lds_byte(fr, fq * 8), boff = pg8::lds_byte(wc * 32 + fr, fq * 8);
    const int cidx = tid & 127, kq = wid >> 1, chalf = wid & 1;
    int slot;
    if (UP) { const int x = cidx & 63; slot = 32 * (x >> 4) + ((cidx >> 6) ? 16 : 0) + (x & 15); } else slot = (cidx & ~31) + perm32_inv(cidx & 31);
    const int bw0 = pg8::lds_byte(slot, 8 * kq), bw1 = pg8::lds_byte(slot, 32 + 8 * kq);
    LAS int* uword = (LAS int*)(lds + MQ_CTL);
    const int nunits = nblk * UPB;
    int bprev = -1;
    for (;;) {
        __syncthreads();
        if (tid == 0) {
            if (UP && bprev >= 0) { __builtin_amdgcn_fence(__ATOMIC_RELEASE, "agent"); asm volatile("s_waitcnt vmcnt(0)" ::: "memory"); (void)xb_add(done + bprev, 1u); }
            const unsigned un = __hip_atomic_fetch_add(qctr, 1u, __ATOMIC_RELAXED, __HIP_MEMORY_SCOPE_AGENT);
            if (!UP && (int)un < nunits) {
                unsigned sp = 0u; while (xb_ld(done + un / UPB) < 8u) { __builtin_amdgcn_s_sleep(2); if (++sp > (1u << 22)) break; }
                __builtin_amdgcn_fence(__ATOMIC_ACQUIRE, "agent"); asm volatile("s_waitcnt vmcnt(0)" ::: "memory");
            }
            uword[0] = (int)un;
        }
        __syncthreads();
        const int u = __builtin_amdgcn_readfirstlane(uword[0]);
        if (u >= nunits) break;
        const int b = u / UPB, j = u % UPB;
        bprev = b;
        const int e = __builtin_amdgcn_readfirstlane(__hip_atomic_load(blk_exp + b, __ATOMIC_RELAXED, __HIP_MEMORY_SCOPE_AGENT));
        unsigned ao[2][2];
#pragma unroll
        for (int h = 0; h < 2; ++h)
#pragma unroll
            for (int i = 0; i < 2; ++i) { const int row = UP ? slot_tok[b * 256 + h * 128 + Rr[i]] : b * 256 + h * 128 + Rr[i]; ao[h][i] = (unsigned)row * (unsigned)(K * 2) + (unsigned)Cc[i] * 2u; }
        const char* Abase = (const char*)(ws + (UP ? WS_UB : WS_HH));
        const float* bcolu;
        if (UP) bcolu = (chalf ? w3 : w1) + (size_t)e * DM * DE + 64 * j; else bcolu = w1 + (size_t)e * DE * DM + 128 * j + 64 * chalf;
        constexpr int LDN = UP ? DE : DM;
        f32x4 acc[8][2];
#pragma unroll
        for (int m = 0; m < 8; ++m)
#pragma unroll
            for (int n = 0; n < 2; ++n) acc[m][n] = (f32x4){0.f, 0.f, 0.f, 0.f};
        float r0[16], r1[16], r2[16];
#define MQ_LOAD_A(t, ra) do { _Pragma("unroll") for (int h = 0; h < 2; ++h) _Pragma("unroll") for (int i = 0; i < 2; ++i) \
            ra[h * 2 + i] = *(const pg8::u32x4*)(Abase + ao[h][i] + (size_t)(t) * 128); } while (0)
#define MQ_WRITE_A(ra, buf) do { _Pragma("unroll") for (int h = 0; h < 2; ++h) _Pragma("unroll") for (int i = 0; i < 2; ++i) \
            *(LAS pg8::u32x4*)(lds + MQ_A + ((buf) * 2 + h) * 16384 + ldsw + i * 8192 + lane * 16) = ra[h * 2 + i]; } while (0)
#define MQ_LOAD_B(t, r) do { const float* p_ = bcolu + (size_t)((t) * 64 + 8 * kq) * LDN; \
            _Pragma("unroll") for (int e_ = 0; e_ < 8; ++e_) { r[e_] = (p_ + (size_t)e_ * LDN)[lane]; r[8 + e_] = (p_ + (size_t)(32 + e_) * LDN)[lane]; } } while (0)
#define MQ_WRITE_B(r, buf) do { pg8::u32x4 w0_, w1_; \
            w0_.x = pg8::cvt_pk_bf16(r[0], r[1]); w0_.y = pg8::cvt_pk_bf16(r[2], r[3]); w0_.z = pg8::cvt_pk_bf16(r[4], r[5]); w0_.w = pg8::cvt_pk_bf16(r[6], r[7]); \
            w1_.x = pg8::cvt_pk_bf16(r[8], r[9]); w1_.y = pg8::cvt_pk_bf16(r[10], r[11]); w1_.z = pg8::cvt_pk_bf16(r[12], r[13]); w1_.w = pg8::cvt_pk_bf16(r[14], r[15]); \
            *(LAS pg8::u32x4*)(lds + MQ_B + (buf) * 16384 + bw0) = w0_; *(LAS pg8::u32x4*)(lds + MQ_B + (buf) * 16384 + bw1) = w1_; } while (0)
#define MQ_COMPUTE(buf) do { const LAS unsigned char* A_ = lds + MQ_A + ((buf) * 2 + wr) * 16384 + aoff; const LAS unsigned char* B_ = lds + MQ_B + (buf) * 16384 + boff; \
            _Pragma("unroll") for (int k = 0; k < 2; ++k) { bf16x8 bf_[2]; \
                _Pragma("unroll") for (int n = 0; n < 2; ++n) bf_[n] = *(const LAS bf16x8*)(B_ + n * 2048 + k * 1024); \
                _Pragma("unroll") for (int mh = 0; mh < 2; ++mh) { bf16x8 af_[4]; \
                    _Pragma("unroll") for (int m = 0; m < 4; ++m) af_[m] = *(const LAS bf16x8*)(A_ + (4 * mh + m) * 2048 + k * 1024); \
                    _Pragma("unroll") for (int m = 0; m < 4; ++m) _Pragma("unroll") for (int n = 0; n < 2; ++n) acc[4 * mh + m][n] = __builtin_amdgcn_mfma_f32_16x16x32_bf16(bf_[n], af_[m], acc[4 * mh + m][n], 0, 0, 0); } } } while (0)
#define MQ_STEP(t, rcur, rnxt, acur, anxt, buf) do { \
            { const int tb_ = (t) + 3 < NT ? (t) + 3 : NT - 1, ta_ = (t) + 2 < NT ? (t) + 2 : NT - 1; MQ_LOAD_A(ta_, acur); MQ_LOAD_B(tb_, rcur); }     \
            MQ_COMPUTE(buf); \
            if ((t) + 1 < NT) { MQ_WRITE_A(anxt, (buf) ^ 1); MQ_WRITE_B(rnxt, (buf) ^ 1); } \
            asm volatile("s_waitcnt lgkmcnt(0)" ::: "memory"); __builtin_amdgcn_s_barrier(); asm volatile("" ::: "memory"); } while (0)
        pg8::u32x4 a0[4], a1[4];
        MQ_LOAD_A(0, a0); MQ_LOAD_B(0, r0); MQ_LOAD_A(1, a1); MQ_LOAD_B(1, r1); MQ_LOAD_B(2, r2);
        MQ_WRITE_A(a0, 0); MQ_WRITE_B(r0, 0);
        asm volatile("s_waitcnt lgkmcnt(0)" ::: "memory"); __builtin_amdgcn_s_barrier(); asm volatile("" ::: "memory");
        static_assert(NT % 6 == 2, "step loop: six steps per trip + two");
#pragma unroll 1
        for (int t = 0; t + 6 <= NT; t += 6) {
            MQ_STEP(t, r0, r1, a0, a1, 0); MQ_STEP(t + 1, r1, r2, a1, a0, 1); MQ_STEP(t + 2, r2, r0, a0, a1, 0);
            MQ_STEP(t + 3, r0, r1, a1, a0, 1); MQ_STEP(t + 4, r1, r2, a0, a1, 0); MQ_STEP(t + 5, r2, r0, a1, a0, 1); }
        { constexpr int t = NT - 2; MQ_STEP(t, r0, r1, a0, a1, 0); MQ_STEP(t + 1, r1, r2, a1, a0, 1); }
        const int row0 = b * 256 + wr * 128 + fr;
        if (UP) {
            bf16* HH = (bf16*)(ws + WS_HH);
#pragma unroll
            for (int m = 0; m < 8; ++m) { float v[4];
#pragma unroll
                for (int r = 0; r < 4; ++r) { const float a = acc[m][0][r], bb = acc[m][1][r]; v[r] = a / (1.f + __expf(-a)) * bb; }
                *(unsigned long long*)(HH + (size_t)(row0 + 16 * m) * DE + 64 * j + 16 * wc + 4 * fq) = (unsigned long long)pg8::cvt_pk_bf16(v[0], v[1]) | ((unsigned long long)pg8::cvt_pk_bf16(v[2], v[3]) << 32); }
        } else {
            bf16* Y = (bf16*)(ws + WS_Y);
#pragma unroll
            for (int m = 0; m < 8; ++m) { const f32x4 v0 = acc[m][0], v1 = acc[m][1];
                pg8::u32x4 w; w.x = pg8::cvt_pk_bf16(v0[0], v0[1]); w.y = pg8::cvt_pk_bf16(v0[2], v0[3]); w.z = pg8::cvt_pk_bf16(v1[0], v1[1]); w.w = pg8::cvt_pk_bf16(v1[2], v1[3]);
                *(pg8::u32x4*)(Y + (size_t)(row0 + 16 * m) * DM + 128 * j + 32 * wc + 8 * fq) = w; }
        }
#undef MQ_LOAD_A
#undef MQ_WRITE_A
#undef MQ_LOAD_B
#undef MQ_WRITE_B
#undef MQ_COMPUTE
#undef MQ_STEP
        if (UP) asm volatile("s_waitcnt vmcnt(0)" ::: "memory");
    }
    asm volatile("s_waitcnt vmcnt(0)" ::: "memory");
    __syncthreads();
}

constexpr int NWAVES = 8;
constexpr int LDS_BYTES = 147456, LDSCTL_OFF = LDS_BYTES - 256;

struct Args { const float* in[31]; float* out; unsigned char* ws; int ph_lo, ph_hi, li, pad; };

struct Epi1 {
    bf16* PG; float* PGATE; bf16* PT;
    __device__ __forceinline__ void operator()(const pg8::f32x4 (&acc)[2][2][4][2], const pg8::Unit& u, int wr, int wc, int fr, int fq) const {
        const int row0 = u.pm * 256 + wr * 64 + fr;
        if (u.kind == 0) {
            if (u.pn < 16) {
                const int col0 = u.pn * 256 + wc * 32 + 8 * fq;
#pragma unroll
                for (int ai = 0; ai < 2; ++ai)
#pragma unroll
                    for (int m = 0; m < 4; ++m) { bf16* rowp = PG + (size_t)(row0 + ai * 128 + m * 16) * 4096 + col0;
#pragma unroll
                        for (int bj = 0; bj < 2; ++bj) { const pg8::f32x4 v0 = acc[ai][bj][m][0], v1 = acc[ai][bj][m][1];
                            pg8::u32x4 w; w.x = pg8::cvt_pk_bf16(v0[0], v0[1]); w.y = pg8::cvt_pk_bf16(v0[2], v0[3]); w.z = pg8::cvt_pk_bf16(v1[0], v1[1]); w.w = pg8::cvt_pk_bf16(v1[2], v1[3]);
                            *(pg8::u32x4*)(rowp + bj * 128) = w; } }
            } else if (wc == 0) {
#pragma unroll
                for (int ai = 0; ai < 2; ++ai)
#pragma unroll
                    for (int m = 0; m < 4; ++m) { float* rowp = PGATE + (size_t)(row0 + ai * 128 + m * 16) * 32 + 8 * fq;
                        *(pg8::f32x4*)(rowp) = acc[ai][0][m][0]; *(pg8::f32x4*)(rowp + 4) = acc[ai][0][m][1]; }
            }
        } else {
            const int col0 = u.pn * 256 + wc * 32 + 8 * fq;
#pragma unroll
            for (int ai = 0; ai < 2; ++ai)
#pragma unroll
                for (int m = 0; m < 4; ++m) { bf16* rowp = PT + (size_t)(row0 + ai * 128 + m * 16) * T + col0;
#pragma unroll
                    for (int bj = 0; bj < 2; ++bj) { const pg8::f32x4 v0 = acc[ai][bj][m][0], v1 = acc[ai][bj][m][1];
                        pg8::u32x4 w; w.x = pg8::cvt_pk_bf16(v0[0], v0[1]); w.y = pg8::cvt_pk_bf16(v0[2], v0[3]); w.z = pg8::cvt_pk_bf16(v1[0], v1[1]); w.w = pg8::cvt_pk_bf16(v1[2], v1[3]);
                        *(pg8::u32x4*)(rowp + bj * 128) = w; } }
        }
    }
};
struct Order1 {
    const char* Hb; const char* WinT; int G, c;
    __device__ __forceinline__ bool next(int i, pg8::Unit& u) const {
        const int L = i * G + c;
        if (L >= 928) return false;
        u.rows = nullptr;
        if (L < 544) { int pm, pn; pg8::tile_of(L, 32, 17, pm, pn); u.pm = pm; u.pn = pn; u.kind = 0;
            u.A = Hb + (size_t)pm * 256 * DM * 2; u.B = WinT + (size_t)(GOFF + pn * 256) * DM * 2; }
        else { int pm, pn; pg8::tile_of(L - 544, 12, 32, pm, pn); u.pm = pm; u.pn = pn; u.kind = 1;
            u.A = WinT + (size_t)pm * 256 * DM * 2; u.B = Hb + (size_t)pn * 256 * DM * 2; }
        return true;
    }
};

struct Epi2 {
    const float* x; bf16* X1;
    __device__ __forceinline__ void operator()(const pg8::f32x4 (&acc)[2][2][4][2], const pg8::Unit& u, int wr, int wc, int fr, int fq) const {
        const int row0 = u.pm * 256 + wr * 64 + fr, col0 = u.pn * 256 + wc * 32 + 8 * fq;
#pragma unroll
        for (int ai = 0; ai < 2; ++ai) {
            pg8::f32x4 xv[4][2][2];
#pragma unroll
            for (int m = 0; m < 4; ++m) { const size_t off = (size_t)(row0 + ai * 128 + m * 16) * DM + col0;
#pragma unroll
                for (int bj = 0; bj < 2; ++bj) { xv[m][bj][0] = *(const pg8::f32x4*)(x + off + bj * 128); xv[m][bj][1] = *(const pg8::f32x4*)(x + off + bj * 128 + 4); } }
            asm volatile("" ::: "memory");
#pragma unroll
            for (int m = 0; m < 4; ++m) { const size_t off = (size_t)(row0 + ai * 128 + m * 16) * DM + col0;
#pragma unroll
                for (int bj = 0; bj < 2; ++bj) { const pg8::f32x4 v0 = xv[m][bj][0] + acc[ai][bj][m][0], v1 = xv[m][bj][1] + acc[ai][bj][m][1];
                    pg8::u32x4 w; w.x = pg8::cvt_pk_bf16(v0[0], v0[1]); w.y = pg8::cvt_pk_bf16(v0[2], v0[3]); w.z = pg8::cvt_pk_bf16(v1[0], v1[1]); w.w = pg8::cvt_pk_bf16(v1[2], v1[3]);
                    *(pg8::u32x4*)(X1 + off + bj * 128) = w; } }
            asm volatile("" ::: "memory"); }
    }
};
struct Order2 {
    const char* A2; const char* WoutT; int G, c;
    __device__ __forceinline__ bool next(int i, pg8::Unit& u) const {
        const int L = i * G + c; if (L >= 256) return false;
        int pm, pn; pg8::tile_of(L, 32, 8, pm, pn); u.pm = pm; u.pn = pn; u.kind = 0; u.rows = nullptr;
        u.A = A2 + (size_t)pm * 256 * DM * 2; u.B = WoutT + (size_t)pn * 256 * DM * 2; return true;
    }
};
struct Epi3 {
    bf16* HH;
    __device__ __forceinline__ void operator()(const pg8::f32x4 (&acc)[2][2][4][2], const pg8::Unit& u, int wr, int wc, int fr, int fq) const {
        const int row0 = u.pm * 256 + wr * 64 + fr, col0 = u.pn * 128 + wc * 32 + 8 * fq;
#pragma unroll
        for (int ai = 0; ai < 2; ++ai)
#pragma unroll
            for (int m = 0; m < 4; ++m) { bf16* rowp = HH + (size_t)(row0 + ai * 128 + m * 16) * DE + col0;
                float v[8];
#pragma unroll
                for (int n = 0; n < 2; ++n)
#pragma unroll
                    for (int j = 0; j < 4; ++j) { const float a = acc[ai][0][m][n][j], b = acc[ai][1][m][n][j]; v[n * 4 + j] = a / (1.f + __expf(-a)) * b; }
                pg8::u32x4 w; w.x = pg8::cvt_pk_bf16(v[0], v[1]); w.y = pg8::cvt_pk_bf16(v[2], v[3]); w.z = pg8::cvt_pk_bf16(v[4], v[5]); w.w = pg8::cvt_pk_bf16(v[6], v[7]);
                *(pg8::u32x4*)rowp = w; }
    }
};
struct Order3 {
    const char* Ub; const char* W13T; const int* slot_tok; const int* blk_exp; int nunits, G, c;
    __device__ __forceinline__ bool next(int i, pg8::Unit& u) const {
        const int L = i * G + c; if (L >= nunits) return false;
        const int b = L >> 2, j = L & 3; u.pm = b; u.pn = j; u.kind = 0; u.rows = slot_tok + b * 256; u.A = Ub;
        const int e = __hip_atomic_load(blk_exp + b, __ATOMIC_RELAXED, __HIP_MEMORY_SCOPE_AGENT);
        u.B = W13T + ((size_t)e * 1024 + j * 256) * DM * 2; return true;
    }
};
struct Epi4 {
    bf16* Y;
    __device__ __forceinline__ void operator()(const pg8::f32x4 (&acc)[2][2][4][2], const pg8::Unit& u, int wr, int wc, int fr, int fq) const {
        const int row0 = u.pm * 256 + wr * 64 + fr, col0 = u.pn * 256 + wc * 32 + 8 * fq;
#pragma unroll
        for (int ai = 0; ai < 2; ++ai)
#pragma unroll
            for (int m = 0; m < 4; ++m) { bf16* rowp = Y + (size_t)(row0 + ai * 128 + m * 16) * DM + col0;
#pragma unroll
                for (int bj = 0; bj < 2; ++bj) { const pg8::f32x4 v0 = acc[ai][bj][m][0], v1 = acc[ai][bj][m][1];
                    pg8::u32x4 w; w.x = pg8::cvt_pk_bf16(v0[0], v0[1]); w.y = pg8::cvt_pk_bf16(v0[2], v0[3]); w.z = pg8::cvt_pk_bf16(v1[0], v1[1]); w.w = pg8::cvt_pk_bf16(v1[2], v1[3]);
                    *(pg8::u32x4*)(rowp + bj * 128) = w; } }
    }
};
struct Order4 {
    const char* HH; const char* W2T; const int* blk_exp; int nunits, G, c;
    __device__ __forceinline__ bool next(int i, pg8::Unit& u) const {
        const int L = i * G + c; if (L >= nunits) return false;
        const int b = L >> 3, j = L & 7; u.pm = b; u.pn = j; u.kind = 0; u.rows = nullptr; u.A = HH + (size_t)b * 256 * DE * 2;
        const int e = __hip_atomic_load(blk_exp + b, __ATOMIC_RELAXED, __HIP_MEMORY_SCOPE_AGENT);
        u.B = W2T + ((size_t)e * DM + j * 256) * DE * 2; return true;
    }
};

struct TrItem { const float* W; int ldn, k0, n0; bf16* WT; size_t dst_row0; int ldk; };
__device__ __forceinline__ void tr_store(const TrItem& I, LAS float* scr, const float (&tv)[32], int lane) {
#pragma unroll
    for (int i = 0; i < 32; ++i) { const int kk = 2 * i + (lane >> 5); scr[kk * 33 + (lane & 31)] = tv[i]; }
    asm volatile("s_waitcnt lgkmcnt(0)" ::: "memory");
    const int c = lane & 7;
#pragma unroll
    for (int j = 0; j < 4; ++j) { const int n = (lane >> 3) + 8 * j; const LAS float* s = scr + (8 * c) * 33 + n;
        v4u o; o.x = pg8::cvt_pk_bf16(s[0 * 33], s[1 * 33]); o.y = pg8::cvt_pk_bf16(s[2 * 33], s[3 * 33]); o.z = pg8::cvt_pk_bf16(s[4 * 33], s[5 * 33]); o.w = pg8::cvt_pk_bf16(s[6 * 33], s[7 * 33]);
        *(GAS v4u*)(I.WT + (I.dst_row0 + n) * I.ldk + I.k0 + 8 * c) = o; }
    asm volatile("s_waitcnt lgkmcnt(0)" ::: "memory");
}
__device__ __forceinline__ void tr_pair(const TrItem& A, const TrItem& B, bool hasB, LAS float* scr, int lane) {
    float ta[32], tb[32];
    const float* pa = A.W + (size_t)(A.k0 + (lane >> 5)) * A.ldn + A.n0 + (lane & 31);
    const float* pb = (hasB ? B.W + (size_t)(B.k0 + (lane >> 5)) * B.ldn + B.n0 : A.W + (size_t)(A.k0 + (lane >> 5)) * A.ldn + A.n0) + (lane & 31);
    const size_t sa = (size_t)2 * A.ldn, sb = (size_t)2 * (hasB ? B.ldn : A.ldn);
#pragma unroll
    for (int i = 0; i < 32; ++i) { ta[i] = pa[i * sa]; tb[i] = pb[i * sb]; }
    tr_store(A, scr, ta, lane);
    if (hasB) tr_store(B, scr, tb, lane);
}
__device__ __forceinline__ void tr_item(const float* W, int ldn, int k0, int n0, bf16* WT, size_t dst_row0, int ldk, LAS float* scr, int lane) {
    const TrItem A{W, ldn, k0, n0, WT, dst_row0, ldk}; tr_pair(A, A, false, scr, lane);
}
__device__ __forceinline__ void rms_row_to_bf16(const float* xrow, const float* w, bf16* orow, int lane) {
    const GAS pg8::f32x4* xr = (const GAS pg8::f32x4*)xrow + lane; const GAS pg8::f32x4* wr = (const GAS pg8::f32x4*)w + lane;
    pg8::f32x4 v[8]; float s = 0.f;
#pragma unroll
    for (int j = 0; j < 8; ++j) { v[j] = xr[64 * j]; s += (v[j].x * v[j].x + v[j].y * v[j].y) + (v[j].z * v[j].z + v[j].w * v[j].w); }
    const float r = rsqrtf(wave_sum(s) * (1.f / DM) + EPS);
    GAS unsigned long long* o8 = (GAS unsigned long long*)orow + lane;
#pragma unroll
    for (int j = 0; j < 8; ++j) { const pg8::f32x4 g = wr[64 * j];
        o8[64 * j] = (unsigned long long)pk2(v[j].x * r * g.x, v[j].y * r * g.y) | ((unsigned long long)pk2(v[j].z * r * g.z, v[j].w * r * g.w) << 32); }
}

__device__ __forceinline__ void rms_rows2_to_bf16(const float* xrow, const float* w, bf16* orow, int lane) {
    const GAS pg8::f32x4* xr = (const GAS pg8::f32x4*)xrow + lane; const GAS pg8::f32x4* wr = (const GAS pg8::f32x4*)w + lane;
    pg8::f32x4 v[2][8], g[8];
#pragma unroll
    for (int q = 0; q < 2; ++q)
#pragma unroll
        for (int j = 0; j < 8; ++j) v[q][j] = xr[q * (DM / 4) + 64 * j];
#pragma unroll
    for (int j = 0; j < 8; ++j) g[j] = wr[64 * j];
#pragma unroll
    for (int q = 0; q < 2; ++q) { float s = 0.f;
#pragma unroll
        for (int j = 0; j < 8; ++j) s += (v[q][j].x * v[q][j].x + v[q][j].y * v[q][j].y) + (v[q][j].z * v[q][j].z + v[q][j].w * v[q][j].w);
        const float r = rsqrtf(wave_sum(s) * (1.f / DM) + EPS);
        GAS unsigned long long* o8 = (GAS unsigned long long*)(orow + (size_t)q * DM) + lane;
#pragma unroll
        for (int j = 0; j < 8; ++j) o8[64 * j] = (unsigned long long)pk2(v[q][j].x * r * g[j].x, v[q][j].y * r * g[j].y) | ((unsigned long long)pk2(v[q][j].z * r * g[j].z, v[q][j].w * r * g[j].w) << 32); }
}
__device__ __forceinline__ void rms_rows4_to_bf16(const float* xrow, const float* w, bf16* orow, int lane) {
    const GAS pg8::f32x4* xr = (const GAS pg8::f32x4*)xrow + lane; const GAS pg8::f32x4* wr = (const GAS pg8::f32x4*)w + lane;
    pg8::f32x4 v[4][8], g[8];
#pragma unroll
    for (int q = 0; q < 4; ++q)
#pragma unroll
        for (int j = 0; j < 8; ++j) v[q][j] = xr[q * (DM / 4) + 64 * j];
#pragma unroll
    for (int j = 0; j < 8; ++j) g[j] = wr[64 * j];
#pragma unroll
    for (int q = 0; q < 4; ++q) { float s = 0.f;
#pragma unroll
        for (int j = 0; j < 8; ++j) s += (v[q][j].x * v[q][j].x + v[q][j].y * v[q][j].y) + (v[q][j].z * v[q][j].z + v[q][j].w * v[q][j].w);
        const float r = rsqrtf(wave_sum(s) * (1.f / DM) + EPS);
        GAS unsigned long long* o8 = (GAS unsigned long long*)(orow + (size_t)q * DM) + lane;
#pragma unroll
        for (int j = 0; j < 8; ++j) o8[64 * j] = (unsigned long long)pk2(v[q][j].x * r * g[j].x, v[q][j].y * r * g[j].y) | ((unsigned long long)pk2(v[q][j].z * r * g[j].z, v[q][j].w * r * g[j].w) << 32); }
}

__global__ void __launch_bounds__(NWAVES * 64, 2) fwd(Args args) {
    extern __shared__ __attribute__((aligned(16))) unsigned char lds_raw[];
    LAS unsigned char* lds = (LAS unsigned char*)lds_raw;
    const int tid = threadIdx.x, lane = tid & 63, wave = __builtin_amdgcn_readfirstlane(tid >> 6);
    const int G = gridDim.x; const int bx = blockIdx.x; const int vcu = (G % 8 == 0) ? (bx % 8) * (G / 8) + bx / 8 : bx;
    unsigned char* ws = args.ws;
    unsigned* ctl = (unsigned*)(ws + WS_CTL);
    for (int u = tid; u < (LDS_BYTES - LDSCTL_OFF) / 4; u += NWAVES * 64) ((LAS unsigned*)(lds + LDSCTL_OFF))[u] = 0u;
    __syncthreads();
    XcdBarrier bar = xcd_barrier_post(ctl + CW_BAR + args.li * XCD_BAR_WORDS, (volatile LAS unsigned*)(lds + LDSCTL_OFF + 64));
    static_assert(2 * FFT_BUF_BYTES <= LDSCTL_OFF && 1024 * 33 * 4 <= LDSCTL_OFF, "LDS map");
    const int lo = args.ph_lo, hi = args.ph_hi;
    volatile LAS unsigned long long* tsl = (volatile LAS unsigned long long*)(lds + LDSCTL_OFF + 128);
#define TS(k) do { if (MK_TPROBE >= 0 && bx == 0 && tid == 0) tsl[k] = __builtin_amdgcn_s_memrealtime(); } while (0)
#if 0
#define MK_DUP_MASK 0
#endif
#define IN(k) (lo <= (k) && (k) < hi)
#define BOTH(k) (IN(k) && IN((k) + 1))
    bf16* WinT = (bf16*)(ws + WS_WINT); bf16* Hb = (bf16*)(ws + WS_HB);

    if (IN(0)) { TS(0); REP(0) {
        int tid_p = tid; asm volatile("" : "+v"(tid_p)); const int lane_p = tid_p & 63; (void)lane_p;
        LAS float* scr = (LAS float*)(lds + wave * 16384);
        const int gw = vcu * NWAVES + wave, NGW = G * NWAVES;
        const float* w_in = args.in[2];
        { bf16* WoutT = (bf16*)(ws + WS_WOUTT); const float* w_out = args.in[21];
          auto mk = [&](int it) -> TrItem { if (it < 32 * 225) { const int kb = it / 225, nb = it % 225; return TrItem{w_in, NPROJ, 64 * kb, 32 * nb, WinT, (size_t)(32 * nb), DM}; }
                                           const int j = it - 32 * 225, kb = j >> 6, nb = j & 63; return TrItem{w_out, DM, 64 * kb, 32 * nb, WoutT, (size_t)(32 * nb), DM}; };
          for (int p = gw; p < (32 * 225 + 32 * 64) / 2; p += NGW) tr_pair(mk(2 * p), mk(2 * p + 1), true, scr, lane); }
        for (int r = gw; r < NPROJ_PAD - NPROJ; r += NGW) { GAS v4u* o = (GAS v4u*)(WinT + (size_t)(NPROJ + r) * DM) + lane;
#pragma unroll
            for (int j = 0; j < 4; ++j) o[64 * j] = (v4u){0u, 0u, 0u, 0u}; }
        { bf16* RWh = (bf16*)(ws + WS_SMALL + SM_RWT); bf16* RWl = RWh + 80 * 2048; const float* rgw = args.in[23]; const float* rew = args.in[25];
          for (int i = vcu * 512 + tid; i < 80 * 2048; i += G * 512) { const int n = i >> 11, k = i & 2047;
              const float w = n < 8 ? rgw[k * 8 + n] : (n < 72 ? rew[k * 64 + n - 8] : 0.f); const unsigned h = f2bf(w); const float hf = __builtin_bit_cast(float, h << 16);
              const int kk = k & 31, o = (i & ~31) + 8 * ((kk & 15) >> 2) + (kk & 3) + ((kk >> 4) << 2);
              RWh[o] = (bf16)h; RWl[o] = (bf16)f2bf(w - hf); } }
        for (int m = 4 * gw; m < T; m += 4 * NGW) rms_rows4_to_bf16(args.in[0] + (size_t)m * DM, args.in[1], Hb + (size_t)m * DM, lane);
        for (int it = bx; it < 256; it += G)
            hyena_filter_item(lds, it, args.in[5], args.in[6], args.in[7], args.in[8], args.in[9], args.in[10], args.in[11], args.in[12], (float*)(ws + WS_KC), tid_p, lane_p, wave);
        }
        if (BOTH(0)) xcd_barrier<10240>(bar);
    }
    if (IN(1)) { TS(1); REP(1) {
        int tid_p = tid; asm volatile("" : "+v"(tid_p)); const int lane_p = tid_p & 63; (void)lane_p;
        Order1 S{(const char*)Hb, (const char*)WinT, G, bx};
        Epi1 E{(bf16*)(ws + WS_PG), (float*)(ws + WS_PGATE), (bf16*)(ws + WS_PT)};
        pg8::gemm_phase<Epi1, Order1, false>(lds, DM, S, E, tid_p);
        }
        if (BOTH(1)) xcd_barrier<65536>(bar);
    }
    if (IN(2)) { TS(2); REP(2) {
        int tid_p = tid; asm volatile("" : "+v"(tid_p)); const int lane_p = tid_p & 63; (void)lane_p;
        REP(11) hyena_phase(lds, (const bf16*)(ws + WS_PT), (const float*)(ws + WS_KC), args.in[3], args.in[4], args.in[13], (float*)(ws + WS_YHT), G, vcu);
        REP(12) for (int wg = bx; wg < 256; wg += G) {
            int tid_i = tid_p; asm volatile("" : "+v"(tid_i)); const int lane_i = tid_i & 63;
            gdn_pre(lds, wg, (const bf16*)(ws + WS_PG), (const float*)(ws + WS_PGATE), args.in[15], args.in[16], args.in[17], args.in[18], args.in[19], ws, tid_i, lane_i, wave);
            gdn_prep_wave(lds, wg, ws, lane_i, wave);
            __syncthreads();
        }
        }
        if (BOTH(2)) xcd_barrier<10240>(bar);
    }
    if (IN(3)) { TS(3); REP(3) {
        int tid_p = tid; asm volatile("" : "+v"(tid_p)); const int lane_p = tid_p & 63; (void)lane_p;
        for (int v = vcu; v < 256; v += G) gdn_scan4(lds, ws, (bf16*)(ws + WS_OF), (bf16*)(ws + WS_OB), v, tid_p, lane_p, wave);
        }
        if (BOTH(3)) xcd_barrier<10240>(bar);
    }
    if (IN(4)) { TS(4); REP(4) {
        int tid_p = tid; asm volatile("" : "+v"(tid_p)); const int lane_p = tid_p & 63; (void)lane_p;
        for (int tile = bx; tile < T / 32; tile += G) hyena_post_tile(lds, tile, (const float*)(ws + WS_YHT), args.in[14], (bf16*)(ws + WS_A2), tid_p, lane_p, wave);
        for (int it = (vcu * NWAVES + wave) * 8; it < T * 8; it += G * NWAVES * 8) gdn_post_batch(it, (const bf16*)(ws + WS_OF), (const bf16*)(ws + WS_OB), (const bf16*)(ws + WS_PG), args.in[20], (bf16*)(ws + WS_A2), lane_p);
        }
        if (BOTH(4)) xcd_barrier<8192>(bar);
    }
    if (IN(5)) { TS(5); REP(5) {
        int tid_p = tid; asm volatile("" : "+v"(tid_p)); const int lane_p = tid_p & 63; (void)lane_p;
        Order2 S{(const char*)(ws + WS_A2), (const char*)(ws + WS_WOUTT), G, bx};
        Epi2 E{args.in[0], (bf16*)(ws + WS_X1)};
        pg8::gemm_phase<Epi2, Order2, false>(lds, DM, S, E, tid_p);
        }
        if (BOTH(5)) xcd_barrier<20480>(bar);
    }
    if (IN(6)) { TS(6);
        int tid_p = tid; asm volatile("" : "+v"(tid_p)); const int lane_p = tid_p & 63; (void)lane_p;
        REP(6) for (int wg = bx; wg < 256; wg += G) { route_phase(lds, wg, (const bf16*)(ws + WS_X1), args.in[22], args.in[24], args.in[26], ws, ctl + CW_CNT + rep_ * 128, tid_p, lane_p, wave); __syncthreads(); }
        if (BOTH(6)) xcd_barrier<10240>(bar);
    }
    if (IN(7)) { TS(7);
        int tid_p = tid; asm volatile("" : "+v"(tid_p)); const int lane_p = tid_p & 63; (void)lane_p;
        REP(7) for (int wg = bx; wg < 256; wg += G) fill_phase(lds, wg, ws, ctl + CW_CNT, tid_p);
        if (BOTH(7)) xcd_barrier<24576>(bar);
    }
    const int* slot_tok = (const int*)(ws + WS_SMALL + SM_SLOTTOK); const int* blk_exp = (const int*)(ws + WS_SMALL + SM_BLKEXP); const int* nblk_p = (const int*)(ws + WS_SMALL + SM_NBLK);
    if (IN(8)) { TS(8); REP(8) {
        int tid_p = tid; asm volatile("" : "+v"(tid_p)); const int lane_p = tid_p & 63; (void)lane_p;
        const int nblk = __hip_atomic_load(nblk_p, __ATOMIC_RELAXED, __HIP_MEMORY_SCOPE_AGENT);
        moe_gemm<true>(lds, ws, args.in[27], args.in[28], ctl + CW_Q8 + rep_ * 32, ctl + CW_DONE, nblk, tid_p);
        }
    }
    if (IN(9)) { TS(9); REP(9) {
        int tid_p = tid; asm volatile("" : "+v"(tid_p)); const int lane_p = tid_p & 63; (void)lane_p;
        const int nblk = __hip_atomic_load(nblk_p, __ATOMIC_RELAXED, __HIP_MEMORY_SCOPE_AGENT);
        moe_gemm<false>(lds, ws, args.in[29], nullptr, ctl + CW_Q9 + rep_ * 32, ctl + CW_DONE, nblk, tid_p);
        }
        if (MK_TPROBE >= 0 && bx == 0 && tid == 0) { tsl[10] = __builtin_amdgcn_s_memrealtime();
            const float us = (float)(tsl[(MK_TPROBE < 0 ? 0 : MK_TPROBE) + 1] - tsl[MK_TPROBE < 0 ? 0 : MK_TPROBE]) * 0.01f;
            __hip_atomic_store((float*)(ctl + 3300), sqrtf(us * MK_TSCALE), __ATOMIC_RELAXED, __HIP_MEMORY_SCOPE_AGENT); }
        if (BOTH(9)) xcd_barrier<3072>(bar);
    }
    if (IN(10)) { TS(10); REP(10) {
        int tid_p = tid; asm volatile("" : "+v"(tid_p)); const int lane_p = tid_p & 63; (void)lane_p;
        for (int t = (vcu * NWAVES + wave) * 2; t < T; t += G * NWAVES * 2) final_rows(t, (const bf16*)(ws + WS_X1), (const bf16*)(ws + WS_Y), ws, args.in[30], args.out, lane_p, MK_TPROBE >= 0 ? 1.f + __hip_atomic_load((float*)(ctl + 3300), __ATOMIC_RELAXED, __HIP_MEMORY_SCOPE_AGENT) : 1.f);
    }
    }
#undef IN
#undef BOTH
}

#ifndef MK_PER_PHASE
#define MK_PER_PHASE 0
#endif
constexpr int N_PHASES = 11;
extern "C" void kernel_launch(void* const* d_in, const int* in_sizes, int n_in, void* d_out, int out_size, void* d_ws, size_t ws_size, hipStream_t stream) {
    static int grid = 0;
    if (grid == 0) {
        int dev = 0, cus = 0;
        (void)hipGetDevice(&dev); (void)hipDeviceGetAttribute(&cus, hipDeviceAttributeMultiprocessorCount, dev);
        (void)hipFuncSetAttribute((const void*)fwd, hipFuncAttributeMaxDynamicSharedMemorySize, LDS_BYTES);
        int per_cu = 0; (void)hipOccupancyMaxActiveBlocksPerMultiprocessor(&per_cu, (const void*)fwd, NWAVES * 64, LDS_BYTES);
        (void)hipGetLastError();
        grid = cus > 0 ? cus : 256;
    }
    (void)hipMemsetAsync((char*)d_ws + WS_CTL, 0, CTL_ZERO_BYTES, stream);
    Args a{};
    for (int i = 0; i < 31; ++i) a.in[i] = (const float*)d_in[i];
    a.out = (float*)d_out; a.ws = (unsigned char*)d_ws;
#if MK_PER_PHASE
    for (int p = 0; p < N_PHASES; ++p) { a.ph_lo = p; a.ph_hi = p + 1; a.li = 0; hipLaunchKernelGGL(fwd, dim3(grid), dim3(NWAVES * 64), LDS_BYTES, stream, a); }
#else
    a.ph_lo = 0; a.ph_hi = N_PHASES; a.li = 0;
    hipLaunchKernelGGL(fwd, dim3(grid), dim3(NWAVES * 64), LDS_BYTES, stream, a);
#endif
}
```

```cpp
#include <hip/hip_runtime.h>
#include <type_traits>
#include <cstdio>
#include <cstdint>
#include <cmath>

constexpr int BATCH = 2, LSEQ = 4096, DM = 2048, T = BATCH * LSEQ;
constexpr int DHY = 1024, DGD = 1024, NH = 8, HD = 128;
constexpr int NPROJ = 3 * DHY + 4 * DGD + 4 * NH;
constexpr int GOFF = 3 * DHY;
constexpr int NPROJ_PAD = 7424;
constexpr int NG = 8, EPG = 8, NE = 64, DE = 512;
constexpr int RB = 256, PMAX = 32768, NBLK_MAX = 128;
constexpr float EPS = 1e-6f;

constexpr size_t MiB = 1u << 20;
constexpr size_t WS_CTL = 0;
constexpr size_t CTL_ZERO_BYTES = 1 * MiB;
constexpr size_t WS_SMALL = 2 * MiB;
constexpr size_t WS_WINT = 16 * MiB;
constexpr size_t WS_WOUTT = 608 * MiB;
constexpr size_t WS_HB = 56 * MiB;
constexpr size_t WS_PT = 88 * MiB;
constexpr size_t WS_PG = 184 * MiB;
constexpr size_t WS_PGATE = 248 * MiB;
constexpr size_t WS_A2 = 250 * MiB;
constexpr size_t WS_KC = 282 * MiB;
constexpr size_t WS_YHT = 314 * MiB;
constexpr size_t WS_X0 = 314 * MiB, WS_VG = 346 * MiB, WS_YH = 378 * MiB;
constexpr size_t WS_QN = 16 * MiB, WS_KN = 32 * MiB, WS_KT = 48 * MiB, WS_VT = 64 * MiB;
constexpr size_t WS_V = 346 * MiB, WS_OF = 378 * MiB, WS_OB = 410 * MiB;
constexpr size_t GW_B = 64 * 272, GKDT_B = 128 * 144, GQK_B = 64 * 144, GUT_B = 128 * 128;
constexpr size_t WS_GW = 442 * MiB;
constexpr size_t WS_GQD = WS_GW + 2048 * GW_B;
constexpr size_t WS_GKDT = WS_GQD + 2048 * GW_B;
constexpr size_t WS_GQK = WS_GKDT + 2048 * GKDT_B;
constexpr size_t WS_GUT = WS_GQK + 2048 * GQK_B;
constexpr size_t WS_GCD = WS_GUT + 2048 * GUT_B + 4096;
static_assert(WS_GCD + 2048 * 4 <= 640 * MiB, "ws map");
constexpr size_t WS_W13T = 640 * MiB;
constexpr size_t WS_W2T = 896 * MiB;
constexpr size_t WS_X1 = 282 * MiB;
constexpr size_t WS_U = 346 * MiB;
constexpr size_t WS_UB = 412 * MiB;
constexpr size_t WS_HH = 446 * MiB;
constexpr size_t WS_Y = 88 * MiB;
constexpr int CW_CNT = 0;
constexpr int CW_Q8 = 1024, CW_Q9 = 2048;
constexpr int CW_DONE = 3072;
constexpr int CW_BAR = 4096;
constexpr size_t SM_LOGITS = 0;
constexpr size_t SM_GB = SM_LOGITS + (size_t)T * 72 * 4;
constexpr size_t SM_EID = SM_GB + (size_t)4 * T * 8 * 4;
constexpr size_t SM_GATE = SM_EID + (size_t)T * 2 * 4;
constexpr size_t SM_POS = SM_GATE + (size_t)T * 2 * 4;
constexpr size_t SM_TSLOT = SM_POS + (size_t)T * 2 * 4;
constexpr size_t SM_SLOTTOK = SM_TSLOT + (size_t)T * 2 * 4;
constexpr size_t SM_BLKEXP = SM_SLOTTOK + (size_t)PMAX * 4;
constexpr size_t SM_PADSTART = SM_BLKEXP + NBLK_MAX * 4;
constexpr size_t SM_NBLK = SM_PADSTART + NE * 4;
constexpr size_t SM_RWT = (SM_NBLK + 256 + 255) / 256 * 256;
static_assert(SM_RWT + 2 * 80 * 2048 * 2 <= 14 * MiB, "small region");

#define LAS __attribute__((address_space(3)))
#define GAS __attribute__((address_space(1)))
typedef unsigned short bf16;
typedef unsigned v4u __attribute__((ext_vector_type(4)));

__device__ __forceinline__ float dpp_f(float v, const int ctrl_unused) { return v; }
#define WS_DPP(v, ctrl) __builtin_bit_cast(float, __builtin_amdgcn_update_dpp(0, __builtin_bit_cast(int, (v)), (ctrl), 0xF, 0xF, true))
__device__ __forceinline__ float wave_sum(float v) {
    v += WS_DPP(v, 0xB1);
    v += WS_DPP(v, 0x4E);
    v += WS_DPP(v, 0x141);
    v += WS_DPP(v, 0x140);
    v += __shfl_xor(v, 16); v += __shfl_xor(v, 32);
    return v;
}
__device__ __forceinline__ float silu_f(float x) { return x * __builtin_amdgcn_rcpf(1.f + __expf(-x)); }
__device__ __forceinline__ float sigmoid_f(float x) { return __builtin_amdgcn_rcpf(1.f + __expf(-x)); }
__device__ __forceinline__ float softplus_f(float x) { return fmaxf(x, 0.f) + log1pf(expf(-fabsf(x))); }
typedef float pk2_f2 __attribute__((ext_vector_type(2)));
typedef __bf16 pk2_b2 __attribute__((ext_vector_type(2)));
__device__ __forceinline__ unsigned pk2(float lo, float hi) { const pk2_f2 f = {lo, hi}; return __builtin_bit_cast(unsigned, __builtin_convertvector(f, pk2_b2)); }
__device__ __forceinline__ unsigned f2bf(float f) { return pk2(f, 0.f) & 0xffffu; }
typedef float up4_f32x4 __attribute__((ext_vector_type(4)));
__device__ __forceinline__ up4_f32x4 unpack4(unsigned long long v) { const unsigned lo = (unsigned)v, hi = (unsigned)(v >> 32);
    return (up4_f32x4){__builtin_bit_cast(float, lo << 16), __builtin_bit_cast(float, lo & 0xffff0000u), __builtin_bit_cast(float, hi << 16), __builtin_bit_cast(float, hi & 0xffff0000u)}; }
__device__ __forceinline__ float bf2f(bf16 b) { return __builtin_bit_cast(float, ((unsigned)b) << 16); }

#ifndef MK_DUP_MASK
#define MK_DUP_MASK 0
#endif
#ifndef MK_TPROBE
#define MK_TPROBE (-1)
#endif
#ifndef MK_TSCALE
#define MK_TSCALE 4e-6f
#endif
#define REP(k) _Pragma("unroll 1") for (int rep_ = 0; rep_ < (((MK_DUP_MASK) >> (k)) & 1) + 1; ++rep_)
constexpr int LDSCTL_OFF_C = 147456 - 256;
namespace pg8 {
#define PG8_LAS __attribute__((address_space(3)))
typedef unsigned short bf16_t;
typedef short bf16x8 __attribute__((ext_vector_type(8)));
typedef float f32x4 __attribute__((ext_vector_type(4)));
typedef unsigned u32x4 __attribute__((ext_vector_type(4)));
constexpr int BM = 256, BK = 64, HALF = 128, HTB = HALF * BK * 2  , STAGE_BYTES = 8 * HTB, NXCD = 8, WGM = 8;

__host__ __device__ __forceinline__ int lds_byte(int r, int c) { const int st = (r >> 4) * 2 + (c >> 5), rr = r & 15, cc = c & 31, ob = rr * 64 + cc * 2; return st * 1024 + (ob ^ (((ob >> 9) & 1) << 5)); }
__host__ __device__ __forceinline__ void stage_rc(int b, int& R, int& C) { const int st = b / 1024, sb = b % 1024, swz = sb ^ (((sb >> 9) & 1) << 5); R = (st >> 1) * 16 + swz / 64; C = (st & 1) * 32 + (swz % 64) / 2; }
__host__ __device__ __forceinline__ int perm32(int rho) { const int n = rho >> 4, i = rho & 15; return 8 * (i >> 2) + 4 * n + (i & 3); }

struct Unit { const char* A; const char* B; const int* rows; int pm, pn, kind; };

__device__ __forceinline__ void tile_of(int L, int nM, int nN, int& pm, int& pn) {
    const int nwg = nM * nN;
    int wgid = L; { const int q = nwg / NXCD, r = nwg % NXCD, xcd = wgid % NXCD, off = wgid / NXCD; wgid = (xcd < r ? xcd * (q + 1) : r * (q + 1) + (xcd - r) * q) + off; }
    const int nig = WGM * nN, gid = wgid / nig, fm = gid * WGM, gsz = (nM - fm) < WGM ? (nM - fm) : WGM;
    pm = fm + ((wgid % nig) % gsz); pn = (wgid % nig) / gsz;
}

typedef float cvt_f2 __attribute__((ext_vector_type(2)));
typedef __bf16 cvt_b2 __attribute__((ext_vector_type(2)));
__device__ __forceinline__ unsigned cvt_pk_bf16(float lo, float hi) { const cvt_f2 f = {lo, hi}; const cvt_b2 v = __builtin_convertvector(f, cvt_b2); return __builtin_bit_cast(unsigned, v); }

template <class Epi, class Sched, bool GATHER>
__device__ __forceinline__ void gemm_phase(PG8_LAS unsigned char* lds, const int K, const Sched& S, const Epi& E, const int tid) {
    const int wid = __builtin_amdgcn_readfirstlane(tid >> 6), lane = tid & 63, wr = wid >> 2, wc = wid & 3, fr = lane & 15, fq = lane >> 4;
    const int nt = K / BK;
    int Rr[2], Cc[2];
    unsigned voffB[2];
#pragma unroll
    for (int i = 0; i < 2; ++i) { stage_rc(tid * 16 + i * 8192, Rr[i], Cc[i]); const int Rb = (Rr[i] & ~31) + perm32(Rr[i] & 31); voffB[i] = (unsigned)(Rb * K + Cc[i]) * 2u; }
    const size_t kstep = (size_t)(BK * 2);
    const size_t hstep = (size_t)HALF * K * 2;
    const unsigned ldsw = (unsigned)wid * 1024u;
    const int aoff = lds_byte(wr * 64 + fr, fq * 8), boff = lds_byte(wc * 32 + fr, fq * 8);
#define PG8_SA(b, h) (((b) * 2 + (h)) * HTB)
#define PG8_SB(b, h) ((4 + (b) * 2 + (h)) * HTB)
#define PG8_STAGE2(bufoff, gbase, v0, v1) do { \
        __builtin_amdgcn_global_load_lds((const unsigned*)((const char*)(gbase) + (v0)), (PG8_LAS unsigned*)(lds + (bufoff) + ldsw), 16, 0, 0); \
        __builtin_amdgcn_global_load_lds((const unsigned*)((const char*)(gbase) + (v1)), (PG8_LAS unsigned*)(lds + (bufoff) + ldsw + 8192), 16, 0, 0); } while (0)
#define PG8_STAGEB(bufoff, gbase) PG8_STAGE2(bufoff, gbase, voffB[0], voffB[1])
#define PG8_LDA(dst, b, h) do { _Pragma("unroll") for (int m = 0; m < 4; ++m) _Pragma("unroll") for (int k = 0; k < 2; ++k) dst[m][k] = *(const PG8_LAS bf16x8*)(lds + PG8_SA(b, h) + aoff + m * 2048 + k * 1024); } while (0)
#define PG8_LDB(dst, b, h) do { _Pragma("unroll") for (int n = 0; n < 2; ++n) _Pragma("unroll") for (int k = 0; k < 2; ++k) dst[n][k] = *(const PG8_LAS bf16x8*)(lds + PG8_SB(b, h) + boff + n * 2048 + k * 1024); } while (0)
#define PG8_MMA(ai, bj, At, Bt) do { __builtin_amdgcn_s_setprio(1); _Pragma("unroll") for (int m = 0; m < 4; ++m) _Pragma("unroll") for (int n = 0; n < 2; ++n) _Pragma("unroll") for (int k = 0; k < 2; ++k) \
        acc[ai][bj][m][n] = __builtin_amdgcn_mfma_f32_16x16x32_bf16(Bt[n][k], At[m][k], acc[ai][bj][m][n], 0, 0, 0); __builtin_amdgcn_s_setprio(0); } while (0)
#define PG8_WAIT_V(n) asm volatile("s_waitcnt vmcnt(" #n ")" ::: "memory")
#define PG8_WAIT_L(n) asm volatile("s_waitcnt lgkmcnt(" #n ")" ::: "memory")
#define PG8_BAR __builtin_amdgcn_s_barrier()
#define PG8_SCHED __builtin_amdgcn_sched_barrier(0)
    Unit cur, nxt; int ui = 0;
    if (!S.next(0, cur)) return;
    f32x4 acc[2][2][4][2];
#pragma unroll
    for (int a = 0; a < 2; ++a)
#pragma unroll
        for (int b = 0; b < 2; ++b)
#pragma unroll
            for (int m = 0; m < 4; ++m)
#pragma unroll
                for (int n = 0; n < 2; ++n) acc[a][b][m][n] = (f32x4){0.f, 0.f, 0.f, 0.f};
    bf16x8 At[4][2], B0[2][2], B1[2][2];
    unsigned c00, c01, c10, c11, n00, n01, n10, n11;
    if constexpr (GATHER) {
        c00 = (unsigned)cur.rows[Rr[0]] * (unsigned)(K * 2) + (unsigned)Cc[0] * 2u; c01 = (unsigned)cur.rows[Rr[1]] * (unsigned)(K * 2) + (unsigned)Cc[1] * 2u;
        c10 = (unsigned)cur.rows[128 + Rr[0]] * (unsigned)(K * 2) + (unsigned)Cc[0] * 2u; c11 = (unsigned)cur.rows[128 + Rr[1]] * (unsigned)(K * 2) + (unsigned)Cc[1] * 2u;
    } else {
        c00 = (unsigned)(Rr[0] * K + Cc[0]) * 2u; c01 = (unsigned)(Rr[1] * K + Cc[1]) * 2u;
        c10 = c00 + (unsigned)hstep; c11 = c01 + (unsigned)hstep;
    }
    n00 = c00; n01 = c01; n10 = c10; n11 = c11;
    const char* cA = cur.A; const char* cB = cur.B;
    PG8_STAGEB(PG8_SB(0, 0), cB); PG8_STAGEB(PG8_SB(0, 1), cB + hstep); PG8_STAGE2(PG8_SA(0, 0), cA, c00, c01); PG8_STAGE2(PG8_SA(0, 1), cA, c10, c11);
    if (wr == 1) PG8_BAR;
    PG8_WAIT_V(2); PG8_BAR;
    PG8_STAGEB(PG8_SB(1, 0), cB + kstep); PG8_STAGE2(PG8_SA(1, 0), cA + kstep, c00, c01); PG8_STAGEB(PG8_SB(1, 1), cB + hstep + kstep);
    PG8_WAIT_V(6); PG8_BAR;
    for (;;) {
        const bool has_next = S.next(ui + 1, nxt);
        const char* nA = has_next ? nxt.A : cA; const char* nB = has_next ? nxt.B : cB;
        if constexpr (GATHER) {
            if (has_next) {
                n00 = (unsigned)nxt.rows[Rr[0]] * (unsigned)(K * 2) + (unsigned)Cc[0] * 2u; n01 = (unsigned)nxt.rows[Rr[1]] * (unsigned)(K * 2) + (unsigned)Cc[1] * 2u;
                n10 = (unsigned)nxt.rows[128 + Rr[0]] * (unsigned)(K * 2) + (unsigned)Cc[0] * 2u; n11 = (unsigned)nxt.rows[128 + Rr[1]] * (unsigned)(K * 2) + (unsigned)Cc[1] * 2u;
            } else { n00 = c00; n01 = c01; n10 = c10; n11 = c11; }
        }
        for (int t = 0; t < nt; t += 2) {
            const bool last = (t == nt - 2);
            const char* a1 = cA + (size_t)(t + 1) * kstep;
            const char* a2 = last ? nA : cA + (size_t)(t + 2) * kstep; const char* b2 = last ? nB : cB + (size_t)(t + 2) * kstep;
            const char* a3 = a2 + kstep; const char* b3 = b2 + kstep;
            unsigned e00, e01, e10, e11;
            if constexpr (GATHER) { e00 = last ? n00 : c00; e01 = last ? n01 : c01; e10 = last ? n10 : c10; e11 = last ? n11 : c11; } else { e00 = c00; e01 = c01; e10 = c10; e11 = c11; }
            PG8_LDB(B0, 0, 0); PG8_LDB(B1, 0, 1); PG8_SCHED; PG8_LDA(At, 0, 0); PG8_STAGE2(PG8_SA(1, 1), a1, c10, c11);
            PG8_WAIT_V(8); PG8_WAIT_L(0); PG8_BAR; PG8_MMA(0, 0, At, B0); PG8_MMA(0, 1, At, B1); PG8_BAR; PG8_SCHED;
            PG8_LDA(At, 0, 1); PG8_STAGEB(PG8_SB(0, 0), b2); PG8_STAGEB(PG8_SB(0, 1), b2 + hstep); PG8_STAGE2(PG8_SA(0, 0), a2, e00, e01);
            PG8_WAIT_V(8); PG8_WAIT_L(0); PG8_BAR; PG8_MMA(1, 0, At, B0); PG8_MMA(1, 1, At, B1); PG8_BAR; PG8_SCHED;
            PG8_LDB(B0, 1, 0); PG8_LDB(B1, 1, 1); PG8_SCHED; PG8_LDA(At, 1, 0); PG8_STAGE2(PG8_SA(0, 1), a2, e10, e11);
            PG8_WAIT_V(8); PG8_WAIT_L(0); PG8_BAR; PG8_MMA(0, 0, At, B0); PG8_MMA(0, 1, At, B1); PG8_BAR; PG8_SCHED;
            PG8_LDA(At, 1, 1); PG8_STAGEB(PG8_SB(1, 0), b3); PG8_STAGEB(PG8_SB(1, 1), b3 + hstep); PG8_STAGE2(PG8_SA(1, 0), a3, e00, e01);
            PG8_WAIT_V(8); PG8_WAIT_L(0); PG8_BAR; PG8_MMA(1, 0, At, B0); PG8_MMA(1, 1, At, B1); PG8_BAR; PG8_SCHED;
        }
        if (wr == 0) PG8_BAR;
        E(acc, cur, wr, wc, fr, fq);
        if (!has_next) break;
#pragma unroll
        for (int a = 0; a < 2; ++a)
#pragma unroll
            for (int b = 0; b < 2; ++b)
#pragma unroll
                for (int m = 0; m < 4; ++m)
#pragma unroll
                    for (int n = 0; n < 2; ++n) acc[a][b][m][n] = (f32x4){0.f, 0.f, 0.f, 0.f};
        cur = nxt; cA = nA; cB = nB; ++ui;
        if constexpr (GATHER) { c00 = n00; c01 = n01; c10 = n10; c11 = n11; }
        if (wr == 1) PG8_BAR;
    }
    PG8_WAIT_V(0);
    PG8_BAR;
#undef PG8_SA
#undef PG8_SB
#undef PG8_STAGE2
#undef PG8_STAGEB
#undef PG8_LDA
#undef PG8_LDB
#undef PG8_MMA
#undef PG8_WAIT_V
#undef PG8_WAIT_L
#undef PG8_BAR
#undef PG8_SCHED
}
}

#define XB_TMO      128
#define XB_XCNT(j)  (256  + 64 * (j))
#define XB_XSUB(j)  (1280 + 64 * (j))
#define XB_XGEN(j)  (2304 + 64 * (j))
#define XB_TOP      3328
#define XB_TOPGEN   3392
#define XCD_BAR_WORDS 3456
#define XB_SPIN_CAP (1u << 18)
__device__ __forceinline__ unsigned xb_ld(unsigned* p)              { return __hip_atomic_load(p, __ATOMIC_RELAXED, __HIP_MEMORY_SCOPE_AGENT); }
__device__ __forceinline__ unsigned xb_add(unsigned* p, unsigned v) { return __hip_atomic_fetch_add(p, v, __ATOMIC_RELAXED, __HIP_MEMORY_SCOPE_AGENT); }
__device__ __forceinline__ unsigned xb_xcc_id() { return (unsigned)__builtin_amdgcn_s_getreg((3 << 11) | 20) & 0xFu; }
#define XB_SPIN(cond, bar) do { unsigned _sp = 0; while (cond) { __builtin_amdgcn_s_sleep(1); \
    if ((++_sp & 255u) == 0u) { if (xb_ld(&(bar)[XB_TMO])) break; if (_sp > XB_SPIN_CAP) { atomicAdd(&(bar)[XB_TMO], 1u); break; } } } } while (0)
struct XcdBarrier { unsigned* bar; unsigned x; volatile LAS unsigned* st; };
__device__ __forceinline__ XcdBarrier xcd_barrier_post(unsigned* bar, volatile LAS unsigned* st) {
    XcdBarrier b; b.bar = bar; b.x = xb_xcc_id(); b.st = st;
    if (threadIdx.x == 0) (void)xb_add(&bar[XB_XCNT(b.x)], 1u);
    return b;
}
__device__ __forceinline__ void xcd_barrier_complete(unsigned* bar, unsigned x, unsigned& nloc, unsigned& nx) {
    const unsigned G = gridDim.x * gridDim.y * gridDim.z;
    unsigned sum, cnt, mine, sp = 0u;
    for (;;) {
        sum = 0u; cnt = 0u; mine = 0u;
#pragma unroll
        for (unsigned j = 0; j < 16; ++j) { const unsigned c = xb_ld(&bar[XB_XCNT(j)]); sum += c; cnt += (c > 0u) ? 1u : 0u; mine = (j == x) ? c : mine; }
        if (sum == G) break;
        __builtin_amdgcn_s_sleep(1);
        if ((++sp & 255u) == 0u) { if (xb_ld(&bar[XB_TMO])) break; if (sp > XB_SPIN_CAP) { atomicAdd(&bar[XB_TMO], 1u); break; } }
    }
    nloc = mine > 0u ? mine : 1u; nx = cnt > 0u ? cnt : 1u;
}
template <int BYTES>
__device__ __forceinline__ void code_prefetch(int idx, int nthr) {
    const char* pc = (const char*)((unsigned long long)__builtin_amdgcn_s_getpc() & ~63ull);
    constexpr int NL = (BYTES + 448 * 16 - 1) / (448 * 16);
    pg8::u32x4 v[NL];
#pragma unroll
    for (int k = 0; k < NL; ++k) { int o = (idx + k * nthr) * 16; o = o < BYTES - 16 ? o : BYTES - 16; v[k] = *(const pg8::u32x4*)(pc + o); }
#pragma unroll
    for (int k = 0; k < NL; ++k) asm volatile("" :: "v"(v[k]));
}
template <int PF = 0>
__device__ __forceinline__ void xcd_barrier(const XcdBarrier& b) {
    asm volatile("s_waitcnt vmcnt(0)" ::: "memory");
    __syncthreads();
    if (PF > 0 && threadIdx.x >= 64) code_prefetch<(PF > 0 ? PF : 16)>((int)threadIdx.x - 64, 448);
    if (threadIdx.x == 0) {
        unsigned* bar = b.bar;
        __builtin_amdgcn_s_waitcnt(0);
        unsigned nloc = b.st[0], nx = b.st[1];
        if (nloc == 0u) { xcd_barrier_complete(bar, b.x, nloc, nx); b.st[0] = nloc; b.st[1] = nx; }
        const unsigned old = xb_add(&bar[XB_XSUB(b.x)], 1u);
        const unsigned gen = old / nloc;
        if (old + 1u == (gen + 1u) * nloc) {
            __builtin_amdgcn_fence(__ATOMIC_RELEASE, "agent");
            asm volatile("s_waitcnt vmcnt(0)" ::: "memory");
            const unsigned og = xb_add(&bar[XB_TOP], 1u);
            const unsigned tg = og / nx;
            if (og + 1u == (tg + 1u) * nx) xb_add(&bar[XB_TOPGEN], 1u);
            else XB_SPIN(xb_ld(&bar[XB_TOPGEN]) == tg, bar);
            __builtin_amdgcn_fence(__ATOMIC_ACQUIRE, "agent");
            xb_add(&bar[XB_XGEN(b.x)], 1u);
            asm volatile("s_waitcnt vmcnt(0)" ::: "memory");
        } else {
            XB_SPIN(xb_ld(&bar[XB_XGEN(b.x)]) == gen, bar);
            __builtin_amdgcn_fence(__ATOMIC_ACQUIRE, "agent");
            asm volatile("s_waitcnt vmcnt(0)" ::: "memory");
        }
    }
    __syncthreads();
}


#define HD __device__ __forceinline__
struct cpx { float x, y; };
HD cpx cadd(cpx a, cpx b) { return cpx{a.x + b.x, a.y + b.y}; }
HD cpx csub(cpx a, cpx b) { return cpx{a.x - b.x, a.y - b.y}; }
HD cpx cmul(cpx a, cpx b) { return cpx{a.x * b.x - a.y * b.y, a.x * b.y + a.y * b.x}; }
HD cpx cconj(cpx a) { return cpx{a.x, -a.y}; }
HD int fft_pp(int p) { return p + 2 * (p >> 5); }
constexpr int FFT_N = 8192, FFT_BUF_BYTES = (FFT_N + 2 * (FFT_N >> 5)) * 8;

template <bool INV> HD cpx mul_w16(cpx d, int k) {
    const float C1 = 0.92387953251128674f, S1 = 0.38268343236508977f, R2 = 0.70710678118654752f;
    float c, s;
    switch (k & 15) {
        case 0: return d;
        case 4: return INV ? cpx{-d.y, d.x} : cpx{d.y, -d.x};
        case 8: return cpx{-d.x, -d.y};
        case 12: return INV ? cpx{d.y, -d.x} : cpx{-d.y, d.x};
        case 1: c = C1; s = S1; break;
        case 2: c = R2; s = R2; break;
        case 3: c = S1; s = C1; break;
        case 5: c = -S1; s = C1; break;
        case 6: c = -R2; s = R2; break;
        case 7: c = -C1; s = S1; break;
        case 9: c = -C1; s = -S1; break;
        case 10: c = -R2; s = -R2; break;
        case 11: c = -S1; s = -C1; break;
        case 13: c = S1; s = -C1; break;
        case 14: c = R2; s = -R2; break;
        default: c = C1; s = -S1; break;
    }
    if (INV) s = -s;
    return cpx{d.x * c + d.y * s, d.y * c - d.x * s};
}
template <bool INV, int HALF> HD void dft16_stage(cpx (&v)[16]) {
#pragma unroll
    for (int g = 0; g < 16; g += 2 * HALF) {
#pragma unroll
        for (int i = 0; i < HALF; ++i) {
            const cpx a = v[g + i], b = v[g + i + HALF];
            v[g + i] = cadd(a, b);
            v[g + i + HALF] = mul_w16<INV>(csub(a, b), i * (8 / HALF));
        }
    }
}
template <bool INV> HD void dft16(cpx (&v)[16]) {
    dft16_stage<INV, 8>(v); dft16_stage<INV, 4>(v); dft16_stage<INV, 2>(v); dft16_stage<INV, 1>(v);
    cpx t;
    t = v[1]; v[1] = v[8]; v[8] = t;   t = v[2]; v[2] = v[4]; v[4] = t;   t = v[3]; v[3] = v[12]; v[12] = t;
    t = v[5]; v[5] = v[10]; v[10] = t; t = v[7]; v[7] = v[14]; v[14] = t; t = v[11]; v[11] = v[13]; v[13] = t;
}
template <bool INV> HD void twiddle16(cpx (&v)[16], float frac) {
    float s, c;
    asm volatile("" : "+v"(frac));
#if defined(__HIP_DEVICE_COMPILE__)
    sincospif(2.0f * frac, &s, &c);
#else
    s = sinf(6.283185307179586f * frac); c = cosf(6.283185307179586f * frac);
#endif
    const cpx w1 = INV ? cpx{c, s} : cpx{c, -s};
    cpx w = w1;
#pragma unroll
    for (int q = 1; q < 16; ++q) { v[q] = cmul(v[q], w); if (q < 15) w = cmul(w, w1); }
}
HD int fft_k_of_p(int p) { return (p >> 9) + 16 * ((p >> 5) & 15) + 256 * (p & 31); }
HD int fft_p_of_k(int k) { return (k & 15) * 512 + ((k >> 4) & 15) * 32 + (k >> 8); }

typedef float f2v __attribute__((ext_vector_type(2)));
__device__ __forceinline__ cpx ldc(const LAS cpx* b, int i) { const f2v v = ((const LAS f2v*)b)[i]; return cpx{v.x, v.y}; }
__device__ __forceinline__ void stc(LAS cpx* b, int i, cpx v) { ((LAS f2v*)b)[i] = (f2v){v.x, v.y}; }
__device__ __forceinline__ float dpp_xor1(float v) { return __builtin_bit_cast(float, __builtin_amdgcn_update_dpp(0, __builtin_bit_cast(int, v), 0xB1, 0xF, 0xF, true)); }
__device__ __forceinline__ void fft_fwd_pass2(LAS cpx* buf, int t) {
    const int blk = t >> 5, r2 = t & 31; cpx v[16];
#pragma unroll
    for (int j = 0; j < 16; ++j) v[j] = ldc(buf, fft_pp(blk * 512 + j * 32 + r2));
    dft16<false>(v); twiddle16<false>(v, (float)r2 * (1.f / 512.f));
#pragma unroll
    for (int q = 0; q < 16; ++q) stc(buf, fft_pp(blk * 512 + q * 32 + r2), v[q]);
}
__device__ __forceinline__ void fft_fwd_pass3(const LAS cpx* buf, int t, cpx (&v)[16]) {
    const int b = t >> 1, r = t & 1;
#pragma unroll
    for (int j = 0; j < 16; ++j) v[j] = ldc(buf, fft_pp(b * 32 + 2 * j + r));
    dft16<false>(v); twiddle16<false>(v, (float)r * (1.f / 32.f));
#pragma unroll
    for (int q = 0; q < 16; ++q) { const float px = dpp_xor1(v[q].x), py = dpp_xor1(v[q].y);
        v[q] = r ? cpx{px - v[q].x, py - v[q].y} : cpx{v[q].x + px, v[q].y + py}; }
}
__device__ __forceinline__ float bload(__amdgpu_buffer_rsrc_t rs, int voff, int soff) { return __builtin_bit_cast(float, __builtin_amdgcn_raw_buffer_load_b32(rs, voff, soff, 0)); }
__device__ __forceinline__ float conv3_b(__amdgpu_buffer_rsrc_t rs, int vo, int e0, float w0, float w1, float w2, float bias, bool lo_ok, bool hi_ok) {
    const bool odd = (vo & 4) != 0; const int h4 = (vo >> 3) << 2;
    const unsigned d0 = (unsigned)__builtin_amdgcn_raw_buffer_load_b32(rs, h4, e0 * 2, 0);
    const unsigned d1 = (e0 > 0) ? (unsigned)__builtin_amdgcn_raw_buffer_load_b32(rs, h4 + (odd ? 8 : 0), e0 * 2 - 4, 0)
                                 : (unsigned)__builtin_amdgcn_raw_buffer_load_b32(rs, h4 + (odd ? 4 : -4), 0, 0);
    const float lo0 = __builtin_bit_cast(float, d0 << 16), hi0 = __builtin_bit_cast(float, d0 & 0xffff0000u);
    const float xm = odd ? lo0 : __builtin_bit_cast(float, d1 & 0xffff0000u), xc = odd ? hi0 : lo0, xp = odd ? __builtin_bit_cast(float, d1 << 16) : hi0;
    return bias + w1 * xc + (lo_ok ? w0 * xm : 0.f) + (hi_ok ? w2 * xp : 0.f);
}
__device__ __forceinline__ void hyena_phase(LAS unsigned char* lds, const bf16* PT, const float* KC, const float* cw, const float* cb, const float* skip, float* YHT, int G, int vcu) {
    LAS cpx* Wb = (LAS cpx*)lds;
    LAS cpx* Lb = (LAS cpx*)(lds + FFT_BUF_BYTES);
    const int t0 = threadIdx.x;
#define HY_T() int t = t0; asm volatile("" : "+v"(t))
    for (int pair = vcu; pair < 512; pair += G) {
        const int c0 = 2 * pair;
        {
            HY_T();
            const __amdgpu_buffer_rsrc_t rsk = __builtin_amdgcn_make_buffer_rsrc((void*)(KC + (size_t)c0 * 8192), 0, 65536, 0x00020000);
            cpx v[16];
#pragma unroll
            for (int j = 0; j < 16; ++j) v[j] = cpx{bload(rsk, t * 4, j * 2048), bload(rsk, t * 4, 32768 + j * 2048)};
            dft16<false>(v); twiddle16<false>(v, (float)t * (1.f / 8192.f));
#pragma unroll
            for (int q = 0; q < 16; ++q) stc(Wb, fft_pp(q * 512 + t), v[q]);
        }
        __syncthreads();
        { HY_T(); fft_fwd_pass2(Wb, t); }
        __syncthreads();
        { HY_T(); cpx v[16]; fft_fwd_pass3(Wb, t, v); __syncthreads();
          const int b = t >> 1, r = t & 1;
#pragma unroll
          for (int q = 0; q < 16; ++q) stc(Wb, fft_pp(b * 32 + 16 * r + q), v[q]); }
        __syncthreads();
#pragma unroll 1
        for (int ch = 0; ch < 2; ++ch) {
            const int c = c0 + ch;
            float vg[2][8];
            {
                HY_T();
                const __amdgpu_buffer_rsrc_t rs1 = __builtin_amdgcn_make_buffer_rsrc((void*)(PT + (size_t)(1024 + c) * T), 0, T * 2, 0x00020000);
                const __amdgpu_buffer_rsrc_t rs2 = __builtin_amdgcn_make_buffer_rsrc((void*)(PT + (size_t)(2048 + c) * T), 0, T * 2, 0x00020000);
                const float a0 = cw[1024 + c], a1 = cw[3072 + 1024 + c], a2 = cw[6144 + 1024 + c], ab = cb[1024 + c];
                const float v0 = cw[2048 + c], v1 = cw[3072 + 2048 + c], v2 = cw[6144 + 2048 + c], vb = cb[2048 + c];
#pragma unroll
                for (int b = 0; b < 2; ++b)
#pragma unroll
                    for (int j = 0; j < 8; ++j) { const bool lo = (j > 0) || (t > 0), hi = (j < 7) || (t < 511);
                        int vo = t * 4;
                        if (j == 0) asm volatile("" : "+v"(vo));
                        vg[b][j] = conv3_b(rs2, vo, b * LSEQ + j * 512, v0, v1, v2, vb, lo, hi) * conv3_b(rs1, vo, b * LSEQ + j * 512, a0, a1, a2, ab, lo, hi);
                        if (j == 7) asm volatile("" : "+v"(vg[b][0]), "+v"(vg[b][1]), "+v"(vg[b][2]), "+v"(vg[b][3]), "+v"(vg[b][4]), "+v"(vg[b][5]), "+v"(vg[b][6]), "+v"(vg[b][7])); }
                cpx v[16];
#pragma unroll
                for (int j = 0; j < 8; ++j) { v[j] = cpx{vg[0][j], vg[1][j]}; v[8 + j] = cpx{0.f, 0.f}; }
                dft16<false>(v); twiddle16<false>(v, (float)t * (1.f / 8192.f));
#pragma unroll
                for (int q = 0; q < 16; ++q) stc(Lb, fft_pp(q * 512 + t), v[q]);
            }
            __syncthreads();
            { HY_T(); fft_fwd_pass2(Lb, t); }
            __syncthreads();
            {
                HY_T();
                cpx v[16]; fft_fwd_pass3(Lb, t, v);
                const int b = t >> 1, r = t & 1;
                const float sc = 0.5f / 8192.f;
#pragma unroll
                for (int q = 0; q < 16; ++q) {
                    const int p = b * 32 + 16 * r + q, k = fft_k_of_p(p), km = (8192 - k) & 8191, pm = fft_p_of_k(km);
                    const cpx Wk = ldc(Wb, fft_pp(p)), Wm = ldc(Wb, fft_pp(pm));
                    cpx H;
                    if (ch == 0) H = cpx{(Wk.x + Wm.x) * sc, (Wk.y - Wm.y) * sc};
                    else H = cpx{(Wk.y + Wm.y) * sc, (Wm.x - Wk.x) * sc};
                    v[q] = cmul(v[q], H);
                    if ((q & 3) == 3) asm volatile("" ::: "memory");
                }
#pragma unroll
                for (int q = 0; q < 16; ++q) { const float px = dpp_xor1(v[q].x), py = dpp_xor1(v[q].y);
                    v[q] = r ? cpx{px - v[q].x, py - v[q].y} : cpx{v[q].x + px, v[q].y + py}; }
                twiddle16<true>(v, (float)r * (1.f / 32.f)); dft16<true>(v);
                __syncthreads();
#pragma unroll
                for (int j = 0; j < 16; ++j) stc(Lb, fft_pp(b * 32 + 2 * j + r), v[j]);
            }
            __syncthreads();
            {
                HY_T();
                const int blk = t >> 5, r2 = t & 31; cpx v[16];
#pragma unroll
                for (int q = 0; q < 16; ++q) v[q] = ldc(Lb, fft_pp(blk * 512 + q * 32 + r2));
                twiddle16<true>(v, (float)r2 * (1.f / 512.f)); dft16<true>(v);
                __syncthreads();
#pragma unroll
                for (int j = 0; j < 16; ++j) stc(Lb, fft_pp(blk * 512 + j * 32 + r2), v[j]);
            }
            __syncthreads();
            {
                HY_T();
                cpx v[16];
#pragma unroll
                for (int q = 0; q < 16; ++q) v[q] = ldc(Lb, fft_pp(q * 512 + t));
                twiddle16<true>(v, (float)t * (1.f / 8192.f)); dft16<true>(v);
                const __amdgpu_buffer_rsrc_t rs0 = __builtin_amdgcn_make_buffer_rsrc((void*)(PT + (size_t)c * T), 0, T * 2, 0x00020000);
                const __amdgpu_buffer_rsrc_t rsy = __builtin_amdgcn_make_buffer_rsrc((void*)(YHT + (size_t)c * T), 0, T * 4, 0x00020000);
                const float x0 = cw[c], x1 = cw[3072 + c], x2 = cw[6144 + c], xb = cb[c], sk = skip[c];
                float o0[8], o1[8];
#pragma unroll
                for (int j = 0; j < 8; ++j) { const bool lo = (j > 0) || (t > 0), hi = (j < 7) || (t < 511);
                    int vo = t * 4;
                    if ((j & 3) == 0) asm volatile("" : "+v"(vo));
                    o0[j] = (v[j].x + vg[0][j] * sk) * conv3_b(rs0, vo, j * 512, x0, x1, x2, xb, lo, hi);
                    o1[j] = (v[j].y + vg[1][j] * sk) * conv3_b(rs0, vo, LSEQ + j * 512, x0, x1, x2, xb, lo, hi); }
                asm volatile("" ::: "memory");
#pragma unroll
                for (int j = 0; j < 8; ++j) {
                    __builtin_amdgcn_raw_buffer_store_b32(__builtin_bit_cast(unsigned, o0[j]), rsy, t * 4, j * 2048, 0);
                    __builtin_amdgcn_raw_buffer_store_b32(__builtin_bit_cast(unsigned, o1[j]), rsy, t * 4, (LSEQ + j * 512) * 4, 0); }
            }
            __syncthreads();
        }
    }
}
#undef HY_T
__device__ __forceinline__ void hyena_filter_item(LAS unsigned char* lds, int item, const float* w1, const float* b1, const float* w2, const float* b2, const float* w3, const float* b3,
                                                  const float* w4, const float* freq, float* KC, int tid, int lane, int wave) {
    typedef pg8::f32x4 f32x4;
    LAS float* H3 = (LAS float*)lds;
    LAS float* sc0 = (LAS float*)(lds + 4096) + wave * 256;
    const int l0 = item * 16;
    int lane_w = lane; asm volatile("" : "+v"(lane_w));
    float w1r[33], w2r[64], w3r[64];
#pragma unroll
    for (int i = 0; i < 33; ++i) w1r[i] = w1[i * 64 + lane_w];
#pragma unroll
    for (int i = 0; i < 64; ++i) w2r[i] = w2[i * 64 + lane_w];
    const float fr = freq[lane], bb1 = b1[lane], bb2 = b2[lane], bb3 = b3[lane];
    __syncthreads();
#pragma unroll
    for (int pp = 0; pp < 2; ++pp) {
        const int l = l0 + wave * 2 + pp; LAS float* sc = sc0 + 128 * pp;
        if (lane == 0) sc[0] = (float)l / (float)(LSEQ - 1);
        if (lane < 16) { const float omega = (2.0f * 3.14159265358979323846f / (float)LSEQ) * (float)l; const float fb = 1e-4f + (float)lane * ((15.0f - 1e-4f) / 15.0f); const float ang = omega * fb;
            sc[1 + lane] = cosf(ang); sc[17 + lane] = -sinf(ang); }
    }
    asm volatile("s_waitcnt lgkmcnt(0)" ::: "memory");
    float s[2], h[2];
#pragma unroll
    for (int pp = 0; pp < 2; ++pp) { const LAS float* sc = sc0 + 128 * pp; s[pp] = bb1;
#pragma unroll
        for (int i4 = 0; i4 < 8; ++i4) { const f32x4 z = *(const LAS f32x4*)(sc + 4 * i4); s[pp] += z.x * w1r[4 * i4] + z.y * w1r[4 * i4 + 1] + z.z * w1r[4 * i4 + 2] + z.w * w1r[4 * i4 + 3]; }
        s[pp] += sc[32] * w1r[32]; h[pp] = sinf(fr * s[pp]); }
    asm volatile("s_waitcnt lgkmcnt(0)" ::: "memory");
#pragma unroll
    for (int i = 0; i < 64; ++i) w3r[i] = w3[i * 64 + lane_w];
#pragma unroll
    for (int pp = 0; pp < 2; ++pp) sc0[128 * pp + 64 + lane] = h[pp];
    asm volatile("s_waitcnt lgkmcnt(0)" ::: "memory");
#pragma unroll
    for (int pp = 0; pp < 2; ++pp) { const LAS float* sc = sc0 + 128 * pp + 64; s[pp] = bb2;
#pragma unroll
        for (int i4 = 0; i4 < 16; ++i4) { const f32x4 z = *(const LAS f32x4*)(sc + 4 * i4); s[pp] += z.x * w2r[4 * i4] + z.y * w2r[4 * i4 + 1] + z.z * w2r[4 * i4 + 2] + z.w * w2r[4 * i4 + 3]; }
        h[pp] = sinf(fr * s[pp]); }
    asm volatile("s_waitcnt lgkmcnt(0)" ::: "memory");
#pragma unroll
    for (int pp = 0; pp < 2; ++pp) sc0[128 * pp + lane] = h[pp];
    asm volatile("s_waitcnt lgkmcnt(0)" ::: "memory");
#pragma unroll
    for (int pp = 0; pp < 2; ++pp) { const LAS float* sc = sc0 + 128 * pp; s[pp] = bb3;
#pragma unroll
        for (int i4 = 0; i4 < 16; ++i4) { const f32x4 z = *(const LAS f32x4*)(sc + 4 * i4); s[pp] += z.x * w3r[4 * i4] + z.y * w3r[4 * i4 + 1] + z.z * w3r[4 * i4 + 2] + z.w * w3r[4 * i4 + 3]; }
        H3[lane * 16 + wave * 2 + pp] = sinf(fr * s[pp]); }
    asm volatile("s_waitcnt lgkmcnt(0)" ::: "memory");
    __syncthreads();
    const float max_decay = logf(1e-2f) / 0.3f, min_decay = logf(1e-2f) / 1.5f;
    float acc[4][16];
#pragma unroll
    for (int a = 0; a < 4; ++a)
#pragma unroll
        for (int l = 0; l < 16; ++l) acc[a][l] = 0.f;
    int tid_o = tid; asm volatile("" : "+v"(tid_o));
    const float* w4t = w4 + tid_o;
#define HF_LOAD(wr_, b_) do { _Pragma("unroll") for (int i = 0; i < 4; ++i) { const float* p_ = w4t + ((b_) * 4 + i) * 2048; \
        wr_[4 * i] = p_[0]; wr_[4 * i + 1] = p_[1024]; wr_[4 * i + 2] = p_[512]; wr_[4 * i + 3] = p_[1536]; } } while (0)
#define HF_COMP(wr_, b_) do { _Pragma("unroll") for (int i = 0; i < 4; ++i) { _Pragma("unroll") for (int l4 = 0; l4 < 4; ++l4) { \
        const pg8::f32x4 hv = *(const LAS pg8::f32x4*)(H3 + ((b_) * 4 + i) * 16 + 4 * l4); \
        _Pragma("unroll") for (int q = 0; q < 4; ++q) { _Pragma("unroll") for (int a = 0; a < 4; ++a) acc[a][4 * l4 + q] = fmaf(hv[q], wr_[4 * i + a], acc[a][4 * l4 + q]); } } } } while (0)
    float wa[16], wb[16];
    HF_LOAD(wa, 0);
#pragma unroll 1
    for (int b = 0; b < 16; b += 2) {
        HF_LOAD(wb, b + 1);
        HF_COMP(wa, b);
        { const int bn = b + 2 < 16 ? b + 2 : 15; HF_LOAD(wa, bn); }
        HF_COMP(wb, b + 1);
    }
#undef HF_LOAD
#undef HF_COMP
#pragma unroll
    for (int cc = 0; cc < 2; ++cc) {
        const int c = tid_o + 512 * cc;
        const float delta = fabsf(min_decay + (float)c * ((max_decay - min_decay) / (float)(DHY - 1)));
        float* kc = KC + (size_t)c * 8192;
#pragma unroll
        for (int l = 0; l < 16; ++l) {
            const int ll = l0 + l; const float win = expf(-((float)ll / (float)(LSEQ - 1)) * delta);
            const float f = acc[2 * cc][l] * win, bb = acc[2 * cc + 1][l] * win;
            if (ll == 0) { kc[0] = f + bb; kc[4096] = 0.f; } else { kc[ll] = f; kc[8192 - ll] = bb; }
        }
    }
    __syncthreads();
}
__device__ __forceinline__ void hyena_post_tile(LAS unsigned char* lds, int tile, const float* YHT, const float* nw, bf16* A2, int tid, int lane, int wave) {
    LAS float* tl = (LAS float*)lds;
    const int tok0 = tile * 32, tk = tid & 31, cg = tid >> 5;
#pragma unroll 1
    for (int i0 = 0; i0 < 64; i0 += 16) { float yv[16];
#pragma unroll
        for (int i = 0; i < 16; ++i) yv[i] = YHT[(size_t)(cg + 16 * (i0 + i)) * T + tok0 + tk];
#pragma unroll
        for (int i = 0; i < 16; ++i) tl[(cg + 16 * (i0 + i)) * 33 + tk] = yv[i]; }
    float gn[16];
#pragma unroll
    for (int i = 0; i < 16; ++i) gn[i] = nw[lane + 64 * i];
    __syncthreads();
    for (int q = 0; q < 4; ++q) {
        const int tq = wave * 4 + q; float v[16]; float ss = 0.f;
#pragma unroll
        for (int i = 0; i < 16; ++i) { v[i] = tl[(lane + 64 * i) * 33 + tq]; ss += v[i] * v[i]; }
        const float r = rsqrtf(wave_sum(ss) * (1.f / DHY) + EPS);
#pragma unroll
        for (int i = 0; i < 16; ++i) { const int c = lane + 64 * i; A2[(size_t)(tok0 + tq) * DM + c] = (bf16)f2bf(v[i] * r * gn[i]); }
    }
    __syncthreads();
}


constexpr int GP_TILE = 128 * 132;
constexpr int GP_GATES = 143104;
constexpr int GP_WREG2 = 8448 + 512;
constexpr int GP_TT = 64 * 68 * 4;
__device__ __forceinline__ int aoff_fn(int i) { const int q = i >> 2, r = i & 3; return 4 * (2 * q * q + q + (r >= 1 ? q : 0) + (r >= 2 ? q + 1 : 0) + (r >= 3 ? q + 1 : 0)); }
static_assert(8 * GP_TILE <= GP_GATES && 8 * GP_WREG2 + 4 * GP_TT <= GP_GATES && GP_GATES + 4096 <= LDSCTL_OFF_C, "gdn prep LDS");
__device__ __forceinline__ void gdn_pre(LAS unsigned char* lds, int wg, const bf16* PG, const float* PGATE, const float* cw, const float* alf, const float* alb, const float* dtf, const float* dtb,
                                        unsigned char* ws, int tid, int lane, int wave) {
    const int bh = wg >> 4, b = bh >> 3, h = bh & 7, l0 = 256 * (wg & 15), cid0 = bh * 64 + 4 * (wg & 15);
    LAS float* gates = (LAS float*)(lds + GP_GATES);
    float w[3][3][2];
#pragma unroll
    for (int x = 0; x < 3; ++x)
#pragma unroll
        for (int tp = 0; tp < 3; ++tp)
#pragma unroll
            for (int e = 0; e < 2; ++e) w[x][tp][e] = cw[tp * 3072 + x * 1024 + h * 128 + 2 * lane + e];
    const int lw = l0 + 32 * wave;
    const unsigned* pgw = (const unsigned*)PG;
    auto ldraw = [&](int l, int x) -> unsigned { const int lc = l < 0 ? 0 : (l >= LSEQ ? LSEQ - 1 : l);
        return pgw[((size_t)(b * LSEQ + lc) * 4096 + x * 1024 + h * 128) / 2 + lane]; };
    if (lane < 32) {
        const int l = lw + lane, li = 32 * wave + lane; const float* pr = PGATE + (size_t)(b * LSEQ + l) * 32;
        gates[0 * 256 + li] = -expf(alf[h]) * softplus_f(pr[16 + h] + dtf[h]);
        gates[1 * 256 + li] = -expf(alb[h]) * softplus_f(pr[24 + h] + dtb[h]);
        gates[2 * 256 + li] = sigmoid_f(pr[h]);
        gates[3 * 256 + li] = sigmoid_f(pr[8 + h]);
    }
#pragma unroll 1
    for (int bt8 = 0; bt8 < 4; ++bt8) {
        unsigned raw[3][10];
#pragma unroll
        for (int x = 0; x < 3; ++x)
#pragma unroll
            for (int k = 0; k < 10; ++k) raw[x][k] = ldraw(lw + 8 * bt8 - 1 + k, x);
#define GP_PIN5(a, i) "+v"(a[i]), "+v"(a[i + 1]), "+v"(a[i + 2]), "+v"(a[i + 3]), "+v"(a[i + 4])
        asm volatile("" : GP_PIN5(raw[0], 0), GP_PIN5(raw[0], 5), GP_PIN5(raw[1], 0));
        asm volatile("" : GP_PIN5(raw[1], 5), GP_PIN5(raw[2], 0), GP_PIN5(raw[2], 5));
#undef GP_PIN5
#pragma unroll
        for (int x = 0; x < 3; ++x)
#pragma unroll
            for (int k = 0; k < 10; ++k) { const int l = lw + 8 * bt8 - 1 + k; raw[x][k] = (l >= 0 && l < LSEQ) ? raw[x][k] : 0u; }
#pragma unroll
        for (int k = 0; k < 8; ++k) {
            const int tt = 8 * bt8 + k, li = 32 * wave + tt, cl = li >> 6, i = li & 63;
            float r[3][2];
#pragma unroll
            for (int x = 0; x < 3; ++x) {
                const unsigned pv = raw[x][k], cv = raw[x][k + 1], nv = raw[x][k + 2];
                const float p0 = __builtin_bit_cast(float, pv << 16), p1 = __builtin_bit_cast(float, pv & 0xffff0000u);
                const float c0 = __builtin_bit_cast(float, cv << 16), c1 = __builtin_bit_cast(float, cv & 0xffff0000u);
                const float n0 = __builtin_bit_cast(float, nv << 16), n1 = __builtin_bit_cast(float, nv & 0xffff0000u);
                r[x][0] = silu_f(w[x][0][0] * p0 + w[x][1][0] * c0 + w[x][2][0] * n0);
                r[x][1] = silu_f(w[x][0][1] * p1 + w[x][1][1] * c1 + w[x][2][1] * n1);
            }
            const float qs = rsqrtf(wave_sum(r[0][0] * r[0][0] + r[0][1] * r[0][1]) + EPS);
            const float ks = rsqrtf(wave_sum(r[1][0] * r[1][0] + r[1][1] * r[1][1]) + EPS);
            const unsigned qp = pk2(r[0][0] * qs, r[0][1] * qs), kp = pk2(r[1][0] * ks, r[1][1] * ks), vp = pk2(r[2][0], r[2][1]);
            const size_t rowoff = ((size_t)(cid0 + cl) * 64 + i) * 64 + lane;
            ((unsigned*)(ws + WS_QN))[rowoff] = qp; ((unsigned*)(ws + WS_KN))[rowoff] = kp;
            LAS bf16* kt = (LAS bf16*)(lds + (cl * 2 + 0) * GP_TILE); LAS bf16* vt = (LAS bf16*)(lds + (cl * 2 + 1) * GP_TILE);
            kt[(2 * lane) * 66 + i] = (bf16)(kp & 0xffffu); kt[(2 * lane + 1) * 66 + i] = (bf16)(kp >> 16);
            vt[(2 * lane) * 66 + i] = (bf16)(vp & 0xffffu); vt[(2 * lane + 1) * 66 + i] = (bf16)(vp >> 16);
        }
    }
    __syncthreads();
    for (int it = wave; it < 8 * 64; it += 8) {
        const int tile = it >> 6, rp = it & 63, row = 2 * rp + (lane >> 5), cl = tile >> 1, which = tile & 1;
        const unsigned v = *(const LAS unsigned*)(lds + tile * GP_TILE + row * 132 + (lane & 31) * 4);
        ((unsigned*)(ws + (which ? WS_VT : WS_KT)))[((size_t)(cid0 + cl) * 128 + row) * 32 + (lane & 31)] = v;
    }
    asm volatile("s_waitcnt vmcnt(0)" ::: "memory");
    __syncthreads();
}
__device__ __forceinline__ void gdn_prep_wave(LAS unsigned char* lds, int wg, unsigned char* ws, int lane, int wave) {
    typedef pg8::bf16x8 bf16x8; typedef pg8::f32x4 f32x4;
    const int cl = wave >> 1, dir = wave & 1, bh = wg >> 4, cid = bh * 64 + 4 * (wg & 15) + cl; const size_t ci = (size_t)cid * 2 + dir;
    const int fr = lane & 15, fq = lane >> 4;
    LAS unsigned char* R = lds + wave * GP_WREG2;
    LAS float* Tt = (LAS float*)(lds + 8 * GP_WREG2 + (wave & 3) * GP_TT);
    LAS float* Ap = (LAS float*)R;
    LAS float* gcA = (LAS float*)(R + 8448); LAS float* btA = gcA + 64;
    const LAS float* gates = (const LAS float*)(lds + GP_GATES);
    const bf16* QN = (const bf16*)(ws + WS_QN) + (size_t)cid * 64 * 128; const bf16* KN = (const bf16*)(ws + WS_KN) + (size_t)cid * 64 * 128;
    const bf16* KT = (const bf16*)(ws + WS_KT) + (size_t)cid * 128 * 64; const bf16* VT = (const bf16*)(ws + WS_VT) + (size_t)cid * 128 * 64;
    unsigned char* GW = ws + WS_GW + ci * GW_B; unsigned char* GQD = ws + WS_GQD + ci * GW_B; unsigned char* GKDT = ws + WS_GKDT + ci * GKDT_B;
    unsigned char* GQK = ws + WS_GQK + ci * GQK_B; unsigned char* GUT = ws + WS_GUT + ci * GUT_B;
#define RIDX(i) (dir ? 63 - (i) : (i))
    const float bt = gates[(2 + dir) * 256 + 64 * cl + RIDX(lane)];
    float gc = gates[dir * 256 + 64 * cl + RIDX(lane)];
#pragma unroll
    for (int o = 1; o < 64; o <<= 1) { const float t = __shfl_up(gc, o); if (lane >= o) gc += t; }
    const float gl = __shfl(gc, 63);
    gcA[lane] = gc; btA[lane] = bt;
    asm volatile("s_waitcnt lgkmcnt(0)" ::: "memory");
    if (lane == 0) ((float*)(ws + WS_GCD))[ci] = expf(gl);
    {
    bf16x8 kfr[4][4];
#pragma unroll
    for (int t4 = 0; t4 < 4; ++t4)
#pragma unroll
        for (int ks = 0; ks < 4; ++ks) kfr[t4][ks] = *(const bf16x8*)(KN + (size_t)RIDX(16 * t4 + fr) * 128 + 32 * ks + 8 * fq);
    __builtin_amdgcn_sched_barrier(0);
#pragma unroll
    for (int mt = 0; mt < 4; ++mt) {
        const f32x4 gi = *(const LAS f32x4*)(gcA + 16 * mt + 4 * fq), bi = *(const LAS f32x4*)(btA + 16 * mt + 4 * fq);
#pragma unroll
        for (int nt = 0; nt <= mt; ++nt) {
            f32x4 c = (f32x4){0.f, 0.f, 0.f, 0.f};
#pragma unroll
            for (int ks = 0; ks < 4; ++ks) c = __builtin_amdgcn_mfma_f32_16x16x32_bf16(kfr[mt][ks], kfr[nt][ks], c, 0, 0, 0);
            const int j = 16 * nt + fr; const float gj = gcA[j];
#pragma unroll
            for (int r = 0; r < 4; ++r) { const int i = 16 * mt + 4 * fq + r; if (j < ((i + 3) & ~3)) Ap[aoff_fn(i) + j] = (j < i) ? bi[r] * c[r] * __expf(gi[r] - gj) : 0.f; }
        }
    }
#pragma unroll 1
    for (int ih = 0; ih < 2; ++ih) {
        bf16x8 qfr[2][4];
#pragma unroll
        for (int t2 = 0; t2 < 2; ++t2)
#pragma unroll
            for (int ks = 0; ks < 4; ++ks) qfr[t2][ks] = *(const bf16x8*)(QN + (size_t)RIDX(16 * (2 * ih + t2) + fr) * 128 + 32 * ks + 8 * fq);
        __builtin_amdgcn_sched_barrier(0);
#pragma unroll
        for (int i2 = 0; i2 < 2; ++i2) {
            const int it = 2 * ih + i2;
            const int i = 16 * it + fr; const float gi = gcA[i];
#pragma unroll
            for (int jt = 0; jt < 4; ++jt) {
                f32x4 c = (f32x4){0.f, 0.f, 0.f, 0.f};
                if (jt <= it) {
#pragma unroll
                    for (int ks = 0; ks < 4; ++ks) c = __builtin_amdgcn_mfma_f32_16x16x32_bf16(kfr[jt][ks], qfr[i2][ks], c, 0, 0, 0);
                }
                const f32x4 gj = *(const LAS f32x4*)(gcA + 16 * jt + 4 * fq);
                float v[4];
#pragma unroll
                for (int r = 0; r < 4; ++r) { const int j = 16 * jt + 4 * fq + r; v[r] = (j <= i) ? c[r] * __expf(gi - gj[r]) * 0.08838834764831845f : 0.f; }
                *(unsigned long long*)(GQK + i * 144 + (32 * (jt >> 1) + 8 * fq + 4 * (jt & 1)) * 2) = (unsigned long long)pg8::cvt_pk_bf16(v[0], v[1]) | ((unsigned long long)pg8::cvt_pk_bf16(v[2], v[3]) << 32);
            }
        }
    }
    }
    auto step4 = [&]() {
    {
        const int L2 = lane & 31, m = 4 * L2, src = (m & ~31) + ((m & 4) ? 16 + 4 * ((m & 31) >> 3) : 4 * ((m & 31) >> 3));
#pragma unroll 1
        for (int rp0 = 0; rp0 < 32; rp0 += 16) {
            unsigned long long qv[16];
#pragma unroll
            for (int u = 0; u < 16; ++u) { const int i = 2 * (rp0 + u) + (lane >> 5); qv[u] = *(const unsigned long long*)(QN + (size_t)RIDX(i) * 128 + src); }
#pragma unroll
            for (int u = 0; u < 16; ++u) {
                const int i = 2 * (rp0 + u) + (lane >> 5); const unsigned long long q = qv[u];
                const float sc = __expf(gcA[i]) * 0.08838834764831845f;
                const unsigned lo = (unsigned)q, hi = (unsigned)(q >> 32);
                const float a0 = __builtin_bit_cast(float, lo << 16) * sc, a1 = __builtin_bit_cast(float, lo & 0xffff0000u) * sc, a2 = __builtin_bit_cast(float, hi << 16) * sc, a3 = __builtin_bit_cast(float, hi & 0xffff0000u) * sc;
                *(unsigned long long*)(GQD + i * 272 + m * 2) = (unsigned long long)pg8::cvt_pk_bf16(a0, a1) | ((unsigned long long)pg8::cvt_pk_bf16(a2, a3) << 32);
            }
        }
        const int L4 = lane & 15, mm = 4 * L4, isrc = (mm & ~31) + ((mm & 4) ? 16 + 4 * ((mm & 31) >> 3) : 4 * ((mm & 31) >> 3));
        const f32x4 gi4 = *(const LAS f32x4*)(gcA + isrc);
        float sc4[4];
#pragma unroll
        for (int r = 0; r < 4; ++r) sc4[r] = __expf(gl - gi4[r]);
#pragma unroll 1
        for (int rq0 = 0; rq0 < 32; rq0 += 16) {
            unsigned long long kv[16];
#pragma unroll
            for (int u = 0; u < 16; ++u) { const int dk = 4 * (rq0 + u) + (lane >> 4); kv[u] = *(const unsigned long long*)(KT + (size_t)dk * 64 + (dir ? 60 - isrc : isrc)); }
#pragma unroll
            for (int u = 0; u < 16; ++u) {
            const int dk = 4 * (rq0 + u) + (lane >> 4);
            const unsigned long long k = kv[u];
            const unsigned lo = (unsigned)k, hi = (unsigned)(k >> 32);
            float e0 = __builtin_bit_cast(float, lo << 16), e1 = __builtin_bit_cast(float, lo & 0xffff0000u), e2 = __builtin_bit_cast(float, hi << 16), e3 = __builtin_bit_cast(float, hi & 0xffff0000u);
            const float f0 = dir ? e3 : e0, f1 = dir ? e2 : e1, f2 = dir ? e1 : e2, f3 = dir ? e0 : e3;
            *(unsigned long long*)(GKDT + dk * 144 + mm * 2) = (unsigned long long)pg8::cvt_pk_bf16(f0 * sc4[0], f1 * sc4[1]) | ((unsigned long long)pg8::cvt_pk_bf16(f2 * sc4[2], f3 * sc4[3]) << 32);
            }
        }
    }
    asm volatile("s_waitcnt lgkmcnt(0)" ::: "memory");
        };
    asm volatile("s_waitcnt lgkmcnt(0)" ::: "memory");
    __syncthreads();
    const float s_u = bt, s_w = bt * __expf(gc);
    const int cn = RIDX(lane);
#pragma unroll 1
    for (int round = 0; round < 2; ++round) {
        if ((wave >> 2) != round) step4();
        else {
            LAS float* trow = Tt + lane * 68;
#pragma unroll
            for (int q = 0; q < 16; ++q) *(LAS f32x4*)(trow + 4 * q) = (f32x4){(4 * q == lane) ? 1.f : 0.f, (4 * q + 1 == lane) ? 1.f : 0.f, (4 * q + 2 == lane) ? 1.f : 0.f, (4 * q + 3 == lane) ? 1.f : 0.f};
            asm volatile("s_waitcnt lgkmcnt(0)" ::: "memory");
            int ao = 0;
#pragma unroll 1
            for (int b = 0; b < 16; ++b) {
                const LAS float* a0 = Ap + ao; const LAS float* a1 = a0 + 4 * b; const LAS float* a2 = a1 + 4 * (b + 1); const LAS float* a3 = a2 + 4 * (b + 1);
                f32x4 s0 = (f32x4){0.f, 0.f, 0.f, 0.f}, s1 = s0, s2 = s0, s3 = s0;
#pragma unroll 1
                for (int q = 0; q < b; q += 2) {
                    const bool two = (q + 1 < b); const int q1 = two ? q + 1 : q;
                    const f32x4 ta = *(const LAS f32x4*)(trow + 4 * q); f32x4 tb = *(const LAS f32x4*)(trow + 4 * q1);
                    const f32x4 x0a = *(const LAS f32x4*)(a0 + 4 * q), x1a = *(const LAS f32x4*)(a1 + 4 * q), x2a = *(const LAS f32x4*)(a2 + 4 * q), x3a = *(const LAS f32x4*)(a3 + 4 * q);
                    const f32x4 x0b = *(const LAS f32x4*)(a0 + 4 * q1), x1b = *(const LAS f32x4*)(a1 + 4 * q1), x2b = *(const LAS f32x4*)(a2 + 4 * q1), x3b = *(const LAS f32x4*)(a3 + 4 * q1);
                    tb = two ? tb : (f32x4){0.f, 0.f, 0.f, 0.f};
                    s0 += x0a * ta + x0b * tb; s1 += x1a * ta + x1b * tb; s2 += x2a * ta + x2b * tb; s3 += x3a * ta + x3b * tb;
                }
                const f32x4 d1 = *(const LAS f32x4*)(a1 + 4 * b), d2 = *(const LAS f32x4*)(a2 + 4 * b), d3 = *(const LAS f32x4*)(a3 + 4 * b);
                const int i0 = 4 * b;
                const float v0 = (s0[0] + s0[1]) + (s0[2] + s0[3]);
                const float t0 = (lane < i0) ? -v0 : (lane == i0 ? 1.f : 0.f);
                const float v1 = (s1[0] + s1[1]) + (s1[2] + s1[3]) + d1[0] * t0;
                const float t1 = (lane < i0 + 1) ? -v1 : (lane == i0 + 1 ? 1.f : 0.f);
                const float v2 = (s2[0] + s2[1]) + (s2[2] + s2[3]) + d2[0] * t0 + d2[1] * t1;
                const float t2 = (lane < i0 + 2) ? -v2 : (lane == i0 + 2 ? 1.f : 0.f);
                const float v3 = (s3[0] + s3[1]) + (s3[2] + s3[3]) + d3[0] * t0 + d3[1] * t1 + d3[2] * t2;
                const float t3 = (lane < i0 + 3) ? -v3 : (lane == i0 + 3 ? 1.f : 0.f);
                *(LAS f32x4*)(trow + i0) = (f32x4){t0, t1, t2, t3};
                asm volatile("s_waitcnt lgkmcnt(0)" ::: "memory");
                ao += 16 * b + 12;
            }
#define GP_WRITE_T(scale) do { LAS bf16* Tq = (LAS bf16*)R; \
                for (int j0 = 0; j0 < 64; j0 += 8) { const f32x4 ta = *(const LAS f32x4*)(trow + j0), tb = *(const LAS f32x4*)(trow + j0 + 4); \
                    _Pragma("unroll") for (int e = 0; e < 4; ++e) { Tq[(j0 + e) * 64 + cn] = (bf16)f2bf(ta[e] * (scale)); Tq[(j0 + 4 + e) * 64 + cn] = (bf16)f2bf(tb[e] * (scale)); } } \
                asm volatile("s_waitcnt lgkmcnt(0)" ::: "memory"); } while (0)
            GP_WRITE_T(s_w);
#pragma unroll 1
            for (int dh = 0; dh < 2; ++dh) {
                bf16x8 ktf[4][2];
#pragma unroll
                for (int d4 = 0; d4 < 4; ++d4)
#pragma unroll
                    for (int ks = 0; ks < 2; ++ks) ktf[d4][ks] = *(const bf16x8*)(KT + (size_t)(16 * (4 * dh + d4) + fr) * 64 + 32 * ks + 8 * fq);
                __builtin_amdgcn_sched_barrier(0);
#pragma unroll 1
                for (int it = 0; it < 4; ++it) {
                    bf16x8 tf[2];
#pragma unroll
                    for (int ks = 0; ks < 2; ++ks) tf[ks] = *(const LAS bf16x8*)(R + ((16 * it + fr) * 64 + 32 * ks + 8 * fq) * 2);
                    const int i = 16 * it + fr;
#pragma unroll
                    for (int d4 = 0; d4 < 4; ++d4) {
                        const int dt = 4 * dh + d4;
                        f32x4 c = (f32x4){0.f, 0.f, 0.f, 0.f};
#pragma unroll
                        for (int ks = 0; ks < 2; ++ks) c = __builtin_amdgcn_mfma_f32_16x16x32_bf16(ktf[d4][ks], tf[ks], c, 0, 0, 0);
                        *(unsigned long long*)(GW + i * 272 + (32 * (dt >> 1) + 8 * fq + 4 * (dt & 1)) * 2) = (unsigned long long)pg8::cvt_pk_bf16(c[0], c[1]) | ((unsigned long long)pg8::cvt_pk_bf16(c[2], c[3]) << 32);
                    }
                }
            }
            asm volatile("s_waitcnt lgkmcnt(0)" ::: "memory");
            GP_WRITE_T(s_u);
#pragma unroll 1
            for (int vh = 0; vh < 2; ++vh) {
                bf16x8 vtf[4][2];
#pragma unroll
                for (int v4 = 0; v4 < 4; ++v4)
#pragma unroll
                    for (int ks = 0; ks < 2; ++ks) vtf[v4][ks] = *(const bf16x8*)(VT + (size_t)(16 * (4 * vh + v4) + fr) * 64 + 32 * ks + 8 * fq);
                __builtin_amdgcn_sched_barrier(0);
#pragma unroll 1
                for (int it = 0; it < 4; ++it) {
                    bf16x8 tf[2];
#pragma unroll
                    for (int ks = 0; ks < 2; ++ks) tf[ks] = *(const LAS bf16x8*)(R + ((16 * it + fr) * 64 + 32 * ks + 8 * fq) * 2);
#pragma unroll
                    for (int v4 = 0; v4 < 4; ++v4) {
                        const int vt = 4 * vh + v4;
                        f32x4 c = (f32x4){0.f, 0.f, 0.f, 0.f};
#pragma unroll
                        for (int ks = 0; ks < 2; ++ks) c = __builtin_amdgcn_mfma_f32_16x16x32_bf16(tf[ks], vtf[v4][ks], c, 0, 0, 0);
                        *(unsigned long long*)(GUT + (16 * vt + fr) * 128 + (16 * it + 4 * fq) * 2) = (unsigned long long)pg8::cvt_pk_bf16(c[0], c[1]) | ((unsigned long long)pg8::cvt_pk_bf16(c[2], c[3]) << 32);
                    }
                }
            }
#undef GP_WRITE_T
        }
        __syncthreads();
    }
#undef RIDX
}

__host__ __device__ __forceinline__ int mperm32(int o) { return ((o & 15) >> 2) * 8 + (o >> 4) * 4 + (o & 3); }
__host__ __device__ __forceinline__ int mcol(int x) { return (x & ~31) + mperm32(x & 31); }
constexpr int SC_W = 0, SC_QD = 17408, SC_KDT = 34816, SC_QK = 53248, SC_UT = 62464, SC_STEP = 64512;
static_assert(2 * SC_STEP <= LDSCTL_OFF_C, "scan LDS");
constexpr int SC_XS = 2 * SC_STEP + 256, SC_XV = SC_XS + 4096, SC_DUMP = SC_XV + 2048;
static_assert(SC_DUMP + 1024 <= LDSCTL_OFF_C, "scan exchange LDS");
__device__ __forceinline__ void gdn_scan4(LAS unsigned char* lds, const unsigned char* ws, bf16* OF, bf16* OB, int vcu, int tid, int lane, int wave) {
    typedef pg8::bf16x8 bf16x8; typedef pg8::f32x4 f32x4;
    const int chain = vcu >> 3, slice = vcu & 7, dir = chain & 1, bh = chain >> 1, b = bh >> 3, h = bh & 7;
    const int fr = lane & 15, fq = lane >> 4;
    const int dv0 = slice * 16;
    bf16* O = dir ? OB : OF;
    auto issue_w = [&](auto wtag, int s, int buf) {
        constexpr int W4 = decltype(wtag)::value;
        const int n = dir ? 63 - s : s; const size_t ci = ((size_t)(bh * 64 + n) * 2 + dir);
        const unsigned char* gW = ws + WS_GW + ci * GW_B + lane * 16; const unsigned char* gQD = ws + WS_GQD + ci * GW_B + lane * 16; const unsigned char* gK = ws + WS_GKDT + ci * GKDT_B + lane * 16;
        const unsigned char* gQK = ws + WS_GQK + ci * GQK_B + lane * 16; const unsigned char* gU = ws + WS_GUT + ci * GUT_B + slice * 2048 + lane * 16;
        LAS unsigned char* lb = lds + buf * SC_STEP;
#pragma unroll
        for (int k = 0; k < 16; ++k) {
            constexpr int dummy = 0; (void)dummy;
            const int p = W4 + 4 * k;
            if (p < 17) __builtin_amdgcn_global_load_lds((const unsigned*)(gW + p * 1024), (LAS unsigned*)(lb + SC_W + p * 1024), 16, 0, 0);
            else if (p < 34) __builtin_amdgcn_global_load_lds((const unsigned*)(gQD + (p - 17) * 1024), (LAS unsigned*)(lb + SC_QD + (p - 17) * 1024), 16, 0, 0);
            else if (p < 52) __builtin_amdgcn_global_load_lds((const unsigned*)(gK + (p - 34) * 1024), (LAS unsigned*)(lb + SC_KDT + (p - 34) * 1024), 16, 0, 0);
            else if (p < 61) __builtin_amdgcn_global_load_lds((const unsigned*)(gQK + (p - 52) * 1024), (LAS unsigned*)(lb + SC_QK + (p - 52) * 1024), 16, 0, 0);
            else if (p < 63) __builtin_amdgcn_global_load_lds((const unsigned*)(gU + (p - 61) * 1024), (LAS unsigned*)(lb + SC_UT + (p - 61) * 1024), 16, 0, 0);
        }
    };
    auto issue = [&](int s, int buf) {
        if (wave == 4) issue_w(std::integral_constant<int, 0>{}, s, buf); else if (wave == 5) issue_w(std::integral_constant<int, 1>{}, s, buf);
        else if (wave == 6) issue_w(std::integral_constant<int, 2>{}, s, buf); else issue_w(std::integral_constant<int, 3>{}, s, buf);
    };
    auto touch = [&](int s2) {
        const int sc_ = s2 < 64 ? s2 : 63; const int n = dir ? 63 - sc_ : sc_; const size_t ci = ((size_t)(bh * 64 + n) * 2 + dir);
        const int d = wave - 4;
#pragma unroll
        for (int j = 0; j < 3; ++j) {
            const unsigned char* g;
            if (j == 2 && d < 2) g = ws + WS_GUT + ci * GUT_B + slice * 2048 + d * 1024;
            else { int p = slice + 8 * (j == 0 ? d : (j == 1 ? d + 4 : 0)); if (p > 60) p -= 8;
                if (p < 17) g = ws + WS_GW + ci * GW_B + p * 1024;
                else if (p < 34) g = ws + WS_GQD + ci * GW_B + (p - 17) * 1024;
                else if (p < 52) g = ws + WS_GKDT + ci * GKDT_B + (p - 34) * 1024;
                else g = ws + WS_GQK + ci * GQK_B + (p - 52) * 1024; }
            __builtin_amdgcn_global_load_lds((const unsigned*)(g + lane * 16), (LAS unsigned*)(lds + SC_DUMP), 16, 0, 0);
        }
    };
    LAS float* cdl = (LAS float*)(lds + 2 * SC_STEP);
    LAS unsigned char* XS = lds + SC_XS; LAS unsigned char* XV = lds + SC_XV;
    f32x4 S0 = (f32x4){0.f, 0.f, 0.f, 0.f}, S1 = S0;
    if (wave == 0) { const int n = dir ? 63 - lane : lane; cdl[lane] = __builtin_bit_cast(float, __hip_atomic_load((const unsigned*)(ws + WS_GCD) + ((size_t)(bh * 64 + n) * 2 + dir), __ATOMIC_RELAXED, __HIP_MEMORY_SCOPE_AGENT)); }
    if (wave < 4) *(LAS pg8::u32x4*)(XS + wave * 1024 + lane * 16) = (pg8::u32x4){0u, 0u, 0u, 0u};
    else { issue(0, 0); touch(1); }
    asm volatile("s_waitcnt vmcnt(0) lgkmcnt(0)" ::: "memory"); __syncthreads();
#pragma unroll 1
    for (int s = 0; s < 64; ++s) {
        const int buf = s & 1;
        if (wave >= 4) {
            issue(s + 1 < 64 ? s + 1 : 63, buf ^ 1);
            touch(s + 2);
            __builtin_amdgcn_s_barrier();
            asm volatile("s_waitcnt vmcnt(3)" ::: "memory");
        } else {
            const LAS unsigned char* L = lds + buf * SC_STEP;
            const int n = dir ? 63 - s : s;
            const float cd = cdl[s];
            const LAS unsigned char* wp = L + (16 * wave + fr) * 272 + fq * 16;
            const LAS unsigned char* kp = L + fr * 144 + fq * 16;
            bf16x8 Sb[4], Wf[4], Qf[4], QKf[2], Kf[2][2];
#pragma unroll
            for (int ks = 0; ks < 4; ++ks) Sb[ks] = *(const LAS bf16x8*)(XS + ks * 1024 + lane * 16);
#pragma unroll
            for (int ks = 0; ks < 4; ++ks) { Wf[ks] = *(const LAS bf16x8*)(wp + SC_W + ks * 64); Qf[ks] = *(const LAS bf16x8*)(wp + SC_QD + ks * 64); }
            const unsigned long long uu = *(const LAS unsigned long long*)(L + SC_UT + fr * 128 + (16 * wave + 4 * fq) * 2);
#pragma unroll
            for (int ks = 0; ks < 2; ++ks) { QKf[ks] = *(const LAS bf16x8*)(kp + SC_QK + wave * 2304 + ks * 64);
                Kf[0][ks] = *(const LAS bf16x8*)(kp + SC_KDT + (2 * wave) * 2304 + ks * 64); Kf[1][ks] = *(const LAS bf16x8*)(kp + SC_KDT + (2 * wave + 1) * 2304 + ks * 64); }
            f32x4 a_ = (f32x4){0.f, 0.f, 0.f, 0.f}, o = (f32x4){0.f, 0.f, 0.f, 0.f};
#pragma unroll
            for (int ks = 0; ks < 4; ++ks) { a_ = __builtin_amdgcn_mfma_f32_16x16x32_bf16(Wf[ks], Sb[ks], a_, 0, 0, 0); o = __builtin_amdgcn_mfma_f32_16x16x32_bf16(Sb[ks], Qf[ks], o, 0, 0, 0); }
            const unsigned ulo = (unsigned)uu, uhi = (unsigned)(uu >> 32);
            const float v0 = __builtin_bit_cast(float, ulo << 16) - a_[0], v1 = __builtin_bit_cast(float, ulo & 0xffff0000u) - a_[1];
            const float v2 = __builtin_bit_cast(float, uhi << 16) - a_[2], v3 = __builtin_bit_cast(float, uhi & 0xffff0000u) - a_[3];
            *(LAS unsigned long long*)(XV + (wave >> 1) * 1024 + lane * 16 + (wave & 1) * 8) = (unsigned long long)pg8::cvt_pk_bf16(v0, v1) | ((unsigned long long)pg8::cvt_pk_bf16(v2, v3) << 32);
            asm volatile("s_waitcnt lgkmcnt(0)" ::: "memory"); __builtin_amdgcn_s_barrier(); asm volatile("" ::: "memory");
            bf16x8 vb[2];
#pragma unroll
            for (int ks = 0; ks < 2; ++ks) vb[ks] = *(const LAS bf16x8*)(XV + ks * 1024 + lane * 16);
#pragma unroll
            for (int ks = 0; ks < 2; ++ks) o = __builtin_amdgcn_mfma_f32_16x16x32_bf16(vb[ks], QKf[ks], o, 0, 0, 0);
            f32x4 n0 = S0 * cd, n1 = S1 * cd;
#pragma unroll
            for (int ks = 0; ks < 2; ++ks) { n0 = __builtin_amdgcn_mfma_f32_16x16x32_bf16(Kf[0][ks], vb[ks], n0, 0, 0, 0); n1 = __builtin_amdgcn_mfma_f32_16x16x32_bf16(Kf[1][ks], vb[ks], n1, 0, 0, 0); }
            S0 = n0; S1 = n1;
            { pg8::u32x4 w; w.x = pg8::cvt_pk_bf16(S0[0], S0[1]); w.y = pg8::cvt_pk_bf16(S0[2], S0[3]); w.z = pg8::cvt_pk_bf16(S1[0], S1[1]); w.w = pg8::cvt_pk_bf16(S1[2], S1[3]);
              *(LAS pg8::u32x4*)(XS + wave * 1024 + lane * 16) = w; }
            { const int i = 16 * wave + fr; const int l = 64 * n + (dir ? 63 - i : i);
              *(unsigned long long*)(O + ((size_t)b * LSEQ + l) * DGD + h * 128 + dv0 + 4 * fq) = (unsigned long long)pg8::cvt_pk_bf16(o[0], o[1]) | ((unsigned long long)pg8::cvt_pk_bf16(o[2], o[3]) << 32); }
        }
        asm volatile("s_waitcnt lgkmcnt(0)" ::: "memory"); __builtin_amdgcn_s_barrier(); asm volatile("" ::: "memory");
    }
    asm volatile("s_waitcnt vmcnt(0)" ::: "memory"); __syncthreads();
}

__device__ __forceinline__ void gdn_post_batch(int item0, const bf16* OF, const bf16* OB, const bf16* PG, const float* nw, bf16* A2, int lane) {
    unsigned a[8], b[8], zz[8];
#pragma unroll
    for (int k = 0; k < 8; ++k) { const int item = item0 + k, tok = item >> 3, h = item & 7; const size_t o = (size_t)tok * DGD + h * 128 + lane * 2;
        a[k] = *(const unsigned*)(OF + o); b[k] = *(const unsigned*)(OB + o); zz[k] = *(const unsigned*)(PG + (size_t)tok * 4096 + 3072 + h * 128 + lane * 2); }
    const float2 g = *(const float2*)(nw + lane * 2);
#pragma unroll
    for (int k = 0; k < 8; ++k) { const int item = item0 + k, tok = item >> 3, h = item & 7;
        const float o0 = __builtin_bit_cast(float, a[k] << 16) + __builtin_bit_cast(float, b[k] << 16), o1 = __builtin_bit_cast(float, a[k] & 0xffff0000u) + __builtin_bit_cast(float, b[k] & 0xffff0000u);
        const float r = rsqrtf(wave_sum(o0 * o0 + o1 * o1) * (1.f / 128.f) + EPS);
        const float z0 = __builtin_bit_cast(float, zz[k] << 16), z1 = __builtin_bit_cast(float, zz[k] & 0xffff0000u);
        *(unsigned*)(A2 + (size_t)tok * DM + 1024 + h * 128 + lane * 2) = pk2(o0 * r * g.x * silu_f(z0), o1 * r * g.y * silu_f(z1)); }
}
constexpr int RT_PART = 0, RT_LG = 81920, RT_RS = 81920 + 32 * 80 * 4;
__device__ __forceinline__ void route_phase(LAS unsigned char* lds, int wg, const bf16* X1, const float* nw, const float* gbias, const float* ebias, unsigned char* ws, unsigned* cnt, int tid, int lane, int wave) {
    typedef pg8::bf16x8 bf16x8; typedef pg8::f32x4 f32x4;
    asm volatile("" : "+v"(lane), "+v"(tid));
    const int tok0 = wg * 32, fr = lane & 15, fq = lane >> 4;
    LAS float* part = (LAS float*)(lds + RT_PART); LAS float* lg = (LAS float*)(lds + RT_LG); LAS float* rs = (LAS float*)(lds + RT_RS);
    LAS int* hist = (LAS int*)(lds + RT_RS + 128);
    if (tid < 64) hist[tid] = 0;
    bf16* Ub = (bf16*)(ws + WS_UB);
    pg8::u32x4 warm[3];
    { const char* rwb = (const char*)(ws + WS_SMALL + SM_RWT) + (size_t)(wg & 31) * 20480;
#pragma unroll
      for (int k = 0; k < 3; ++k) { int o = (tid + 512 * k) * 16; o = o < 20480 - 16 ? o : 20480 - 16; warm[k] = *(const pg8::u32x4*)(rwb + o); } }
    {
        const GAS f32x4* wr = (const GAS f32x4*)nw + lane;
        f32x4 v[4][8], g[8];
        unsigned long long vr[4][8];
#pragma unroll
        for (int q = 0; q < 4; ++q) { const GAS unsigned long long* xr = (const GAS unsigned long long*)(X1 + (size_t)(tok0 + 4 * wave + q) * DM) + lane;
#pragma unroll
            for (int j = 0; j < 8; ++j) vr[q][j] = xr[64 * j]; }
#pragma unroll
        for (int j = 0; j < 8; ++j) g[j] = wr[64 * j];
#pragma unroll
        for (int q = 0; q < 4; ++q)
#pragma unroll
            for (int j = 0; j < 8; ++j) v[q][j] = unpack4(vr[q][j]);
#pragma unroll
        for (int q = 0; q < 4; ++q) { const int t = 4 * wave + q; float s = 0.f;
#pragma unroll
            for (int j = 0; j < 8; ++j) s += (v[q][j].x * v[q][j].x + v[q][j].y * v[q][j].y) + (v[q][j].z * v[q][j].z + v[q][j].w * v[q][j].w);
            const float r = rsqrtf(wave_sum(s) * (1.f / DM) + EPS);
            GAS unsigned long long* o8 = (GAS unsigned long long*)(Ub + (size_t)(tok0 + t) * DM) + lane;
#pragma unroll
            for (int j = 0; j < 8; ++j) o8[64 * j] = (unsigned long long)pk2(v[q][j].x * r * g[j].x, v[q][j].y * r * g[j].y) | ((unsigned long long)pk2(v[q][j].z * r * g[j].z, v[q][j].w * r * g[j].w) << 32);
            if (lane == 0) rs[t] = r; }
    }
    asm volatile("" :: "v"(warm[0]), "v"(warm[1]), "v"(warm[2]));
    if (wg == 0) { GAS unsigned long long* z = (GAS unsigned long long*)(Ub + (size_t)T * DM); z[tid] = 0ull; }
    { int* slot_tok = (int*)(ws + WS_SMALL + SM_SLOTTOK); if (tid < PMAX / 256) slot_tok[wg * (PMAX / 256) + tid] = T; }
    __syncthreads();
    const bf16* RWh = (const bf16*)(ws + WS_SMALL + SM_RWT); const bf16* RWl = RWh + 80 * 2048;
    f32x4 acc[2][5];
#pragma unroll
    for (int mt = 0; mt < 2; ++mt)
#pragma unroll
        for (int nt = 0; nt < 5; ++nt) acc[mt][nt] = (f32x4){0.f, 0.f, 0.f, 0.f};
    struct RtSet { f32x4 g0, g1; unsigned long long x0[2], x1[2]; bf16x8 bh[5], bl[5]; };
    const float rr[2] = {rs[fr], rs[16 + fr]};
#define RT_LOAD(ks_, S) do { const int ka_ = 256 * wave + 32 * (ks_) + 4 * fq, kb_ = 256 * wave + 32 * (ks_) + 8 * fq; \
        S.g0 = *(const f32x4*)(nw + ka_); S.g1 = *(const f32x4*)(nw + ka_ + 16); \
        _Pragma("unroll") for (int mt = 0; mt < 2; ++mt) { const bf16* xp = X1 + (size_t)(tok0 + 16 * mt + fr) * DM + ka_; S.x0[mt] = *(const unsigned long long*)xp; S.x1[mt] = *(const unsigned long long*)(xp + 16); } \
        _Pragma("unroll") for (int nt = 0; nt < 5; ++nt) { S.bh[nt] = *(const bf16x8*)(RWh + (size_t)(16 * nt + fr) * 2048 + kb_); S.bl[nt] = *(const bf16x8*)(RWl + (size_t)(16 * nt + fr) * 2048 + kb_); } } while (0)
#define RT_COMP(S) do { bf16x8 ah[2], al[2]; \
        _Pragma("unroll") for (int mt = 0; mt < 2; ++mt) { const float r = rr[mt]; float u[8], hf[8]; \
            const f32x4 xa_ = unpack4(S.x0[mt]), xb_ = unpack4(S.x1[mt]); \
            _Pragma("unroll") for (int j = 0; j < 4; ++j) { u[j] = xa_[j] * r * S.g0[j]; u[4 + j] = xb_[j] * r * S.g1[j]; } \
            pg8::u32x4 wh, wl; \
            wh.x = pg8::cvt_pk_bf16(u[0], u[1]); wh.y = pg8::cvt_pk_bf16(u[2], u[3]); wh.z = pg8::cvt_pk_bf16(u[4], u[5]); wh.w = pg8::cvt_pk_bf16(u[6], u[7]); \
            hf[0] = __builtin_bit_cast(float, wh.x << 16); hf[1] = __builtin_bit_cast(float, wh.x & 0xffff0000u); hf[2] = __builtin_bit_cast(float, wh.y << 16); hf[3] = __builtin_bit_cast(float, wh.y & 0xffff0000u); \
            hf[4] = __builtin_bit_cast(float, wh.z << 16); hf[5] = __builtin_bit_cast(float, wh.z & 0xffff0000u); hf[6] = __builtin_bit_cast(float, wh.w << 16); hf[7] = __builtin_bit_cast(float, wh.w & 0xffff0000u); \
            wl.x = pg8::cvt_pk_bf16(u[0] - hf[0], u[1] - hf[1]); wl.y = pg8::cvt_pk_bf16(u[2] - hf[2], u[3] - hf[3]); wl.z = pg8::cvt_pk_bf16(u[4] - hf[4], u[5] - hf[5]); wl.w = pg8::cvt_pk_bf16(u[6] - hf[6], u[7] - hf[7]); \
            ah[mt] = __builtin_bit_cast(bf16x8, wh); al[mt] = __builtin_bit_cast(bf16x8, wl); } \
        _Pragma("unroll") for (int nt = 0; nt < 5; ++nt) { _Pragma("unroll") for (int mt = 0; mt < 2; ++mt) { \
            acc[mt][nt] = __builtin_amdgcn_mfma_f32_16x16x32_bf16(ah[mt], S.bh[nt], acc[mt][nt], 0, 0, 0); \
            acc[mt][nt] = __builtin_amdgcn_mfma_f32_16x16x32_bf16(al[mt], S.bh[nt], acc[mt][nt], 0, 0, 0); \
            acc[mt][nt] = __builtin_amdgcn_mfma_f32_16x16x32_bf16(ah[mt], S.bl[nt], acc[mt][nt], 0, 0, 0); } } } while (0)
    {
        RtSet s0, s1;
#define RT_PIN() asm volatile("" ::: "memory")
        RT_LOAD(0, s0); RT_LOAD(1, s1); RT_PIN();
        RT_COMP(s0); RT_PIN(); RT_LOAD(2, s0); RT_PIN(); RT_COMP(s1); RT_PIN(); RT_LOAD(3, s1); RT_PIN();
        RT_COMP(s0); RT_PIN(); RT_LOAD(4, s0); RT_PIN(); RT_COMP(s1); RT_PIN(); RT_LOAD(5, s1); RT_PIN();
        RT_COMP(s0); RT_PIN(); RT_LOAD(6, s0); RT_PIN(); RT_COMP(s1); RT_PIN(); RT_LOAD(7, s1); RT_PIN();
        RT_COMP(s0); RT_COMP(s1);
#undef RT_PIN
    }
#undef RT_LOAD
#undef RT_COMP
#pragma unroll
    for (int mt = 0; mt < 2; ++mt)
#pragma unroll
        for (int nt = 0; nt < 5; ++nt) *(LAS f32x4*)(part + ((wave * 10 + mt * 5 + nt) * 64 + lane) * 4) = acc[mt][nt];
    __syncthreads();
    for (int o = tid; o < 32 * 80; o += 512) {
        const int t = o / 80, col = o % 80, mt = t >> 4, tr = t & 15, nt = col >> 4, ln = (tr >> 2) * 16 + (col & 15), rg = tr & 3;
        float s = 0.f;
#pragma unroll
        for (int w = 0; w < 8; ++w) s += part[((w * 10 + mt * 5 + nt) * 64 + ln) * 4 + rg];
        lg[t * 80 + col] = s;
    }
    __syncthreads();
    if (tid < 32) {
        const int t = tok0 + tid; const LAS float* l = lg + tid * 80;
        float g[8]; int gi = 0; float gm = -INFINITY;
#pragma unroll
        for (int i = 0; i < 8; ++i) { g[i] = l[i] + gbias[i]; if (g[i] > gm) { gm = g[i]; gi = i; } }
        float gs = 0.f;
#pragma unroll
        for (int i = 0; i < 8; ++i) gs += expf(g[i] - gm);
        const float ggate = 1.f / gs;
        float e[8]; float em = -INFINITY;
#pragma unroll
        for (int i = 0; i < 8; ++i) { e[i] = l[8 + gi * 8 + i] + ebias[gi * 8 + i]; em = fmaxf(em, e[i]); }
        float es = 0.f; float p[8];
#pragma unroll
        for (int i = 0; i < 8; ++i) { p[i] = expf(e[i] - em); es += p[i]; }
        int i1 = 0; float p1 = -1.f;
#pragma unroll
        for (int i = 0; i < 8; ++i) if (p[i] > p1) { p1 = p[i]; i1 = i; }
        int i2 = 0; float p2 = -1.f;
#pragma unroll
        for (int i = 0; i < 8; ++i) if (i != i1 && p[i] > p2) { p2 = p[i]; i2 = i; }
        const float q1 = p1 / es, q2 = p2 / es, qs = q1 + q2;
        const int e1 = gi * 8 + i1, e2 = gi * 8 + i2;
        int* eid = (int*)(ws + WS_SMALL + SM_EID); float* gate = (float*)(ws + WS_SMALL + SM_GATE); int* pos = (int*)(ws + WS_SMALL + SM_POS);
        eid[t * 2] = e1; eid[t * 2 + 1] = e2;
        gate[t * 2] = ggate * (q1 / qs); gate[t * 2 + 1] = ggate * (q2 / qs);
        pos[t * 2] = __hip_atomic_fetch_add(hist + e1, 1, __ATOMIC_RELAXED, __HIP_MEMORY_SCOPE_WORKGROUP);
        pos[t * 2 + 1] = __hip_atomic_fetch_add(hist + e2, 1, __ATOMIC_RELAXED, __HIP_MEMORY_SCOPE_WORKGROUP);
    }
    __syncthreads();
    if (tid < 64) ((int*)(ws + WS_SMALL + SM_LOGITS))[wg * 64 + tid] = hist[tid];
}
__device__ __forceinline__ void fill_phase(LAS unsigned char* lds, int wg, unsigned char* ws, unsigned* cnt, int tid) {
    LAS int* ps = (LAS int*)lds;
    char* sm = (char*)(ws + WS_SMALL);
    if (tid < 64) {
        const int* tab = (const int*)(sm + SM_LOGITS) + tid;
        int below = 0, total = 0;
#pragma unroll 1
        for (int w0 = 0; w0 < 256; w0 += 32) { int v[32];
#pragma unroll
            for (int i = 0; i < 32; ++i) v[i] = tab[(w0 + i) * 64];
#pragma unroll
            for (int i = 0; i < 32; ++i) { total += v[i]; below += (w0 + i < wg) ? v[i] : 0; } }
        const int padded = (total + RB - 1) / RB * RB;
        int inc = padded;
#pragma unroll
        for (int o = 1; o < 64; o <<= 1) { const int t = __shfl_up(inc, o); if (tid >= o) inc += t; }
        ps[tid] = inc - padded; if (tid == 63) ps[NE] = inc;
        ps[128 + tid] = inc - padded + below;
    }
    __syncthreads();
    if (wg == 0) {
        int* blk_exp = (int*)(sm + SM_BLKEXP); int* nblk = (int*)(sm + SM_NBLK);
        if (tid < NE) { const int b0 = ps[tid] / RB, b1 = ps[tid + 1] / RB; for (int bb = b0; bb < b1; ++bb) blk_exp[bb] = tid; }
        if (tid == 0) *nblk = ps[NE] / RB;
    }
    if (tid < 64) {
        const int i = wg * 64 + tid; const int* eid = (const int*)(sm + SM_EID); const int* pos = (const int*)(sm + SM_POS);
        const int s = ps[128 + eid[i]] + pos[i];
        ((int*)(sm + SM_SLOTTOK))[s] = i >> 1; ((int*)(sm + SM_TSLOT))[i] = s;
    }
    __syncthreads();
}
__device__ __forceinline__ void final_rows(int t0, const bf16* X1, const bf16* Y, unsigned char* ws, const float* fw, float* out, int lane, float probe_scale) {
    typedef pg8::f32x4 f32x4;
    const char* sm = (const char*)(ws + WS_SMALL);
    const int4 sl = *(const int4*)((const int*)(sm + SM_TSLOT) + t0 * 2); const float4 gt = *(const float4*)((const float*)(sm + SM_GATE) + t0 * 2);
    const int ss[4] = {sl.x, sl.y, sl.z, sl.w}; const float gg[4] = {gt.x, gt.y, gt.z, gt.w};
    f32x4 x[2][8]; unsigned long long xq[2][8], ya[2][8], yb[2][8];
#pragma unroll
    for (int q = 0; q < 2; ++q) {
        const GAS unsigned long long* xr = (const GAS unsigned long long*)(X1 + (size_t)(t0 + q) * DM) + lane;
        const GAS unsigned long long* y1 = (const GAS unsigned long long*)(Y + (size_t)ss[2 * q] * DM) + lane; const GAS unsigned long long* y2 = (const GAS unsigned long long*)(Y + (size_t)ss[2 * q + 1] * DM) + lane;
#pragma unroll
        for (int j = 0; j < 8; ++j) { xq[q][j] = xr[64 * j]; ya[q][j] = y1[64 * j]; yb[q][j] = y2[64 * j]; }
    }
    int lane_g = lane; asm volatile("" : "+v"(lane_g));
    const GAS f32x4* wr = (const GAS f32x4*)fw + lane_g;
    f32x4 gw[8];
#pragma unroll
    for (int q = 0; q < 2; ++q) {
        const float g1 = gg[2 * q], g2 = gg[2 * q + 1]; float sq = 0.f;
#pragma unroll
        for (int j = 0; j < 8; ++j) {
            const unsigned alo = (unsigned)ya[q][j], ahi = (unsigned)(ya[q][j] >> 32), blo = (unsigned)yb[q][j], bhi = (unsigned)(yb[q][j] >> 32);
            f32x4 r = unpack4(xq[q][j]);
            r.x += g1 * __builtin_bit_cast(float, alo << 16) + g2 * __builtin_bit_cast(float, blo << 16);
            r.y += g1 * __builtin_bit_cast(float, alo & 0xffff0000u) + g2 * __builtin_bit_cast(float, blo & 0xffff0000u);
            r.z += g1 * __builtin_bit_cast(float, ahi << 16) + g2 * __builtin_bit_cast(float, bhi << 16);
            r.w += g1 * __builtin_bit_cast(float, ahi & 0xffff0000u) + g2 * __builtin_bit_cast(float, bhi & 0xffff0000u);
            x[q][j] = r; sq += (r.x * r.x + r.y * r.y) + (r.z * r.z + r.w * r.w);
        }
        if (q == 0) {
#pragma unroll
            for (int j = 0; j < 8; ++j) gw[j] = wr[64 * j]; }
        const float rr = rsqrtf(wave_sum(sq) * (1.f / DM) + EPS);
        GAS f32x4* o = (GAS f32x4*)(out + (size_t)(t0 + q) * DM) + lane;
#pragma unroll
        for (int j = 0; j < 8; ++j) o[64 * j] = x[q][j] * (MK_TPROBE >= 0 ? rr * probe_scale : rr) * gw[j];
    }
}


constexpr int MQ_A = 0, MQ_B = 65536, MQ_CTL = 98304;
__device__ __forceinline__ int perm32_inv(int c) { return 16 * ((c >> 2) & 1) + 4 * (c >> 3) + (c & 3); }
template <bool UP>
__device__ __forceinline__ void moe_gemm(LAS unsigned char* lds, unsigned char* ws, const float* w1, const float* w3  , unsigned* qctr, unsigned* done, int nblk, int tid) {
    typedef pg8::bf16x8 bf16x8; typedef pg8::f32x4 f32x4;
    constexpr int K = UP ? DM : DE, NT = K / 64, UPB = UP ? 8 : 16;
    const int wid = __builtin_amdgcn_readfirstlane(tid >> 6), lane = tid & 63, wr = wid >> 2, wc = wid & 3, fr = lane & 15, fq = lane >> 4;
    const int* slot_tok = (const int*)(ws + WS_SMALL + SM_SLOTTOK); const int* blk_exp = (const int*)(ws + WS_SMALL + SM_BLKEXP);
    int Rr[2], Cc[2];
#pragma unroll
    for (int i = 0; i < 2; ++i) pg8::stage_rc(tid * 16 + i * 8192, Rr[i], Cc[i]);
    const unsigned ldsw = (unsigned)wid * 1024u;
    const int aoff = pg8::lds_byte(fr, fq * 8), boff = pg8::lds_byte(wc * 32 + fr, fq * 8);
    const int cidx = tid & 127, kq = wid >> 1, chalf = wid & 1;
    int slot;
    if (UP) { const int x = cidx & 63; slot = 32 * (x >> 4) + ((cidx >> 6) ? 16 : 0) + (x & 15); } else slot = (cidx & ~31) + perm32_inv(cidx & 31);
    const int bw0 = pg8::lds_byte(slot, 8 * kq), bw1 = pg8::lds_byte(slot, 32 + 8 * kq);
    LAS int* uword = (LAS int*)(lds + MQ_CTL);
    const int nunits = nblk * UPB;
    int bprev = -1;
    for (;;) {
        __syncthreads();
        if (tid == 0) {
            if (UP && bprev >= 0) { __builtin_amdgcn_fence(__ATOMIC_RELEASE, "agent"); asm volatile("s_waitcnt vmcnt(0)" ::: "memory"); (void)xb_add(done + bprev, 1u); }
            const unsigned un = __hip_atomic_fetch_add(qctr, 1u, __ATOMIC_RELAXED, __HIP_MEMORY_SCOPE_AGENT);
            if (!UP && (int)un < nunits) {
                unsigned sp = 0u; while (xb_ld(done + un / UPB) < 8u) { __builtin_amdgcn_s_sleep(2); if (++sp > (1u << 22)) break; }
                __builtin_amdgcn_fence(__ATOMIC_ACQUIRE, "agent"); asm volatile("s_waitcnt vmcnt(0)" ::: "memory");
            }
            uword[0] = (int)un;
        }
        __syncthreads();
        const int u = __builtin_amdgcn_readfirstlane(uword[0]);
        if (u >= nunits) break;
        const int b = u / UPB, j = u % UPB;
        bprev = b;
        const int e = __builtin_amdgcn_readfirstlane(__hip_atomic_load(blk_exp + b, __ATOMIC_RELAXED, __HIP_MEMORY_SCOPE_AGENT));
        unsigned ao[2][2];
#pragma unroll
        for (int h = 0; h < 2; ++h)
#pragma unroll
            for (int i = 0; i < 2; ++i) { const int row = UP ? slot_tok[b * 256 + h * 128 + Rr[i]] : b * 256 + h * 128 + Rr[i]; ao[h][i] = (unsigned)row * (unsigned)(K * 2) + (unsigned)Cc[i] * 2u; }
        const char* Abase = (const char*)(ws + (UP ? WS_UB : WS_HH));
        const float* bcolu;
        if (UP) bcolu = (chalf ? w3 : w1) + (size_t)e * DM * DE + 64 * j; else bcolu = w1 + (size_t)e * DE * DM + 128 * j + 64 * chalf;
        constexpr int LDN = UP ? DE : DM;
        f32x4 acc[8][2];
#pragma unroll
        for (int m = 0; m < 8; ++m)
#pragma unroll
            for (int n = 0; n < 2; ++n) acc[m][n] = (f32x4){0.f, 0.f, 0.f, 0.f};
        float r0[16], r1[16], r2[16];
#define MQ_LOAD_A(t, ra) do { _Pragma("unroll") for (int h = 0; h < 2; ++h) _Pragma("unroll") for (int i = 0; i < 2; ++i) \
            ra[h * 2 + i] = *(const pg8::u32x4*)(Abase + ao[h][i] + (size_t)(t) * 128); } while (0)
#define MQ_WRITE_A(ra, buf) do { _Pragma("unroll") for (int h = 0; h < 2; ++h) _Pragma("unroll") for (int i = 0; i < 2; ++i) \
            *(LAS pg8::u32x4*)(lds + MQ_A + ((buf) * 2 + h) * 16384 + ldsw + i * 8192 + lane * 16) = ra[h * 2 + i]; } while (0)
#define MQ_LOAD_B(t, r) do { const float* p_ = bcolu + (size_t)((t) * 64 + 8 * kq) * LDN; \
            _Pragma("unroll") for (int e_ = 0; e_ < 8; ++e_) { r[e_] = (p_ + (size_t)e_ * LDN)[lane]; r[8 + e_] = (p_ + (size_t)(32 + e_) * LDN)[lane]; } } while (0)
#define MQ_WRITE_B(r, buf) do { pg8::u32x4 w0_, w1_; \
            w0_.x = pg8::cvt_pk_bf16(r[0], r[1]); w0_.y = pg8::cvt_pk_bf16(r[2], r[3]); w0_.z = pg8::cvt_pk_bf16(r[4], r[5]); w0_.w = pg8::cvt_pk_bf16(r[6], r[7]); \
            w1_.x = pg8::cvt_pk_bf16(r[8], r[9]); w1_.y = pg8::cvt_pk_bf16(r[10], r[11]); w1_.z = pg8::cvt_pk_bf16(r[12], r[13]); w1_.w = pg8::cvt_pk_bf16(r[14], r[15]); \
            *(LAS pg8::u32x4*)(lds + MQ_B + (buf) * 16384 + bw0) = w0_; *(LAS pg8::u32x4*)(lds + MQ_B + (buf) * 16384 + bw1) = w1_; } while (0)
#define MQ_COMPUTE(buf) do { const LAS unsigned char* A_ = lds + MQ_A + ((buf) * 2 + wr) * 16384 + aoff; const LAS unsigned char* B_ = lds + MQ_B + (buf) * 16384 + boff; \
            _Pragma("unroll") for (int k = 0; k < 2; ++k) { bf16x8 bf_[2]; \
                _Pragma("unroll") for (int n = 0; n < 2; ++n) bf_[n] = *(const LAS bf16x8*)(B_ + n * 2048 + k * 1024); \
                _Pragma("unroll") for (int mh = 0; mh < 2; ++mh) { bf16x8 af_[4]; \
                    _Pragma("unroll") for (int m = 0; m < 4; ++m) af_[m] = *(const LAS bf16x8*)(A_ + (4 * mh + m) * 2048 + k * 1024); \
                    _Pragma("unroll") for (int m = 0; m < 4; ++m) _Pragma("unroll") for (int n = 0; n < 2; ++n) acc[4 * mh + m][n] = __builtin_amdgcn_mfma_f32_16x16x32_bf16(bf_[n], af_[m], acc[4 * mh + m][n], 0, 0, 0); } } } while (0)
#define MQ_STEP(t, rcur, rnxt, acur, anxt, buf) do { \
            { const int tb_ = (t) + 3 < NT ? (t) + 3 : NT - 1, ta_ = (t) + 2 < NT ? (t) + 2 : NT - 1; MQ_LOAD_A(ta_, acur); MQ_LOAD_B(tb_, rcur); }     \
            MQ_COMPUTE(buf); \
            if ((t) + 1 < NT) { MQ_WRITE_A(anxt, (buf) ^ 1); MQ_WRITE_B(rnxt, (buf) ^ 1); } \
            asm volatile("s_waitcnt lgkmcnt(0)" ::: "memory"); __builtin_amdgcn_s_barrier(); asm volatile("" ::: "memory"); } while (0)
        pg8::u32x4 a0[4], a1[4];
        MQ_LOAD_A(0, a0); MQ_LOAD_B(0, r0); MQ_LOAD_A(1, a1); MQ_LOAD_B(1, r1); MQ_LOAD_B(2, r2);
        MQ_WRITE_A(a0, 0); MQ_WRITE_B(r0, 0);
        asm volatile("s_waitcnt lgkmcnt(0)" ::: "memory"); __builtin_amdgcn_s_barrier(); asm volatile("" ::: "memory");
        static_assert(NT % 6 == 2, "step loop: six steps per trip + two");
#pragma unroll 1
        for (int t = 0; t + 6 <= NT; t += 6) {
            MQ_STEP(t, r0, r1, a0, a1, 0); MQ_STEP(t + 1, r1, r2, a1, a0, 1); MQ_STEP(t + 2, r2, r0, a0, a1, 0);
            MQ_STEP(t + 3, r0, r1, a1, a0, 1); MQ_STEP(t + 4, r1, r2, a0, a1, 0); MQ_STEP(t + 5, r2, r0, a1, a0, 1); }
        { constexpr int t = NT - 2; MQ_STEP(t, r0, r1, a0, a1, 0); MQ_STEP(t + 1, r1, r2, a1, a0, 1); }
        const int row0 = b * 256 + wr * 128 + fr;
        if (UP) {
            bf16* HH = (bf16*)(ws + WS_HH);
#pragma unroll
            for (int m = 0; m < 8; ++m) { float v[4];
#pragma unroll
                for (int r = 0; r < 4; ++r) { const float a = acc[m][0][r], bb = acc[m][1][r]; v[r] = a / (1.f + __expf(-a)) * bb; }
                *(unsigned long long*)(HH + (size_t)(row0 + 16 * m) * DE + 64 * j + 16 * wc + 4 * fq) = (unsigned long long)pg8::cvt_pk_bf16(v[0], v[1]) | ((unsigned long long)pg8::cvt_pk_bf16(v[2], v[3]) << 32); }
        } else {
            bf16* Y = (bf16*)(ws + WS_Y);
#pragma unroll
            for (int m = 0; m < 8; ++m) { const f32x4 v0 = acc[m][0], v1 = acc[m][1];
                pg8::u32x4 w; w.x = pg8::cvt_pk_bf16(v0[0], v0[1]); w.y = pg8::cvt_pk_bf16(v0[2], v0[3]); w.z = pg8::cvt_pk_bf16(v1[0], v1[1]); w.w = pg8::cvt_pk_bf16(v1[2], v1[3]);
                *(pg8::u32x4*)(Y + (size_t)(row0 + 16 * m) * DM + 128 * j + 32 * wc + 8 * fq) = w; }
        }
#undef MQ_LOAD_A
#undef MQ_WRITE_A
#undef MQ_LOAD_B
#undef MQ_WRITE_B
#undef MQ_COMPUTE
#undef MQ_STEP
        if (UP) asm volatile("s_waitcnt vmcnt(0)" ::: "memory");
    }
    asm volatile("s_waitcnt vmcnt(0)" ::: "memory");
    __syncthreads();
}

constexpr int NWAVES = 8;
constexpr int LDS_BYTES = 147456, LDSCTL_OFF = LDS_BYTES - 256;

struct Args { const float* in[31]; float* out; unsigned char* ws; int ph_lo, ph_hi, li, pad; };

struct Epi1 {
    bf16* PG; float* PGATE; bf16* PT;
    __device__ __forceinline__ void operator()(const pg8::f32x4 (&acc)[2][2][4][2], const pg8::Unit& u, int wr, int wc, int fr, int fq) const {
        const int row0 = u.pm * 256 + wr * 64 + fr;
        if (u.kind == 0) {
            if (u.pn < 16) {
                const int col0 = u.pn * 256 + wc * 32 + 8 * fq;
#pragma unroll
                for (int ai = 0; ai < 2; ++ai)
#pragma unroll
                    for (int m = 0; m < 4; ++m) { bf16* rowp = PG + (size_t)(row0 + ai * 128 + m * 16) * 4096 + col0;
#pragma unroll
                        for (int bj = 0; bj < 2; ++bj) { const pg8::f32x4 v0 = acc[ai][bj][m][0], v1 = acc[ai][bj][m][1];
                            pg8::u32x4 w; w.x = pg8::cvt_pk_bf16(v0[0], v0[1]); w.y = pg8::cvt_pk_bf16(v0[2], v0[3]); w.z = pg8::cvt_pk_bf16(v1[0], v1[1]); w.w = pg8::cvt_pk_bf16(v1[2], v1[3]);
                            *(pg8::u32x4*)(rowp + bj * 128) = w; } }
            } else if (wc == 0) {
#pragma unroll
                for (int ai = 0; ai < 2; ++ai)
#pragma unroll
                    for (int m = 0; m < 4; ++m) { float* rowp = PGATE + (size_t)(row0 + ai * 128 + m * 16) * 32 + 8 * fq;
                        *(pg8::f32x4*)(rowp) = acc[ai][0][m][0]; *(pg8::f32x4*)(rowp + 4) = acc[ai][0][m][1]; }
            }
        } else {
            const int col0 = u.pn * 256 + wc * 32 + 8 * fq;
#pragma unroll
            for (int ai = 0; ai < 2; ++ai)
#pragma unroll
                for (int m = 0; m < 4; ++m) { bf16* rowp = PT + (size_t)(row0 + ai * 128 + m * 16) * T + col0;
#pragma unroll
                    for (int bj = 0; bj < 2; ++bj) { const pg8::f32x4 v0 = acc[ai][bj][m][0], v1 = acc[ai][bj][m][1];
                        pg8::u32x4 w; w.x = pg8::cvt_pk_bf16(v0[0], v0[1]); w.y = pg8::cvt_pk_bf16(v0[2], v0[3]); w.z = pg8::cvt_pk_bf16(v1[0], v1[1]); w.w = pg8::cvt_pk_bf16(v1[2], v1[3]);
                        *(pg8::u32x4*)(rowp + bj * 128) = w; } }
        }
    }
};
struct Order1 {
    const char* Hb; const char* WinT; int G, c;
    __device__ __forceinline__ bool next(int i, pg8::Unit& u) const {
        const int L = i * G + c;
        if (L >= 928) return false;
        u.rows = nullptr;
        if (L < 544) { int pm, pn; pg8::tile_of(L, 32, 17, pm, pn); u.pm = pm; u.pn = pn; u.kind = 0;
            u.A = Hb + (size_t)pm * 256 * DM * 2; u.B = WinT + (size_t)(GOFF + pn * 256) * DM * 2; }
        else { int pm, pn; pg8::tile_of(L - 544, 12, 32, pm, pn); u.pm = pm; u.pn = pn; u.kind = 1;
            u.A = WinT + (size_t)pm * 256 * DM * 2; u.B = Hb + (size_t)pn * 256 * DM * 2; }
        return true;
    }
};

struct Epi2 {
    const float* x; bf16* X1;
    __device__ __forceinline__ void operator()(const pg8::f32x4 (&acc)[2][2][4][2], const pg8::Unit& u, int wr, int wc, int fr, int fq) const {
        const int row0 = u.pm * 256 + wr * 64 + fr, col0 = u.pn * 256 + wc * 32 + 8 * fq;
#pragma unroll
        for (int ai = 0; ai < 2; ++ai) {
            pg8::f32x4 xv[4][2][2];
#pragma unroll
            for (int m = 0; m < 4; ++m) { const size_t off = (size_t)(row0 + ai * 128 + m * 16) * DM + col0;
#pragma unroll
                for (int bj = 0; bj < 2; ++bj) { xv[m][bj][0] = *(const pg8::f32x4*)(x + off + bj * 128); xv[m][bj][1] = *(const pg8::f32x4*)(x + off + bj * 128 + 4); } }
            asm volatile("" ::: "memory");
#pragma unroll
            for (int m = 0; m < 4; ++m) { const size_t off = (size_t)(row0 + ai * 128 + m * 16) * DM + col0;
#pragma unroll
                for (int bj = 0; bj < 2; ++bj) { const pg8::f32x4 v0 = xv[m][bj][0] + acc[ai][bj][m][0], v1 = xv[m][bj][1] + acc[ai][bj][m][1];
                    pg8::u32x4 w; w.x = pg8::cvt_pk_bf16(v0[0], v0[1]); w.y = pg8::cvt_pk_bf16(v0[2], v0[3]); w.z = pg8::cvt_pk_bf16(v1[0], v1[1]); w.w = pg8::cvt_pk_bf16(v1[2], v1[3]);
                    *(pg8::u32x4*)(X1 + off + bj * 128) = w; } }
            asm volatile("" ::: "memory"); }
    }
};
struct Order2 {
    const char* A2; const char* WoutT; int G, c;
    __device__ __forceinline__ bool next(int i, pg8::Unit& u) const {
        const int L = i * G + c; if (L >= 256) return false;
        int pm, pn; pg8::tile_of(L, 32, 8, pm, pn); u.pm = pm; u.pn = pn; u.kind = 0; u.rows = nullptr;
        u.A = A2 + (size_t)pm * 256 * DM * 2; u.B = WoutT + (size_t)pn * 256 * DM * 2; return true;
    }
};
struct Epi3 {
    bf16* HH;
    __device__ __forceinline__ void operator()(const pg8::f32x4 (&acc)[2][2][4][2], const pg8::Unit& u, int wr, int wc, int fr, int fq) const {
        const int row0 = u.pm * 256 + wr * 64 + fr, col0 = u.pn * 128 + wc * 32 + 8 * fq;
#pragma unroll
        for (int ai = 0; ai < 2; ++ai)
#pragma unroll
            for (int m = 0; m < 4; ++m) { bf16* rowp = HH + (size_t)(row0 + ai * 128 + m * 16) * DE + col0;
                float v[8];
#pragma unroll
                for (int n = 0; n < 2; ++n)
#pragma unroll
                    for (int j = 0; j < 4; ++j) { const float a = acc[ai][0][m][n][j], b = acc[ai][1][m][n][j]; v[n * 4 + j] = a / (1.f + __expf(-a)) * b; }
                pg8::u32x4 w; w.x = pg8::cvt_pk_bf16(v[0], v[1]); w.y = pg8::cvt_pk_bf16(v[2], v[3]); w.z = pg8::cvt_pk_bf16(v[4], v[5]); w.w = pg8::cvt_pk_bf16(v[6], v[7]);
                *(pg8::u32x4*)rowp = w; }
    }
};
struct Order3 {
    const char* Ub; const char* W13T; const int* slot_tok; const int* blk_exp; int nunits, G, c;
    __device__ __forceinline__ bool next(int i, pg8::Unit& u) const {
        const int L = i * G + c; if (L >= nunits) return false;
        const int b = L >> 2, j = L & 3; u.pm = b; u.pn = j; u.kind = 0; u.rows = slot_tok + b * 256; u.A = Ub;
        const int e = __hip_atomic_load(blk_exp + b, __ATOMIC_RELAXED, __HIP_MEMORY_SCOPE_AGENT);
        u.B = W13T + ((size_t)e * 1024 + j * 256) * DM * 2; return true;
    }
};
struct Epi4 {
    bf16* Y;
    __device__ __forceinline__ void operator()(const pg8::f32x4 (&acc)[2][2][4][2], const pg8::Unit& u, int wr, int wc, int fr, int fq) const {
        const int row0 = u.pm * 256 + wr * 64 + fr, col0 = u.pn * 256 + wc * 32 + 8 * fq;
#pragma unroll
        for (int ai = 0; ai < 2; ++ai)
#pragma unroll
            for (int m = 0; m < 4; ++m) { bf16* rowp = Y + (size_t)(row0 + ai * 128 + m * 16) * DM + col0;
#pragma unroll
                for (int bj = 0; bj < 2; ++bj) { const pg8::f32x4 v0 = acc[ai][bj][m][0], v1 = acc[ai][bj][m][1];
                    pg8::u32x4 w; w.x = pg8::cvt_pk_bf16(v0[0], v0[1]); w.y = pg8::cvt_pk_bf16(v0[2], v0[3]); w.z = pg8::cvt_pk_bf16(v1[0], v1[1]); w.w = pg8::cvt_pk_bf16(v1[2], v1[3]);
                    *(pg8::u32x4*)(rowp + bj * 128) = w; } }
    }
};
struct Order4 {
    const char* HH; const char* W2T; const int* blk_exp; int nunits, G, c;
    __device__ __forceinline__ bool next(int i, pg8::Unit& u) const {
        const int L = i * G + c; if (L >= nunits) return false;
        const int b = L >> 3, j = L & 7; u.pm = b; u.pn = j; u.kind = 0; u.rows = nullptr; u.A = HH + (size_t)b * 256 * DE * 2;
        const int e = __hip_atomic_load(blk_exp + b, __ATOMIC_RELAXED, __HIP_MEMORY_SCOPE_AGENT);
        u.B = W2T + ((size_t)e * DM + j * 256) * DE * 2; return true;
    }
};

struct TrItem { const float* W; int ldn, k0, n0; bf16* WT; size_t dst_row0; int ldk; };
__device__ __forceinline__ void tr_store(const TrItem& I, LAS float* scr, const float (&tv)[32], int lane) {
#pragma unroll
    for (int i = 0; i < 32; ++i) { const int kk = 2 * i + (lane >> 5); scr[kk * 33 + (lane & 31)] = tv[i]; }
    asm volatile("s_waitcnt lgkmcnt(0)" ::: "memory");
    const int c = lane & 7;
#pragma unroll
    for (int j = 0; j < 4; ++j) { const int n = (lane >> 3) + 8 * j; const LAS float* s = scr + (8 * c) * 33 + n;
        v4u o; o.x = pg8::cvt_pk_bf16(s[0 * 33], s[1 * 33]); o.y = pg8::cvt_pk_bf16(s[2 * 33], s[3 * 33]); o.z = pg8::cvt_pk_bf16(s[4 * 33], s[5 * 33]); o.w = pg8::cvt_pk_bf16(s[6 * 33], s[7 * 33]);
        *(GAS v4u*)(I.WT + (I.dst_row0 + n) * I.ldk + I.k0 + 8 * c) = o; }
    asm volatile("s_waitcnt lgkmcnt(0)" ::: "memory");
}
__device__ __forceinline__ void tr_pair(const TrItem& A, const TrItem& B, bool hasB, LAS float* scr, int lane) {
    float ta[32], tb[32];
    const float* pa = A.W + (size_t)(A.k0 + (lane >> 5)) * A.ldn + A.n0 + (lane & 31);
    const float* pb = (hasB ? B.W + (size_t)(B.k0 + (lane >> 5)) * B.ldn + B.n0 : A.W + (size_t)(A.k0 + (lane >> 5)) * A.ldn + A.n0) + (lane & 31);
    const size_t sa = (size_t)2 * A.ldn, sb = (size_t)2 * (hasB ? B.ldn : A.ldn);
#pragma unroll
    for (int i = 0; i < 32; ++i) { ta[i] = pa[i * sa]; tb[i] = pb[i * sb]; }
    tr_store(A, scr, ta, lane);
    if (hasB) tr_store(B, scr, tb, lane);
}
__device__ __forceinline__ void tr_item(const float* W, int ldn, int k0, int n0, bf16* WT, size_t dst_row0, int ldk, LAS float* scr, int lane) {
    const TrItem A{W, ldn, k0, n0, WT, dst_row0, ldk}; tr_pair(A, A, false, scr, lane);
}
__device__ __forceinline__ void rms_row_to_bf16(const float* xrow, const float* w, bf16* orow, int lane) {
    const GAS pg8::f32x4* xr = (const GAS pg8::f32x4*)xrow + lane; const GAS pg8::f32x4* wr = (const GAS pg8::f32x4*)w + lane;
    pg8::f32x4 v[8]; float s = 0.f;
#pragma unroll
    for (int j = 0; j < 8; ++j) { v[j] = xr[64 * j]; s += (v[j].x * v[j].x + v[j].y * v[j].y) + (v[j].z * v[j].z + v[j].w * v[j].w); }
    const float r = rsqrtf(wave_sum(s) * (1.f / DM) + EPS);
    GAS unsigned long long* o8 = (GAS unsigned long long*)orow + lane;
#pragma unroll
    for (int j = 0; j < 8; ++j) { const pg8::f32x4 g = wr[64 * j];
        o8[64 * j] = (unsigned long long)pk2(v[j].x * r * g.x, v[j].y * r * g.y) | ((unsigned long long)pk2(v[j].z * r * g.z, v[j].w * r * g.w) << 32); }
}

__device__ __forceinline__ void rms_rows2_to_bf16(const float* xrow, const float* w, bf16* orow, int lane) {
    const GAS pg8::f32x4* xr = (const GAS pg8::f32x4*)xrow + lane; const GAS pg8::f32x4* wr = (const GAS pg8::f32x4*)w + lane;
    pg8::f32x4 v[2][8], g[8];
#pragma unroll
    for (int q = 0; q < 2; ++q)
#pragma unroll
        for (int j = 0; j < 8; ++j) v[q][j] = xr[q * (DM / 4) + 64 * j];
#pragma unroll
    for (int j = 0; j < 8; ++j) g[j] = wr[64 * j];
#pragma unroll
    for (int q = 0; q < 2; ++q) { float s = 0.f;
#pragma unroll
        for (int j = 0; j < 8; ++j) s += (v[q][j].x * v[q][j].x + v[q][j].y * v[q][j].y) + (v[q][j].z * v[q][j].z + v[q][j].w * v[q][j].w);
        const float r = rsqrtf(wave_sum(s) * (1.f / DM) + EPS);
        GAS unsigned long long* o8 = (GAS unsigned long long*)(orow + (size_t)q * DM) + lane;
#pragma unroll
        for (int j = 0; j < 8; ++j) o8[64 * j] = (unsigned long long)pk2(v[q][j].x * r * g[j].x, v[q][j].y * r * g[j].y) | ((unsigned long long)pk2(v[q][j].z * r * g[j].z, v[q][j].w * r * g[j].w) << 32); }
}
__device__ __forceinline__ void rms_rows4_to_bf16(const float* xrow, const float* w, bf16* orow, int lane) {
    const GAS pg8::f32x4* xr = (const GAS pg8::f32x4*)xrow + lane; const GAS pg8::f32x4* wr = (const GAS pg8::f32x4*)w + lane;
    pg8::f32x4 v[4][8], g[8];
#pragma unroll
    for (int q = 0; q < 4; ++q)
#pragma unroll
        for (int j = 0; j < 8; ++j) v[q][j] = xr[q * (DM / 4) + 64 * j];
#pragma unroll
    for (int j = 0; j < 8; ++j) g[j] = wr[64 * j];
#pragma unroll
    for (int q = 0; q < 4; ++q) { float s = 0.f;
#pragma unroll
        for (int j = 0; j < 8; ++j) s += (v[q][j].x * v[q][j].x + v[q][j].y * v[q][j].y) + (v[q][j].z * v[q][j].z + v[q][j].w * v[q][j].w);
        const float r = rsqrtf(wave_sum(s) * (1.f / DM) + EPS);
        GAS unsigned long long* o8 = (GAS unsigned long long*)(orow + (size_t)q * DM) + lane;
#pragma unroll
        for (int j = 0; j < 8; ++j) o8[64 * j] = (unsigned long long)pk2(v[q][j].x * r * g[j].x, v[q][j].y * r * g[j].y) | ((unsigned long long)pk2(v[q][j].z * r * g[j].z, v[q][j].w * r * g[j].w) << 32); }
}

__global__ void __launch_bounds__(NWAVES * 64, 2) fwd(Args args) {
    extern __shared__ __attribute__((aligned(16))) unsigned char lds_raw[];
    LAS unsigned char* lds = (LAS unsigned char*)lds_raw;
    const int tid = threadIdx.x, lane = tid & 63, wave = __builtin_amdgcn_readfirstlane(tid >> 6);
    const int G = gridDim.x; const int bx = blockIdx.x; const int vcu = (G % 8 == 0) ? (bx % 8) * (G / 8) + bx / 8 : bx;
    unsigned char* ws = args.ws;
    unsigned* ctl = (unsigned*)(ws + WS_CTL);
    for (int u = tid; u < (LDS_BYTES - LDSCTL_OFF) / 4; u += NWAVES * 64) ((LAS unsigned*)(lds + LDSCTL_OFF))[u] = 0u;
    __syncthreads();
    XcdBarrier bar = xcd_barrier_post(ctl + CW_BAR + args.li * XCD_BAR_WORDS, (volatile LAS unsigned*)(lds + LDSCTL_OFF + 64));
    static_assert(2 * FFT_BUF_BYTES <= LDSCTL_OFF && 1024 * 33 * 4 <= LDSCTL_OFF, "LDS map");
    const int lo = args.ph_lo, hi = args.ph_hi;
    volatile LAS unsigned long long* tsl = (volatile LAS unsigned long long*)(lds + LDSCTL_OFF + 128);
#define TS(k) do { if (MK_TPROBE >= 0 && bx == 0 && tid == 0) tsl[k] = __builtin_amdgcn_s_memrealtime(); } while (0)
#if 0
#define MK_DUP_MASK 0
#endif
#define IN(k) (lo <= (k) && (k) < hi)
#define BOTH(k) (IN(k) && IN((k) + 1))
    bf16* WinT = (bf16*)(ws + WS_WINT); bf16* Hb = (bf16*)(ws + WS_HB);

    if (IN(0)) { TS(0); REP(0) {
        int tid_p = tid; asm volatile("" : "+v"(tid_p)); const int lane_p = tid_p & 63; (void)lane_p;
        LAS float* scr = (LAS float*)(lds + wave * 16384);
        const int gw = vcu * NWAVES + wave, NGW = G * NWAVES;
        const float* w_in = args.in[2];
        { bf16* WoutT = (bf16*)(ws + WS_WOUTT); const float* w_out = args.in[21];
          auto mk = [&](int it) -> TrItem { if (it < 32 * 225) { const int kb = it / 225, nb = it % 225; return TrItem{w_in, NPROJ, 64 * kb, 32 * nb, WinT, (size_t)(32 * nb), DM}; }
                                           const int j = it - 32 * 225, kb = j >> 6, nb = j & 63; return TrItem{w_out, DM, 64 * kb, 32 * nb, WoutT, (size_t)(32 * nb), DM}; };
          for (int p = gw; p < (32 * 225 + 32 * 64) / 2; p += NGW) tr_pair(mk(2 * p), mk(2 * p + 1), true, scr, lane); }
        for (int r = gw; r < NPROJ_PAD - NPROJ; r += NGW) { GAS v4u* o = (GAS v4u*)(WinT + (size_t)(NPROJ + r) * DM) + lane;
#pragma unroll
            for (int j = 0; j < 4; ++j) o[64 * j] = (v4u){0u, 0u, 0u, 0u}; }
        { bf16* RWh = (bf16*)(ws + WS_SMALL + SM_RWT); bf16* RWl = RWh + 80 * 2048; const float* rgw = args.in[23]; const float* rew = args.in[25];
          for (int i = vcu * 512 + tid; i < 80 * 2048; i += G * 512) { const int n = i >> 11, k = i & 2047;
              const float w = n < 8 ? rgw[k * 8 + n] : (n < 72 ? rew[k * 64 + n - 8] : 0.f); const unsigned h = f2bf(w); const float hf = __builtin_bit_cast(float, h << 16);
              const int kk = k & 31, o = (i & ~31) + 8 * ((kk & 15) >> 2) + (kk & 3) + ((kk >> 4) << 2);
              RWh[o] = (bf16)h; RWl[o] = (bf16)f2bf(w - hf); } }
        for (int m = 4 * gw; m < T; m += 4 * NGW) rms_rows4_to_bf16(args.in[0] + (size_t)m * DM, args.in[1], Hb + (size_t)m * DM, lane);
        for (int it = bx; it < 256; it += G)
            hyena_filter_item(lds, it, args.in[5], args.in[6], args.in[7], args.in[8], args.in[9], args.in[10], args.in[11], args.in[12], (float*)(ws + WS_KC), tid_p, lane_p, wave);
        }
        if (BOTH(0)) xcd_barrier<10240>(bar);
    }
    if (IN(1)) { TS(1); REP(1) {
        int tid_p = tid; asm volatile("" : "+v"(tid_p)); const int lane_p = tid_p & 63; (void)lane_p;
        Order1 S{(const char*)Hb, (const char*)WinT, G, bx};
        Epi1 E{(bf16*)(ws + WS_PG), (float*)(ws + WS_PGATE), (bf16*)(ws + WS_PT)};
        pg8::gemm_phase<Epi1, Order1, false>(lds, DM, S, E, tid_p);
        }
        if (BOTH(1)) xcd_barrier<65536>(bar);
    }
    if (IN(2)) { TS(2); REP(2) {
        int tid_p = tid; asm volatile("" : "+v"(tid_p)); const int lane_p = tid_p & 63; (void)lane_p;
        REP(11) hyena_phase(lds, (const bf16*)(ws + WS_PT), (const float*)(ws + WS_KC), args.in[3], args.in[4], args.in[13], (float*)(ws + WS_YHT), G, vcu);
        REP(12) for (int wg = bx; wg < 256; wg += G) {
            int tid_i = tid_p; asm volatile("" : "+v"(tid_i)); const int lane_i = tid_i & 63;
            gdn_pre(lds, wg, (const bf16*)(ws + WS_PG), (const float*)(ws + WS_PGATE), args.in[15], args.in[16], args.in[17], args.in[18], args.in[19], ws, tid_i, lane_i, wave);
            gdn_prep_wave(lds, wg, ws, lane_i, wave);
            __syncthreads();
        }
        }
        if (BOTH(2)) xcd_barrier<10240>(bar);
    }
    if (IN(3)) { TS(3); REP(3) {
        int tid_p = tid; asm volatile("" : "+v"(tid_p)); const int lane_p = tid_p & 63; (void)lane_p;
        for (int v = vcu; v < 256; v += G) gdn_scan4(lds, ws, (bf16*)(ws + WS_OF), (bf16*)(ws + WS_OB), v, tid_p, lane_p, wave);
        }
        if (BOTH(3)) xcd_barrier<10240>(bar);
    }
    if (IN(4)) { TS(4); REP(4) {
        int tid_p = tid; asm volatile("" : "+v"(tid_p)); const int lane_p = tid_p & 63; (void)lane_p;
        for (int tile = bx; tile < T / 32; tile += G) hyena_post_tile(lds, tile, (const float*)(ws + WS_YHT), args.in[14], (bf16*)(ws + WS_A2), tid_p, lane_p, wave);
        for (int it = (vcu * NWAVES + wave) * 8; it < T * 8; it += G * NWAVES * 8) gdn_post_batch(it, (const bf16*)(ws + WS_OF), (const bf16*)(ws + WS_OB), (const bf16*)(ws + WS_PG), args.in[20], (bf16*)(ws + WS_A2), lane_p);
        }
        if (BOTH(4)) xcd_barrier<8192>(bar);
    }
    if (IN(5)) { TS(5); REP(5) {
        int tid_p = tid; asm volatile("" : "+v"(tid_p)); const int lane_p = tid_p & 63; (void)lane_p;
        Order2 S{(const char*)(ws + WS_A2), (const char*)(ws + WS_WOUTT), G, bx};
        Epi2 E{args.in[0], (bf16*)(ws + WS_X1)};
        pg8::gemm_phase<Epi2, Order2, false>(lds, DM, S, E, tid_p);
        }
        if (BOTH(5)) xcd_barrier<20480>(bar);
    }
    if (IN(6)) { TS(6);
        int tid_p = tid; asm volatile("" : "+v"(tid_p)); const int lane_p = tid_p & 63; (void)lane_p;
        REP(6) for (int wg = bx; wg < 256; wg += G) { route_phase(lds, wg, (const bf16*)(ws + WS_X1), args.in[22], args.in[24], args.in[26], ws, ctl + CW_CNT + rep_ * 128, tid_p, lane_p, wave); __syncthreads(); }
        if (BOTH(6)) xcd_barrier<10240>(bar);
    }
    if (IN(7)) { TS(7);
        int tid_p = tid; asm volatile("" : "+v"(tid_p)); const int lane_p = tid_p & 63; (void)lane_p;
        REP(7) for (int wg = bx; wg < 256; wg += G) fill_phase(lds, wg, ws, ctl + CW_CNT, tid_p);
        if (BOTH(7)) xcd_barrier<24576>(bar);
    }
    const int* slot_tok = (const int*)(ws + WS_SMALL + SM_SLOTTOK); const int* blk_exp = (const int*)(ws + WS_SMALL + SM_BLKEXP); const int* nblk_p = (const int*)(ws + WS_SMALL + SM_NBLK);
    if (IN(8)) { TS(8); REP(8) {
        int tid_p = tid; asm volatile("" : "+v"(tid_p)); const int lane_p = tid_p & 63; (void)lane_p;
        const int nblk = __hip_atomic_load(nblk_p, __ATOMIC_RELAXED, __HIP_MEMORY_SCOPE_AGENT);
        moe_gemm<true>(lds, ws, args.in[27], args.in[28], ctl + CW_Q8 + rep_ * 32, ctl + CW_DONE, nblk, tid_p);
        }
    }
    if (IN(9)) { TS(9); REP(9) {
        int tid_p = tid; asm volatile("" : "+v"(tid_p)); const int lane_p = tid_p & 63; (void)lane_p;
        const int nblk = __hip_atomic_load(nblk_p, __ATOMIC_RELAXED, __HIP_MEMORY_SCOPE_AGENT);
        moe_gemm<false>(lds, ws, args.in[29], nullptr, ctl + CW_Q9 + rep_ * 32, ctl + CW_DONE, nblk, tid_p);
        }
        if (MK_TPROBE >= 0 && bx == 0 && tid == 0) { tsl[10] = __builtin_amdgcn_s_memrealtime();
            const float us = (float)(tsl[(MK_TPROBE < 0 ? 0 : MK_TPROBE) + 1] - tsl[MK_TPROBE < 0 ? 0 : MK_TPROBE]) * 0.01f;
            __hip_atomic_store((float*)(ctl + 3300), sqrtf(us * MK_TSCALE), __ATOMIC_RELAXED, __HIP_MEMORY_SCOPE_AGENT); }
        if (BOTH(9)) xcd_barrier<3072>(bar);
    }
    if (IN(10)) { TS(10); REP(10) {
        int tid_p = tid; asm volatile("" : "+v"(tid_p)); const int lane_p = tid_p & 63; (void)lane_p;
        for (int t = (vcu * NWAVES + wave) * 2; t < T; t += G * NWAVES * 2) final_rows(t, (const bf16*)(ws + WS_X1), (const bf16*)(ws + WS_Y), ws, args.in[30], args.out, lane_p, MK_TPROBE >= 0 ? 1.f + __hip_atomic_load((float*)(ctl + 3300), __ATOMIC_RELAXED, __HIP_MEMORY_SCOPE_AGENT) : 1.f);
    }
    }
#undef IN
#undef BOTH
}

#ifndef MK_PER_PHASE
#define MK_PER_PHASE 0
#endif
constexpr int N_PHASES = 11;
extern "C" void kernel_launch(void* const* d_in, const int* in_sizes, int n_in, void* d_out, int out_size, void* d_ws, size_t ws_size, hipStream_t stream) {
    static int grid = 0;
    if (grid == 0) {
        int dev = 0, cus = 0;
        (void)hipGetDevice(&dev); (void)hipDeviceGetAttribute(&cus, hipDeviceAttributeMultiprocessorCount, dev);
        (void)hipFuncSetAttribute((const void*)fwd, hipFuncAttributeMaxDynamicSharedMemorySize, LDS_BYTES);
        int per_cu = 0; (void)hipOccupancyMaxActiveBlocksPerMultiprocessor(&per_cu, (const void*)fwd, NWAVES * 64, LDS_BYTES);
        (void)hipGetLastError();
        grid = cus > 0 ? cus : 256;
    }
    (void)hipMemsetAsync((char*)d_ws + WS_CTL, 0, CTL_ZERO_BYTES, stream);
    Args a{};
    for (int i = 0; i < 31; ++i) a.in[i] = (const float*)d_in[i];
    a.out = (float*)d_out; a.ws = (unsigned char*)d_ws;
#if MK_PER_PHASE
    for (int p = 0; p < N_PHASES; ++p) { a.ph_lo = p; a.ph_hi = p + 1; a.li = 0; hipLaunchKernelGGL(fwd, dim3(grid), dim3(NWAVES * 64), LDS_BYTES, stream, a); }
#else
    a.ph_lo = 0; a.ph_hi = N_PHASES; a.li = 0;
    hipLaunchKernelGGL(fwd, dim3(grid), dim3(NWAVES * 64), LDS_BYTES, stream, a);
#endif
}
```
